# Optimizing an MI355X kernel written in HIP

```python
import jax
import jax.numpy as jnp
from jax import lax
import numpy as np


D_MODEL = 1024
BATCH = 4
SEQ = 4096
DEPTH = 1

D_MIX = D_MODEL
RWKV_WIDTH = D_MIX // 2
RWKV_HEAD_DIM = 64
RWKV_HEADS = RWKV_WIDTH // RWKV_HEAD_DIM
DECAY_LORA = 64
ICLR_LORA = 64
GATE_LORA = 128
GLA_V_WIDTH = D_MIX - RWKV_WIDTH
GLA_HEADS = 4
GLA_DV = GLA_V_WIDTH // GLA_HEADS
GLA_DK = GLA_DV // 2
GLA_K_WIDTH = GLA_HEADS * GLA_DK
GLA_GATE_LORA = 16
GLA_TAU = 16.0
GLA_CHUNK = 16
N_GROUPS = 4
EXPERTS_PER_GROUP = 8
N_EXPERTS = N_GROUPS * EXPERTS_PER_GROUP
TOP_K = 2
D_EXPERT = 512
MOE_BLOCK = 128
RMS_EPS = 1e-6
RWKV_GN_EPS = 64e-5

RWKV_SPLITS = (RWKV_WIDTH, RWKV_WIDTH, RWKV_WIDTH, DECAY_LORA, DECAY_LORA, ICLR_LORA, ICLR_LORA, GATE_LORA)
GLA_SPLITS = (GLA_K_WIDTH, GLA_K_WIDTH, GLA_V_WIDTH, GLA_GATE_LORA, GLA_GATE_LORA, GLA_V_WIDTH)
RWKV_COLS = sum(RWKV_SPLITS)
D_IN_PROJ = RWKV_COLS + sum(GLA_SPLITS)

kernel_name = 'bidir_hybrid_rwkv7_gla_hmoe'


def _split(p, sizes):
    return jnp.split(p, np.cumsum(sizes)[:-1].tolist(), axis=-1)


def rmsnorm(x, w):
    xf = x.astype(jnp.float32)
    y = xf * lax.rsqrt(jnp.mean(xf * xf, axis=-1, keepdims=True) + RMS_EPS)
    return (y * w.astype(jnp.float32)).astype(x.dtype)


def centred_shift(p):
    prev = jnp.pad(p[:, :-1], ((0, 0), (1, 0), (0, 0)))
    nxt = jnp.pad(p[:, 1:], ((0, 0), (0, 1), (0, 0)))
    return 0.5 * (prev + nxt)


def rwkv7_bidir_scan(r, w, k, v, kk, b):
    def to_dir(z):
        z = jnp.stack([z[0], jnp.flip(z[1], axis=1)])
        return jnp.moveaxis(z, 2, 0)

    def both(z):
        return to_dir(jnp.stack([z, z]))

    xs = (both(r), to_dir(w), to_dir(k), both(v), both(kk), to_dir(b))
    bsz, _, h, n = r.shape
    s0 = jnp.zeros((2, bsz, h, n, n), jnp.float32)

    def step(s, inp):
        r_t, w_t, k_t, v_t, kk_t, b_t = inp
        sa = jnp.einsum('dbhvk,dbhk->dbhv', s, -kk_t)
        s = s * w_t[..., None, :] + sa[..., None] * b_t[..., None, :] + v_t[..., None] * k_t[..., None, :]
        return s, jnp.einsum('dbhvk,dbhk->dbhv', s, r_t)

    _, ys = lax.scan(step, s0, xs)
    ys = jnp.moveaxis(ys, 0, 2)
    return ys[0] + jnp.flip(ys[1], axis=1)


def rwkv7_mixer(p, mu, w0_f, w2_f, w0_b, w2_b, a0_f, a2_f, a0_b, a2_b, g2, k_k, k_a, r_k, ln_w, ln_b):
    p = p.astype(jnp.float32)
    p = p + mu * (centred_shift(p) - p)
    r, k, v, wl_f, wl_b, al_f, al_b, gl = _split(p, RWKV_SPLITS)

    def decay(w0, wl, w2):
        logw = -jax.nn.softplus(-(w0 + jnp.tanh(wl) @ w2)) - 0.5
        return jnp.exp(-jnp.exp(logw))

    def heads(z):
        return z.reshape(z.shape[:-1] + (RWKV_HEADS, RWKV_HEAD_DIM))

    w = jnp.stack([decay(w0_f, wl_f, w2_f), decay(w0_b, wl_b, w2_b)])
    a = jax.nn.sigmoid(jnp.stack([a0_f + al_f @ a2_f, a0_b + al_b @ a2_b]))
    g = jax.nn.sigmoid(gl) @ g2
    kk = heads(k * k_k)
    kk = kk / jnp.maximum(jnp.sqrt(jnp.sum(kk * kk, axis=-1, keepdims=True)), 1e-12)
    k_dir = k * (1.0 + (a - 1.0) * k_a)
    b = kk * heads(a)
    rh, vh = heads(r), heads(v)
    y = rwkv7_bidir_scan(rh, heads(w), heads(k_dir), vh, kk, b)
    mean = jnp.mean(y, axis=-1, keepdims=True)
    var = jnp.var(y, axis=-1, keepdims=True)
    y = (y - mean) * lax.rsqrt(var + RWKV_GN_EPS)
    y = y.reshape(y.shape[:-2] + (RWKV_WIDTH,)) * ln_w + ln_b
    bonus = jnp.sum(rh * heads(k_dir[0] + k_dir[1]) * r_k, axis=-1, keepdims=True) * vh
    return (y + bonus.reshape(y.shape)) * g


def gla_chunked(q, k, v, g):
    bsz, h, t, dk = q.shape
    dv = v.shape[-1]
    c = GLA_CHUNK
    n = t // c
    q, k, g = (z.reshape(bsz, h, n, c, dk) for z in (q, k, g))
    v = v.reshape(bsz, h, n, c, dv)
    bc = jnp.cumsum(g, axis=3)
    causal = jnp.tril(jnp.ones((c, c), dtype=bool))
    diff = bc[..., :, None, :] - bc[..., None, :, :]
    dec = jnp.exp(jnp.where(causal[:, :, None], diff, -jnp.inf))
    att = jnp.einsum('bhnid,bhnjd,bhnijd->bhnij', q, k, dec)
    o = jnp.einsum('bhnij,bhnjv->bhniv', att, v)
    b_last = bc[..., -1, :]
    u = jnp.einsum('bhncd,bhncv->nbhdv', k * jnp.exp(b_last[..., None, :] - bc), v)

    def step(s, inp):
        u_n, d_n = inp
        return s * d_n[..., None] + u_n, s

    s0 = jnp.zeros((bsz, h, dk, dv), jnp.float32)
    _, s_in = lax.scan(step, s0, (u, jnp.moveaxis(jnp.exp(b_last), 2, 0)))
    o = o + jnp.einsum('bhncd,nbhdv->bhncv', q * jnp.exp(bc), s_in)
    return o.reshape(bsz, h, t, dv)


def gla_mixer(p, gw2_f, gb_f, gw2_b, gb_b, norm_w):
    p = p.astype(jnp.float32)
    bsz, t, _ = p.shape
    q, k, v, gl_f, gl_b, og = _split(p, GLA_SPLITS)

    def heads(z, d):
        return jnp.moveaxis(z.reshape(z.shape[:-1] + (GLA_HEADS, d)), 2, 1)

    q = heads(q, GLA_DK) * (GLA_DK ** -0.5)
    k = heads(k, GLA_DK)
    v = heads(v, GLA_DV)
    g_f = heads(jax.nn.log_sigmoid(gl_f @ gw2_f + gb_f) / GLA_TAU, GLA_DK)
    g_b = heads(jax.nn.log_sigmoid(gl_b @ gw2_b + gb_b) / GLA_TAU, GLA_DK)

    def flip(z):
        return jnp.flip(z, axis=2)

    o = gla_chunked(q, k, v, g_f) + flip(gla_chunked(flip(q), flip(k), flip(v), flip(g_b)))
    o = o * lax.rsqrt(jnp.mean(o * o, axis=-1, keepdims=True) + RMS_EPS)
    o = jnp.moveaxis(o, 1, 2).reshape(bsz, t, GLA_V_WIDTH)
    return o * norm_w * jax.nn.silu(og)


def hier_moe(h, w_coarse, b_coarse, w_fine, b_fine, w_gate, w_up, w_down):
    bsz, t, d = h.shape
    n_tok = bsz * t
    hf = h.reshape(n_tok, d)
    tok_idx = jnp.arange(n_tok)
    coarse = (hf @ w_coarse + b_coarse).astype(jnp.float32)
    pc = jax.nn.softmax(coarse, axis=-1)
    gsel = jnp.argmax(coarse, axis=-1)
    pg = pc[tok_idx, gsel]
    fine = (hf @ w_fine + b_fine).astype(jnp.float32).reshape(n_tok, N_GROUPS, EXPERTS_PER_GROUP)
    pf = jax.nn.softmax(fine[tok_idx, gsel], axis=-1)
    top_p, top_e = lax.top_k(pf, TOP_K)
    comb = pg[:, None] * top_p / jnp.sum(top_p, axis=-1, keepdims=True)
    eid = (gsel[:, None] * EXPERTS_PER_GROUP + top_e).reshape(-1).astype(jnp.int32)
    n_asg = n_tok * TOP_K
    tok = jnp.repeat(tok_idx, TOP_K).astype(jnp.int32)
    wts = comb.reshape(-1)
    order = jnp.argsort(eid, stable=True)
    se, st, sw = eid[order], tok[order], wts[order]
    counts = jnp.bincount(eid, length=N_EXPERTS).astype(jnp.int32)
    starts = jnp.cumsum(counts) - counts
    padded = ((counts + MOE_BLOCK - 1) // MOE_BLOCK) * MOE_BLOCK
    pends = jnp.cumsum(padded)
    pstarts = pends - padded
    dest = pstarts[se] + jnp.arange(n_asg, dtype=jnp.int32) - starts[se]
    n_blocks = -(-n_asg // MOE_BLOCK) + N_EXPERTS
    n_rows = n_blocks * MOE_BLOCK
    row_tok = jnp.zeros((n_rows,), jnp.int32).at[dest].set(st)
    row_w = jnp.zeros((n_rows,), jnp.float32).at[dest].set(sw)
    block_e = jnp.minimum(jnp.searchsorted(pends, jnp.arange(n_blocks, dtype=jnp.int32) * MOE_BLOCK, side='right'), N_EXPERTS - 1)
    xs = hf[row_tok].reshape(n_blocks, MOE_BLOCK, d)

    def expert_block(args):
        xb, e = args
        return (jax.nn.silu(xb @ w_gate[e]) * (xb @ w_up[e])) @ w_down[e]

    ys = lax.map(expert_block, (xs, block_e)).reshape(n_rows, d)
    out = jax.ops.segment_sum(ys * row_w[:, None].astype(ys.dtype), row_tok, num_segments=n_tok)
    return out.reshape(bsz, t, d)


def setup_inputs(seed: int = 0) -> dict:
    key = jax.random.key(seed)
    ks = iter(jax.random.split(key, 40))

    def nrm(shape, scale):
        return jax.random.normal(next(ks), shape, jnp.float32) * scale

    def unif(shape, lo, hi):
        return jax.random.uniform(next(ks), shape, jnp.float32, lo, hi)

    L, D = DEPTH, D_MODEL
    return {
        'x': nrm((BATCH, SEQ, D), 1.0),
        'ln1_w': 1.0 + nrm((L, D), 0.05),
        'w_in': nrm((L, D, D_IN_PROJ), D ** -0.5),
        'rw_mu': unif((L, RWKV_COLS), 0.0, 1.0),
        'rw_w0_f': unif((L, RWKV_WIDTH), -6.0, -1.0),
        'rw_w2_f': nrm((L, DECAY_LORA, RWKV_WIDTH), 0.1),
        'rw_w0_b': unif((L, RWKV_WIDTH), -6.0, -1.0),
        'rw_w2_b': nrm((L, DECAY_LORA, RWKV_WIDTH), 0.1),
        'rw_a0_f': nrm((L, RWKV_WIDTH), 0.1),
        'rw_a2_f': nrm((L, ICLR_LORA, RWKV_WIDTH), 0.5 * ICLR_LORA ** -0.5),
        'rw_a0_b': nrm((L, RWKV_WIDTH), 0.1),
        'rw_a2_b': nrm((L, ICLR_LORA, RWKV_WIDTH), 0.5 * ICLR_LORA ** -0.5),
        'rw_g2': nrm((L, GATE_LORA, RWKV_WIDTH), GATE_LORA ** -0.5),
        'rw_k_k': 0.85 + nrm((L, RWKV_WIDTH), 0.05),
        'rw_k_a': 1.0 + nrm((L, RWKV_WIDTH), 0.05),
        'rw_r_k': nrm((L, RWKV_HEADS, RWKV_HEAD_DIM), 0.1),
        'rw_ln_w': 1.0 + nrm((L, RWKV_WIDTH), 0.05),
        'rw_ln_b': nrm((L, RWKV_WIDTH), 0.01),
        'gla_gw2_f': nrm((L, GLA_GATE_LORA, GLA_K_WIDTH), GLA_GATE_LORA ** -0.5),
        'gla_gb_f': 2.0 + nrm((L, GLA_K_WIDTH), 0.5),
        'gla_gw2_b': nrm((L, GLA_GATE_LORA, GLA_K_WIDTH), GLA_GATE_LORA ** -0.5),
        'gla_gb_b': 2.0 + nrm((L, GLA_K_WIDTH), 0.5),
        'gla_norm_w': 1.0 + nrm((L, GLA_V_WIDTH), 0.05),
        'w_out': nrm((L, D_MIX, D), D_MIX ** -0.5),
        'ln2_w': 1.0 + nrm((L, D), 0.05),
        'moe_w_coarse': nrm((L, D, N_GROUPS), D ** -0.5),
        'moe_b_coarse': nrm((L, N_GROUPS), 0.01),
        'moe_w_fine': nrm((L, D, N_EXPERTS), D ** -0.5),
        'moe_b_fine': nrm((L, N_EXPERTS), 0.01),
        'moe_w_gate': nrm((L, N_EXPERTS, D, D_EXPERT), D ** -0.5),
        'moe_w_up': nrm((L, N_EXPERTS, D, D_EXPERT), D ** -0.5),
        'moe_w_down': nrm((L, N_EXPERTS, D_EXPERT, D), D_EXPERT ** -0.5),
        'ln_f_w': 1.0 + nrm((D,), 0.05),
    }


def reference(x, ln1_w, w_in, rw_mu, rw_w0_f, rw_w2_f, rw_w0_b, rw_w2_b, rw_a0_f, rw_a2_f, rw_a0_b, rw_a2_b, rw_g2, rw_k_k, rw_k_a, rw_r_k, rw_ln_w, rw_ln_b, gla_gw2_f, gla_gb_f, gla_gw2_b, gla_gb_b, gla_norm_w, w_out, ln2_w, moe_w_coarse, moe_b_coarse, moe_w_fine, moe_b_fine, moe_w_gate, moe_w_up, moe_w_down, ln_f_w):
    for l in range(DEPTH):
        h = rmsnorm(x, ln1_w[l])
        p = h @ w_in[l]
        y_rw = rwkv7_mixer(p[..., :RWKV_COLS], rw_mu[l], rw_w0_f[l], rw_w2_f[l], rw_w0_b[l], rw_w2_b[l],
                           rw_a0_f[l], rw_a2_f[l], rw_a0_b[l], rw_a2_b[l], rw_g2[l], rw_k_k[l], rw_k_a[l],
                           rw_r_k[l], rw_ln_w[l], rw_ln_b[l])
        y_gla = gla_mixer(p[..., RWKV_COLS:], gla_gw2_f[l], gla_gb_f[l], gla_gw2_b[l], gla_gb_b[l], gla_norm_w[l])
        mix = jnp.concatenate([y_rw, y_gla], axis=-1).astype(x.dtype)
        x = x + mix @ w_out[l]
        x = x + hier_moe(rmsnorm(x, ln2_w[l]), moe_w_coarse[l], moe_b_coarse[l], moe_w_fine[l], moe_b_fine[l],
                         moe_w_gate[l], moe_w_up[l], moe_w_down[l])
    return rmsnorm(x, ln_f_w)
```

```cpp
#include <hip/hip_runtime.h>
#include <cstdio>
#include <cstdint>

#ifndef MK_PER_PHASE
#define MK_PER_PHASE 0
#endif

#define LAS __attribute__((address_space(3)))
#define GAS __attribute__((address_space(1)))
typedef unsigned short bf16_t;
typedef short bf16x8 __attribute__((ext_vector_type(8)));
typedef float f32x4 __attribute__((ext_vector_type(4)));
typedef float f32x16 __attribute__((ext_vector_type(16)));
typedef unsigned u32x4 __attribute__((ext_vector_type(4)));
typedef unsigned u32x2 __attribute__((ext_vector_type(2)));
typedef LAS unsigned char* ldsp_t;

constexpr int NTOK = 16384, SEQ = 4096, DM = 1024;
constexpr int LDA_RW = 2048;
constexpr int LDB_GL = 1792;
constexpr int RW_COLS = 1920, GL_COLS = 1568;
constexpr int NEXP = 32, DEXP = 512;
constexpr int NPH = 14;

constexpr size_t MiB = 1u << 20;
constexpr size_t WS_CTL = 0, CTL_ZERO_BYTES = 64 * 1024;
constexpr size_t WS_LORA = 1 * MiB;
constexpr size_t WS_BT_RW = 2 * MiB, WS_BT_GL = 6 * MiB, WS_BT_OUT = 10 * MiB;
constexpr size_t WS_BON = 12 * MiB;
constexpr size_t WS_ELIST = 13 * MiB;
constexpr size_t WS_DEC = 15 * MiB;
constexpr size_t WS_H = 16 * MiB;
constexpr size_t WS_OF = 16 * MiB, WS_OB = 32 * MiB;
constexpr size_t WS_H2 = 16 * MiB;
constexpr size_t WS_RM = 48 * MiB, WS_RP = 80 * MiB, WS_RNT = 112 * MiB;
constexpr size_t WS_GQ = 48 * MiB, WS_GNT = 64 * MiB;
constexpr size_t WS_MIX = 48 * MiB;
constexpr size_t WS_YF = 144 * MiB, WS_YB = 160 * MiB, WS_G = 176 * MiB, WS_VS = 192 * MiB;
constexpr size_t WS_PB = 208 * MiB;
constexpr size_t WS_WGU = 80 * MiB, WS_WDN = 144 * MiB;
constexpr size_t WS_ACT = 176 * MiB;
constexpr size_t WS_YK0 = 48 * MiB, WS_YK1 = 216 * MiB;
constexpr size_t WS_ELW = 248 * MiB;
constexpr size_t WS_END = 264 * MiB;
constexpr int CW_CNT = 0;
constexpr int CW_BAR = 4096;

constexpr int LDS_BYTES = 160 * 1024;
constexpr int LDS_MISC = LDS_BYTES - 64;
constexpr int LDS_TAB = 131072;

__device__ __forceinline__ float bf2f(unsigned b) { return __uint_as_float(b << 16); }
__device__ __forceinline__ unsigned f2bf(float f) { unsigned u = __float_as_uint(f); return (u + 0x7fffu + ((u >> 16) & 1u)) >> 16; }
__device__ __forceinline__ unsigned pk2(float lo, float hi) { return f2bf(lo) | (f2bf(hi) << 16); }
__device__ __forceinline__ float wave_sum(float v) {
#pragma unroll
    for (int o = 1; o < 64; o <<= 1) v += __shfl_xor(v, o);
    return v;
}
__device__ __forceinline__ float sigmoidf_(float x) { return 1.f / (1.f + __expf(-x)); }
__device__ __forceinline__ float tanhf_(float x) { return 2.f / (1.f + __expf(-2.f * x)) - 1.f; }
__device__ __forceinline__ void unpack8(const u32x4& v, float (&o)[8]) {
    o[0] = bf2f(v.x & 0xffffu); o[1] = bf2f(v.x >> 16); o[2] = bf2f(v.y & 0xffffu); o[3] = bf2f(v.y >> 16);
    o[4] = bf2f(v.z & 0xffffu); o[5] = bf2f(v.z >> 16); o[6] = bf2f(v.w & 0xffffu); o[7] = bf2f(v.w >> 16);
}
__device__ __forceinline__ u32x4 pack8(const float (&o)[8]) {
    u32x4 v; v.x = pk2(o[0], o[1]); v.y = pk2(o[2], o[3]); v.z = pk2(o[4], o[5]); v.w = pk2(o[6], o[7]); return v;
}

#define XB_TMO      128
#define XB_XCNT(j)  (256  + 64 * (j))
#define XB_XSUB(j)  (1280 + 64 * (j))
#define XB_XGEN(j)  (2304 + 64 * (j))
#define XB_TOP      3328
#define XB_TOPGEN   3392
#define XCD_BAR_WORDS 3456
#define XB_SPIN_CAP (1u << 18)
__device__ __forceinline__ unsigned xb_ld(unsigned* p)              { return __hip_atomic_load(p, __ATOMIC_RELAXED, __HIP_MEMORY_SCOPE_AGENT); }
__device__ __forceinline__ unsigned xb_add(unsigned* p, unsigned v) { return __hip_atomic_fetch_add(p, v, __ATOMIC_RELAXED, __HIP_MEMORY_SCOPE_AGENT); }
__device__ __forceinline__ unsigned xb_xcc_id() { return (unsigned)__builtin_amdgcn_s_getreg((3 << 11) | 20) & 0xFu; }
#define XB_SPIN(cond, bar) do { unsigned _sp = 0; while (cond) { __builtin_amdgcn_s_sleep(1); \
    if ((++_sp & 255u) == 0u) { if (xb_ld(&(bar)[XB_TMO])) break; if (_sp > XB_SPIN_CAP) { atomicAdd(&(bar)[XB_TMO], 1u); break; } } } } while (0)
struct XcdBarrier { unsigned* bar; unsigned x; volatile LAS unsigned* st; };
__device__ __forceinline__ XcdBarrier xcd_barrier_post(unsigned* bar, volatile LAS unsigned* st) {
    XcdBarrier b; b.bar = bar; b.x = xb_xcc_id(); b.st = st;
    if (threadIdx.x == 0) (void)xb_add(&bar[XB_XCNT(b.x)], 1u);
    return b;
}
__device__ __forceinline__ void xcd_barrier_complete(unsigned* bar, unsigned x, unsigned& nloc, unsigned& nx) {
    const unsigned G = gridDim.x * gridDim.y * gridDim.z;
    unsigned sum, cnt, mine, sp = 0u;
    for (;;) {
        sum = 0u; cnt = 0u; mine = 0u;
#pragma unroll
        for (unsigned j = 0; j < 16; ++j) { const unsigned c = xb_ld(&bar[XB_XCNT(j)]); sum += c; cnt += (c > 0u) ? 1u : 0u; mine = (j == x) ? c : mine; }
        if (sum == G) break;
        __builtin_amdgcn_s_sleep(1);
        if ((++sp & 255u) == 0u) { if (xb_ld(&bar[XB_TMO])) break; if (sp > XB_SPIN_CAP) { atomicAdd(&bar[XB_TMO], 1u); break; } }
    }
    nloc = mine > 0u ? mine : 1u; nx = cnt > 0u ? cnt : 1u;
}
__device__ __forceinline__ void xcd_barrier(const XcdBarrier& b) {
    asm volatile("s_waitcnt vmcnt(0)" ::: "memory");
    __syncthreads();
    if (threadIdx.x == 0) {
        unsigned* bar = b.bar;
        __builtin_amdgcn_s_waitcnt(0);
        unsigned nloc = b.st[0], nx = b.st[1];
        if (nloc == 0u) { xcd_barrier_complete(bar, b.x, nloc, nx); b.st[0] = nloc; b.st[1] = nx; }
        const unsigned old = xb_add(&bar[XB_XSUB(b.x)], 1u);
        const unsigned gen = old / nloc;
        if (old + 1u == (gen + 1u) * nloc) {
            __builtin_amdgcn_fence(__ATOMIC_RELEASE, "agent");
            asm volatile("s_waitcnt vmcnt(0)" ::: "memory");
            const unsigned og = xb_add(&bar[XB_TOP], 1u);
            const unsigned tg = og / nx;
            if (og + 1u == (tg + 1u) * nx) xb_add(&bar[XB_TOPGEN], 1u);
            else XB_SPIN(xb_ld(&bar[XB_TOPGEN]) == tg, bar);
            __builtin_amdgcn_fence(__ATOMIC_ACQUIRE, "agent");
            xb_add(&bar[XB_XGEN(b.x)], 1u);
            asm volatile("s_waitcnt vmcnt(0)" ::: "memory");
        } else {
            XB_SPIN(xb_ld(&bar[XB_XGEN(b.x)]) == gen, bar);
            __builtin_amdgcn_fence(__ATOMIC_ACQUIRE, "agent");
            asm volatile("s_waitcnt vmcnt(0)" ::: "memory");
        }
    }
    __syncthreads();
}

struct Params {
    const float* x; const float* ln1_w; const float* w_in; const float* rw_mu;
    const float* w0_f; const float* w2_f; const float* w0_b; const float* w2_b;
    const float* a0_f; const float* a2_f; const float* a0_b; const float* a2_b;
    const float* g2; const float* k_k; const float* k_a; const float* r_k; const float* ln_w; const float* ln_b;
    const float* gw2_f; const float* gb_f; const float* gw2_b; const float* gb_b; const float* gnorm_w;
    const float* w_out; const float* ln2_w; const float* w_coarse; const float* b_coarse; const float* w_fine; const float* b_fine;
    const float* w_gate; const float* w_up; const float* w_down; const float* ln_f_w;
    float* out; unsigned char* ws;
    int ph_lo, ph_hi;
};

namespace pg8 {
constexpr int BM = 256, BK = 64, HALF = 128, HTB = HALF * BK * 2, STAGE_BYTES = 8 * HTB, NXCD = 8, WGM = 8;
__host__ __device__ __forceinline__ int lds_byte(int r, int c) { const int st = (r >> 4) * 2 + (c >> 5), rr = r & 15, cc = c & 31, ob = rr * 64 + cc * 2; return st * 1024 + (ob ^ (((ob >> 9) & 1) << 5)); }
__host__ __device__ __forceinline__ void stage_rc(int b, int& R, int& C) { const int st = b / 1024, sb = b % 1024, swz = sb ^ (((sb >> 9) & 1) << 5); R = (st >> 1) * 16 + swz / 64; C = (st & 1) * 32 + (swz % 64) / 2; }
__host__ __device__ __forceinline__ int perm32(int rho) { const int n = rho >> 4, i = rho & 15; return 8 * (i >> 2) + 4 * n + (i & 3); }

struct Unit { const char* a; const char* b; int pm, pn, e, mt; };

struct StaticOrder {
    const char* A; const char* Bt; int K;
    int nM, nN, nwg, G, c;
    __device__ void init(const void* A_, const void* Bt_, int M, int N, int K_, int G_, int c_) { A = (const char*)A_; Bt = (const char*)Bt_; K = K_; nM = M / BM; nN = N / BM; nwg = nM * nN; G = G_; c = c_; }
    __device__ __forceinline__ bool next(int i, Unit& u) const {
        const long L = (long)i * G + c; if (L >= nwg) return false;
        int wgid = (int)L; { const int q = nwg / NXCD, r = nwg % NXCD, xcd = wgid % NXCD, off = wgid / NXCD; wgid = (xcd < r ? xcd * (q + 1) : r * (q + 1) + (xcd - r) * q) + off; }
        const int nig = WGM * nN, gid = wgid / nig, fm = gid * WGM, gsz = (nM - fm) < WGM ? (nM - fm) : WGM;
        u.pm = fm + ((wgid % nig) % gsz); u.pn = (wgid % nig) / gsz; u.e = 0; u.mt = 0;
        u.a = A + (size_t)u.pm * 256 * K * 2; u.b = Bt + (size_t)u.pn * 256 * K * 2; return true;
    }
    __device__ __forceinline__ void rows(const Unit&, int, int, unsigned&, unsigned&) const {}
};

template <class Epi, class Sched, bool GATHER>
__device__ __forceinline__ void gemm_phase(ldsp_t lds, const int K, const Sched& S, const Epi& E) {
    const int tid = threadIdx.x, wid = __builtin_amdgcn_readfirstlane(tid >> 6), lane = tid & 63, wr = wid >> 2, wc = wid & 3, fr = lane & 15, fq = lane >> 4;
    const int nt = K / BK;
    unsigned voffA[2], voffB[2]; int RA[2], CA[2];
#pragma unroll
    for (int i = 0; i < 2; ++i) { int R, C; stage_rc(tid * 16 + i * 8192, R, C); const int Rb = Epi::PERM ? ((R & ~31) + perm32(R & 31)) : R;
        RA[i] = R; CA[i] = C; voffA[i] = (unsigned)(R * K + C) * 2u; voffB[i] = (unsigned)(Rb * K + C) * 2u; }
    const size_t kstep = (size_t)(BK * 2);
    const unsigned hstep = (unsigned)HALF * K * 2;
    const unsigned ldsw = (unsigned)wid * 1024u;
    const int aoff = lds_byte(wr * 64 + fr, fq * 8), boff = lds_byte(wc * 32 + fr, fq * 8);
#define PG8_SA(b, h) (((b) * 2 + (h)) * HTB)
#define PG8_SB(b, h) ((4 + (b) * 2 + (h)) * HTB)
#define PG8_STAGE2(bufoff, gbase, v0, v1) do { \
        __builtin_amdgcn_global_load_lds((const unsigned*)((const char*)(gbase) + (v0)), (LAS unsigned*)(lds + (bufoff) + ldsw), 16, 0, 0); \
        __builtin_amdgcn_global_load_lds((const unsigned*)((const char*)(gbase) + (v1)), (LAS unsigned*)(lds + (bufoff) + ldsw + 8192), 16, 0, 0); } while (0)
#define PG8_STAGEB(bufoff, gbase) PG8_STAGE2(bufoff, gbase, voffB[0], voffB[1])
#define PG8_LDA(dst, b, h) do { _Pragma("unroll") for (int m = 0; m < 4; ++m) _Pragma("unroll") for (int k = 0; k < 2; ++k) dst[m][k] = *(const LAS bf16x8*)(lds + PG8_SA(b, h) + aoff + m * 2048 + k * 1024); } while (0)
#define PG8_LDB(dst, b, h) do { _Pragma("unroll") for (int n = 0; n < 2; ++n) _Pragma("unroll") for (int k = 0; k < 2; ++k) dst[n][k] = *(const LAS bf16x8*)(lds + PG8_SB(b, h) + boff + n * 2048 + k * 1024); } while (0)
#define PG8_MMA(ai, bj, At, Bt) do { __builtin_amdgcn_s_setprio(1); _Pragma("unroll") for (int m = 0; m < 4; ++m) _Pragma("unroll") for (int n = 0; n < 2; ++n) _Pragma("unroll") for (int k = 0; k < 2; ++k) \
        acc[ai][bj][m][n] = __builtin_amdgcn_mfma_f32_16x16x32_bf16(Bt[n][k], At[m][k], acc[ai][bj][m][n], 0, 0, 0); __builtin_amdgcn_s_setprio(0); } while (0)
#define PG8_WAIT_V(n) asm volatile("s_waitcnt vmcnt(" #n ")" ::: "memory")
#define PG8_WAIT_L(n) asm volatile("s_waitcnt lgkmcnt(" #n ")" ::: "memory")
#define PG8_BAR __builtin_amdgcn_s_barrier()
#define PG8_SCHED __builtin_amdgcn_sched_barrier(0)
    Unit cur, nxt; int ui = 0;
    if (!S.next(0, cur)) return;
    f32x4 acc[2][2][4][2];
#pragma unroll
    for (int a = 0; a < 2; ++a)
#pragma unroll
        for (int b = 0; b < 2; ++b)
#pragma unroll
            for (int m = 0; m < 4; ++m)
#pragma unroll
                for (int n = 0; n < 2; ++n) acc[a][b][m][n] = (f32x4){0.f, 0.f, 0.f, 0.f};
    bf16x8 At[4][2], B0[2][2], B1[2][2];
    unsigned oc0[2], oc1[2], on0[2], on1[2];
    if constexpr (GATHER) {
#pragma unroll
        for (int i = 0; i < 2; ++i) { unsigned r0, r1; S.rows(cur, RA[i], RA[i] + 128, r0, r1); oc0[i] = r0 * (unsigned)(K * 2) + (unsigned)CA[i] * 2u; oc1[i] = r1 * (unsigned)(K * 2) + (unsigned)CA[i] * 2u; on0[i] = oc0[i]; on1[i] = oc1[i]; }
    } else {
#pragma unroll
        for (int i = 0; i < 2; ++i) { oc0[i] = voffA[i]; oc1[i] = voffA[i] + hstep; on0[i] = oc0[i]; on1[i] = oc1[i]; }
    }
    const char* cA = cur.a; const char* cB = cur.b;
    PG8_STAGEB(PG8_SB(0, 0), cB); PG8_STAGE2(PG8_SA(0, 0), cA, oc0[0], oc0[1]); PG8_STAGEB(PG8_SB(0, 1), cB + hstep); PG8_STAGE2(PG8_SA(0, 1), cA, oc1[0], oc1[1]);
    if (wr == 1) PG8_BAR;
    PG8_WAIT_V(4); PG8_BAR;
    PG8_STAGEB(PG8_SB(1, 0), cB + kstep); PG8_STAGE2(PG8_SA(1, 0), cA + kstep, oc0[0], oc0[1]); PG8_STAGEB(PG8_SB(1, 1), cB + hstep + kstep);
    PG8_WAIT_V(6); PG8_BAR;
    for (;;) {
        const bool has_next = S.next(ui + 1, nxt);
        const char* nA = has_next ? nxt.a : cA; const char* nB = has_next ? nxt.b : cB;
        if constexpr (GATHER) {
            if (has_next) {
#pragma unroll
                for (int i = 0; i < 2; ++i) { unsigned r0, r1; S.rows(nxt, RA[i], RA[i] + 128, r0, r1); on0[i] = r0 * (unsigned)(K * 2) + (unsigned)CA[i] * 2u; on1[i] = r1 * (unsigned)(K * 2) + (unsigned)CA[i] * 2u; }
            } else {
#pragma unroll
                for (int i = 0; i < 2; ++i) { on0[i] = oc0[i]; on1[i] = oc1[i]; }
            }
        }
        for (int t = 0; t < nt; t += 2) {
            const bool last = (t == nt - 2);
            const char* a1 = cA + (size_t)(t + 1) * kstep;
            const char* a2 = last ? nA : cA + (size_t)(t + 2) * kstep; const char* b2 = last ? nB : cB + (size_t)(t + 2) * kstep;
            const char* a3 = a2 + kstep; const char* b3 = b2 + kstep;
            unsigned p00, p01, p10, p11;
            if constexpr (GATHER) { p00 = last ? on0[0] : oc0[0]; p01 = last ? on0[1] : oc0[1]; p10 = last ? on1[0] : oc1[0]; p11 = last ? on1[1] : oc1[1]; }
            else { p00 = oc0[0]; p01 = oc0[1]; p10 = oc1[0]; p11 = oc1[1]; }
            PG8_LDB(B0, 0, 0); PG8_SCHED; PG8_LDA(At, 0, 0); PG8_STAGE2(PG8_SA(1, 1), a1, oc1[0], oc1[1]);
            PG8_WAIT_L(8); PG8_BAR; PG8_WAIT_L(0); PG8_MMA(0, 0, At, B0); PG8_BAR; PG8_SCHED;
            PG8_LDB(B1, 0, 1); PG8_STAGEB(PG8_SB(0, 0), b2);
            PG8_BAR; PG8_WAIT_L(0); PG8_MMA(0, 1, At, B1); PG8_BAR;
            PG8_LDA(At, 0, 1); PG8_STAGE2(PG8_SA(0, 0), a2, p00, p01);
            PG8_BAR; PG8_WAIT_L(0); PG8_MMA(1, 0, At, B0); PG8_BAR; PG8_SCHED;
            PG8_STAGEB(PG8_SB(0, 1), b2 + hstep);
            PG8_WAIT_V(6); PG8_BAR; PG8_MMA(1, 1, At, B1); PG8_BAR;
            PG8_LDB(B0, 1, 0); PG8_SCHED; PG8_LDA(At, 1, 0); PG8_STAGE2(PG8_SA(0, 1), a2, p10, p11);
            PG8_WAIT_L(8); PG8_BAR; PG8_WAIT_L(0); PG8_MMA(0, 0, At, B0); PG8_BAR; PG8_SCHED;
            PG8_LDB(B1, 1, 1); PG8_STAGEB(PG8_SB(1, 0), b3);
            PG8_BAR; PG8_WAIT_L(0); PG8_MMA(0, 1, At, B1); PG8_BAR;
            PG8_LDA(At, 1, 1); PG8_STAGE2(PG8_SA(1, 0), a3, p00, p01);
            PG8_BAR; PG8_WAIT_L(0); PG8_MMA(1, 0, At, B0); PG8_BAR; PG8_SCHED;
            PG8_STAGEB(PG8_SB(1, 1), b3 + hstep);
            PG8_WAIT_V(6); PG8_BAR; PG8_MMA(1, 1, At, B1); PG8_BAR;
        }
        E(acc, cur, wr, wc, fr, fq);
        if (!has_next) break;
#pragma unroll
        for (int a = 0; a < 2; ++a)
#pragma unroll
            for (int b = 0; b < 2; ++b)
#pragma unroll
                for (int m = 0; m < 4; ++m)
#pragma unroll
                    for (int n = 0; n < 2; ++n) acc[a][b][m][n] = (f32x4){0.f, 0.f, 0.f, 0.f};
        cur = nxt; cA = nA; cB = nB; ++ui;
#pragma unroll
        for (int i = 0; i < 2; ++i) { oc0[i] = on0[i]; oc1[i] = on1[i]; }
    }
    PG8_WAIT_V(0);
    if (wr == 0) PG8_BAR;
    PG8_BAR;
#undef PG8_SA
#undef PG8_SB
#undef PG8_STAGE2
#undef PG8_STAGEB
#undef PG8_LDA
#undef PG8_LDB
#undef PG8_MMA
#undef PG8_WAIT_V
#undef PG8_WAIT_L
#undef PG8_BAR
#undef PG8_SCHED
}

struct EpiBf16 {
    static constexpr bool PERM = true;
    bf16_t* O; int ldc;
    __device__ __forceinline__ void operator()(const f32x4 (&acc)[2][2][4][2], const Unit& u, int wr, int wc, int fr, int fq) const {
        const int row0 = u.pm * BM + wr * 64 + fr, col0 = u.pn * BM + wc * 32 + 8 * fq;
#pragma unroll
        for (int ai = 0; ai < 2; ++ai)
#pragma unroll
            for (int m = 0; m < 4; ++m) { bf16_t* rowp = O + (size_t)(row0 + ai * HALF + m * 16) * ldc + col0;
#pragma unroll
                for (int bj = 0; bj < 2; ++bj) { const f32x4 v0 = acc[ai][bj][m][0], v1 = acc[ai][bj][m][1];
                    u32x4 o; o.x = pk2(v0[0], v0[1]); o.y = pk2(v0[2], v0[3]); o.z = pk2(v1[0], v1[1]); o.w = pk2(v1[2], v1[3]);
                    *(u32x4*)(rowp + bj * HALF) = o; } }
    }
};
struct EpiResF32 {
    static constexpr bool PERM = false;
    float* C; const float* X; int ldc;
    __device__ __forceinline__ void operator()(const f32x4 (&acc)[2][2][4][2], const Unit& u, int wr, int wc, int fr, int fq) const {
        const int row0 = u.pm * BM + wr * 64 + fr, col0 = u.pn * BM + wc * 32 + 4 * fq;
#pragma unroll
        for (int ai = 0; ai < 2; ++ai)
#pragma unroll
            for (int m = 0; m < 4; ++m) { const size_t ro = (size_t)(row0 + ai * HALF + m * 16) * ldc + col0;
#pragma unroll
                for (int bj = 0; bj < 2; ++bj)
#pragma unroll
                    for (int n = 0; n < 2; ++n) { const f32x4 xv = *(const f32x4*)(X + ro + bj * HALF + n * 16); *(f32x4*)(C + ro + bj * HALF + n * 16) = acc[ai][bj][m][n] + xv; } }
    }
};
}

template <int KS>
__device__ __forceinline__ f32x4 tile_n(const LAS unsigned char* A, int lda, const LAS unsigned char* Bt, int ldb, f32x4 acc, int lane) {
    const LAS unsigned char* ap = A + (lane & 15) * lda + (lane >> 4) * 16;
    const LAS unsigned char* bp = Bt + (lane & 15) * ldb + (lane >> 4) * 16;
#pragma unroll
    for (int k = 0; k < KS; ++k) { const bf16x8 a = *(const LAS bf16x8*)(ap + k * 64), b = *(const LAS bf16x8*)(bp + k * 64); acc = __builtin_amdgcn_mfma_f32_16x16x32_bf16(a, b, acc, 0, 0, 0); }
    return acc;
}
template <int KS>
__device__ __forceinline__ f32x4 tile_s(const LAS unsigned char* A, int lda, const LAS unsigned char* Bt, int ldb, f32x4 acc, int lane) {
    const LAS unsigned char* ap = A + (lane & 15) * lda + (lane >> 4) * 16;
    const LAS unsigned char* bp = Bt + (lane & 15) * ldb + (lane >> 4) * 16;
#pragma unroll
    for (int k = 0; k < KS; ++k) { const bf16x8 a = *(const LAS bf16x8*)(ap + k * 64), b = *(const LAS bf16x8*)(bp + k * 64); acc = __builtin_amdgcn_mfma_f32_16x16x32_bf16(b, a, acc, 0, 0, 0); }
    return acc;
}
__device__ __forceinline__ void st4bf(LAS unsigned char* p, const f32x4& v) { u32x2 o; o.x = pk2(v[0], v[1]); o.y = pk2(v[2], v[3]); *(LAS u32x2*)p = o; }
__device__ __forceinline__ void st4bf_g(bf16_t* p, const f32x4& v) { u32x2 o; o.x = pk2(v[0], v[1]); o.y = pk2(v[2], v[3]); *(u32x2*)p = o; }


struct Ctx { ldsp_t lds; int tid, lane, wid, vcu, G; };

__device__ __forceinline__ void transpose_block(const float* W, int N, bf16_t* WT, int ldk, int dst_row0, int k0, int n0, LAS float* scr, int lane) {
#pragma unroll 8
    for (int i = 0; i < 32; ++i) { const int kk = 2 * i + (lane >> 5); scr[kk * 33 + (lane & 31)] = W[(size_t)(k0 + kk) * N + n0 + (lane & 31)]; }
    asm volatile("s_waitcnt lgkmcnt(0)" ::: "memory");
    const int c = lane & 7;
#pragma unroll
    for (int j = 0; j < 4; ++j) { const int n = (lane >> 3) + 8 * j; const LAS float* s = scr + (8 * c) * 33 + n;
        u32x4 o; o.x = pk2(s[0 * 33], s[1 * 33]); o.y = pk2(s[2 * 33], s[3 * 33]); o.z = pk2(s[4 * 33], s[5 * 33]); o.w = pk2(s[6 * 33], s[7 * 33]);
        *(u32x4*)(WT + (size_t)(dst_row0 + n) * ldk + k0 + 8 * c) = o; }
    asm volatile("s_waitcnt lgkmcnt(0)" ::: "memory");
}
__device__ __forceinline__ void rms_row_to_bf16(const float* xrow, const float* w, bf16_t* orow, int lane) {
    const f32x4* xr = (const f32x4*)xrow + lane; const f32x4* wr = (const f32x4*)w + lane;
    f32x4 v[4]; float s = 0.f;
#pragma unroll
    for (int j = 0; j < 4; ++j) { v[j] = xr[64 * j]; s += (v[j].x * v[j].x + v[j].y * v[j].y) + (v[j].z * v[j].z + v[j].w * v[j].w); }
    const float inv = rsqrtf(wave_sum(s) * (1.f / 1024.f) + 1e-6f);
    u32x2* o8 = (u32x2*)orow + lane;
#pragma unroll
    for (int j = 0; j < 4; ++j) { const f32x4 g = wr[64 * j]; u32x2 o; o.x = pk2(v[j].x * inv * g.x, v[j].y * inv * g.y); o.y = pk2(v[j].z * inv * g.z, v[j].w * inv * g.w); o8[64 * j] = o; }
}
__device__ __forceinline__ void p0_prologue(const Params& P, const Ctx& F) {
    LAS float* scr = (LAS float*)(F.lds + F.wid * 16384);
    const int gw = F.vcu * 8 + F.wid, NGW = F.G * 8;
    unsigned char* ws = P.ws;
    bf16_t* BT_RW = (bf16_t*)(ws + WS_BT_RW); bf16_t* BT_GL = (bf16_t*)(ws + WS_BT_GL); bf16_t* BT_OUT = (bf16_t*)(ws + WS_BT_OUT);
    bf16_t* LORA = (bf16_t*)(ws + WS_LORA);
    constexpr int I_IN = 16 * 109, I_OUT = 16 * 32, I_L = 16, I_G = 32;
    constexpr int NITEMS = I_IN + I_OUT + 4 * I_L + I_G;
    for (int it = gw; it < NITEMS; it += NGW) {
        int r = it;
        if (r < I_IN) { const int kb = r / 109, nb = r % 109, n0 = 32 * nb;
            if (n0 < RW_COLS) transpose_block(P.w_in, 3488, BT_RW, 1024, n0, 64 * kb, n0, scr, F.lane);
            else transpose_block(P.w_in, 3488, BT_GL, 1024, n0 - RW_COLS, 64 * kb, n0, scr, F.lane);
            continue; }
        r -= I_IN;
        if (r < I_OUT) { const int kb = r / 32, nb = r % 32; transpose_block(P.w_out, 1024, BT_OUT, 1024, 32 * nb, 64 * kb, 32 * nb, scr, F.lane); continue; }
        r -= I_OUT;
        if (r < 4 * I_L) { const int which = r / I_L, nb = r % I_L;
            const float* src = which == 0 ? P.w2_f : which == 1 ? P.w2_b : which == 2 ? P.a2_f : P.a2_b;
            transpose_block(src, 512, LORA + (size_t)which * 32768, 64, 32 * nb, 0, 32 * nb, scr, F.lane); continue; }
        r -= 4 * I_L;
        { const int kb = r / 16, nb = r % 16; transpose_block(P.g2, 512, LORA + 4 * 32768, 128, 32 * nb, 64 * kb, 32 * nb, scr, F.lane); }
    }
    { const int gt = F.vcu * 512 + F.tid, NGT = F.G * 512; const u32x4 z = {0u, 0u, 0u, 0u};
      u32x4* p1 = (u32x4*)(BT_RW + (size_t)RW_COLS * 1024); for (int i = gt; i < (2048 - RW_COLS) * 128; i += NGT) p1[i] = z;
      u32x4* p2 = (u32x4*)(BT_GL + (size_t)GL_COLS * 1024); for (int i = gt; i < (1792 - GL_COLS) * 128; i += NGT) p2[i] = z; }
    bf16_t* H = (bf16_t*)(ws + WS_H);
    for (int m = gw; m < NTOK; m += NGW) rms_row_to_bf16(P.x + (size_t)m * 1024, P.ln1_w, H + (size_t)m * 1024, F.lane);
}

constexpr int RS = 144;
constexpr int RMS_ = 64 * RS;
constexpr int L_AT = 0, L_BT = RMS_, L_KT = 2 * RMS_, L_RT = 3 * RMS_, L_ATT = 4 * RMS_, L_BHT = 5 * RMS_, L_KHT = 6 * RMS_, L_VT = 7 * RMS_;
constexpr int L_U1 = 8 * RMS_;
constexpr int L_TW = L_U1, L_AL = L_U1 + RMS_, L_SG = L_U1 + 2 * RMS_, L_LW = L_SG + 64 * 272, L_AA = L_LW + 16384;
constexpr int L_L0 = L_U1, L_LT0 = L_U1 + RMS_, L_L1 = L_U1 + 2 * RMS_, L_LT1 = L_U1 + 3 * RMS_, L_T0 = L_U1 + 4 * RMS_, L_T1 = L_U1 + 5 * RMS_,
              L_LAK = L_U1 + 6 * RMS_, L_RB = L_U1 + 7 * RMS_, L_RK = L_U1 + 8 * RMS_, L_WC = L_U1 + 9 * RMS_;
constexpr int L_XT = 0, L_G1T = 2 * RMS_;
static_assert(L_AA + 16384 <= L_WC && L_WC + 256 <= LDS_MISC, "rwkv LDS map");

__device__ __forceinline__ void rwkv_item(const Params& P, const Ctx& F, const int item) {
    const int tid = F.tid, lane = F.lane, wid = F.wid; ldsp_t lds = F.lds;
    const int dir = item & 1, h = (item >> 1) & 7, c = (item >> 4) & 63, b = item >> 10;
    const int t0 = c * 64, tb = b * SEQ;
    unsigned char* ws = P.ws;
    const bf16_t* PA = (const bf16_t*)P.out;
    const int hi = h * 64 + lane;

#pragma unroll
    for (int it = 0; it < 4; ++it) {
        const int q = tid + 512 * it, j = q >> 5, ch = q & 31;
        if (!(dir == 1 && ch >= 16)) {
            int col0, act; LAS unsigned char* dst;
            if (ch < 8) { col0 = 1536 + 64 * dir + 8 * ch; act = 0; dst = lds + L_TW + j * RS + ch * 16; }
            else if (ch < 16) { col0 = 1664 + 64 * dir + 8 * (ch - 8); act = 1; dst = lds + L_AL + j * RS + (ch - 8) * 16; }
            else { col0 = 1792 + 8 * (ch - 16); act = 2; dst = lds + L_SG + j * 272 + (ch - 16) * 16; }
            const int tn = dir ? t0 + 63 - j : t0 + j;
            const bf16_t* row = PA + (size_t)(tb + tn) * LDA_RW + col0;
            const u32x4 zc = {0u, 0u, 0u, 0u};
            const u32x4 xc = *(const u32x4*)row;
            const u32x4 xp = tn > 0 ? *(const u32x4*)(row - LDA_RW) : zc;
            const u32x4 xn = tn < SEQ - 1 ? *(const u32x4*)(row + LDA_RW) : zc;
            const f32x4 m0 = *(const f32x4*)(P.rw_mu + col0), m1 = *(const f32x4*)(P.rw_mu + col0 + 4);
            float fc[8], fp[8], fn[8], o[8]; unpack8(xc, fc); unpack8(xp, fp); unpack8(xn, fn);
            const float mu[8] = {m0.x, m0.y, m0.z, m0.w, m1.x, m1.y, m1.z, m1.w};
#pragma unroll
            for (int e = 0; e < 8; ++e) { const float v = fc[e] + mu[e] * (0.5f * (fp[e] + fn[e]) - fc[e]); o[e] = act == 0 ? tanhf_(v) : act == 1 ? v : sigmoidf_(v); }
            *(LAS u32x4*)dst = pack8(o);
        }
    }
    float rr[8], kr[8], vr[8];
    {
        const int jlo = 8 * wid;
        const int tlo = dir ? (t0 + 55 - jlo) : (t0 + jlo - 1);
        float raw_r[10], raw_k[10], raw_v[10];
#pragma unroll
        for (int q = 0; q < 10; ++q) { const int tn = tlo + q; const bool ok = (tn >= 0) && (tn < SEQ);
            const bf16_t* row = PA + (size_t)(tb + (ok ? tn : 0)) * LDA_RW + hi;
            raw_r[q] = ok ? bf2f(row[0]) : 0.f; raw_k[q] = ok ? bf2f(row[512]) : 0.f; raw_v[q] = ok ? bf2f(row[1024]) : 0.f; }
        const float mur = P.rw_mu[hi], muk = P.rw_mu[512 + hi], muv = P.rw_mu[1024 + hi];
#pragma unroll
        for (int jj = 0; jj < 8; ++jj) {
            const float cr = dir ? raw_r[8 - jj] : raw_r[1 + jj], pr = dir ? raw_r[7 - jj] : raw_r[jj], nr = dir ? raw_r[9 - jj] : raw_r[2 + jj];
            const float ck = dir ? raw_k[8 - jj] : raw_k[1 + jj], pk = dir ? raw_k[7 - jj] : raw_k[jj], nk = dir ? raw_k[9 - jj] : raw_k[2 + jj];
            const float cv = dir ? raw_v[8 - jj] : raw_v[1 + jj], pv = dir ? raw_v[7 - jj] : raw_v[jj], nv = dir ? raw_v[9 - jj] : raw_v[2 + jj];
            rr[jj] = cr + mur * (0.5f * (pr + nr) - cr); kr[jj] = ck + muk * (0.5f * (pk + nk) - ck); vr[jj] = cv + muv * (0.5f * (pv + nv) - cv);
        }
    }
    __syncthreads();
    {
        const int rb = wid >> 1, cb0 = 2 * (wid & 1);
        const bf16_t* LORA = (const bf16_t*)(ws + WS_LORA);
        const bf16_t* W2t = LORA + (size_t)dir * 32768;
        const bf16_t* A2t = LORA + (size_t)(2 + dir) * 32768;
        const bf16_t* G2t = LORA + (size_t)4 * 32768;
        const float* w0 = dir ? P.w0_b : P.w0_f; const float* a0 = dir ? P.a0_b : P.a0_f;
        bf16_t* Gout = (bf16_t*)(ws + WS_G);
#pragma unroll
        for (int t = 0; t < 2; ++t) {
            const int cb = cb0 + t, n = 16 * cb + (lane & 15), hn = h * 64 + n;
            f32x4 zw = {0.f, 0.f, 0.f, 0.f}, za = {0.f, 0.f, 0.f, 0.f};
            const LAS unsigned char* ap_w = lds + L_TW + (16 * rb + (lane & 15)) * RS + (lane >> 4) * 16;
            const LAS unsigned char* ap_a = lds + L_AL + (16 * rb + (lane & 15)) * RS + (lane >> 4) * 16;
#pragma unroll
            for (int kk = 0; kk < 2; ++kk) {
                const bf16x8 bw = *(const bf16x8*)(W2t + (size_t)hn * 64 + 8 * (lane >> 4) + 32 * kk);
                const bf16x8 ba = *(const bf16x8*)(A2t + (size_t)hn * 64 + 8 * (lane >> 4) + 32 * kk);
                zw = __builtin_amdgcn_mfma_f32_16x16x32_bf16(*(const LAS bf16x8*)(ap_w + kk * 64), bw, zw, 0, 0, 0);
                za = __builtin_amdgcn_mfma_f32_16x16x32_bf16(*(const LAS bf16x8*)(ap_a + kk * 64), ba, za, 0, 0, 0);
            }
            const float w0v = w0[hn], a0v = a0[hn];
#pragma unroll
            for (int r = 0; r < 4; ++r) { const int j = 16 * rb + 4 * (lane >> 4) + r;
                *(LAS float*)(lds + L_LW + (j * 64 + n) * 4) = -0.60653066f * sigmoidf_(w0v + zw[r]);
                *(LAS float*)(lds + L_AA + (j * 64 + n) * 4) = sigmoidf_(a0v + za[r]); }
            if (dir == 0) {
                f32x4 zg = {0.f, 0.f, 0.f, 0.f};
                const LAS unsigned char* ap_g = lds + L_SG + (16 * rb + (lane & 15)) * 272 + (lane >> 4) * 16;
#pragma unroll
                for (int kk = 0; kk < 4; ++kk) { const bf16x8 bg = *(const bf16x8*)(G2t + (size_t)hn * 128 + 8 * (lane >> 4) + 32 * kk);
                    zg = __builtin_amdgcn_mfma_f32_16x16x32_bf16(*(const LAS bf16x8*)(ap_g + kk * 64), bg, zg, 0, 0, 0); }
#pragma unroll
                for (int r = 0; r < 4; ++r) { const int j = 16 * rb + 4 * (lane >> 4) + r; Gout[(size_t)(tb + t0 + j) * 512 + hn] = (bf16_t)f2bf(zg[r]); }
            }
        }
    }
    __syncthreads();
    {
        float total = 0.f, pre = 0.f;
#pragma unroll 8
        for (int s = 0; s < 64; ++s) { const float v = *(const LAS float*)(lds + L_LW + (s * 64 + lane) * 4); total += v; pre += (s < 8 * wid) ? v : 0.f; }
        const float kkw = P.k_k[hi], kaw = P.k_a[hi], rkw = P.r_k[hi];
        float* BON = (float*)(ws + WS_BON); bf16_t* VS = (bf16_t*)(ws + WS_VS);
        float at_[8], bh_[8], kh_[8];
#pragma unroll
        for (int jj = 0; jj < 8; ++jj) {
            const int j = 8 * wid + jj, tok = tb + (dir ? t0 + 63 - j : t0 + j);
            const float lwj = *(const LAS float*)(lds + L_LW + (j * 64 + lane) * 4), a = *(const LAS float*)(lds + L_AA + (j * 64 + lane) * 4);
            const float lw_prev = pre; pre += lwj; const float lw = pre;
            const float kraw = kr[jj] * kkw; const float ss = wave_sum(kraw * kraw);
            const float kkv = kraw / fmaxf(sqrtf(ss), 1e-12f);
            const float kd = kr[jj] * (1.f + (a - 1.f) * kaw), bb = kkv * a;
            const float bon = wave_sum(rr[jj] * kd * rkw);
            if (lane == 0) BON[((size_t)dir * NTOK + tok) * 8 + h] = bon;
            if (dir == 0) VS[(size_t)tok * 512 + hi] = (bf16_t)f2bf(vr[jj]);
            const float eprev = __expf(lw_prev), einv = __expf(-lw), ee = __expf(lw), eh = __expf(total - lw);
            at_[jj] = -kkv * eprev; bh_[jj] = bb * eh; kh_[jj] = kd * eh;
            *(LAS bf16_t*)(lds + L_AT + j * RS + lane * 2) = (bf16_t)f2bf(at_[jj]);
            *(LAS bf16_t*)(lds + L_BT + j * RS + lane * 2) = (bf16_t)f2bf(bb * einv);
            *(LAS bf16_t*)(lds + L_KT + j * RS + lane * 2) = (bf16_t)f2bf(kd * einv);
            *(LAS bf16_t*)(lds + L_RT + j * RS + lane * 2) = (bf16_t)f2bf(rr[jj] * ee);
        }
        *(LAS u32x4*)(lds + L_ATT + lane * RS + wid * 16) = pack8(at_);
        *(LAS u32x4*)(lds + L_BHT + lane * RS + wid * 16) = pack8(bh_);
        *(LAS u32x4*)(lds + L_KHT + lane * RS + wid * 16) = pack8(kh_);
        *(LAS u32x4*)(lds + L_VT + lane * RS + wid * 16) = pack8(vr);
        if (wid == 0) *(LAS float*)(lds + L_WC + lane * 4) = __expf(total);
    }
    __syncthreads();
    const int rb = wid >> 1, cb0 = 2 * (wid & 1);
    const int jr = 16 * rb + (lane & 15);
    const int q4 = 4 * (lane >> 4);
    const f32x4 zero4 = {0.f, 0.f, 0.f, 0.f};
#pragma unroll
    for (int t = 0; t < 2; ++t) {
        const int cb = cb0 + t;
        const LAS unsigned char* Arow_at = lds + L_AT + 16 * rb * RS; const LAS unsigned char* Arow_rt = lds + L_RT + 16 * rb * RS;
        const LAS unsigned char* Brow_bt = lds + L_BT + 16 * cb * RS; const LAS unsigned char* Brow_kt = lds + L_KT + 16 * cb * RS;
        f32x4 lab_s = tile_s<2>(Arow_at, RS, Brow_bt, RS, zero4, lane);
        f32x4 lab_n = tile_n<2>(Arow_at, RS, Brow_bt, RS, zero4, lane);
        f32x4 lak_s = tile_s<2>(Arow_at, RS, Brow_kt, RS, zero4, lane);
        f32x4 rb_s = tile_s<2>(Arow_rt, RS, Brow_bt, RS, zero4, lane);
        f32x4 rk_s = tile_s<2>(Arow_rt, RS, Brow_kt, RS, zero4, lane);
        f32x4 t0v;
#pragma unroll
        for (int r = 0; r < 4; ++r) { const int s = 16 * cb + q4 + r;
            lab_s[r] = (jr > s) ? lab_s[r] : 0.f; lak_s[r] = (jr > s) ? lak_s[r] : 0.f;
            rb_s[r] = (jr >= s) ? rb_s[r] : 0.f; rk_s[r] = (jr >= s) ? rk_s[r] : 0.f;
            t0v[r] = lab_s[r] + ((jr == s) ? 1.f : 0.f); }
        st4bf(lds + L_L0 + jr * RS + (16 * cb + q4) * 2, lab_s);
        st4bf(lds + L_T0 + jr * RS + (16 * cb + q4) * 2, t0v);
        st4bf(lds + L_LAK + jr * RS + (16 * cb + q4) * 2, lak_s);
        st4bf(lds + L_RB + jr * RS + (16 * cb + q4) * 2, rb_s);
        st4bf(lds + L_RK + jr * RS + (16 * cb + q4) * 2, rk_s);
        { const int s = 16 * cb + (lane & 15);
#pragma unroll
          for (int r = 0; r < 4; ++r) { const int j = 16 * rb + q4 + r; lab_n[r] = (j > s) ? lab_n[r] : 0.f; }
          st4bf(lds + L_LT0 + s * RS + (16 * rb + q4) * 2, lab_n); }
    }
    __syncthreads();
#pragma unroll
    for (int kk = 1; kk <= 6; ++kk) {
        const int Lc = (kk & 1) ? L_L0 : L_L1, LTc = (kk & 1) ? L_LT0 : L_LT1, Ln = (kk & 1) ? L_L1 : L_L0, LTn = (kk & 1) ? L_LT1 : L_LT0;
        const int Tc = (kk & 1) ? L_T1 : L_T0, Tn = (kk & 1) ? L_T0 : L_T1;
#pragma unroll
        for (int t = 0; t < 2; ++t) {
            const int cb = cb0 + t;
            if (kk <= 5) {
                f32x4 ls = tile_s<2>(lds + Lc + 16 * rb * RS, RS, lds + LTc + 16 * cb * RS, RS, zero4, lane);
                f32x4 ln = tile_n<2>(lds + Lc + 16 * rb * RS, RS, lds + LTc + 16 * cb * RS, RS, zero4, lane);
                st4bf(lds + Ln + jr * RS + (16 * cb + q4) * 2, ls);
                st4bf(lds + LTn + (16 * cb + (lane & 15)) * RS + (16 * rb + q4) * 2, ln);
            }
            if (kk >= 2) {
                const u32x2 tv = *(const LAS u32x2*)(lds + Tc + jr * RS + (16 * cb + q4) * 2);
                f32x4 ti = {bf2f(tv.x & 0xffffu), bf2f(tv.x >> 16), bf2f(tv.y & 0xffffu), bf2f(tv.y >> 16)};
                ti = tile_s<2>(lds + Tc + 16 * rb * RS, RS, lds + LTc + 16 * cb * RS, RS, ti, lane);
                st4bf(lds + Tn + jr * RS + (16 * cb + q4) * 2, ti);
            }
            if (kk == 1) {
                f32x4 g1 = tile_n<2>(lds + L_LAK + 16 * rb * RS, RS, lds + L_VT + 16 * cb * RS, RS, zero4, lane);
                st4bf(lds + L_G1T + (16 * cb + (lane & 15)) * RS + (16 * rb + q4) * 2, g1);
            }
        }
        __syncthreads();
    }
    {
        const int cbx0 = 4 * (wid & 1);
        f32x4 xv[4];
#pragma unroll
        for (int t = 0; t < 4; ++t) { const int cb = cbx0 + t;
            const LAS unsigned char* bt = (cb < 4) ? (lds + L_ATT + 16 * cb * RS) : (lds + L_G1T + 16 * (cb - 4) * RS);
            xv[t] = tile_n<2>(lds + L_T1 + 16 * rb * RS, RS, bt, RS, zero4, lane); }
        __syncthreads();
#pragma unroll
        for (int t = 0; t < 4; ++t) { const int cb = cbx0 + t; st4bf(lds + L_XT + (16 * cb + (lane & 15)) * RS + (16 * rb + q4) * 2, xv[t]); }
    }
    __syncthreads();
    {
        bf16_t* RM = (bf16_t*)(ws + WS_RM) + (size_t)item * 4096; bf16_t* RP = (bf16_t*)(ws + WS_RP) + (size_t)item * 4096; bf16_t* RNT = (bf16_t*)(ws + WS_RNT) + (size_t)item * 4096;
        bf16_t* Y = (bf16_t*)(ws + (dir ? WS_YB : WS_YF));
        const int pg4 = 4 * ((lane >> 4) == 1 ? 2 : (lane >> 4) == 2 ? 1 : (lane >> 4));
#pragma unroll
        for (int t = 0; t < 2; ++t) {
            const int cb = cb0 + t;
            f32x4 mv = tile_s<2>(lds + L_BHT + 16 * rb * RS, RS, lds + L_XT + 16 * cb * RS, RS, zero4, lane);
            { const float wc = *(const LAS float*)(lds + L_WC + jr * 4);
#pragma unroll
              for (int r = 0; r < 4; ++r) mv[r] += (jr == 16 * cb + q4 + r) ? wc : 0.f; }
            st4bf_g(RM + jr * 64 + 16 * cb + pg4, mv);
            f32x4 nv = tile_n<2>(lds + L_BHT + 16 * rb * RS, RS, lds + L_XT + (64 + 16 * cb) * RS, RS, zero4, lane);
            nv = tile_n<2>(lds + L_KHT + 16 * rb * RS, RS, lds + L_VT + 16 * cb * RS, RS, nv, lane);
            st4bf_g(RNT + (16 * cb + (lane & 15)) * 64 + 16 * rb + q4, nv);
            f32x4 pv = tile_s<2>(lds + L_RB + 16 * rb * RS, RS, lds + L_XT + 16 * cb * RS, RS, zero4, lane);
            { const u32x2 rv = *(const LAS u32x2*)(lds + L_RT + jr * RS + (16 * cb + q4) * 2);
              pv[0] += bf2f(rv.x & 0xffffu); pv[1] += bf2f(rv.x >> 16); pv[2] += bf2f(rv.y & 0xffffu); pv[3] += bf2f(rv.y >> 16); }
            st4bf_g(RP + jr * 64 + 16 * cb + pg4, pv);
            f32x4 zv = tile_s<2>(lds + L_RB + 16 * rb * RS, RS, lds + L_XT + (64 + 16 * cb) * RS, RS, zero4, lane);
            zv = tile_s<2>(lds + L_RK + 16 * rb * RS, RS, lds + L_VT + 16 * cb * RS, RS, zv, lane);
            { const int tok = tb + (dir ? t0 + 63 - jr : t0 + jr); st4bf_g(Y + (size_t)tok * 512 + h * 64 + 16 * cb + q4, zv); }
        }
    }
    __syncthreads();
}

__device__ __forceinline__ bf16x8 pack_step(const f32x16& x, int s) {
    u32x4 p; p.x = pk2(x[8 * s + 0], x[8 * s + 1]); p.y = pk2(x[8 * s + 2], x[8 * s + 3]); p.z = pk2(x[8 * s + 4], x[8 * s + 5]); p.w = pk2(x[8 * s + 6], x[8 * s + 7]);
    return __builtin_bit_cast(bf16x8, p);
}
#define MFMA32(a, b, c) __builtin_amdgcn_mfma_f32_32x32x16_bf16((a), (b), (c), 0, 0, 0)

__device__ __forceinline__ void rwkv_chain(const Params& P, const int chain, const int lane) {
    const int vh = chain & 1, dir = (chain >> 1) & 1, h = (chain >> 2) & 7, b = chain >> 5;
    unsigned char* ws = P.ws;
    const int r = lane & 31, hh = lane >> 5, tb = b * SEQ;
    bf16_t* Y = (bf16_t*)(ws + (dir ? WS_YB : WS_YF));
    f32x16 X0, X1;
#pragma unroll
    for (int i = 0; i < 16; ++i) { X0[i] = 0.f; X1[i] = 0.f; }
    for (int st = 0; st < 64; ++st) {
        const int c = dir ? 63 - st : st, t0 = c * 64;
        const int item = ((b * 64 + c) * 8 + h) * 2 + dir;
        const bf16_t* RM = (const bf16_t*)(ws + WS_RM) + (size_t)item * 4096; const bf16_t* RP = (const bf16_t*)(ws + WS_RP) + (size_t)item * 4096;
        const bf16_t* RNT = (const bf16_t*)(ws + WS_RNT) + (size_t)item * 4096;
        const bf16x8 b00 = pack_step(X0, 0), b01 = pack_step(X0, 1), b10 = pack_step(X1, 0), b11 = pack_step(X1, 1);
        f32x16 Yv[2];
#pragma unroll
        for (int jb = 0; jb < 2; ++jb) {
#pragma unroll
            for (int i = 0; i < 16; ++i) { const int j = 32 * jb + (i & 3) + 8 * (i >> 2) + 4 * hh; const int tok = tb + (dir ? t0 + 63 - j : t0 + j);
                Yv[jb][i] = bf2f(Y[(size_t)tok * 512 + h * 64 + 32 * vh + r]); }
            const bf16_t* ap = RP + (32 * jb + r) * 64 + 8 * hh;
            Yv[jb] = MFMA32(*(const bf16x8*)(ap + 0), b00, Yv[jb]);
            Yv[jb] = MFMA32(*(const bf16x8*)(ap + 16), b01, Yv[jb]);
            Yv[jb] = MFMA32(*(const bf16x8*)(ap + 32), b10, Yv[jb]);
            Yv[jb] = MFMA32(*(const bf16x8*)(ap + 48), b11, Yv[jb]);
#pragma unroll
            for (int i = 0; i < 16; ++i) { const int j = 32 * jb + (i & 3) + 8 * (i >> 2) + 4 * hh; const int tok = tb + (dir ? t0 + 63 - j : t0 + j);
                Y[(size_t)tok * 512 + h * 64 + 32 * vh + r] = (bf16_t)f2bf(Yv[jb][i]); }
        }
        f32x16 Hn[2];
#pragma unroll
        for (int kb = 0; kb < 2; ++kb) {
#pragma unroll
            for (int g = 0; g < 4; ++g) { const u32x2 nv = *(const u32x2*)(RNT + (32 * vh + r) * 64 + 32 * kb + 8 * g + 4 * hh);
                Hn[kb][4 * g + 0] = bf2f(nv.x & 0xffffu); Hn[kb][4 * g + 1] = bf2f(nv.x >> 16); Hn[kb][4 * g + 2] = bf2f(nv.y & 0xffffu); Hn[kb][4 * g + 3] = bf2f(nv.y >> 16); }
            const bf16_t* ap = RM + (32 * kb + r) * 64 + 8 * hh;
            Hn[kb] = MFMA32(*(const bf16x8*)(ap + 0), b00, Hn[kb]);
            Hn[kb] = MFMA32(*(const bf16x8*)(ap + 16), b01, Hn[kb]);
            Hn[kb] = MFMA32(*(const bf16x8*)(ap + 32), b10, Hn[kb]);
            Hn[kb] = MFMA32(*(const bf16x8*)(ap + 48), b11, Hn[kb]);
        }
        X0 = Hn[0]; X1 = Hn[1];
    }
}

constexpr int G_QT = 0, G_KT = RMS_, G_KHT = 2 * RMS_, G_VT = 3 * RMS_, G_AM = 5 * RMS_, G_GK = 6 * RMS_;
__device__ __forceinline__ void gla_item(const Params& P, const Ctx& F, const int item) {
    const int lane = F.lane, wid = F.wid; ldsp_t lds = F.lds;
    const int dir = item & 1, hd = (item >> 1) & 3, c = (item >> 3) & 63, b = item >> 9;
    const int t0 = c * 64, tb = b * SEQ;
    unsigned char* ws = P.ws;
    const bf16_t* PB = (const bf16_t*)(ws + WS_PB);
    const int hi = hd * 64 + lane;
    const float* gw2 = dir ? P.gw2_b : P.gw2_f; const float* gb = dir ? P.gb_b : P.gb_f;
    float qv[8], kv[8];
    {
        float w2[16];
#pragma unroll
        for (int m = 0; m < 16; ++m) w2[m] = gw2[m * 256 + hi];
        const float gbv = gb[hi];
        float v0[8], v1[8];
#pragma unroll
        for (int jj = 0; jj < 8; ++jj) {
            const int j = 8 * wid + jj, tok = tb + (dir ? t0 + 63 - j : t0 + j);
            const bf16_t* row = PB + (size_t)tok * LDB_GL;
            const u32x4 g0 = *(const u32x4*)(row + 1024 + 16 * dir), g1 = *(const u32x4*)(row + 1024 + 16 * dir + 8);
            float gl[16]; { float t8[8]; unpack8(g0, t8);
#pragma unroll
                for (int e = 0; e < 8; ++e) gl[e] = t8[e];
                unpack8(g1, t8);
#pragma unroll
                for (int e = 0; e < 8; ++e) gl[8 + e] = t8[e]; }
            float z = gbv;
#pragma unroll
            for (int m = 0; m < 16; ++m) z += gl[m] * w2[m];
            const float ls = fminf(z, 0.f) - __logf(1.f + __expf(-fabsf(z)));
            *(LAS float*)(lds + G_GK + (j * 64 + lane) * 4) = ls * (1.f / 16.f);
            qv[jj] = bf2f(row[hi]) * 0.125f; kv[jj] = bf2f(row[256 + hi]);
            v0[jj] = bf2f(row[512 + hd * 128 + lane]); v1[jj] = bf2f(row[512 + hd * 128 + 64 + lane]);
        }
        *(LAS u32x4*)(lds + G_VT + lane * RS + wid * 16) = pack8(v0);
        *(LAS u32x4*)(lds + G_VT + (64 + lane) * RS + wid * 16) = pack8(v1);
    }
    __syncthreads();
    {
        float total = 0.f, pre = 0.f;
#pragma unroll 8
        for (int s = 0; s < 64; ++s) { const float v = *(const LAS float*)(lds + G_GK + (s * 64 + lane) * 4); total += v; pre += (s < 8 * wid) ? v : 0.f; }
        bf16_t* GQ = (bf16_t*)(ws + WS_GQ) + (size_t)item * 4096;
        const int blk = lane >> 4, g4 = (lane >> 2) & 3, pgp = (g4 == 1) ? 2 : (g4 == 2) ? 1 : g4;
        const int pcol = 16 * blk + 4 * pgp + (lane & 3);
        float kh_[8];
#pragma unroll
        for (int jj = 0; jj < 8; ++jj) {
            const int j = 8 * wid + jj;
            pre += *(const LAS float*)(lds + G_GK + (j * 64 + lane) * 4);
            const float e = __expf(pre), einv = __expf(-pre), eh = __expf(total - pre);
            const float qs = qv[jj] * e;
            *(LAS bf16_t*)(lds + G_QT + j * RS + lane * 2) = (bf16_t)f2bf(qs);
            *(LAS bf16_t*)(lds + G_KT + j * RS + lane * 2) = (bf16_t)f2bf(kv[jj] * einv);
            kh_[jj] = kv[jj] * eh;
            GQ[j * 64 + pcol] = (bf16_t)f2bf(qs);
        }
        *(LAS u32x4*)(lds + G_KHT + lane * RS + wid * 16) = pack8(kh_);
        if (wid == 0) ((float*)(ws + WS_DEC))[(size_t)item * 64 + lane] = __expf(total);
    }
    __syncthreads();
    const int rb = wid >> 1, cb0 = 2 * (wid & 1);
    const int jr = 16 * rb + (lane & 15), q4 = 4 * (lane >> 4);
    const f32x4 zero4 = {0.f, 0.f, 0.f, 0.f};
#pragma unroll
    for (int t = 0; t < 2; ++t) { const int cb = cb0 + t;
        f32x4 av = tile_s<2>(lds + G_QT + 16 * rb * RS, RS, lds + G_KT + 16 * cb * RS, RS, zero4, lane);
#pragma unroll
        for (int r = 0; r < 4; ++r) av[r] = (jr >= 16 * cb + q4 + r) ? av[r] : 0.f;
        st4bf(lds + G_AM + jr * RS + (16 * cb + q4) * 2, av); }
    __syncthreads();
    {
        bf16_t* O = (bf16_t*)(ws + (dir ? WS_OB : WS_OF));
        bf16_t* GNT = (bf16_t*)(ws + WS_GNT) + (size_t)item * 8192;
        const int cbz0 = 4 * (wid & 1);
        const int tok = tb + (dir ? t0 + 63 - jr : t0 + jr);
#pragma unroll
        for (int t = 0; t < 4; ++t) { const int cb = cbz0 + t;
            f32x4 zv = tile_s<2>(lds + G_AM + 16 * rb * RS, RS, lds + G_VT + 16 * cb * RS, RS, zero4, lane);
            st4bf_g(O + (size_t)tok * 512 + hd * 128 + 16 * cb + q4, zv);
            f32x4 nv = tile_n<2>(lds + G_KHT + 16 * rb * RS, RS, lds + G_VT + 16 * cb * RS, RS, zero4, lane);
            st4bf_g(GNT + (16 * cb + (lane & 15)) * 64 + 16 * rb + q4, nv); }
    }
    __syncthreads();
}

__device__ __forceinline__ void gla_chain(const Params& P, const int chain, const int lane) {
    const int qt = chain & 3, dir = (chain >> 2) & 1, hd = (chain >> 3) & 3, b = chain >> 5;
    unsigned char* ws = P.ws;
    const int r = lane & 31, hh = lane >> 5, tb = b * SEQ;
    bf16_t* O = (bf16_t*)(ws + (dir ? WS_OB : WS_OF));
    const int vcol = hd * 128 + 32 * qt + r;
    f32x16 X0, X1;
#pragma unroll
    for (int i = 0; i < 16; ++i) { X0[i] = 0.f; X1[i] = 0.f; }
    for (int st = 0; st < 64; ++st) {
        const int c = dir ? 63 - st : st, t0 = c * 64;
        const int item = ((b * 64 + c) * 4 + hd) * 2 + dir;
        const bf16_t* GQ = (const bf16_t*)(ws + WS_GQ) + (size_t)item * 4096; const bf16_t* GNT = (const bf16_t*)(ws + WS_GNT) + (size_t)item * 8192;
        const float* DEC = (const float*)(ws + WS_DEC) + (size_t)item * 64;
        const bf16x8 b00 = pack_step(X0, 0), b01 = pack_step(X0, 1), b10 = pack_step(X1, 0), b11 = pack_step(X1, 1);
        f32x16 Ov[2];
#pragma unroll
        for (int jb = 0; jb < 2; ++jb) {
#pragma unroll
            for (int i = 0; i < 16; ++i) { const int j = 32 * jb + (i & 3) + 8 * (i >> 2) + 4 * hh; const int tok = tb + (dir ? t0 + 63 - j : t0 + j);
                Ov[jb][i] = bf2f(O[(size_t)tok * 512 + vcol]); }
            const bf16_t* ap = GQ + (32 * jb + r) * 64 + 8 * hh;
            Ov[jb] = MFMA32(*(const bf16x8*)(ap + 0), b00, Ov[jb]);
            Ov[jb] = MFMA32(*(const bf16x8*)(ap + 16), b01, Ov[jb]);
            Ov[jb] = MFMA32(*(const bf16x8*)(ap + 32), b10, Ov[jb]);
            Ov[jb] = MFMA32(*(const bf16x8*)(ap + 48), b11, Ov[jb]);
#pragma unroll
            for (int i = 0; i < 16; ++i) { const int j = 32 * jb + (i & 3) + 8 * (i >> 2) + 4 * hh; const int tok = tb + (dir ? t0 + 63 - j : t0 + j);
                O[(size_t)tok * 512 + vcol] = (bf16_t)f2bf(Ov[jb][i]); }
        }
#pragma unroll
        for (int g = 0; g < 4; ++g) {
            const f32x4 d0 = *(const f32x4*)(DEC + 8 * g + 4 * hh), d1 = *(const f32x4*)(DEC + 32 + 8 * g + 4 * hh);
            const u32x2 n0 = *(const u32x2*)(GNT + (32 * qt + r) * 64 + 8 * g + 4 * hh), n1 = *(const u32x2*)(GNT + (32 * qt + r) * 64 + 32 + 8 * g + 4 * hh);
            X0[4 * g + 0] = d0.x * X0[4 * g + 0] + bf2f(n0.x & 0xffffu); X0[4 * g + 1] = d0.y * X0[4 * g + 1] + bf2f(n0.x >> 16);
            X0[4 * g + 2] = d0.z * X0[4 * g + 2] + bf2f(n0.y & 0xffffu); X0[4 * g + 3] = d0.w * X0[4 * g + 3] + bf2f(n0.y >> 16);
            X1[4 * g + 0] = d1.x * X1[4 * g + 0] + bf2f(n1.x & 0xffffu); X1[4 * g + 1] = d1.y * X1[4 * g + 1] + bf2f(n1.x >> 16);
            X1[4 * g + 2] = d1.z * X1[4 * g + 2] + bf2f(n1.y & 0xffffu); X1[4 * g + 3] = d1.w * X1[4 * g + 3] + bf2f(n1.y >> 16);
        }
    }
}

__device__ __forceinline__ void mix_token(const Params& P, const int tok, const int lane) {
    unsigned char* ws = P.ws;
    const bf16_t* YF = (const bf16_t*)(ws + WS_YF); const bf16_t* YB = (const bf16_t*)(ws + WS_YB);
    const bf16_t* GG = (const bf16_t*)(ws + WS_G); const bf16_t* VS = (const bf16_t*)(ws + WS_VS);
    const float* BON = (const float*)(ws + WS_BON);
    const bf16_t* OF = (const bf16_t*)(ws + WS_OF); const bf16_t* OB = (const bf16_t*)(ws + WS_OB);
    const bf16_t* PB = (const bf16_t*)(ws + WS_PB);
    bf16_t* MIX = (bf16_t*)(ws + WS_MIX);
    const size_t o512 = (size_t)tok * 512 + 8 * lane;
    {
        float a[8], bq[8], y[8];
        unpack8(*(const u32x4*)(YF + o512), a); unpack8(*(const u32x4*)(YB + o512), bq);
        float s = 0.f;
#pragma unroll
        for (int e = 0; e < 8; ++e) { y[e] = a[e] + bq[e]; s += y[e]; }
        s += __shfl_xor(s, 1); s += __shfl_xor(s, 2); s += __shfl_xor(s, 4);
        const float mean = s * (1.f / 64.f);
        float s2 = 0.f;
#pragma unroll
        for (int e = 0; e < 8; ++e) { y[e] -= mean; s2 += y[e] * y[e]; }
        s2 += __shfl_xor(s2, 1); s2 += __shfl_xor(s2, 2); s2 += __shfl_xor(s2, 4);
        const float rs = rsqrtf(s2 * (1.f / 64.f) + 64e-5f);
        const int h = lane >> 3;
        const float bon = BON[(size_t)tok * 8 + h] + BON[((size_t)NTOK + tok) * 8 + h];
        float g[8], vs[8], o[8];
        unpack8(*(const u32x4*)(GG + o512), g); unpack8(*(const u32x4*)(VS + o512), vs);
        const f32x4 w0 = *(const f32x4*)(P.ln_w + 8 * lane), w1 = *(const f32x4*)(P.ln_w + 8 * lane + 4);
        const f32x4 c0 = *(const f32x4*)(P.ln_b + 8 * lane), c1 = *(const f32x4*)(P.ln_b + 8 * lane + 4);
        const float lw[8] = {w0.x, w0.y, w0.z, w0.w, w1.x, w1.y, w1.z, w1.w}, lb[8] = {c0.x, c0.y, c0.z, c0.w, c1.x, c1.y, c1.z, c1.w};
#pragma unroll
        for (int e = 0; e < 8; ++e) o[e] = (y[e] * rs * lw[e] + lb[e] + bon * vs[e]) * g[e];
        *(u32x4*)(MIX + (size_t)tok * 1024 + 8 * lane) = pack8(o);
    }
    {
        float a[8], bq[8], y[8], og[8], o[8];
        unpack8(*(const u32x4*)(OF + o512), a); unpack8(*(const u32x4*)(OB + o512), bq);
        float s2 = 0.f;
#pragma unroll
        for (int e = 0; e < 8; ++e) { y[e] = a[e] + bq[e]; s2 += y[e] * y[e]; }
        s2 += __shfl_xor(s2, 1); s2 += __shfl_xor(s2, 2); s2 += __shfl_xor(s2, 4); s2 += __shfl_xor(s2, 8);
        const float rs = rsqrtf(s2 * (1.f / 128.f) + 1e-6f);
        unpack8(*(const u32x4*)(PB + (size_t)tok * LDB_GL + 1056 + 8 * lane), og);
        const f32x4 w0 = *(const f32x4*)(P.gnorm_w + 8 * lane), w1 = *(const f32x4*)(P.gnorm_w + 8 * lane + 4);
        const float nw[8] = {w0.x, w0.y, w0.z, w0.w, w1.x, w1.y, w1.z, w1.w};
#pragma unroll
        for (int e = 0; e < 8; ++e) o[e] = y[e] * rs * nw[e] * (og[e] * sigmoidf_(og[e]));
        *(u32x4*)(MIX + (size_t)tok * 1024 + 512 + 8 * lane) = pack8(o);
    }
}

__device__ __forceinline__ void p5b_convert(const Params& P, const Ctx& F) {
    LAS float* scr = (LAS float*)(F.lds + F.wid * 16384);
    const int gw = F.vcu * 8 + F.wid, NGW = F.G * 8;
    bf16_t* WGU = (bf16_t*)(P.ws + WS_WGU); bf16_t* WDN = (bf16_t*)(P.ws + WS_WDN);
    for (int it = gw; it < NEXP * 768; it += NGW) {
        const int e = it / 768, r = it % 768;
        if (r < 512) { const int up = r >> 8, q = r & 255, kb = q >> 4, nb = q & 15, n0 = 32 * nb;
            const float* src = (up ? P.w_up : P.w_gate) + (size_t)e * 1024 * 512;
            const int drow0 = 256 * (n0 >> 7) + (n0 & 127) + 128 * up;
            transpose_block(src, 512, WGU + (size_t)e * 1024 * 1024, 1024, drow0, 64 * kb, n0, scr, F.lane);
        } else { const int q = r - 512, kb = q >> 5, nb = q & 31;
            transpose_block(P.w_down + (size_t)e * 512 * 1024, 1024, WDN + (size_t)e * 1024 * 512, 512, 32 * nb, 64 * kb, 32 * nb, scr, F.lane); }
    }
}

__device__ __forceinline__ void p6_router(const Params& P, const Ctx& F) {
    ldsp_t lds = F.lds; const int lane = F.lane;
    for (int i = F.tid; i < 1024 * 36; i += 512) { const int k = i / 36, cc = i % 36;
        *(LAS float*)(lds + i * 4) = cc < 4 ? P.w_coarse[k * 4 + cc] : P.w_fine[k * 32 + cc - 4]; }
    __syncthreads();
    const int gw = F.vcu * 8 + F.wid, NGW = F.G * 8;
    unsigned* CNT = (unsigned*)(P.ws + WS_CTL) + CW_CNT;
    int* ELIST = (int*)(P.ws + WS_ELIST); float* ELW = (float*)(P.ws + WS_ELW);
    bf16_t* H2 = (bf16_t*)(P.ws + WS_H2);
    for (int tok = gw; tok < NTOK; tok += NGW) {
        const f32x4* xr = (const f32x4*)(P.out + (size_t)tok * 1024) + lane; const f32x4* wr = (const f32x4*)P.ln2_w + lane;
        f32x4 v[4]; float s = 0.f;
#pragma unroll
        for (int j = 0; j < 4; ++j) { v[j] = xr[64 * j]; s += (v[j].x * v[j].x + v[j].y * v[j].y) + (v[j].z * v[j].z + v[j].w * v[j].w); }
        const float inv = rsqrtf(wave_sum(s) * (1.f / 1024.f) + 1e-6f);
        u32x2* o8 = (u32x2*)(H2 + (size_t)tok * 1024) + lane;
        float acc[36];
#pragma unroll
        for (int cc = 0; cc < 36; ++cc) acc[cc] = 0.f;
#pragma unroll
        for (int j = 0; j < 4; ++j) { const f32x4 g = wr[64 * j];
            u32x2 o; o.x = pk2(v[j].x * inv * g.x, v[j].y * inv * g.y); o.y = pk2(v[j].z * inv * g.z, v[j].w * inv * g.w); o8[64 * j] = o; }
        {
            const float* xs = P.out + (size_t)tok * 1024;
#pragma unroll 1
            for (int kk = 0; kk < 16; ++kk) { const int k = 256 * (kk >> 2) + 4 * lane + (kk & 3);
                const float hvk = xs[k] * inv * P.ln2_w[k];
                const LAS f32x4* wl = (const LAS f32x4*)(lds + k * 144);
#pragma unroll
                for (int c4 = 0; c4 < 9; ++c4) { const f32x4 w = wl[c4]; acc[4 * c4 + 0] += hvk * w.x; acc[4 * c4 + 1] += hvk * w.y; acc[4 * c4 + 2] += hvk * w.z; acc[4 * c4 + 3] += hvk * w.w; } }
        }
#pragma unroll
        for (int cc = 0; cc < 36; ++cc) acc[cc] = wave_sum(acc[cc]);
        float cl[4];
#pragma unroll
        for (int i = 0; i < 4; ++i) cl[i] = acc[i] + P.b_coarse[i];
        int g = 0; float cm = cl[0];
#pragma unroll
        for (int i = 1; i < 4; ++i) if (cl[i] > cm) { cm = cl[i]; g = i; }
        float cs = 0.f;
#pragma unroll
        for (int i = 0; i < 4; ++i) cs += __expf(cl[i] - cm);
        const float pg = 1.f / cs;
        float fl[8];
#pragma unroll
        for (int i = 0; i < 8; ++i) { const float f0 = acc[4 + i], f1 = acc[12 + i], f2 = acc[20 + i], f3 = acc[28 + i];
            fl[i] = (g == 0 ? f0 : g == 1 ? f1 : g == 2 ? f2 : f3) + P.b_fine[8 * g + i]; }
        int i1 = 0; float m1 = fl[0];
#pragma unroll
        for (int i = 1; i < 8; ++i) if (fl[i] > m1) { m1 = fl[i]; i1 = i; }
        int i2 = -1; float m2 = -3.0e38f;
#pragma unroll
        for (int i = 0; i < 8; ++i) if (i != i1 && fl[i] > m2) { m2 = fl[i]; i2 = i; }
        const float e2 = __expf(m2 - m1);
        const float c1 = pg / (1.f + e2), c2 = pg * e2 / (1.f + e2);
        if (lane == 0) {
            const int ea = 8 * g + i1, eb = 8 * g + i2;
            const unsigned sa = atomicAdd(&CNT[64 * ea], 1u); ELIST[(size_t)ea * NTOK + sa] = tok * 2; ELW[(size_t)ea * NTOK + sa] = c1;
            const unsigned sb = atomicAdd(&CNT[64 * eb], 1u); ELIST[(size_t)eb * NTOK + sb] = tok * 2 + 1; ELW[(size_t)eb * NTOK + sb] = c2;
        }
    }
}

__device__ __forceinline__ void build_group_tables(const Params& P, const Ctx& F) {
    LAS int* tab = (LAS int*)(F.lds + LDS_TAB);
    if (F.tid < 32) tab[F.tid] = (int)__hip_atomic_load((unsigned*)(P.ws + WS_CTL) + CW_CNT + 64 * F.tid, __ATOMIC_RELAXED, __HIP_MEMORY_SCOPE_AGENT);
    __syncthreads();
    if (F.tid == 0) { int s = 0; for (int e = 0; e < 32; ++e) { tab[32 + e] = s; s += (tab[e] + 255) >> 8; } tab[64] = s; }
    __syncthreads();
}
struct GroupOrder {
    LAS const int* tab; const char* Abase; const char* Bbase; const int* elist;
    int G, c, K, gather;
    __device__ __forceinline__ bool next(int i, pg8::Unit& u) const {
        const int L = i * G + c, ntile = tab[64];
        if (L >= ntile * 4) return false;
        const int mg = L >> 2; u.pn = L & 3;
        int e = 0;
#pragma unroll 1
        for (int q = 1; q < 32; ++q) e = (tab[32 + q] <= mg) ? q : e;
        u.e = e; u.mt = mg - tab[32 + e]; u.pm = mg;
        u.a = gather ? Abase : Abase + (size_t)mg * 256 * K * 2;
        u.b = Bbase + ((size_t)e * 1024 + 256 * u.pn) * K * 2;
        return true;
    }
    __device__ __forceinline__ void rows(const pg8::Unit& u, int R0, int R1, unsigned& r0, unsigned& r1) const {
        const int cnt = tab[u.e]; const int p0 = 256 * u.mt + R0, p1 = 256 * u.mt + R1;
        const int* el = elist + (size_t)u.e * NTOK;
        r0 = p0 < cnt ? (unsigned)(el[p0] >> 1) : 0u; r1 = p1 < cnt ? (unsigned)(el[p1] >> 1) : 0u;
    }
};
struct EpiSwiGLU {
    static constexpr bool PERM = true;
    bf16_t* ACT;
    __device__ __forceinline__ void operator()(const f32x4 (&acc)[2][2][4][2], const pg8::Unit& u, int wr, int wc, int fr, int fq) const {
        const int row0 = u.pm * 256 + wr * 64 + fr, col0 = u.pn * 128 + wc * 32 + 8 * fq;
#pragma unroll
        for (int ai = 0; ai < 2; ++ai)
#pragma unroll
            for (int m = 0; m < 4; ++m) {
                float o[8];
#pragma unroll
                for (int n = 0; n < 2; ++n)
#pragma unroll
                    for (int q = 0; q < 4; ++q) { const float gt = acc[ai][0][m][n][q], up = acc[ai][1][m][n][q]; o[4 * n + q] = gt * sigmoidf_(gt) * up; }
                *(u32x4*)(ACT + (size_t)(row0 + ai * 128 + m * 16) * 512 + col0) = pack8(o);
            }
    }
};
struct EpiDown {
    static constexpr bool PERM = true;
    LAS const int* tab; const int* elist; const float* elw; bf16_t* YK0; bf16_t* YK1;
    __device__ __forceinline__ void operator()(const f32x4 (&acc)[2][2][4][2], const pg8::Unit& u, int wr, int wc, int fr, int fq) const {
        const int cnt = tab[u.e]; const int col0 = u.pn * 256 + wc * 32 + 8 * fq;
#pragma unroll
        for (int ai = 0; ai < 2; ++ai)
#pragma unroll
            for (int m = 0; m < 4; ++m) {
                const int pos = 256 * u.mt + ai * 128 + wr * 64 + m * 16 + fr;
                if (pos < cnt) {
                    const int en = elist[(size_t)u.e * NTOK + pos]; const float w = elw[(size_t)u.e * NTOK + pos];
                    bf16_t* rowp = ((en & 1) ? YK1 : YK0) + (size_t)(en >> 1) * 1024 + col0;
#pragma unroll
                    for (int bj = 0; bj < 2; ++bj) { const f32x4 v0 = acc[ai][bj][m][0], v1 = acc[ai][bj][m][1];
                        u32x4 o; o.x = pk2(v0[0] * w, v0[1] * w); o.y = pk2(v0[2] * w, v0[3] * w); o.z = pk2(v1[0] * w, v1[1] * w); o.w = pk2(v1[2] * w, v1[3] * w);
                        *(u32x4*)(rowp + bj * 128) = o; }
                }
            }
    }
};

__device__ __forceinline__ void final_token(const Params& P, const int tok, const int lane) {
    float* orow = P.out + (size_t)tok * 1024;
    const bf16_t* y0 = (const bf16_t*)(P.ws + WS_YK0) + (size_t)tok * 1024; const bf16_t* y1 = (const bf16_t*)(P.ws + WS_YK1) + (size_t)tok * 1024;
    f32x4 v[4]; float s = 0.f;
#pragma unroll
    for (int j = 0; j < 4; ++j) {
        v[j] = *((const f32x4*)orow + lane + 64 * j);
        const u32x2 a = *((const u32x2*)y0 + lane + 64 * j), b = *((const u32x2*)y1 + lane + 64 * j);
        v[j].x += bf2f(a.x & 0xffffu) + bf2f(b.x & 0xffffu); v[j].y += bf2f(a.x >> 16) + bf2f(b.x >> 16);
        v[j].z += bf2f(a.y & 0xffffu) + bf2f(b.y & 0xffffu); v[j].w += bf2f(a.y >> 16) + bf2f(b.y >> 16);
        s += (v[j].x * v[j].x + v[j].y * v[j].y) + (v[j].z * v[j].z + v[j].w * v[j].w);
    }
    const float inv = rsqrtf(wave_sum(s) * (1.f / 1024.f) + 1e-6f);
#pragma unroll
    for (int j = 0; j < 4; ++j) { const f32x4 g = *((const f32x4*)P.ln_f_w + lane + 64 * j);
        f32x4 o; o.x = v[j].x * inv * g.x; o.y = v[j].y * inv * g.y; o.z = v[j].z * inv * g.z; o.w = v[j].w * inv * g.w;
        *((f32x4*)orow + lane + 64 * j) = o; }
}

__global__ void __launch_bounds__(512, 2) mk_fwd(Params P) {
    extern __shared__ __attribute__((aligned(16))) unsigned char lds_raw[];
    Ctx F;
    F.lds = (ldsp_t)lds_raw;
    F.tid = threadIdx.x; F.lane = F.tid & 63; F.wid = __builtin_amdgcn_readfirstlane(F.tid >> 6);
    F.G = gridDim.x; { const int bx = blockIdx.x; F.vcu = (F.G % 8 == 0) ? (bx % 8) * (F.G / 8) + bx / 8 : bx; }
    volatile LAS unsigned* MISC = (volatile LAS unsigned*)(F.lds + LDS_MISC);
    if (F.tid < 16) MISC[F.tid] = 0u;
    __syncthreads();
    unsigned* ctl = (unsigned*)(P.ws + WS_CTL);
    const int lo = P.ph_lo, hi = P.ph_hi;
    XcdBarrier bar; bar.bar = ctl + CW_BAR; bar.x = 0; bar.st = MISC;
    if (hi - lo > 1) bar = xcd_barrier_post(ctl + CW_BAR, MISC);
#ifndef PHASE_MASK
#define PHASE_MASK 0xFFFFF
#endif
#define IN(k) (((PHASE_MASK >> (k)) & 1) && lo <= (k) && (k) < hi)
#define SEAM(k) do { if (IN(k) && IN((k) + 1)) xcd_barrier(bar); } while (0)
    unsigned char* ws = P.ws;
    const int gw = F.vcu * 8 + F.wid, NGW = F.G * 8;

    if (IN(0)) { p0_prologue(P, F); }
    SEAM(0);
    if (IN(1)) {
        pg8::StaticOrder S; S.init(ws + WS_H, ws + WS_BT_RW, NTOK, 2048, 1024, F.G, (int)blockIdx.x);
        pg8::EpiBf16 E{(bf16_t*)P.out, LDA_RW};
        pg8::gemm_phase<pg8::EpiBf16, pg8::StaticOrder, false>(F.lds, 1024, S, E);
    }
    SEAM(1);
    if (IN(2)) { for (int it = F.vcu; it < 4096; it += F.G) rwkv_item(P, F, it); }
    SEAM(2);
    if (IN(3)) { if (F.wid == 0 && F.vcu < 128) rwkv_chain(P, F.vcu, F.lane); }
    SEAM(3);
    if (IN(4)) {
        pg8::StaticOrder S; S.init(ws + WS_H, ws + WS_BT_GL, NTOK, 1792, 1024, F.G, (int)blockIdx.x);
        pg8::EpiBf16 E{(bf16_t*)(ws + WS_PB), LDB_GL};
        pg8::gemm_phase<pg8::EpiBf16, pg8::StaticOrder, false>(F.lds, 1024, S, E);
    }
    SEAM(4);
    if (IN(5)) { for (int it = F.vcu; it < 2048; it += F.G) gla_item(P, F, it); }
    SEAM(5);
    if (IN(6)) { if (F.wid == 0 && F.vcu < 128) gla_chain(P, F.vcu, F.lane); }
    SEAM(6);
    if (IN(7)) { for (int tok = gw; tok < NTOK; tok += NGW) mix_token(P, tok, F.lane); }
    SEAM(7);
    if (IN(8)) {
        pg8::StaticOrder S; S.init(ws + WS_MIX, ws + WS_BT_OUT, NTOK, 1024, 1024, F.G, (int)blockIdx.x);
        pg8::EpiResF32 E{P.out, P.x, 1024};
        pg8::gemm_phase<pg8::EpiResF32, pg8::StaticOrder, false>(F.lds, 1024, S, E);
    }
    SEAM(8);
    if (IN(9)) { p5b_convert(P, F); }
    SEAM(9);
    if (IN(10)) { p6_router(P, F); }
    SEAM(10);
    if (IN(11)) {
        build_group_tables(P, F);
        GroupOrder S{(LAS const int*)(F.lds + LDS_TAB), (const char*)(ws + WS_H2), (const char*)(ws + WS_WGU), (const int*)(ws + WS_ELIST), F.G, (int)blockIdx.x, 1024, 1};
        EpiSwiGLU E{(bf16_t*)(ws + WS_ACT)};
        pg8::gemm_phase<EpiSwiGLU, GroupOrder, true>(F.lds, 1024, S, E);
    }
    SEAM(11);
    if (IN(12)) {
        build_group_tables(P, F);
        GroupOrder S{(LAS const int*)(F.lds + LDS_TAB), (const char*)(ws + WS_ACT), (const char*)(ws + WS_WDN), (const int*)(ws + WS_ELIST), F.G, (int)blockIdx.x, 512, 0};
        EpiDown E{(LAS const int*)(F.lds + LDS_TAB), (const int*)(ws + WS_ELIST), (const float*)(ws + WS_ELW), (bf16_t*)(ws + WS_YK0), (bf16_t*)(ws + WS_YK1)};
        pg8::gemm_phase<EpiDown, GroupOrder, false>(F.lds, 512, S, E);
    }
    SEAM(12);
    if (IN(13)) { for (int tok = gw; tok < NTOK; tok += NGW) final_token(P, tok, F.lane); }
#undef IN
#undef SEAM
}

extern "C" void kernel_launch(void* const* d_in, const int* in_sizes, int n_in, void* d_out, int out_size, void* d_ws, size_t ws_size, hipStream_t stream) {
    static int grid = 0;
    if (grid == 0) {
        if (n_in != 33 || out_size != NTOK * DM || ws_size < WS_END) { fprintf(stderr, "kernel_launch: unexpected problem (n_in %d, out %d, ws %zu, need %zu)\n", n_in, out_size, ws_size, (size_t)WS_END); grid = -1; return; }
        int dev = 0, cus = 0, per_cu = 0;
        if (hipGetDevice(&dev) != hipSuccess || hipDeviceGetAttribute(&cus, hipDeviceAttributeMultiprocessorCount, dev) != hipSuccess) { grid = -1; return; }
        if (hipFuncSetAttribute((const void*)mk_fwd, hipFuncAttributeMaxDynamicSharedMemorySize, LDS_BYTES) != hipSuccess) { fprintf(stderr, "kernel_launch: hipFuncSetAttribute failed\n"); grid = -1; return; }
        if (hipOccupancyMaxActiveBlocksPerMultiprocessor(&per_cu, (const void*)mk_fwd, 512, LDS_BYTES) != hipSuccess || per_cu < 1) fprintf(stderr, "kernel_launch: occupancy query says %d\n", per_cu);
        (void)hipGetLastError();
        grid = cus;
    }
    if (grid < 0) return;
    (void)hipMemsetAsync((char*)d_ws + WS_CTL, 0, CTL_ZERO_BYTES, stream);
    Params p{};
    const float* const* in = (const float* const*)d_in;
    p.x = in[0]; p.ln1_w = in[1]; p.w_in = in[2]; p.rw_mu = in[3];
    p.w0_f = in[4]; p.w2_f = in[5]; p.w0_b = in[6]; p.w2_b = in[7];
    p.a0_f = in[8]; p.a2_f = in[9]; p.a0_b = in[10]; p.a2_b = in[11];
    p.g2 = in[12]; p.k_k = in[13]; p.k_a = in[14]; p.r_k = in[15]; p.ln_w = in[16]; p.ln_b = in[17];
    p.gw2_f = in[18]; p.gb_f = in[19]; p.gw2_b = in[20]; p.gb_b = in[21]; p.gnorm_w = in[22];
    p.w_out = in[23]; p.ln2_w = in[24]; p.w_coarse = in[25]; p.b_coarse = in[26]; p.w_fine = in[27]; p.b_fine = in[28];
    p.w_gate = in[29]; p.w_up = in[30]; p.w_down = in[31]; p.ln_f_w = in[32];
    p.out = (float*)d_out; p.ws = (unsigned char*)d_ws;
#if MK_PER_PHASE
    for (int k = 0; k < NPH; ++k) { p.ph_lo = k; p.ph_hi = k + 1; hipLaunchKernelGGL(mk_fwd, dim3(grid), dim3(512), LDS_BYTES, stream, p); }
#else
    p.ph_lo = 0; p.ph_hi = NPH; hipLaunchKernelGGL(mk_fwd, dim3(grid), dim3(512), LDS_BYTES, stream, p);
#endif
}
```

```cpp
#include <hip/hip_runtime.h>
#include <cstdio>
#include <cstdint>

#ifndef MK_PER_PHASE
#define MK_PER_PHASE 0
#endif

#define LAS __attribute__((address_space(3)))
#define GAS __attribute__((address_space(1)))
typedef unsigned short bf16_t;
typedef short bf16x8 __attribute__((ext_vector_type(8)));
typedef float f32x4 __attribute__((ext_vector_type(4)));
typedef float f32x16 __attribute__((ext_vector_type(16)));
typedef unsigned u32x4 __attribute__((ext_vector_type(4)));
typedef unsigned u32x2 __attribute__((ext_vector_type(2)));
typedef LAS unsigned char* ldsp_t;

constexpr int NTOK = 16384, SEQ = 4096, DM = 1024;
constexpr int LDA_RW = 2048;
constexpr int LDB_GL = 1792;
constexpr int RW_COLS = 1920, GL_COLS = 1568;
constexpr int NEXP = 32, DEXP = 512;
constexpr int NPH = 13;

constexpr size_t MiB = 1u << 20;
constexpr size_t WS_CTL = 0, CTL_ZERO_BYTES = 64 * 1024;
constexpr size_t WS_LORA = 1 * MiB;
constexpr size_t WS_BT_RW = 2 * MiB, WS_BT_GL = 6 * MiB, WS_BT_OUT = 10 * MiB;
constexpr size_t WS_BON = 12 * MiB;
constexpr size_t WS_ELIST = 13 * MiB;
constexpr size_t WS_DEC = 15 * MiB;
constexpr size_t WS_H = 16 * MiB;
constexpr size_t WS_OF = 16 * MiB, WS_OB = 32 * MiB;
constexpr size_t WS_H2 = 16 * MiB;
constexpr size_t WS_RM = 48 * MiB, WS_RP = 80 * MiB, WS_RNT = 112 * MiB;
constexpr size_t WS_GQ = 48 * MiB, WS_GNT = 64 * MiB;
constexpr size_t WS_MIX = 48 * MiB;
constexpr size_t WS_YF = 144 * MiB, WS_YB = 160 * MiB, WS_G = 176 * MiB, WS_VS = 192 * MiB;
constexpr size_t WS_PB = 208 * MiB;
constexpr size_t WS_WGU = 80 * MiB, WS_WDN = 144 * MiB;
constexpr size_t WS_ACT = 176 * MiB;
constexpr size_t WS_YK0 = 48 * MiB, WS_YK1 = 216 * MiB;
constexpr size_t WS_ELW = 248 * MiB;
constexpr size_t WS_END = 264 * MiB;
constexpr int CW_CNT = 0;
constexpr int CW_BAR = 4096;

constexpr int LDS_BYTES = 160 * 1024;
constexpr int LDS_MISC = LDS_BYTES - 64;
constexpr int LDS_TAB = 131072;

__device__ __forceinline__ float bf2f(unsigned b) { return __uint_as_float(b << 16); }
__device__ __forceinline__ unsigned f2bf(float f) { unsigned u = __float_as_uint(f); return (u + 0x7fffu + ((u >> 16) & 1u)) >> 16; }
__device__ __forceinline__ unsigned pk2(float lo, float hi) { return f2bf(lo) | (f2bf(hi) << 16); }
__device__ __forceinline__ float wave_sum(float v) {
#pragma unroll
    for (int o = 1; o < 64; o <<= 1) v += __shfl_xor(v, o);
    return v;
}
template <int N> __device__ __forceinline__ void wave_sum_n(float (&v)[N]) {
#pragma unroll
    for (int o = 1; o < 64; o <<= 1) { float t[N];
#pragma unroll
        for (int i = 0; i < N; ++i) t[i] = __shfl_xor(v[i], o);
#pragma unroll
        for (int i = 0; i < N; ++i) v[i] += t[i]; }
}
__device__ __forceinline__ float sigmoidf_(float x) { return 1.f / (1.f + __expf(-x)); }
__device__ __forceinline__ float tanhf_(float x) { return 2.f / (1.f + __expf(-2.f * x)) - 1.f; }
__device__ __forceinline__ void unpack8(const u32x4& v, float (&o)[8]) {
    o[0] = bf2f(v.x & 0xffffu); o[1] = bf2f(v.x >> 16); o[2] = bf2f(v.y & 0xffffu); o[3] = bf2f(v.y >> 16);
    o[4] = bf2f(v.z & 0xffffu); o[5] = bf2f(v.z >> 16); o[6] = bf2f(v.w & 0xffffu); o[7] = bf2f(v.w >> 16);
}
__device__ __forceinline__ u32x4 pack8(const float (&o)[8]) {
    u32x4 v; v.x = pk2(o[0], o[1]); v.y = pk2(o[2], o[3]); v.z = pk2(o[4], o[5]); v.w = pk2(o[6], o[7]); return v;
}

#define XB_TMO      128
#define XB_XCNT(j)  (256  + 64 * (j))
#define XB_XSUB(j)  (1280 + 64 * (j))
#define XB_XGEN(j)  (2304 + 64 * (j))
#define XB_TOP      3328
#define XB_TOPGEN   3392
#define XCD_BAR_WORDS 3456
#define XB_SPIN_CAP (1u << 18)
__device__ __forceinline__ unsigned xb_ld(unsigned* p)              { return __hip_atomic_load(p, __ATOMIC_RELAXED, __HIP_MEMORY_SCOPE_AGENT); }
__device__ __forceinline__ unsigned xb_add(unsigned* p, unsigned v) { return __hip_atomic_fetch_add(p, v, __ATOMIC_RELAXED, __HIP_MEMORY_SCOPE_AGENT); }
__device__ __forceinline__ unsigned xb_xcc_id() { return (unsigned)__builtin_amdgcn_s_getreg((3 << 11) | 20) & 0xFu; }
#define XB_SPIN(cond, bar) do { unsigned _sp = 0; while (cond) { __builtin_amdgcn_s_sleep(1); \
    if ((++_sp & 255u) == 0u) { if (xb_ld(&(bar)[XB_TMO])) break; if (_sp > XB_SPIN_CAP) { atomicAdd(&(bar)[XB_TMO], 1u); break; } } } } while (0)
struct XcdBarrier { unsigned* bar; unsigned x; volatile LAS unsigned* st; };
__device__ __forceinline__ XcdBarrier xcd_barrier_post(unsigned* bar, volatile LAS unsigned* st) {
    XcdBarrier b; b.bar = bar; b.x = xb_xcc_id(); b.st = st;
    if (threadIdx.x == 0) (void)xb_add(&bar[XB_XCNT(b.x)], 1u);
    return b;
}
__device__ __forceinline__ void xcd_barrier_complete(unsigned* bar, unsigned x, unsigned& nloc, unsigned& nx) {
    const unsigned G = gridDim.x * gridDim.y * gridDim.z;
    unsigned sum, cnt, mine, sp = 0u;
    for (;;) {
        sum = 0u; cnt = 0u; mine = 0u;
#pragma unroll
        for (unsigned j = 0; j < 16; ++j) { const unsigned c = xb_ld(&bar[XB_XCNT(j)]); sum += c; cnt += (c > 0u) ? 1u : 0u; mine = (j == x) ? c : mine; }
        if (sum == G) break;
        __builtin_amdgcn_s_sleep(1);
        if ((++sp & 255u) == 0u) { if (xb_ld(&bar[XB_TMO])) break; if (sp > XB_SPIN_CAP) { atomicAdd(&bar[XB_TMO], 1u); break; } }
    }
    nloc = mine > 0u ? mine : 1u; nx = cnt > 0u ? cnt : 1u;
}
__device__ __forceinline__ void xcd_barrier(const XcdBarrier& b) {
    asm volatile("s_waitcnt vmcnt(0)" ::: "memory");
    __syncthreads();
    if (threadIdx.x == 0) {
        unsigned* bar = b.bar;
        __builtin_amdgcn_s_waitcnt(0);
        unsigned nloc = b.st[0], nx = b.st[1];
        if (nloc == 0u) { xcd_barrier_complete(bar, b.x, nloc, nx); b.st[0] = nloc; b.st[1] = nx; }
        const unsigned old = xb_add(&bar[XB_XSUB(b.x)], 1u);
        const unsigned gen = old / nloc;
        if (old + 1u == (gen + 1u) * nloc) {
            __builtin_amdgcn_fence(__ATOMIC_RELEASE, "agent");
            asm volatile("s_waitcnt vmcnt(0)" ::: "memory");
            const unsigned og = xb_add(&bar[XB_TOP], 1u);
            const unsigned tg = og / nx;
            if (og + 1u == (tg + 1u) * nx) xb_add(&bar[XB_TOPGEN], 1u);
            else XB_SPIN(xb_ld(&bar[XB_TOPGEN]) == tg, bar);
            __builtin_amdgcn_fence(__ATOMIC_ACQUIRE, "agent");
            xb_add(&bar[XB_XGEN(b.x)], 1u);
            asm volatile("s_waitcnt vmcnt(0)" ::: "memory");
        } else {
            XB_SPIN(xb_ld(&bar[XB_XGEN(b.x)]) == gen, bar);
            __builtin_amdgcn_fence(__ATOMIC_ACQUIRE, "agent");
            asm volatile("s_waitcnt vmcnt(0)" ::: "memory");
        }
    }
    __syncthreads();
}

struct Params {
    const float* x; const float* ln1_w; const float* w_in; const float* rw_mu;
    const float* w0_f; const float* w2_f; const float* w0_b; const float* w2_b;
    const float* a0_f; const float* a2_f; const float* a0_b; const float* a2_b;
    const float* g2; const float* k_k; const float* k_a; const float* r_k; const float* ln_w; const float* ln_b;
    const float* gw2_f; const float* gb_f; const float* gw2_b; const float* gb_b; const float* gnorm_w;
    const float* w_out; const float* ln2_w; const float* w_coarse; const float* b_coarse; const float* w_fine; const float* b_fine;
    const float* w_gate; const float* w_up; const float* w_down; const float* ln_f_w;
    float* out; unsigned char* ws;
    int ph_lo, ph_hi;
};

namespace pg8 {
constexpr int BM = 256, BK = 64, HALF = 128, HTB = HALF * BK * 2, STAGE_BYTES = 8 * HTB, NXCD = 8, WGM = 8;
__host__ __device__ __forceinline__ int lds_byte(int r, int c) { const int st = (r >> 4) * 2 + (c >> 5), rr = r & 15, cc = c & 31, ob = rr * 64 + cc * 2; return st * 1024 + (ob ^ (((ob >> 9) & 1) << 5)); }
__host__ __device__ __forceinline__ void stage_rc(int b, int& R, int& C) { const int st = b / 1024, sb = b % 1024, swz = sb ^ (((sb >> 9) & 1) << 5); R = (st >> 1) * 16 + swz / 64; C = (st & 1) * 32 + (swz % 64) / 2; }
__host__ __device__ __forceinline__ int perm32(int rho) { const int n = rho >> 4, i = rho & 15; return 8 * (i >> 2) + 4 * n + (i & 3); }

struct Unit { const char* a; const char* b; int pm, pn, e, mt; };

struct StaticOrder {
    const char* A; const char* Bt; int K;
    int nM, nN, nwg, G, c;
    __device__ void init(const void* A_, const void* Bt_, int M, int N, int K_, int G_, int c_) { A = (const char*)A_; Bt = (const char*)Bt_; K = K_; nM = M / BM; nN = N / BM; nwg = nM * nN; G = G_; c = c_; }
    __device__ __forceinline__ bool next(int i, Unit& u) const {
        const long L = (long)i * G + c; if (L >= nwg) return false;
        int wgid = (int)L; { const int q = nwg / NXCD, r = nwg % NXCD, xcd = wgid % NXCD, off = wgid / NXCD; wgid = (xcd < r ? xcd * (q + 1) : r * (q + 1) + (xcd - r) * q) + off; }
        const int nig = WGM * nN, gid = wgid / nig, fm = gid * WGM, gsz = (nM - fm) < WGM ? (nM - fm) : WGM;
        u.pm = fm + ((wgid % nig) % gsz); u.pn = (wgid % nig) / gsz; u.e = 0; u.mt = 0;
        u.a = A + (size_t)u.pm * 256 * K * 2; u.b = Bt + (size_t)u.pn * 256 * K * 2; return true;
    }
    __device__ __forceinline__ void rows(const Unit&, int, int, unsigned&, unsigned&) const {}
};

template <class Epi, class Sched, bool GATHER>
__device__ __forceinline__ void gemm_phase(ldsp_t lds, const int K, const Sched& S, const Epi& E) {
    const int tid = threadIdx.x, wid = __builtin_amdgcn_readfirstlane(tid >> 6), lane = tid & 63, wr = wid >> 2, wc = wid & 3, fr = lane & 15, fq = lane >> 4;
    const int nt = K / BK;
    unsigned voffA[2], voffB[2]; int RA[2], CA[2];
#pragma unroll
    for (int i = 0; i < 2; ++i) { int R, C; stage_rc(tid * 16 + i * 8192, R, C); const int Rb = Epi::PERM ? ((R & ~31) + perm32(R & 31)) : R;
        RA[i] = R; CA[i] = C; voffA[i] = (unsigned)(R * K + C) * 2u; voffB[i] = (unsigned)(Rb * K + C) * 2u; }
    const size_t kstep = (size_t)(BK * 2);
    const unsigned hstep = (unsigned)HALF * K * 2;
    const unsigned ldsw = (unsigned)wid * 1024u;
    const int aoff = lds_byte(wr * 64 + fr, fq * 8), boff = lds_byte(wc * 32 + fr, fq * 8);
#define PG8_SA(b, h) (((b) * 2 + (h)) * HTB)
#define PG8_SB(b, h) ((4 + (b) * 2 + (h)) * HTB)
#define PG8_STAGE2(bufoff, gbase, v0, v1) do { \
        __builtin_amdgcn_global_load_lds((const unsigned*)((const char*)(gbase) + (v0)), (LAS unsigned*)(lds + (bufoff) + ldsw), 16, 0, 0); \
        __builtin_amdgcn_global_load_lds((const unsigned*)((const char*)(gbase) + (v1)), (LAS unsigned*)(lds + (bufoff) + ldsw + 8192), 16, 0, 0); } while (0)
#define PG8_STAGEB(bufoff, gbase) PG8_STAGE2(bufoff, gbase, voffB[0], voffB[1])
#define PG8_LDA(dst, b, h) do { _Pragma("unroll") for (int m = 0; m < 4; ++m) _Pragma("unroll") for (int k = 0; k < 2; ++k) dst[m][k] = *(const LAS bf16x8*)(lds + PG8_SA(b, h) + aoff + m * 2048 + k * 1024); } while (0)
#define PG8_LDB(dst, b, h) do { _Pragma("unroll") for (int n = 0; n < 2; ++n) _Pragma("unroll") for (int k = 0; k < 2; ++k) dst[n][k] = *(const LAS bf16x8*)(lds + PG8_SB(b, h) + boff + n * 2048 + k * 1024); } while (0)
#define PG8_MMA(ai, bj, At, Bt) do { __builtin_amdgcn_s_setprio(1); _Pragma("unroll") for (int m = 0; m < 4; ++m) _Pragma("unroll") for (int n = 0; n < 2; ++n) _Pragma("unroll") for (int k = 0; k < 2; ++k) \
        acc[ai][bj][m][n] = __builtin_amdgcn_mfma_f32_16x16x32_bf16(Bt[n][k], At[m][k], acc[ai][bj][m][n], 0, 0, 0); __builtin_amdgcn_s_setprio(0); } while (0)
#define PG8_WAIT_V(n) asm volatile("s_waitcnt vmcnt(" #n ")" ::: "memory")
#define PG8_WAIT_L(n) asm volatile("s_waitcnt lgkmcnt(" #n ")" ::: "memory")
#define PG8_BAR __builtin_amdgcn_s_barrier()
#define PG8_SCHED __builtin_amdgcn_sched_barrier(0)
    Unit cur, nxt; int ui = 0;
    if (!S.next(0, cur)) return;
    f32x4 acc[2][2][4][2];
#pragma unroll
    for (int a = 0; a < 2; ++a)
#pragma unroll
        for (int b = 0; b < 2; ++b)
#pragma unroll
            for (int m = 0; m < 4; ++m)
#pragma unroll
                for (int n = 0; n < 2; ++n) acc[a][b][m][n] = (f32x4){0.f, 0.f, 0.f, 0.f};
    bf16x8 At[4][2], B0[2][2], B1[2][2];
    unsigned oc0[2], oc1[2], on0[2], on1[2];
    if constexpr (GATHER) {
#pragma unroll
        for (int i = 0; i < 2; ++i) { unsigned r0, r1; S.rows(cur, RA[i], RA[i] + 128, r0, r1); oc0[i] = r0 * (unsigned)(K * 2) + (unsigned)CA[i] * 2u; oc1[i] = r1 * (unsigned)(K * 2) + (unsigned)CA[i] * 2u; on0[i] = oc0[i]; on1[i] = oc1[i]; }
    } else {
#pragma unroll
        for (int i = 0; i < 2; ++i) { oc0[i] = voffA[i]; oc1[i] = voffA[i] + hstep; on0[i] = oc0[i]; on1[i] = oc1[i]; }
    }
    const char* cA = cur.a; const char* cB = cur.b;
    PG8_STAGEB(PG8_SB(0, 0), cB); PG8_STAGE2(PG8_SA(0, 0), cA, oc0[0], oc0[1]); PG8_STAGEB(PG8_SB(0, 1), cB + hstep); PG8_STAGE2(PG8_SA(0, 1), cA, oc1[0], oc1[1]);
    if (wr == 1) PG8_BAR;
    PG8_WAIT_V(4); PG8_BAR;
    PG8_STAGEB(PG8_SB(1, 0), cB + kstep); PG8_STAGE2(PG8_SA(1, 0), cA + kstep, oc0[0], oc0[1]); PG8_STAGEB(PG8_SB(1, 1), cB + hstep + kstep);
    PG8_WAIT_V(6); PG8_BAR;
    for (;;) {
        const bool has_next = S.next(ui + 1, nxt);
        const char* nA = has_next ? nxt.a : cA; const char* nB = has_next ? nxt.b : cB;
        if constexpr (GATHER) {
            if (has_next) {
#pragma unroll
                for (int i = 0; i < 2; ++i) { unsigned r0, r1; S.rows(nxt, RA[i], RA[i] + 128, r0, r1); on0[i] = r0 * (unsigned)(K * 2) + (unsigned)CA[i] * 2u; on1[i] = r1 * (unsigned)(K * 2) + (unsigned)CA[i] * 2u; }
            } else {
#pragma unroll
                for (int i = 0; i < 2; ++i) { on0[i] = oc0[i]; on1[i] = oc1[i]; }
            }
        }
        for (int t = 0; t < nt; t += 2) {
            const bool last = (t == nt - 2);
            const char* a1 = cA + (size_t)(t + 1) * kstep;
            const char* a2 = last ? nA : cA + (size_t)(t + 2) * kstep; const char* b2 = last ? nB : cB + (size_t)(t + 2) * kstep;
            const char* a3 = a2 + kstep; const char* b3 = b2 + kstep;
            unsigned p00, p01, p10, p11;
            if constexpr (GATHER) { p00 = last ? on0[0] : oc0[0]; p01 = last ? on0[1] : oc0[1]; p10 = last ? on1[0] : oc1[0]; p11 = last ? on1[1] : oc1[1]; }
            else { p00 = oc0[0]; p01 = oc0[1]; p10 = oc1[0]; p11 = oc1[1]; }
            PG8_LDB(B0, 0, 0); PG8_SCHED; PG8_LDA(At, 0, 0); PG8_STAGE2(PG8_SA(1, 1), a1, oc1[0], oc1[1]);
            PG8_WAIT_L(8); PG8_BAR; PG8_WAIT_L(0); PG8_MMA(0, 0, At, B0); PG8_BAR; PG8_SCHED;
            PG8_LDB(B1, 0, 1); PG8_STAGEB(PG8_SB(0, 0), b2);
            PG8_BAR; PG8_WAIT_L(0); PG8_MMA(0, 1, At, B1); PG8_BAR;
            PG8_LDA(At, 0, 1); PG8_STAGE2(PG8_SA(0, 0), a2, p00, p01);
            PG8_BAR; PG8_WAIT_L(0); PG8_MMA(1, 0, At, B0); PG8_BAR; PG8_SCHED;
            PG8_STAGEB(PG8_SB(0, 1), b2 + hstep);
            PG8_WAIT_V(6); PG8_BAR; PG8_MMA(1, 1, At, B1); PG8_BAR;
            PG8_LDB(B0, 1, 0); PG8_SCHED; PG8_LDA(At, 1, 0); PG8_STAGE2(PG8_SA(0, 1), a2, p10, p11);
            PG8_WAIT_L(8); PG8_BAR; PG8_WAIT_L(0); PG8_MMA(0, 0, At, B0); PG8_BAR; PG8_SCHED;
            PG8_LDB(B1, 1, 1); PG8_STAGEB(PG8_SB(1, 0), b3);
            PG8_BAR; PG8_WAIT_L(0); PG8_MMA(0, 1, At, B1); PG8_BAR;
            PG8_LDA(At, 1, 1); PG8_STAGE2(PG8_SA(1, 0), a3, p00, p01);
            PG8_BAR; PG8_WAIT_L(0); PG8_MMA(1, 0, At, B0); PG8_BAR; PG8_SCHED;
            PG8_STAGEB(PG8_SB(1, 1), b3 + hstep);
            PG8_WAIT_V(6); PG8_BAR; PG8_MMA(1, 1, At, B1); PG8_BAR;
        }
        E(acc, cur, wr, wc, fr, fq);
        if (!has_next) break;
#pragma unroll
        for (int a = 0; a < 2; ++a)
#pragma unroll
            for (int b = 0; b < 2; ++b)
#pragma unroll
                for (int m = 0; m < 4; ++m)
#pragma unroll
                    for (int n = 0; n < 2; ++n) acc[a][b][m][n] = (f32x4){0.f, 0.f, 0.f, 0.f};
        cur = nxt; cA = nA; cB = nB; ++ui;
#pragma unroll
        for (int i = 0; i < 2; ++i) { oc0[i] = on0[i]; oc1[i] = on1[i]; }
    }
    PG8_WAIT_V(0);
    if (wr == 0) PG8_BAR;
    PG8_BAR;
#undef PG8_SA
#undef PG8_SB
#undef PG8_STAGE2
#undef PG8_STAGEB
#undef PG8_LDA
#undef PG8_LDB
#undef PG8_MMA
#undef PG8_WAIT_V
#undef PG8_WAIT_L
#undef PG8_BAR
#undef PG8_SCHED
}

struct EpiBf16 {
    static constexpr bool PERM = true;
    bf16_t* O; int ldc;
    __device__ __forceinline__ void operator()(const f32x4 (&acc)[2][2][4][2], const Unit& u, int wr, int wc, int fr, int fq) const {
        const int row0 = u.pm * BM + wr * 64 + fr, col0 = u.pn * BM + wc * 32 + 8 * fq;
#pragma unroll
        for (int ai = 0; ai < 2; ++ai)
#pragma unroll
            for (int m = 0; m < 4; ++m) { bf16_t* rowp = O + (size_t)(row0 + ai * HALF + m * 16) * ldc + col0;
#pragma unroll
                for (int bj = 0; bj < 2; ++bj) { const f32x4 v0 = acc[ai][bj][m][0], v1 = acc[ai][bj][m][1];
                    u32x4 o; o.x = pk2(v0[0], v0[1]); o.y = pk2(v0[2], v0[3]); o.z = pk2(v1[0], v1[1]); o.w = pk2(v1[2], v1[3]);
                    *(u32x4*)(rowp + bj * HALF) = o; } }
    }
};
struct EpiResF32 {
    static constexpr bool PERM = false;
    float* C; const float* X; int ldc;
    __device__ __forceinline__ void operator()(const f32x4 (&acc)[2][2][4][2], const Unit& u, int wr, int wc, int fr, int fq) const {
        const int row0 = u.pm * BM + wr * 64 + fr, col0 = u.pn * BM + wc * 32 + 4 * fq;
#pragma unroll
        for (int ai = 0; ai < 2; ++ai)
#pragma unroll
            for (int m = 0; m < 4; ++m) { const size_t ro = (size_t)(row0 + ai * HALF + m * 16) * ldc + col0;
#pragma unroll
                for (int bj = 0; bj < 2; ++bj)
#pragma unroll
                    for (int n = 0; n < 2; ++n) { const f32x4 xv = *(const f32x4*)(X + ro + bj * HALF + n * 16); *(f32x4*)(C + ro + bj * HALF + n * 16) = acc[ai][bj][m][n] + xv; } }
    }
};
}

template <int KS>
__device__ __forceinline__ f32x4 tile_n(const LAS unsigned char* A, int lda, const LAS unsigned char* Bt, int ldb, f32x4 acc, int lane) {
    const LAS unsigned char* ap = A + (lane & 15) * lda + (lane >> 4) * 16;
    const LAS unsigned char* bp = Bt + (lane & 15) * ldb + (lane >> 4) * 16;
#pragma unroll
    for (int k = 0; k < KS; ++k) { const bf16x8 a = *(const LAS bf16x8*)(ap + k * 64), b = *(const LAS bf16x8*)(bp + k * 64); acc = __builtin_amdgcn_mfma_f32_16x16x32_bf16(a, b, acc, 0, 0, 0); }
    return acc;
}
template <int KS>
__device__ __forceinline__ f32x4 tile_s(const LAS unsigned char* A, int lda, const LAS unsigned char* Bt, int ldb, f32x4 acc, int lane) {
    const LAS unsigned char* ap = A + (lane & 15) * lda + (lane >> 4) * 16;
    const LAS unsigned char* bp = Bt + (lane & 15) * ldb + (lane >> 4) * 16;
#pragma unroll
    for (int k = 0; k < KS; ++k) { const bf16x8 a = *(const LAS bf16x8*)(ap + k * 64), b = *(const LAS bf16x8*)(bp + k * 64); acc = __builtin_amdgcn_mfma_f32_16x16x32_bf16(b, a, acc, 0, 0, 0); }
    return acc;
}
__device__ __forceinline__ void st4bf(LAS unsigned char* p, const f32x4& v) { u32x2 o; o.x = pk2(v[0], v[1]); o.y = pk2(v[2], v[3]); *(LAS u32x2*)p = o; }
__device__ __forceinline__ void st4bf_g(bf16_t* p, const f32x4& v) { u32x2 o; o.x = pk2(v[0], v[1]); o.y = pk2(v[2], v[3]); *(u32x2*)p = o; }


struct Ctx { ldsp_t lds; int tid, lane, wid, vcu, G; };

__device__ __forceinline__ void transpose_block(const float* W, int N, bf16_t* WT, int ldk, int dst_row0, int k0, int n0, LAS float* scr, int lane) {
#pragma unroll 8
    for (int i = 0; i < 32; ++i) { const int kk = 2 * i + (lane >> 5); scr[kk * 33 + (lane & 31)] = W[(size_t)(k0 + kk) * N + n0 + (lane & 31)]; }
    asm volatile("s_waitcnt lgkmcnt(0)" ::: "memory");
    const int c = lane & 7;
#pragma unroll
    for (int j = 0; j < 4; ++j) { const int n = (lane >> 3) + 8 * j; const LAS float* s = scr + (8 * c) * 33 + n;
        u32x4 o; o.x = pk2(s[0 * 33], s[1 * 33]); o.y = pk2(s[2 * 33], s[3 * 33]); o.z = pk2(s[4 * 33], s[5 * 33]); o.w = pk2(s[6 * 33], s[7 * 33]);
        *(u32x4*)(WT + (size_t)(dst_row0 + n) * ldk + k0 + 8 * c) = o; }
    asm volatile("s_waitcnt lgkmcnt(0)" ::: "memory");
}
__device__ __forceinline__ void rms_row_to_bf16(const float* xrow, const float* w, bf16_t* orow, int lane) {
    const f32x4* xr = (const f32x4*)xrow + lane; const f32x4* wr = (const f32x4*)w + lane;
    f32x4 v[4]; float s = 0.f;
#pragma unroll
    for (int j = 0; j < 4; ++j) { v[j] = xr[64 * j]; s += (v[j].x * v[j].x + v[j].y * v[j].y) + (v[j].z * v[j].z + v[j].w * v[j].w); }
    const float inv = rsqrtf(wave_sum(s) * (1.f / 1024.f) + 1e-6f);
    u32x2* o8 = (u32x2*)orow + lane;
#pragma unroll
    for (int j = 0; j < 4; ++j) { const f32x4 g = wr[64 * j]; u32x2 o; o.x = pk2(v[j].x * inv * g.x, v[j].y * inv * g.y); o.y = pk2(v[j].z * inv * g.z, v[j].w * inv * g.w); o8[64 * j] = o; }
}
__device__ __forceinline__ void p0_prologue(const Params& P, const Ctx& F) {
    LAS float* scr = (LAS float*)(F.lds + F.wid * 16384);
    const int gw = F.vcu * 8 + F.wid, NGW = F.G * 8;
    unsigned char* ws = P.ws;
    bf16_t* BT_RW = (bf16_t*)(ws + WS_BT_RW); bf16_t* BT_GL = (bf16_t*)(ws + WS_BT_GL); bf16_t* BT_OUT = (bf16_t*)(ws + WS_BT_OUT);
    bf16_t* LORA = (bf16_t*)(ws + WS_LORA);
    constexpr int I_IN = 16 * 109, I_OUT = 16 * 32, I_L = 16, I_G = 32;
    constexpr int NITEMS = I_IN + I_OUT + 4 * I_L + I_G;
    for (int it = gw; it < NITEMS; it += NGW) {
        int r = it;
        if (r < I_IN) { const int kb = r / 109, nb = r % 109, n0 = 32 * nb;
            if (n0 < RW_COLS) transpose_block(P.w_in, 3488, BT_RW, 1024, n0, 64 * kb, n0, scr, F.lane);
            else transpose_block(P.w_in, 3488, BT_GL, 1024, n0 - RW_COLS, 64 * kb, n0, scr, F.lane);
            continue; }
        r -= I_IN;
        if (r < I_OUT) { const int kb = r / 32, nb = r % 32; transpose_block(P.w_out, 1024, BT_OUT, 1024, 32 * nb, 64 * kb, 32 * nb, scr, F.lane); continue; }
        r -= I_OUT;
        if (r < 4 * I_L) { const int which = r / I_L, nb = r % I_L;
            const float* src = which == 0 ? P.w2_f : which == 1 ? P.w2_b : which == 2 ? P.a2_f : P.a2_b;
            transpose_block(src, 512, LORA + (size_t)which * 32768, 64, 32 * nb, 0, 32 * nb, scr, F.lane); continue; }
        r -= 4 * I_L;
        { const int kb = r / 16, nb = r % 16; transpose_block(P.g2, 512, LORA + 4 * 32768, 128, 32 * nb, 64 * kb, 32 * nb, scr, F.lane); }
    }
    { const int gt = F.vcu * 512 + F.tid, NGT = F.G * 512; const u32x4 z = {0u, 0u, 0u, 0u};
      u32x4* p1 = (u32x4*)(BT_RW + (size_t)RW_COLS * 1024); for (int i = gt; i < (2048 - RW_COLS) * 128; i += NGT) p1[i] = z;
      u32x4* p2 = (u32x4*)(BT_GL + (size_t)GL_COLS * 1024); for (int i = gt; i < (1792 - GL_COLS) * 128; i += NGT) p2[i] = z; }
    bf16_t* H = (bf16_t*)(ws + WS_H);
    for (int m = gw; m < NTOK; m += NGW) rms_row_to_bf16(P.x + (size_t)m * 1024, P.ln1_w, H + (size_t)m * 1024, F.lane);
}

constexpr size_t OUT_GQ = 0, OUT_GNT = 16 * MiB;
constexpr int RS = 144;
constexpr int RMS_ = 64 * RS;
constexpr int L_AT = 0, L_BT = RMS_, L_KT = 2 * RMS_, L_RT = 3 * RMS_, L_ATT = 4 * RMS_, L_BHT = 5 * RMS_, L_KHT = 6 * RMS_, L_VT = 7 * RMS_;
constexpr int L_U1 = 8 * RMS_;
constexpr int L_TW = L_U1, L_AL = L_U1 + RMS_, L_SG = L_U1 + 2 * RMS_, L_LW = L_SG + 64 * 272, L_AA = L_LW + 16384;
constexpr int L_L0 = L_U1, L_LT0 = L_U1 + RMS_, L_L1 = L_U1 + 2 * RMS_, L_LT1 = L_U1 + 3 * RMS_, L_T0 = L_U1 + 4 * RMS_, L_T1 = L_U1 + 5 * RMS_,
              L_LAK = L_U1 + 6 * RMS_, L_RB = L_U1 + 7 * RMS_, L_RK = L_U1 + 8 * RMS_, L_WC = L_U1 + 9 * RMS_;
constexpr int L_XT = 0, L_G1T = 2 * RMS_;
static_assert(L_AA + 16384 <= L_WC && L_WC + 256 <= LDS_MISC, "rwkv LDS map");

__device__ __forceinline__ void rwkv_item(const Params& P, const Ctx& F, const int item) {
    const int tid = F.tid, lane = F.lane, wid = F.wid; ldsp_t lds = F.lds;
    const int dir = item & 1, h = (item >> 1) & 7, c = (item >> 4) & 63, b = item >> 10;
    const int t0 = c * 64, tb = b * SEQ;
    unsigned char* ws = P.ws;
    const bf16_t* PA = (const bf16_t*)P.out;
    const int hi = h * 64 + lane;

#pragma unroll
    for (int it = 0; it < 4; ++it) {
        const int q = tid + 512 * it, j = q >> 5, ch = q & 31;
        if (!(dir == 1 && ch >= 16)) {
            int col0, act; LAS unsigned char* dst;
            if (ch < 8) { col0 = 1536 + 64 * dir + 8 * ch; act = 0; dst = lds + L_TW + j * RS + ch * 16; }
            else if (ch < 16) { col0 = 1664 + 64 * dir + 8 * (ch - 8); act = 1; dst = lds + L_AL + j * RS + (ch - 8) * 16; }
            else { col0 = 1792 + 8 * (ch - 16); act = 2; dst = lds + L_SG + j * 272 + (ch - 16) * 16; }
            const int tn = dir ? t0 + 63 - j : t0 + j;
            const bf16_t* row = PA + (size_t)(tb + tn) * LDA_RW + col0;
            const u32x4 zc = {0u, 0u, 0u, 0u};
            const u32x4 xc = *(const u32x4*)row;
            const u32x4 xp = tn > 0 ? *(const u32x4*)(row - LDA_RW) : zc;
            const u32x4 xn = tn < SEQ - 1 ? *(const u32x4*)(row + LDA_RW) : zc;
            const f32x4 m0 = *(const f32x4*)(P.rw_mu + col0), m1 = *(const f32x4*)(P.rw_mu + col0 + 4);
            float fc[8], fp[8], fn[8], o[8]; unpack8(xc, fc); unpack8(xp, fp); unpack8(xn, fn);
            const float mu[8] = {m0.x, m0.y, m0.z, m0.w, m1.x, m1.y, m1.z, m1.w};
#pragma unroll
            for (int e = 0; e < 8; ++e) { const float v = fc[e] + mu[e] * (0.5f * (fp[e] + fn[e]) - fc[e]); o[e] = act == 0 ? tanhf_(v) : act == 1 ? v : sigmoidf_(v); }
            *(LAS u32x4*)dst = pack8(o);
        }
    }
    float rr[8], kr[8], vr[8];
    {
        const int jlo = 8 * wid;
        const int tlo = dir ? (t0 + 55 - jlo) : (t0 + jlo - 1);
        float raw_r[10], raw_k[10], raw_v[10];
#pragma unroll
        for (int q = 0; q < 10; ++q) { const int tn = tlo + q; const bool ok = (tn >= 0) && (tn < SEQ);
            const bf16_t* row = PA + (size_t)(tb + (ok ? tn : 0)) * LDA_RW + hi;
            raw_r[q] = ok ? bf2f(row[0]) : 0.f; raw_k[q] = ok ? bf2f(row[512]) : 0.f; raw_v[q] = ok ? bf2f(row[1024]) : 0.f; }
        const float mur = P.rw_mu[hi], muk = P.rw_mu[512 + hi], muv = P.rw_mu[1024 + hi];
#pragma unroll
        for (int jj = 0; jj < 8; ++jj) {
            const float cr = dir ? raw_r[8 - jj] : raw_r[1 + jj], pr = dir ? raw_r[7 - jj] : raw_r[jj], nr = dir ? raw_r[9 - jj] : raw_r[2 + jj];
            const float ck = dir ? raw_k[8 - jj] : raw_k[1 + jj], pk = dir ? raw_k[7 - jj] : raw_k[jj], nk = dir ? raw_k[9 - jj] : raw_k[2 + jj];
            const float cv = dir ? raw_v[8 - jj] : raw_v[1 + jj], pv = dir ? raw_v[7 - jj] : raw_v[jj], nv = dir ? raw_v[9 - jj] : raw_v[2 + jj];
            rr[jj] = cr + mur * (0.5f * (pr + nr) - cr); kr[jj] = ck + muk * (0.5f * (pk + nk) - ck); vr[jj] = cv + muv * (0.5f * (pv + nv) - cv);
        }
    }
    __syncthreads();
    {
        const int rb = wid >> 1, cb0 = 2 * (wid & 1);
        const bf16_t* LORA = (const bf16_t*)(ws + WS_LORA);
        const bf16_t* W2t = LORA + (size_t)dir * 32768;
        const bf16_t* A2t = LORA + (size_t)(2 + dir) * 32768;
        const bf16_t* G2t = LORA + (size_t)4 * 32768;
        const float* w0 = dir ? P.w0_b : P.w0_f; const float* a0 = dir ? P.a0_b : P.a0_f;
        bf16_t* Gout = (bf16_t*)(ws + WS_G);
#pragma unroll
        for (int t = 0; t < 2; ++t) {
            const int cb = cb0 + t, n = 16 * cb + (lane & 15), hn = h * 64 + n;
            f32x4 zw = {0.f, 0.f, 0.f, 0.f}, za = {0.f, 0.f, 0.f, 0.f};
            const LAS unsigned char* ap_w = lds + L_TW + (16 * rb + (lane & 15)) * RS + (lane >> 4) * 16;
            const LAS unsigned char* ap_a = lds + L_AL + (16 * rb + (lane & 15)) * RS + (lane >> 4) * 16;
#pragma unroll
            for (int kk = 0; kk < 2; ++kk) {
                const bf16x8 bw = *(const bf16x8*)(W2t + (size_t)hn * 64 + 8 * (lane >> 4) + 32 * kk);
                const bf16x8 ba = *(const bf16x8*)(A2t + (size_t)hn * 64 + 8 * (lane >> 4) + 32 * kk);
                zw = __builtin_amdgcn_mfma_f32_16x16x32_bf16(*(const LAS bf16x8*)(ap_w + kk * 64), bw, zw, 0, 0, 0);
                za = __builtin_amdgcn_mfma_f32_16x16x32_bf16(*(const LAS bf16x8*)(ap_a + kk * 64), ba, za, 0, 0, 0);
            }
            const float w0v = w0[hn], a0v = a0[hn];
#pragma unroll
            for (int r = 0; r < 4; ++r) { const int j = 16 * rb + 4 * (lane >> 4) + r;
                *(LAS float*)(lds + L_LW + (j * 64 + n) * 4) = -0.60653066f * sigmoidf_(w0v + zw[r]);
                *(LAS float*)(lds + L_AA + (j * 64 + n) * 4) = sigmoidf_(a0v + za[r]); }
            if (dir == 0) {
                f32x4 zg = {0.f, 0.f, 0.f, 0.f};
                const LAS unsigned char* ap_g = lds + L_SG + (16 * rb + (lane & 15)) * 272 + (lane >> 4) * 16;
#pragma unroll
                for (int kk = 0; kk < 4; ++kk) { const bf16x8 bg = *(const bf16x8*)(G2t + (size_t)hn * 128 + 8 * (lane >> 4) + 32 * kk);
                    zg = __builtin_amdgcn_mfma_f32_16x16x32_bf16(*(const LAS bf16x8*)(ap_g + kk * 64), bg, zg, 0, 0, 0); }
#pragma unroll
                for (int r = 0; r < 4; ++r) { const int j = 16 * rb + 4 * (lane >> 4) + r; Gout[(size_t)(tb + t0 + j) * 512 + hn] = (bf16_t)f2bf(zg[r]); }
            }
        }
    }
    __syncthreads();
    {
        float total = 0.f, pre = 0.f;
#pragma unroll 8
        for (int s = 0; s < 64; ++s) { const float v = *(const LAS float*)(lds + L_LW + (s * 64 + lane) * 4); total += v; pre += (s < 8 * wid) ? v : 0.f; }
        const float kkw = P.k_k[hi], kaw = P.k_a[hi], rkw = P.r_k[hi];
        float* BON = (float*)(ws + WS_BON); bf16_t* VS = (bf16_t*)(ws + WS_VS);
        float at_[8], bh_[8], kh_[8];
        float red[16], kd_[8], av_[8], lwv_[8];
#pragma unroll
        for (int jj = 0; jj < 8; ++jj) {
            const int j = 8 * wid + jj;
            lwv_[jj] = *(const LAS float*)(lds + L_LW + (j * 64 + lane) * 4); av_[jj] = *(const LAS float*)(lds + L_AA + (j * 64 + lane) * 4);
            const float kraw = kr[jj] * kkw;
            kd_[jj] = kr[jj] * (1.f + (av_[jj] - 1.f) * kaw);
            red[jj] = kraw * kraw; red[8 + jj] = rr[jj] * kd_[jj] * rkw;
        }
        wave_sum_n<16>(red);
#pragma unroll
        for (int jj = 0; jj < 8; ++jj) {
            const int j = 8 * wid + jj, tok = tb + (dir ? t0 + 63 - j : t0 + j);
            const float lwj = lwv_[jj], a = av_[jj];
            const float lw_prev = pre; pre += lwj; const float lw = pre;
            const float kkv = (kr[jj] * kkw) / fmaxf(sqrtf(red[jj]), 1e-12f);
            const float kd = kd_[jj], bb = kkv * a;
            if (lane == 0) BON[((size_t)dir * NTOK + tok) * 8 + h] = red[8 + jj];
            if (dir == 0) VS[(size_t)tok * 512 + hi] = (bf16_t)f2bf(vr[jj]);
            const float eprev = __expf(lw_prev), einv = __expf(-lw), ee = __expf(lw), eh = __expf(total - lw);
            at_[jj] = -kkv * eprev; bh_[jj] = bb * eh; kh_[jj] = kd * eh;
            *(LAS bf16_t*)(lds + L_AT + j * RS + lane * 2) = (bf16_t)f2bf(at_[jj]);
            *(LAS bf16_t*)(lds + L_BT + j * RS + lane * 2) = (bf16_t)f2bf(bb * einv);
            *(LAS bf16_t*)(lds + L_KT + j * RS + lane * 2) = (bf16_t)f2bf(kd * einv);
            *(LAS bf16_t*)(lds + L_RT + j * RS + lane * 2) = (bf16_t)f2bf(rr[jj] * ee);
        }
        *(LAS u32x4*)(lds + L_ATT + lane * RS + wid * 16) = pack8(at_);
        *(LAS u32x4*)(lds + L_BHT + lane * RS + wid * 16) = pack8(bh_);
        *(LAS u32x4*)(lds + L_KHT + lane * RS + wid * 16) = pack8(kh_);
        *(LAS u32x4*)(lds + L_VT + lane * RS + wid * 16) = pack8(vr);
        if (wid == 0) *(LAS float*)(lds + L_WC + lane * 4) = __expf(total);
    }
    __syncthreads();
    const int rb = wid >> 1, cb0 = 2 * (wid & 1);
    const int jr = 16 * rb + (lane & 15);
    const int q4 = 4 * (lane >> 4);
    const f32x4 zero4 = {0.f, 0.f, 0.f, 0.f};
#pragma unroll
    for (int t = 0; t < 2; ++t) {
        const int cb = cb0 + t;
        const LAS unsigned char* Arow_at = lds + L_AT + 16 * rb * RS; const LAS unsigned char* Arow_rt = lds + L_RT + 16 * rb * RS;
        const LAS unsigned char* Brow_bt = lds + L_BT + 16 * cb * RS; const LAS unsigned char* Brow_kt = lds + L_KT + 16 * cb * RS;
        f32x4 lab_s = tile_s<2>(Arow_at, RS, Brow_bt, RS, zero4, lane);
        f32x4 lab_n = tile_n<2>(Arow_at, RS, Brow_bt, RS, zero4, lane);
        f32x4 lak_s = tile_s<2>(Arow_at, RS, Brow_kt, RS, zero4, lane);
        f32x4 rb_s = tile_s<2>(Arow_rt, RS, Brow_bt, RS, zero4, lane);
        f32x4 rk_s = tile_s<2>(Arow_rt, RS, Brow_kt, RS, zero4, lane);
        f32x4 t0v;
#pragma unroll
        for (int r = 0; r < 4; ++r) { const int s = 16 * cb + q4 + r;
            lab_s[r] = (jr > s) ? lab_s[r] : 0.f; lak_s[r] = (jr > s) ? lak_s[r] : 0.f;
            rb_s[r] = (jr >= s) ? rb_s[r] : 0.f; rk_s[r] = (jr >= s) ? rk_s[r] : 0.f;
            t0v[r] = lab_s[r] + ((jr == s) ? 1.f : 0.f); }
        st4bf(lds + L_L0 + jr * RS + (16 * cb + q4) * 2, lab_s);
        st4bf(lds + L_T0 + jr * RS + (16 * cb + q4) * 2, t0v);
        st4bf(lds + L_LAK + jr * RS + (16 * cb + q4) * 2, lak_s);
        st4bf(lds + L_RB + jr * RS + (16 * cb + q4) * 2, rb_s);
        st4bf(lds + L_RK + jr * RS + (16 * cb + q4) * 2, rk_s);
        { const int s = 16 * cb + (lane & 15);
#pragma unroll
          for (int r = 0; r < 4; ++r) { const int j = 16 * rb + q4 + r; lab_n[r] = (j > s) ? lab_n[r] : 0.f; }
          st4bf(lds + L_LT0 + s * RS + (16 * rb + q4) * 2, lab_n); }
    }
    __syncthreads();
#pragma unroll
    for (int kk = 1; kk <= 6; ++kk) {
        const int Lc = (kk & 1) ? L_L0 : L_L1, LTc = (kk & 1) ? L_LT0 : L_LT1, Ln = (kk & 1) ? L_L1 : L_L0, LTn = (kk & 1) ? L_LT1 : L_LT0;
        const int Tc = (kk & 1) ? L_T1 : L_T0, Tn = (kk & 1) ? L_T0 : L_T1;
#pragma unroll
        for (int t = 0; t < 2; ++t) {
            const int cb = cb0 + t;
            if (kk <= 5) {
                f32x4 ls = tile_s<2>(lds + Lc + 16 * rb * RS, RS, lds + LTc + 16 * cb * RS, RS, zero4, lane);
                f32x4 ln = tile_n<2>(lds + Lc + 16 * rb * RS, RS, lds + LTc + 16 * cb * RS, RS, zero4, lane);
                st4bf(lds + Ln + jr * RS + (16 * cb + q4) * 2, ls);
                st4bf(lds + LTn + (16 * cb + (lane & 15)) * RS + (16 * rb + q4) * 2, ln);
            }
            if (kk >= 2) {
                const u32x2 tv = *(const LAS u32x2*)(lds + Tc + jr * RS + (16 * cb + q4) * 2);
                f32x4 ti = {bf2f(tv.x & 0xffffu), bf2f(tv.x >> 16), bf2f(tv.y & 0xffffu), bf2f(tv.y >> 16)};
                ti = tile_s<2>(lds + Tc + 16 * rb * RS, RS, lds + LTc + 16 * cb * RS, RS, ti, lane);
                st4bf(lds + Tn + jr * RS + (16 * cb + q4) * 2, ti);
            }
            if (kk == 1) {
                f32x4 g1 = tile_n<2>(lds + L_LAK + 16 * rb * RS, RS, lds + L_VT + 16 * cb * RS, RS, zero4, lane);
                st4bf(lds + L_G1T + (16 * cb + (lane & 15)) * RS + (16 * rb + q4) * 2, g1);
            }
        }
        __syncthreads();
    }
    {
        const int cbx0 = 4 * (wid & 1);
        f32x4 xv[4];
#pragma unroll
        for (int t = 0; t < 4; ++t) { const int cb = cbx0 + t;
            const LAS unsigned char* bt = (cb < 4) ? (lds + L_ATT + 16 * cb * RS) : (lds + L_G1T + 16 * (cb - 4) * RS);
            xv[t] = tile_n<2>(lds + L_T1 + 16 * rb * RS, RS, bt, RS, zero4, lane); }
        __syncthreads();
#pragma unroll
        for (int t = 0; t < 4; ++t) { const int cb = cbx0 + t; st4bf(lds + L_XT + (16 * cb + (lane & 15)) * RS + (16 * rb + q4) * 2, xv[t]); }
    }
    __syncthreads();
    {
        bf16_t* RM = (bf16_t*)(ws + WS_RM) + (size_t)item * 4096; bf16_t* RP = (bf16_t*)(ws + WS_RP) + (size_t)item * 4096; bf16_t* RNT = (bf16_t*)(ws + WS_RNT) + (size_t)item * 4096;
        bf16_t* Y = (bf16_t*)(ws + (dir ? WS_YB : WS_YF));
        const int pg4 = 4 * ((lane >> 4) == 1 ? 2 : (lane >> 4) == 2 ? 1 : (lane >> 4));
#pragma unroll
        for (int t = 0; t < 2; ++t) {
            const int cb = cb0 + t;
            f32x4 mv = tile_s<2>(lds + L_BHT + 16 * rb * RS, RS, lds + L_XT + 16 * cb * RS, RS, zero4, lane);
            { const float wc = *(const LAS float*)(lds + L_WC + jr * 4);
#pragma unroll
              for (int r = 0; r < 4; ++r) mv[r] += (jr == 16 * cb + q4 + r) ? wc : 0.f; }
            st4bf_g(RM + jr * 64 + 16 * cb + pg4, mv);
            f32x4 nv = tile_n<2>(lds + L_BHT + 16 * rb * RS, RS, lds + L_XT + (64 + 16 * cb) * RS, RS, zero4, lane);
            nv = tile_n<2>(lds + L_KHT + 16 * rb * RS, RS, lds + L_VT + 16 * cb * RS, RS, nv, lane);
            st4bf_g(RNT + (16 * cb + (lane & 15)) * 64 + 16 * rb + q4, nv);
            f32x4 pv = tile_s<2>(lds + L_RB + 16 * rb * RS, RS, lds + L_XT + 16 * cb * RS, RS, zero4, lane);
            { const u32x2 rv = *(const LAS u32x2*)(lds + L_RT + jr * RS + (16 * cb + q4) * 2);
              pv[0] += bf2f(rv.x & 0xffffu); pv[1] += bf2f(rv.x >> 16); pv[2] += bf2f(rv.y & 0xffffu); pv[3] += bf2f(rv.y >> 16); }
            st4bf_g(RP + jr * 64 + 16 * cb + pg4, pv);
            f32x4 zv = tile_n<2>(lds + L_RB + 16 * rb * RS, RS, lds + L_XT + (64 + 16 * cb) * RS, RS, zero4, lane);
            zv = tile_n<2>(lds + L_RK + 16 * rb * RS, RS, lds + L_VT + 16 * cb * RS, RS, zv, lane);
            { const int j0 = 16 * rb + q4, tokb = tb + (dir ? t0 + 60 - j0 : t0 + j0);
              const f32x4 zs = dir ? (f32x4){zv[3], zv[2], zv[1], zv[0]} : zv;
              st4bf_g(Y + ((size_t)(tokb >> 2) * 512 + h * 64 + 16 * cb + (lane & 15)) * 4, zs); }
        }
    }
    __syncthreads();
}

__device__ __forceinline__ bf16x8 pack_step(const f32x16& x, int s) {
    u32x4 p; p.x = pk2(x[8 * s + 0], x[8 * s + 1]); p.y = pk2(x[8 * s + 2], x[8 * s + 3]); p.z = pk2(x[8 * s + 4], x[8 * s + 5]); p.w = pk2(x[8 * s + 6], x[8 * s + 7]);
    return __builtin_bit_cast(bf16x8, p);
}
#define MFMA32(a, b, c) __builtin_amdgcn_mfma_f32_32x32x16_bf16((a), (b), (c), 0, 0, 0)

__device__ __forceinline__ void rwkv_ld_mn(const unsigned char* ws, int item, int vh, int r, int hh, bf16x8 (&Mf)[8], u32x2 (&Nf)[8]) {
    const bf16_t* RM = (const bf16_t*)(ws + WS_RM) + (size_t)item * 4096; const bf16_t* RNT = (const bf16_t*)(ws + WS_RNT) + (size_t)item * 4096;
#pragma unroll
    for (int kb = 0; kb < 2; ++kb) {
        const bf16_t* ap = RM + (32 * kb + r) * 64 + 8 * hh;
#pragma unroll
        for (int q = 0; q < 4; ++q) Mf[4 * kb + q] = *(const bf16x8*)(ap + 16 * q);
#pragma unroll
        for (int g = 0; g < 4; ++g) Nf[4 * kb + g] = *(const u32x2*)(RNT + (32 * vh + r) * 64 + 32 * kb + 8 * g + 4 * hh);
    }
}
__device__ __forceinline__ void rwkv_step(const unsigned char* ws, bf16_t* Y, int b, int h, int dir, int vh, int r, int hh, int st,
                                          f32x16& X0, f32x16& X1, const bf16x8 (&Mc)[8], const u32x2 (&Nc)[8], bf16x8 (&Mn)[8], u32x2 (&Nn)[8]) {
    const int tb = b * SEQ;
    const int c = dir ? 63 - st : st, t0 = c * 64;
    const int item = ((b * 64 + c) * 8 + h) * 2 + dir;
    const int stn = st < 63 ? st + 1 : 63, cn = dir ? 63 - stn : stn, itemn = ((b * 64 + cn) * 8 + h) * 2 + dir;
    const bf16_t* RP = (const bf16_t*)(ws + WS_RP) + (size_t)item * 4096;
    bf16x8 Pf[8]; u32x2 Zr[8];
    bf16_t* Yb = Y + ((size_t)((tb + t0) >> 2) * 512 + h * 64 + 32 * vh + r) * 4;
#pragma unroll
    for (int jb = 0; jb < 2; ++jb) {
        const bf16_t* ap = RP + (32 * jb + r) * 64 + 8 * hh;
#pragma unroll
        for (int q = 0; q < 4; ++q) Pf[4 * jb + q] = *(const bf16x8*)(ap + 16 * q);
#pragma unroll
        for (int g = 0; g < 4; ++g) { const int j0 = 32 * jb + 8 * g + 4 * hh, tg = (dir ? 60 - j0 : j0) >> 2;
            Zr[4 * jb + g] = *(const u32x2*)(Yb + (size_t)tg * 2048); }
    }
    rwkv_ld_mn(ws, itemn, vh, r, hh, Mn, Nn);
    const bf16x8 b00 = pack_step(X0, 0), b01 = pack_step(X0, 1), b10 = pack_step(X1, 0), b11 = pack_step(X1, 1);
    f32x16 Hn[2];
#pragma unroll
    for (int kb = 0; kb < 2; ++kb) {
#pragma unroll
        for (int g = 0; g < 4; ++g) { const u32x2 nv = Nc[4 * kb + g];
            Hn[kb][4 * g + 0] = bf2f(nv.x & 0xffffu); Hn[kb][4 * g + 1] = bf2f(nv.x >> 16); Hn[kb][4 * g + 2] = bf2f(nv.y & 0xffffu); Hn[kb][4 * g + 3] = bf2f(nv.y >> 16); }
        Hn[kb] = MFMA32(Mc[4 * kb + 0], b00, Hn[kb]);
        Hn[kb] = MFMA32(Mc[4 * kb + 1], b01, Hn[kb]);
        Hn[kb] = MFMA32(Mc[4 * kb + 2], b10, Hn[kb]);
        Hn[kb] = MFMA32(Mc[4 * kb + 3], b11, Hn[kb]);
    }
#pragma unroll
    for (int jb = 0; jb < 2; ++jb) {
        f32x16 Yv;
#pragma unroll
        for (int g = 0; g < 4; ++g) { const u32x2 z = Zr[4 * jb + g];
            const float p0 = bf2f(z.x & 0xffffu), p1 = bf2f(z.x >> 16), p2 = bf2f(z.y & 0xffffu), p3 = bf2f(z.y >> 16);
            Yv[4 * g + 0] = dir ? p3 : p0; Yv[4 * g + 1] = dir ? p2 : p1; Yv[4 * g + 2] = dir ? p1 : p2; Yv[4 * g + 3] = dir ? p0 : p3; }
        Yv = MFMA32(Pf[4 * jb + 0], b00, Yv);
        Yv = MFMA32(Pf[4 * jb + 1], b01, Yv);
        Yv = MFMA32(Pf[4 * jb + 2], b10, Yv);
        Yv = MFMA32(Pf[4 * jb + 3], b11, Yv);
#pragma unroll
        for (int g = 0; g < 4; ++g) { const int j0 = 32 * jb + 8 * g + 4 * hh, tg = (dir ? 60 - j0 : j0) >> 2;
            u32x2 o; o.x = dir ? pk2(Yv[4 * g + 3], Yv[4 * g + 2]) : pk2(Yv[4 * g + 0], Yv[4 * g + 1]); o.y = dir ? pk2(Yv[4 * g + 1], Yv[4 * g + 0]) : pk2(Yv[4 * g + 2], Yv[4 * g + 3]);
            *(u32x2*)(Yb + (size_t)tg * 2048) = o; }
    }
    X0 = Hn[0]; X1 = Hn[1];
}
__device__ __forceinline__ void rwkv_chain(const Params& P, const int chain, const int lane) {
    const int vh = chain & 1, dir = (chain >> 1) & 1, h = (chain >> 2) & 7, b = chain >> 5;
    const unsigned char* ws = P.ws;
    const int r = lane & 31, hh = lane >> 5;
    bf16_t* Y = (bf16_t*)(P.ws + (dir ? WS_YB : WS_YF));
    f32x16 X0, X1;
#pragma unroll
    for (int i = 0; i < 16; ++i) { X0[i] = 0.f; X1[i] = 0.f; }
    bf16x8 MA[8], MB[8]; u32x2 NA[8], NB[8];
    { const int c0 = dir ? 63 : 0; rwkv_ld_mn(ws, ((b * 64 + c0) * 8 + h) * 2 + dir, vh, r, hh, MA, NA); }
#pragma unroll 1
    for (int st = 0; st < 64; st += 2) {
        rwkv_step(ws, Y, b, h, dir, vh, r, hh, st, X0, X1, MA, NA, MB, NB);
        rwkv_step(ws, Y, b, h, dir, vh, r, hh, st + 1, X0, X1, MB, NB, MA, NA);
    }
}

constexpr int G_QT = 0, G_KT = RMS_, G_KHT = 2 * RMS_, G_VT = 3 * RMS_, G_AM = 5 * RMS_, G_GK = 6 * RMS_;
__device__ __forceinline__ void gla_item(const Params& P, const Ctx& F, const int item) {
    const int lane = F.lane, wid = F.wid; ldsp_t lds = F.lds;
    const int dir = item & 1, hd = (item >> 1) & 3, c = (item >> 3) & 63, b = item >> 9;
    const int t0 = c * 64, tb = b * SEQ;
    unsigned char* ws = P.ws;
    const bf16_t* PB = (const bf16_t*)(ws + WS_PB);
    const int hi = hd * 64 + lane;
    const float* gw2 = dir ? P.gw2_b : P.gw2_f; const float* gb = dir ? P.gb_b : P.gb_f;
    float qv[8], kv[8];
    {
        float w2[16];
#pragma unroll
        for (int m = 0; m < 16; ++m) w2[m] = gw2[m * 256 + hi];
        const float gbv = gb[hi];
        float v0[8], v1[8];
#pragma unroll
        for (int jj = 0; jj < 8; ++jj) {
            const int j = 8 * wid + jj, tok = tb + (dir ? t0 + 63 - j : t0 + j);
            const bf16_t* row = PB + (size_t)tok * LDB_GL;
            const u32x4 g0 = *(const u32x4*)(row + 1024 + 16 * dir), g1 = *(const u32x4*)(row + 1024 + 16 * dir + 8);
            float gl[16]; { float t8[8]; unpack8(g0, t8);
#pragma unroll
                for (int e = 0; e < 8; ++e) gl[e] = t8[e];
                unpack8(g1, t8);
#pragma unroll
                for (int e = 0; e < 8; ++e) gl[8 + e] = t8[e]; }
            float z = gbv;
#pragma unroll
            for (int m = 0; m < 16; ++m) z += gl[m] * w2[m];
            const float ls = fminf(z, 0.f) - __logf(1.f + __expf(-fabsf(z)));
            *(LAS float*)(lds + G_GK + (j * 64 + lane) * 4) = ls * (1.f / 16.f);
            qv[jj] = bf2f(row[hi]) * 0.125f; kv[jj] = bf2f(row[256 + hi]);
            v0[jj] = bf2f(row[512 + hd * 128 + lane]); v1[jj] = bf2f(row[512 + hd * 128 + 64 + lane]);
        }
        *(LAS u32x4*)(lds + G_VT + lane * RS + wid * 16) = pack8(v0);
        *(LAS u32x4*)(lds + G_VT + (64 + lane) * RS + wid * 16) = pack8(v1);
    }
    __syncthreads();
    {
        float total = 0.f, pre = 0.f;
#pragma unroll 8
        for (int s = 0; s < 64; ++s) { const float v = *(const LAS float*)(lds + G_GK + (s * 64 + lane) * 4); total += v; pre += (s < 8 * wid) ? v : 0.f; }
        bf16_t* GQ = (bf16_t*)((unsigned char*)P.out + OUT_GQ) + (size_t)item * 4096;
        const int blk = lane >> 4, g4 = (lane >> 2) & 3, pgp = (g4 == 1) ? 2 : (g4 == 2) ? 1 : g4;
        const int pcol = 16 * blk + 4 * pgp + (lane & 3);
        float kh_[8];
#pragma unroll
        for (int jj = 0; jj < 8; ++jj) {
            const int j = 8 * wid + jj;
            pre += *(const LAS float*)(lds + G_GK + (j * 64 + lane) * 4);
            const float e = __expf(pre), einv = __expf(-pre), eh = __expf(total - pre);
            const float qs = qv[jj] * e;
            *(LAS bf16_t*)(lds + G_QT + j * RS + lane * 2) = (bf16_t)f2bf(qs);
            *(LAS bf16_t*)(lds + G_KT + j * RS + lane * 2) = (bf16_t)f2bf(kv[jj] * einv);
            kh_[jj] = kv[jj] * eh;
            GQ[j * 64 + pcol] = (bf16_t)f2bf(qs);
        }
        *(LAS u32x4*)(lds + G_KHT + lane * RS + wid * 16) = pack8(kh_);
        if (wid == 0) ((float*)(ws + WS_DEC))[(size_t)item * 64 + lane] = __expf(total);
    }
    __syncthreads();
    const int rb = wid >> 1, cb0 = 2 * (wid & 1);
    const int jr = 16 * rb + (lane & 15), q4 = 4 * (lane >> 4);
    const f32x4 zero4 = {0.f, 0.f, 0.f, 0.f};
#pragma unroll
    for (int t = 0; t < 2; ++t) { const int cb = cb0 + t;
        f32x4 av = tile_s<2>(lds + G_QT + 16 * rb * RS, RS, lds + G_KT + 16 * cb * RS, RS, zero4, lane);
#pragma unroll
        for (int r = 0; r < 4; ++r) av[r] = (jr >= 16 * cb + q4 + r) ? av[r] : 0.f;
        st4bf(lds + G_AM + jr * RS + (16 * cb + q4) * 2, av); }
    __syncthreads();
    {
        bf16_t* O = (bf16_t*)(ws + (dir ? WS_OB : WS_OF));
        bf16_t* GNT = (bf16_t*)((unsigned char*)P.out + OUT_GNT) + (size_t)item * 8192;
        const int cbz0 = 4 * (wid & 1);
        const int j0 = 16 * rb + q4, tokb = tb + (dir ? t0 + 60 - j0 : t0 + j0);
#pragma unroll
        for (int t = 0; t < 4; ++t) { const int cb = cbz0 + t;
            f32x4 zv = tile_n<2>(lds + G_AM + 16 * rb * RS, RS, lds + G_VT + 16 * cb * RS, RS, zero4, lane);
            const f32x4 zs = dir ? (f32x4){zv[3], zv[2], zv[1], zv[0]} : zv;
            st4bf_g(O + ((size_t)(tokb >> 2) * 512 + hd * 128 + 16 * cb + (lane & 15)) * 4, zs);
            f32x4 nv = tile_n<2>(lds + G_KHT + 16 * rb * RS, RS, lds + G_VT + 16 * cb * RS, RS, zero4, lane);
            st4bf_g(GNT + (16 * cb + (lane & 15)) * 64 + 16 * rb + q4, nv); }
    }
    __syncthreads();
}

__device__ __forceinline__ void gla_ld_nd(const unsigned char* ob, const unsigned char* ws, int item, int qt, int r, int hh, u32x2 (&Nf)[8], f32x4 (&Df)[8]) {
    const bf16_t* GNT = (const bf16_t*)(ob + OUT_GNT) + (size_t)item * 8192; const float* DEC = (const float*)(ws + WS_DEC) + (size_t)item * 64;
#pragma unroll
    for (int g = 0; g < 4; ++g) {
        Df[g] = *(const f32x4*)(DEC + 8 * g + 4 * hh); Df[4 + g] = *(const f32x4*)(DEC + 32 + 8 * g + 4 * hh);
        Nf[g] = *(const u32x2*)(GNT + (32 * qt + r) * 64 + 8 * g + 4 * hh); Nf[4 + g] = *(const u32x2*)(GNT + (32 * qt + r) * 64 + 32 + 8 * g + 4 * hh);
    }
}
__device__ __forceinline__ void gla_step(const unsigned char* ob, const unsigned char* ws, bf16_t* O, int b, int hd, int dir, int qt, int r, int hh, int st,
                                         f32x16& X0, f32x16& X1, const u32x2 (&Nc)[8], const f32x4 (&Dc)[8], u32x2 (&Nn)[8], f32x4 (&Dn)[8]) {
    const int tb = b * SEQ;
    const int c = dir ? 63 - st : st, t0 = c * 64;
    const int item = ((b * 64 + c) * 4 + hd) * 2 + dir;
    const int stn = st < 63 ? st + 1 : 63, cn = dir ? 63 - stn : stn, itemn = ((b * 64 + cn) * 4 + hd) * 2 + dir;
    const bf16_t* GQ = (const bf16_t*)(ob + OUT_GQ) + (size_t)item * 4096;
    const int vcol = hd * 128 + 32 * qt + r;
    bf16x8 Qf[8]; u32x2 Zr[8];
    bf16_t* Ob = O + ((size_t)((tb + t0) >> 2) * 512 + vcol) * 4;
#pragma unroll
    for (int jb = 0; jb < 2; ++jb) {
        const bf16_t* ap = GQ + (32 * jb + r) * 64 + 8 * hh;
#pragma unroll
        for (int q = 0; q < 4; ++q) Qf[4 * jb + q] = *(const bf16x8*)(ap + 16 * q);
#pragma unroll
        for (int g = 0; g < 4; ++g) { const int j0 = 32 * jb + 8 * g + 4 * hh, tg = (dir ? 60 - j0 : j0) >> 2;
            Zr[4 * jb + g] = *(const u32x2*)(Ob + (size_t)tg * 2048); }
    }
    gla_ld_nd(ob, ws, itemn, qt, r, hh, Nn, Dn);
    const bf16x8 b00 = pack_step(X0, 0), b01 = pack_step(X0, 1), b10 = pack_step(X1, 0), b11 = pack_step(X1, 1);
#pragma unroll
    for (int g = 0; g < 4; ++g) {
        const f32x4 d0 = Dc[g], d1 = Dc[4 + g]; const u32x2 n0 = Nc[g], n1 = Nc[4 + g];
        X0[4 * g + 0] = d0.x * X0[4 * g + 0] + bf2f(n0.x & 0xffffu); X0[4 * g + 1] = d0.y * X0[4 * g + 1] + bf2f(n0.x >> 16);
        X0[4 * g + 2] = d0.z * X0[4 * g + 2] + bf2f(n0.y & 0xffffu); X0[4 * g + 3] = d0.w * X0[4 * g + 3] + bf2f(n0.y >> 16);
        X1[4 * g + 0] = d1.x * X1[4 * g + 0] + bf2f(n1.x & 0xffffu); X1[4 * g + 1] = d1.y * X1[4 * g + 1] + bf2f(n1.x >> 16);
        X1[4 * g + 2] = d1.z * X1[4 * g + 2] + bf2f(n1.y & 0xffffu); X1[4 * g + 3] = d1.w * X1[4 * g + 3] + bf2f(n1.y >> 16);
    }
#pragma unroll
    for (int jb = 0; jb < 2; ++jb) {
        f32x16 Ov;
#pragma unroll
        for (int g = 0; g < 4; ++g) { const u32x2 z = Zr[4 * jb + g];
            const float p0 = bf2f(z.x & 0xffffu), p1 = bf2f(z.x >> 16), p2 = bf2f(z.y & 0xffffu), p3 = bf2f(z.y >> 16);
            Ov[4 * g + 0] = dir ? p3 : p0; Ov[4 * g + 1] = dir ? p2 : p1; Ov[4 * g + 2] = dir ? p1 : p2; Ov[4 * g + 3] = dir ? p0 : p3; }
        Ov = MFMA32(Qf[4 * jb + 0], b00, Ov);
        Ov = MFMA32(Qf[4 * jb + 1], b01, Ov);
        Ov = MFMA32(Qf[4 * jb + 2], b10, Ov);
        Ov = MFMA32(Qf[4 * jb + 3], b11, Ov);
#pragma unroll
        for (int g = 0; g < 4; ++g) { const int j0 = 32 * jb + 8 * g + 4 * hh, tg = (dir ? 60 - j0 : j0) >> 2;
            u32x2 o; o.x = dir ? pk2(Ov[4 * g + 3], Ov[4 * g + 2]) : pk2(Ov[4 * g + 0], Ov[4 * g + 1]); o.y = dir ? pk2(Ov[4 * g + 1], Ov[4 * g + 0]) : pk2(Ov[4 * g + 2], Ov[4 * g + 3]);
            *(u32x2*)(Ob + (size_t)tg * 2048) = o; }
    }
}
__device__ __forceinline__ void gla_chain(const Params& P, const int chain, const int lane) {
    const int qt = chain & 3, dir = (chain >> 2) & 1, hd = (chain >> 3) & 3, b = chain >> 5;
    const unsigned char* ws = P.ws; const unsigned char* ob = (const unsigned char*)P.out;
    const int r = lane & 31, hh = lane >> 5;
    bf16_t* O = (bf16_t*)(P.ws + (dir ? WS_OB : WS_OF));
    f32x16 X0, X1;
#pragma unroll
    for (int i = 0; i < 16; ++i) { X0[i] = 0.f; X1[i] = 0.f; }
    u32x2 NA[8], NB[8]; f32x4 DA[8], DB[8];
    { const int c0 = dir ? 63 : 0; gla_ld_nd(ob, ws, ((b * 64 + c0) * 4 + hd) * 2 + dir, qt, r, hh, NA, DA); }
#pragma unroll 1
    for (int st = 0; st < 64; st += 2) {
        gla_step(ob, ws, O, b, hd, dir, qt, r, hh, st, X0, X1, NA, DA, NB, DB);
        gla_step(ob, ws, O, b, hd, dir, qt, r, hh, st + 1, X0, X1, NB, DB, NA, DA);
    }
}

__device__ __forceinline__ void ld_tok4(const bf16_t* base, int tok4, int lane, float (&y)[4][8]) {
    const u32x4* p = (const u32x4*)(base + ((size_t)tok4 * 512 + 8 * lane) * 4);
#pragma unroll
    for (int i = 0; i < 4; ++i) { const u32x4 v = p[i];
        y[0][2 * i] = bf2f(v.x & 0xffffu); y[1][2 * i] = bf2f(v.x >> 16); y[2][2 * i] = bf2f(v.y & 0xffffu); y[3][2 * i] = bf2f(v.y >> 16);
        y[0][2 * i + 1] = bf2f(v.z & 0xffffu); y[1][2 * i + 1] = bf2f(v.z >> 16); y[2][2 * i + 1] = bf2f(v.w & 0xffffu); y[3][2 * i + 1] = bf2f(v.w >> 16); }
}
__device__ __forceinline__ void mix_tok4(const Params& P, const int tok4, const int lane) {
    unsigned char* ws = P.ws;
    const bf16_t* YF = (const bf16_t*)(ws + WS_YF); const bf16_t* YB = (const bf16_t*)(ws + WS_YB);
    const bf16_t* GG = (const bf16_t*)(ws + WS_G); const bf16_t* VS = (const bf16_t*)(ws + WS_VS);
    const float* BON = (const float*)(ws + WS_BON);
    const bf16_t* OF = (const bf16_t*)(ws + WS_OF); const bf16_t* OB = (const bf16_t*)(ws + WS_OB);
    const bf16_t* PB = (const bf16_t*)(ws + WS_PB);
    bf16_t* MIX = (bf16_t*)(ws + WS_MIX);
    {
        float ya[4][8], yb[4][8];
        ld_tok4(YF, tok4, lane, ya); ld_tok4(YB, tok4, lane, yb);
        const f32x4 w0 = *(const f32x4*)(P.ln_w + 8 * lane), w1 = *(const f32x4*)(P.ln_w + 8 * lane + 4);
        const f32x4 c0 = *(const f32x4*)(P.ln_b + 8 * lane), c1 = *(const f32x4*)(P.ln_b + 8 * lane + 4);
        const float lw[8] = {w0.x, w0.y, w0.z, w0.w, w1.x, w1.y, w1.z, w1.w}, lb[8] = {c0.x, c0.y, c0.z, c0.w, c1.x, c1.y, c1.z, c1.w};
        const int h = lane >> 3;
#pragma unroll
        for (int q = 0; q < 4; ++q) {
            const int tok = 4 * tok4 + q; const size_t o512 = (size_t)tok * 512 + 8 * lane;
            float y[8]; float s = 0.f;
#pragma unroll
            for (int e = 0; e < 8; ++e) { y[e] = ya[q][e] + yb[q][e]; s += y[e]; }
            s += __shfl_xor(s, 1); s += __shfl_xor(s, 2); s += __shfl_xor(s, 4);
            const float mean = s * (1.f / 64.f);
            float s2 = 0.f;
#pragma unroll
            for (int e = 0; e < 8; ++e) { y[e] -= mean; s2 += y[e] * y[e]; }
            s2 += __shfl_xor(s2, 1); s2 += __shfl_xor(s2, 2); s2 += __shfl_xor(s2, 4);
            const float rs = rsqrtf(s2 * (1.f / 64.f) + 64e-5f);
            const float bon = BON[(size_t)tok * 8 + h] + BON[((size_t)NTOK + tok) * 8 + h];
            float g[8], vs[8], o[8];
            unpack8(*(const u32x4*)(GG + o512), g); unpack8(*(const u32x4*)(VS + o512), vs);
#pragma unroll
            for (int e = 0; e < 8; ++e) o[e] = (y[e] * rs * lw[e] + lb[e] + bon * vs[e]) * g[e];
            *(u32x4*)(MIX + (size_t)tok * 1024 + 8 * lane) = pack8(o);
        }
    }
    {
        float ya[4][8], yb[4][8];
        ld_tok4(OF, tok4, lane, ya); ld_tok4(OB, tok4, lane, yb);
        const f32x4 w0 = *(const f32x4*)(P.gnorm_w + 8 * lane), w1 = *(const f32x4*)(P.gnorm_w + 8 * lane + 4);
        const float nw[8] = {w0.x, w0.y, w0.z, w0.w, w1.x, w1.y, w1.z, w1.w};
#pragma unroll
        for (int q = 0; q < 4; ++q) {
            const int tok = 4 * tok4 + q;
            float y[8], og[8], o[8]; float s2 = 0.f;
#pragma unroll
            for (int e = 0; e < 8; ++e) { y[e] = ya[q][e] + yb[q][e]; s2 += y[e] * y[e]; }
            s2 += __shfl_xor(s2, 1); s2 += __shfl_xor(s2, 2); s2 += __shfl_xor(s2, 4); s2 += __shfl_xor(s2, 8);
            const float rs = rsqrtf(s2 * (1.f / 128.f) + 1e-6f);
            unpack8(*(const u32x4*)(PB + (size_t)tok * LDB_GL + 1056 + 8 * lane), og);
#pragma unroll
            for (int e = 0; e < 8; ++e) o[e] = y[e] * rs * nw[e] * (og[e] * sigmoidf_(og[e]));
            *(u32x4*)(MIX + (size_t)tok * 1024 + 512 + 8 * lane) = pack8(o);
        }
    }
}

__device__ __forceinline__ void p5b_convert(const Params& P, const Ctx& F) {
    LAS float* scr = (LAS float*)(F.lds + F.wid * 16384);
    const int gw = F.vcu * 8 + F.wid, NGW = F.G * 8;
    bf16_t* WGU = (bf16_t*)(P.ws + WS_WGU); bf16_t* WDN = (bf16_t*)(P.ws + WS_WDN);
    for (int it = gw; it < NEXP * 768; it += NGW) {
        const int e = it / 768, r = it % 768;
        if (r < 512) { const int up = r >> 8, q = r & 255, kb = q >> 4, nb = q & 15, n0 = 32 * nb;
            const float* src = (up ? P.w_up : P.w_gate) + (size_t)e * 1024 * 512;
            const int drow0 = 256 * (n0 >> 7) + (n0 & 127) + 128 * up;
            transpose_block(src, 512, WGU + (size_t)e * 1024 * 1024, 1024, drow0, 64 * kb, n0, scr, F.lane);
        } else { const int q = r - 512, kb = q >> 5, nb = q & 31;
            transpose_block(P.w_down + (size_t)e * 512 * 1024, 1024, WDN + (size_t)e * 1024 * 512, 512, 32 * nb, 64 * kb, 32 * nb, scr, F.lane); }
    }
}

__device__ __forceinline__ void p6_router(const Params& P, const Ctx& F) {
    ldsp_t lds = F.lds; const int lane = F.lane;
    for (int i = F.tid; i < 1024 * 36; i += 512) { const int k = i / 36, cc = i % 36;
        *(LAS float*)(lds + i * 4) = cc < 4 ? P.w_coarse[k * 4 + cc] : P.w_fine[k * 32 + cc - 4]; }
    __syncthreads();
    const int gw = F.vcu * 8 + F.wid, NGW = F.G * 8;
    unsigned* CNT = (unsigned*)(P.ws + WS_CTL) + CW_CNT;
    int* ELIST = (int*)(P.ws + WS_ELIST); float* ELW = (float*)(P.ws + WS_ELW);
    bf16_t* H2 = (bf16_t*)(P.ws + WS_H2);
    for (int tok = gw; tok < NTOK; tok += NGW) {
        const f32x4* xr = (const f32x4*)(P.out + (size_t)tok * 1024) + lane; const f32x4* wr = (const f32x4*)P.ln2_w + lane;
        f32x4 v[4]; float s = 0.f;
#pragma unroll
        for (int j = 0; j < 4; ++j) { v[j] = xr[64 * j]; s += (v[j].x * v[j].x + v[j].y * v[j].y) + (v[j].z * v[j].z + v[j].w * v[j].w); }
        const float inv = rsqrtf(wave_sum(s) * (1.f / 1024.f) + 1e-6f);
        u32x2* o8 = (u32x2*)(H2 + (size_t)tok * 1024) + lane;
        float acc[36];
#pragma unroll
        for (int cc = 0; cc < 36; ++cc) acc[cc] = 0.f;
#pragma unroll
        for (int j = 0; j < 4; ++j) { const f32x4 g = wr[64 * j];
            u32x2 o; o.x = pk2(v[j].x * inv * g.x, v[j].y * inv * g.y); o.y = pk2(v[j].z * inv * g.z, v[j].w * inv * g.w); o8[64 * j] = o; }
        {
            const float* xs = P.out + (size_t)tok * 1024;
#pragma unroll 1
            for (int kk = 0; kk < 16; ++kk) { const int k = 256 * (kk >> 2) + 4 * lane + (kk & 3);
                const float hvk = xs[k] * inv * P.ln2_w[k];
                const LAS f32x4* wl = (const LAS f32x4*)(lds + k * 144);
#pragma unroll
                for (int c4 = 0; c4 < 9; ++c4) { const f32x4 w = wl[c4]; acc[4 * c4 + 0] += hvk * w.x; acc[4 * c4 + 1] += hvk * w.y; acc[4 * c4 + 2] += hvk * w.z; acc[4 * c4 + 3] += hvk * w.w; } }
        }
        wave_sum_n<36>(acc);
        float cl[4];
#pragma unroll
        for (int i = 0; i < 4; ++i) cl[i] = acc[i] + P.b_coarse[i];
        int g = 0; float cm = cl[0];
#pragma unroll
        for (int i = 1; i < 4; ++i) if (cl[i] > cm) { cm = cl[i]; g = i; }
        float cs = 0.f;
#pragma unroll
        for (int i = 0; i < 4; ++i) cs += __expf(cl[i] - cm);
        const float pg = 1.f / cs;
        float fl[8];
#pragma unroll
        for (int i = 0; i < 8; ++i) { const float f0 = acc[4 + i], f1 = acc[12 + i], f2 = acc[20 + i], f3 = acc[28 + i];
            fl[i] = (g == 0 ? f0 : g == 1 ? f1 : g == 2 ? f2 : f3) + P.b_fine[8 * g + i]; }
        int i1 = 0; float m1 = fl[0];
#pragma unroll
        for (int i = 1; i < 8; ++i) if (fl[i] > m1) { m1 = fl[i]; i1 = i; }
        int i2 = -1; float m2 = -3.0e38f;
#pragma unroll
        for (int i = 0; i < 8; ++i) if (i != i1 && fl[i] > m2) { m2 = fl[i]; i2 = i; }
        const float e2 = __expf(m2 - m1);
        const float c1 = pg / (1.f + e2), c2 = pg * e2 / (1.f + e2);
        if (lane == 0) {
            const int ea = 8 * g + i1, eb = 8 * g + i2;
            const unsigned sa = atomicAdd(&CNT[64 * ea], 1u); ELIST[(size_t)ea * NTOK + sa] = tok * 2; ELW[(size_t)ea * NTOK + sa] = c1;
            const unsigned sb = atomicAdd(&CNT[64 * eb], 1u); ELIST[(size_t)eb * NTOK + sb] = tok * 2 + 1; ELW[(size_t)eb * NTOK + sb] = c2;
        }
    }
}

__device__ __forceinline__ void build_group_tables(const Params& P, const Ctx& F) {
    LAS int* tab = (LAS int*)(F.lds + LDS_TAB);
    if (F.tid < 32) tab[F.tid] = (int)__hip_atomic_load((unsigned*)(P.ws + WS_CTL) + CW_CNT + 64 * F.tid, __ATOMIC_RELAXED, __HIP_MEMORY_SCOPE_AGENT);
    __syncthreads();
    if (F.tid == 0) { int s = 0; for (int e = 0; e < 32; ++e) { tab[32 + e] = s; s += (tab[e] + 255) >> 8; } tab[64] = s; }
    __syncthreads();
}
struct GroupOrder {
    LAS const int* tab; const char* Abase; const char* Bbase; const int* elist;
    int G, c, K, gather;
    __device__ __forceinline__ bool next(int i, pg8::Unit& u) const {
        const int L = i * G + c, ntile = tab[64];
        if (L >= ntile * 4) return false;
        const int mg = L >> 2; u.pn = L & 3;
        int e = 0;
#pragma unroll 1
        for (int q = 1; q < 32; ++q) e = (tab[32 + q] <= mg) ? q : e;
        u.e = e; u.mt = mg - tab[32 + e]; u.pm = mg;
        u.a = gather ? Abase : Abase + (size_t)mg * 256 * K * 2;
        u.b = Bbase + ((size_t)e * 1024 + 256 * u.pn) * K * 2;
        return true;
    }
    __device__ __forceinline__ void rows(const pg8::Unit& u, int R0, int R1, unsigned& r0, unsigned& r1) const {
        const int cnt = tab[u.e]; const int p0 = 256 * u.mt + R0, p1 = 256 * u.mt + R1;
        const int* el = elist + (size_t)u.e * NTOK;
        r0 = p0 < cnt ? (unsigned)(el[p0] >> 1) : 0u; r1 = p1 < cnt ? (unsigned)(el[p1] >> 1) : 0u;
    }
};
struct EpiSwiGLU {
    static constexpr bool PERM = true;
    bf16_t* ACT;
    __device__ __forceinline__ void operator()(const f32x4 (&acc)[2][2][4][2], const pg8::Unit& u, int wr, int wc, int fr, int fq) const {
        const int row0 = u.pm * 256 + wr * 64 + fr, col0 = u.pn * 128 + wc * 32 + 8 * fq;
#pragma unroll
        for (int ai = 0; ai < 2; ++ai)
#pragma unroll
            for (int m = 0; m < 4; ++m) {
                float o[8];
#pragma unroll
                for (int n = 0; n < 2; ++n)
#pragma unroll
                    for (int q = 0; q < 4; ++q) { const float gt = acc[ai][0][m][n][q], up = acc[ai][1][m][n][q]; o[4 * n + q] = gt * sigmoidf_(gt) * up; }
                *(u32x4*)(ACT + (size_t)(row0 + ai * 128 + m * 16) * 512 + col0) = pack8(o);
            }
    }
};
struct EpiDown {
    static constexpr bool PERM = true;
    LAS const int* tab; const int* elist; const float* elw; bf16_t* YK0; bf16_t* YK1;
    __device__ __forceinline__ void operator()(const f32x4 (&acc)[2][2][4][2], const pg8::Unit& u, int wr, int wc, int fr, int fq) const {
        const int cnt = tab[u.e]; const int col0 = u.pn * 256 + wc * 32 + 8 * fq;
#pragma unroll
        for (int ai = 0; ai < 2; ++ai)
#pragma unroll
            for (int m = 0; m < 4; ++m) {
                const int pos = 256 * u.mt + ai * 128 + wr * 64 + m * 16 + fr;
                if (pos < cnt) {
                    const int en = elist[(size_t)u.e * NTOK + pos]; const float w = elw[(size_t)u.e * NTOK + pos];
                    bf16_t* rowp = ((en & 1) ? YK1 : YK0) + (size_t)(en >> 1) * 1024 + col0;
#pragma unroll
                    for (int bj = 0; bj < 2; ++bj) { const f32x4 v0 = acc[ai][bj][m][0], v1 = acc[ai][bj][m][1];
                        u32x4 o; o.x = pk2(v0[0] * w, v0[1] * w); o.y = pk2(v0[2] * w, v0[3] * w); o.z = pk2(v1[0] * w, v1[1] * w); o.w = pk2(v1[2] * w, v1[3] * w);
                        *(u32x4*)(rowp + bj * 128) = o; }
                }
            }
    }
};

__device__ __forceinline__ void final_token(const Params& P, const int tok, const int lane) {
    float* orow = P.out + (size_t)tok * 1024;
    const bf16_t* y0 = (const bf16_t*)(P.ws + WS_YK0) + (size_t)tok * 1024; const bf16_t* y1 = (const bf16_t*)(P.ws + WS_YK1) + (size_t)tok * 1024;
    f32x4 v[4]; float s = 0.f;
#pragma unroll
    for (int j = 0; j < 4; ++j) {
        v[j] = *((const f32x4*)orow + lane + 64 * j);
        const u32x2 a = *((const u32x2*)y0 + lane + 64 * j), b = *((const u32x2*)y1 + lane + 64 * j);
        v[j].x += bf2f(a.x & 0xffffu) + bf2f(b.x & 0xffffu); v[j].y += bf2f(a.x >> 16) + bf2f(b.x >> 16);
        v[j].z += bf2f(a.y & 0xffffu) + bf2f(b.y & 0xffffu); v[j].w += bf2f(a.y >> 16) + bf2f(b.y >> 16);
        s += (v[j].x * v[j].x + v[j].y * v[j].y) + (v[j].z * v[j].z + v[j].w * v[j].w);
    }
    const float inv = rsqrtf(wave_sum(s) * (1.f / 1024.f) + 1e-6f);
#pragma unroll
    for (int j = 0; j < 4; ++j) { const f32x4 g = *((const f32x4*)P.ln_f_w + lane + 64 * j);
        f32x4 o; o.x = v[j].x * inv * g.x; o.y = v[j].y * inv * g.y; o.z = v[j].z * inv * g.z; o.w = v[j].w * inv * g.w;
        *((f32x4*)orow + lane + 64 * j) = o; }
}

__global__ void __launch_bounds__(512, 2) mk_fwd(Params P) {
    extern __shared__ __attribute__((aligned(16))) unsigned char lds_raw[];
    Ctx F;
    F.lds = (ldsp_t)lds_raw;
    F.tid = threadIdx.x; F.lane = F.tid & 63; F.wid = __builtin_amdgcn_readfirstlane(F.tid >> 6);
    F.G = gridDim.x; { const int bx = blockIdx.x; F.vcu = (F.G % 8 == 0) ? (bx % 8) * (F.G / 8) + bx / 8 : bx; }
    volatile LAS unsigned* MISC = (volatile LAS unsigned*)(F.lds + LDS_MISC);
    if (F.tid < 16) MISC[F.tid] = 0u;
    __syncthreads();
    unsigned* ctl = (unsigned*)(P.ws + WS_CTL);
    const int lo = P.ph_lo, hi = P.ph_hi;
    XcdBarrier bar; bar.bar = ctl + CW_BAR; bar.x = 0; bar.st = MISC;
    if (hi - lo > 1) bar = xcd_barrier_post(ctl + CW_BAR, MISC);
#ifndef PHASE_MASK
#define PHASE_MASK 0xFFFFF
#endif
#define IN(k) (((PHASE_MASK >> (k)) & 1) && lo <= (k) && (k) < hi)
#ifndef REP_MASK
#define REP_MASK 0
#endif
#define NREP(k) (1 + ((REP_MASK >> (k)) & 1))
#define SEAM(k) do { if (IN(k) && IN((k) + 1)) xcd_barrier(bar); } while (0)
    unsigned char* ws = P.ws;
    const int gw = F.vcu * 8 + F.wid, NGW = F.G * 8;

    if (IN(0)) { for (int rep = 0; rep < NREP(0); ++rep) { p0_prologue(P, F); __syncthreads(); } }
    SEAM(0);
    if (IN(1)) {
        pg8::StaticOrder S; S.init(ws + WS_H, ws + WS_BT_RW, NTOK, 2048, 1024, F.G, (int)blockIdx.x);
        pg8::EpiBf16 E{(bf16_t*)P.out, LDA_RW};
        pg8::gemm_phase<pg8::EpiBf16, pg8::StaticOrder, false>(F.lds, 1024, S, E);
    }
    SEAM(1);
    if (IN(2)) { for (int rep = 0; rep < NREP(2); ++rep) for (int it = F.vcu; it < 4096; it += F.G) rwkv_item(P, F, it); }
    SEAM(2);
    if (IN(3)) {
        pg8::StaticOrder S; S.init(ws + WS_H, ws + WS_BT_GL, NTOK, 1792, 1024, F.G, (int)blockIdx.x);
        pg8::EpiBf16 E{(bf16_t*)(ws + WS_PB), LDB_GL};
        pg8::gemm_phase<pg8::EpiBf16, pg8::StaticOrder, false>(F.lds, 1024, S, E);
    }
    SEAM(3);
    if (IN(4)) { for (int rep = 0; rep < NREP(4); ++rep) for (int it = F.vcu; it < 2048; it += F.G) gla_item(P, F, it); }
    SEAM(4);
    if (IN(5)) { if (F.wid == 0) { if (F.vcu < 128) rwkv_chain(P, F.vcu, F.lane); else if (F.vcu < 256) gla_chain(P, F.vcu - 128, F.lane); } }
    SEAM(5);
    if (IN(6)) { for (int rep = 0; rep < NREP(6); ++rep) for (int t4 = gw; t4 < NTOK / 4; t4 += NGW) mix_tok4(P, t4, F.lane); }
    SEAM(6);
    if (IN(7)) {
        pg8::StaticOrder S; S.init(ws + WS_MIX, ws + WS_BT_OUT, NTOK, 1024, 1024, F.G, (int)blockIdx.x);
        pg8::EpiResF32 E{P.out, P.x, 1024};
        pg8::gemm_phase<pg8::EpiResF32, pg8::StaticOrder, false>(F.lds, 1024, S, E);
    }
    SEAM(7);
    if (IN(8)) { for (int rep = 0; rep < NREP(8); ++rep) { p5b_convert(P, F); __syncthreads(); } }
    SEAM(8);
    if (IN(9)) { p6_router(P, F); }
    SEAM(9);
    if (IN(10)) {
        build_group_tables(P, F);
        GroupOrder S{(LAS const int*)(F.lds + LDS_TAB), (const char*)(ws + WS_H2), (const char*)(ws + WS_WGU), (const int*)(ws + WS_ELIST), F.G, (int)blockIdx.x, 1024, 1};
        EpiSwiGLU E{(bf16_t*)(ws + WS_ACT)};
        pg8::gemm_phase<EpiSwiGLU, GroupOrder, true>(F.lds, 1024, S, E);
    }
    SEAM(10);
    if (IN(11)) {
        build_group_tables(P, F);
        GroupOrder S{(LAS const int*)(F.lds + LDS_TAB), (const char*)(ws + WS_ACT), (const char*)(ws + WS_WDN), (const int*)(ws + WS_ELIST), F.G, (int)blockIdx.x, 512, 0};
        EpiDown E{(LAS const int*)(F.lds + LDS_TAB), (const int*)(ws + WS_ELIST), (const float*)(ws + WS_ELW), (bf16_t*)(ws + WS_YK0), (bf16_t*)(ws + WS_YK1)};
        pg8::gemm_phase<EpiDown, GroupOrder, false>(F.lds, 512, S, E);
    }
    SEAM(11);
    if (IN(12)) { for (int tok = gw; tok < NTOK; tok += NGW) final_token(P, tok, F.lane); }
#undef IN
#undef SEAM
}

extern "C" void kernel_launch(void* const* d_in, const int* in_sizes, int n_in, void* d_out, int out_size, void* d_ws, size_t ws_size, hipStream_t stream) {
    static int grid = 0;
    if (grid == 0) {
        if (n_in != 33 || out_size != NTOK * DM || ws_size < WS_END) { fprintf(stderr, "kernel_launch: unexpected problem (n_in %d, out %d, ws %zu, need %zu)\n", n_in, out_size, ws_size, (size_t)WS_END); grid = -1; return; }
        int dev = 0, cus = 0, per_cu = 0;
        if (hipGetDevice(&dev) != hipSuccess || hipDeviceGetAttribute(&cus, hipDeviceAttributeMultiprocessorCount, dev) != hipSuccess) { grid = -1; return; }
        if (hipFuncSetAttribute((const void*)mk_fwd, hipFuncAttributeMaxDynamicSharedMemorySize, LDS_BYTES) != hipSuccess) { fprintf(stderr, "kernel_launch: hipFuncSetAttribute failed\n"); grid = -1; return; }
        if (hipOccupancyMaxActiveBlocksPerMultiprocessor(&per_cu, (const void*)mk_fwd, 512, LDS_BYTES) != hipSuccess || per_cu < 1) fprintf(stderr, "kernel_launch: occupancy query says %d\n", per_cu);
        (void)hipGetLastError();
        grid = cus;
    }
    if (grid < 0) return;
    (void)hipMemsetAsync((char*)d_ws + WS_CTL, 0, CTL_ZERO_BYTES, stream);
    Params p{};
    const float* const* in = (const float* const*)d_in;
    p.x = in[0]; p.ln1_w = in[1]; p.w_in = in[2]; p.rw_mu = in[3];
    p.w0_f = in[4]; p.w2_f = in[5]; p.w0_b = in[6]; p.w2_b = in[7];
    p.a0_f = in[8]; p.a2_f = in[9]; p.a0_b = in[10]; p.a2_b = in[11];
    p.g2 = in[12]; p.k_k = in[13]; p.k_a = in[14]; p.r_k = in[15]; p.ln_w = in[16]; p.ln_b = in[17];
    p.gw2_f = in[18]; p.gb_f = in[19]; p.gw2_b = in[20]; p.gb_b = in[21]; p.gnorm_w = in[22];
    p.w_out = in[23]; p.ln2_w = in[24]; p.w_coarse = in[25]; p.b_coarse = in[26]; p.w_fine = in[27]; p.b_fine = in[28];
    p.w_gate = in[29]; p.w_up = in[30]; p.w_down = in[31]; p.ln_f_w = in[32];
    p.out = (float*)d_out; p.ws = (unsigned char*)d_ws;
#if MK_PER_PHASE
    for (int k = 0; k < NPH; ++k) { p.ph_lo = k; p.ph_hi = k + 1; hipLaunchKernelGGL(mk_fwd, dim3(grid), dim3(512), LDS_BYTES, stream, p); }
#else
    p.ph_lo = 0; p.ph_hi = NPH; hipLaunchKernelGGL(mk_fwd, dim3(grid), dim3(512), LDS_BYTES, stream, p);
#endif
}
```

```cpp
#include <hip/hip_runtime.h>
#include <cstdio>
#include <cstdint>

#ifndef MK_PER_PHASE
#define MK_PER_PHASE 0
#endif

#define LAS __attribute__((address_space(3)))
#define GAS __attribute__((address_space(1)))
typedef unsigned short bf16_t;
typedef short bf16x8 __attribute__((ext_vector_type(8)));
typedef float f32x4 __attribute__((ext_vector_type(4)));
typedef float f32x16 __attribute__((ext_vector_type(16)));
typedef unsigned u32x4 __attribute__((ext_vector_type(4)));
typedef unsigned u32x2 __attribute__((ext_vector_type(2)));
typedef LAS unsigned char* ldsp_t;

constexpr int NTOK = 16384, SEQ = 4096, DM = 1024;
constexpr int LDA_RW = 2048;
constexpr int LDB_GL = 1792;
constexpr int RW_COLS = 1920, GL_COLS = 1568;
constexpr int NEXP = 32, DEXP = 512;
constexpr int NPH = 13;

constexpr size_t MiB = 1u << 20;
constexpr size_t WS_CTL = 0, CTL_ZERO_BYTES = 64 * 1024;
constexpr size_t WS_LORA = 1 * MiB;
constexpr size_t WS_BT_RW = 2 * MiB, WS_BT_GL = 6 * MiB, WS_BT_OUT = 10 * MiB;
constexpr size_t WS_BON = 12 * MiB;
constexpr size_t WS_RSTD = 12 * MiB;
constexpr size_t WS_ELIST = 13 * MiB;
constexpr size_t WS_DEC = 15 * MiB;
constexpr size_t WS_H = 16 * MiB;
constexpr size_t WS_OF = 16 * MiB, WS_OB = 32 * MiB;
constexpr size_t WS_H2 = 16 * MiB;
constexpr size_t WS_RM = 48 * MiB, WS_RP = 80 * MiB, WS_RNT = 112 * MiB;
constexpr size_t WS_GQ = 48 * MiB, WS_GNT = 64 * MiB;
constexpr size_t WS_MIX = 48 * MiB;
constexpr size_t WS_YF = 144 * MiB, WS_YB = 160 * MiB, WS_G = 176 * MiB, WS_VS = 192 * MiB;
constexpr size_t WS_PB = 208 * MiB;
constexpr size_t WS_WGU = 80 * MiB, WS_WDN = 144 * MiB;
constexpr size_t WS_XMID = 176 * MiB;
constexpr size_t WS_YK0 = 48 * MiB, WS_YK1 = 216 * MiB;
constexpr size_t WS_ELW = 248 * MiB;
constexpr size_t WS_END = 264 * MiB;
constexpr int CW_CNT = 0;
constexpr int CW_BAR = 4096;
constexpr int CW_PN = 12288;
constexpr int CW_MT = 8192;

constexpr int LDS_BYTES = 160 * 1024;
constexpr int LDS_MISC = LDS_BYTES - 64;
constexpr int LDS_TAB = 131072;

#ifndef PROBE_ID
#define PROBE_ID 0
#endif
#ifndef PROBE_MULT
#define PROBE_MULT 1
#endif
#define PROBE_BEGIN(id) long long _pb_##id = 0; if (PROBE_ID == (id)) { _pb_##id = __builtin_readcyclecounter(); }
#define PROBE_END(id) if (PROBE_ID == (id)) { const long long _e = __builtin_readcyclecounter(); const long long _d = (_e - _pb_##id) * PROBE_MULT; while (__builtin_readcyclecounter() - _e < _d) __builtin_amdgcn_s_sleep(2); }
__device__ __forceinline__ float bf2f(unsigned b) { return __uint_as_float(b << 16); }
typedef __bf16 bf2_t __attribute__((ext_vector_type(2)));
typedef float f2_t __attribute__((ext_vector_type(2)));
__device__ __forceinline__ unsigned f2bf(float f) { const __bf16 b = (__bf16)f; return (unsigned)__builtin_bit_cast(unsigned short, b); }
__device__ __forceinline__ unsigned pk2(float lo, float hi) { const f2_t v = {lo, hi}; const bf2_t r = __builtin_convertvector(v, bf2_t); return __builtin_bit_cast(unsigned, r); }
template <int CTRL> __device__ __forceinline__ float dpp_mov(float x) { return __int_as_float(__builtin_amdgcn_update_dpp(0, __float_as_int(x), CTRL, 0xF, 0xF, true)); }
template <int N> __device__ __forceinline__ void wave_sum_n(float (&v)[N]) {
#pragma unroll
    for (int i = 0; i < N; ++i) v[i] += dpp_mov<0xB1>(v[i]);
#pragma unroll
    for (int i = 0; i < N; ++i) v[i] += dpp_mov<0x4E>(v[i]);
#pragma unroll
    for (int i = 0; i < N; ++i) v[i] += dpp_mov<0x141>(v[i]);
#pragma unroll
    for (int i = 0; i < N; ++i) v[i] += dpp_mov<0x140>(v[i]);
    { float t[N];
#pragma unroll
      for (int i = 0; i < N; ++i) t[i] = __int_as_float(__builtin_amdgcn_ds_swizzle(__float_as_int(v[i]), 0x401F));
#pragma unroll
      for (int i = 0; i < N; ++i) v[i] += t[i]; }
    { float t[N];
#pragma unroll
      for (int i = 0; i < N; ++i) t[i] = __shfl_xor(v[i], 32);
#pragma unroll
      for (int i = 0; i < N; ++i) v[i] += t[i]; }
}
__device__ __forceinline__ float wave_sum(float v) { float t[1] = {v}; wave_sum_n<1>(t); return t[0]; }
__device__ __forceinline__ float sigmoidf_(float x) { return __builtin_amdgcn_rcpf(1.f + __expf(-x)); }
__device__ __forceinline__ float tanhf_(float x) { return 1.f - 2.f * __builtin_amdgcn_rcpf(1.f + __expf(2.f * x)); }
__device__ __forceinline__ void unpack8(const u32x4& v, float (&o)[8]) {
    o[0] = bf2f(v.x & 0xffffu); o[1] = bf2f(v.x >> 16); o[2] = bf2f(v.y & 0xffffu); o[3] = bf2f(v.y >> 16);
    o[4] = bf2f(v.z & 0xffffu); o[5] = bf2f(v.z >> 16); o[6] = bf2f(v.w & 0xffffu); o[7] = bf2f(v.w >> 16);
}
__device__ __forceinline__ u32x4 pack8(const float (&o)[8]) {
    u32x4 v; v.x = pk2(o[0], o[1]); v.y = pk2(o[2], o[3]); v.z = pk2(o[4], o[5]); v.w = pk2(o[6], o[7]); return v;
}

#define XB_TMO      128
#define XB_XCNT(j)  (256  + 64 * (j))
#define XB_XSUB(j)  (1280 + 64 * (j))
#define XB_XGEN(j)  (2304 + 64 * (j))
#define XB_TOP      3328
#define XB_TOPGEN   3392
#define XCD_BAR_WORDS 3456
#define XB_SPIN_CAP (1u << 18)
__device__ __forceinline__ unsigned xb_ld(unsigned* p)              { return __hip_atomic_load(p, __ATOMIC_RELAXED, __HIP_MEMORY_SCOPE_AGENT); }
__device__ __forceinline__ unsigned xb_add(unsigned* p, unsigned v) { return __hip_atomic_fetch_add(p, v, __ATOMIC_RELAXED, __HIP_MEMORY_SCOPE_AGENT); }
__device__ __forceinline__ unsigned xb_xcc_id() { return (unsigned)__builtin_amdgcn_s_getreg((3 << 11) | 20) & 0xFu; }
#define XB_SPIN(cond, bar) do { unsigned _sp = 0; while (cond) { __builtin_amdgcn_s_sleep(1); \
    if ((++_sp & 255u) == 0u) { if (xb_ld(&(bar)[XB_TMO])) break; if (_sp > XB_SPIN_CAP) { atomicAdd(&(bar)[XB_TMO], 1u); break; } } } } while (0)
struct XcdBarrier { unsigned* bar; unsigned x; volatile LAS unsigned* st; };
__device__ __forceinline__ XcdBarrier xcd_barrier_post(unsigned* bar, volatile LAS unsigned* st) {
    XcdBarrier b; b.bar = bar; b.x = xb_xcc_id(); b.st = st;
    if (threadIdx.x == 0) (void)xb_add(&bar[XB_XCNT(b.x)], 1u);
    return b;
}
__device__ __forceinline__ void xcd_barrier_complete(unsigned* bar, unsigned x, unsigned& nloc, unsigned& nx) {
    const unsigned G = gridDim.x * gridDim.y * gridDim.z;
    unsigned sum, cnt, mine, sp = 0u;
    for (;;) {
        sum = 0u; cnt = 0u; mine = 0u;
#pragma unroll
        for (unsigned j = 0; j < 16; ++j) { const unsigned c = xb_ld(&bar[XB_XCNT(j)]); sum += c; cnt += (c > 0u) ? 1u : 0u; mine = (j == x) ? c : mine; }
        if (sum == G) break;
        __builtin_amdgcn_s_sleep(1);
        if ((++sp & 255u) == 0u) { if (xb_ld(&bar[XB_TMO])) break; if (sp > XB_SPIN_CAP) { atomicAdd(&bar[XB_TMO], 1u); break; } }
    }
    nloc = mine > 0u ? mine : 1u; nx = cnt > 0u ? cnt : 1u;
}
__device__ __forceinline__ void xcd_barrier(const XcdBarrier& b) {
    asm volatile("s_waitcnt vmcnt(0)" ::: "memory");
    __syncthreads();
    if (threadIdx.x == 0) {
        unsigned* bar = b.bar;
        __builtin_amdgcn_s_waitcnt(0);
        unsigned nloc = b.st[0], nx = b.st[1];
        if (nloc == 0u) { xcd_barrier_complete(bar, b.x, nloc, nx); b.st[0] = nloc; b.st[1] = nx; }
        const unsigned old = xb_add(&bar[XB_XSUB(b.x)], 1u);
        const unsigned gen = old / nloc;
        if (old + 1u == (gen + 1u) * nloc) {
            __builtin_amdgcn_fence(__ATOMIC_RELEASE, "agent");
            asm volatile("s_waitcnt vmcnt(0)" ::: "memory");
            const unsigned og = xb_add(&bar[XB_TOP], 1u);
            const unsigned tg = og / nx;
            if (og + 1u == (tg + 1u) * nx) xb_add(&bar[XB_TOPGEN], 1u);
            else XB_SPIN(xb_ld(&bar[XB_TOPGEN]) == tg, bar);
            __builtin_amdgcn_fence(__ATOMIC_ACQUIRE, "agent");
            xb_add(&bar[XB_XGEN(b.x)], 1u);
            asm volatile("s_waitcnt vmcnt(0)" ::: "memory");
        } else {
            XB_SPIN(xb_ld(&bar[XB_XGEN(b.x)]) == gen, bar);
            __builtin_amdgcn_fence(__ATOMIC_ACQUIRE, "agent");
            asm volatile("s_waitcnt vmcnt(0)" ::: "memory");
        }
    }
    __syncthreads();
}

struct Params {
    const float* x; const float* ln1_w; const float* w_in; const float* rw_mu;
    const float* w0_f; const float* w2_f; const float* w0_b; const float* w2_b;
    const float* a0_f; const float* a2_f; const float* a0_b; const float* a2_b;
    const float* g2; const float* k_k; const float* k_a; const float* r_k; const float* ln_w; const float* ln_b;
    const float* gw2_f; const float* gb_f; const float* gw2_b; const float* gb_b; const float* gnorm_w;
    const float* w_out; const float* ln2_w; const float* w_coarse; const float* b_coarse; const float* w_fine; const float* b_fine;
    const float* w_gate; const float* w_up; const float* w_down; const float* ln_f_w;
    float* out; unsigned char* ws;
    int ph_lo, ph_hi;
};

namespace pg8 {
constexpr int BM = 256, BK = 64, HALF = 128, HTB = HALF * BK * 2, STAGE_BYTES = 8 * HTB, NXCD = 8, WGM = 8;
__host__ __device__ __forceinline__ int lds_byte(int r, int c) { const int st = (r >> 4) * 2 + (c >> 5), rr = r & 15, cc = c & 31, ob = rr * 64 + cc * 2; return st * 1024 + (ob ^ (((ob >> 9) & 1) << 5)); }
__host__ __device__ __forceinline__ void stage_rc(int b, int& R, int& C) { const int st = b / 1024, sb = b % 1024, swz = sb ^ (((sb >> 9) & 1) << 5); R = (st >> 1) * 16 + swz / 64; C = (st & 1) * 32 + (swz % 64) / 2; }
__host__ __device__ __forceinline__ int perm32(int rho) { const int n = rho >> 4, i = rho & 15; return 8 * (i >> 2) + 4 * n + (i & 3); }

struct Unit { const char* a; const char* b; int pm, pn, e, mt; };

struct StaticOrder {
    static constexpr int A_AUX = 0;
    const char* A; const char* Bt; int K;
    int nM, nN, nwg, G, c;
    __device__ void init(const void* A_, const void* Bt_, int M, int N, int K_, int G_, int c_) { A = (const char*)A_; Bt = (const char*)Bt_; K = K_; nM = M / BM; nN = N / BM; nwg = nM * nN; G = G_; c = c_; }
    __device__ __forceinline__ bool next(int i, Unit& u) const {
        const long L = (long)i * G + c; if (L >= nwg) return false;
        int wgid = (int)L; { const int q = nwg / NXCD, r = nwg % NXCD, xcd = wgid % NXCD, off = wgid / NXCD; wgid = (xcd < r ? xcd * (q + 1) : r * (q + 1) + (xcd - r) * q) + off; }
        const int nig = WGM * nN, gid = wgid / nig, fm = gid * WGM, gsz = (nM - fm) < WGM ? (nM - fm) : WGM;
        u.pm = fm + ((wgid % nig) % gsz); u.pn = (wgid % nig) / gsz; u.e = 0; u.mt = 0;
        u.a = A + (size_t)u.pm * 256 * K * 2; u.b = Bt + (size_t)u.pn * 256 * K * 2; return true;
    }
    __device__ __forceinline__ void rows(const Unit&, int, int, unsigned&, unsigned&) const {}
    __device__ __forceinline__ void a_ready(const Unit&) const {}
    __device__ __forceinline__ void done(const Unit&) const {}
};

template <class Epi, class Sched, bool GATHER>
__device__ __forceinline__ void gemm_phase(ldsp_t lds, const int K, const Sched& S, const Epi& E) {
    const int tid = threadIdx.x, wid = __builtin_amdgcn_readfirstlane(tid >> 6), lane = tid & 63, wr = wid >> 2, wc = wid & 3, fr = lane & 15, fq = lane >> 4;
    const int nt = K / BK;
    unsigned voffA[2], voffB[2]; int RA[2], CA[2];
#pragma unroll
    for (int i = 0; i < 2; ++i) { int R, C; stage_rc(tid * 16 + i * 8192, R, C); const int Rb = Epi::PERM ? ((R & ~31) + perm32(R & 31)) : R;
        RA[i] = R; CA[i] = C; voffA[i] = (unsigned)(R * K + C) * 2u; voffB[i] = (unsigned)(Rb * K + C) * 2u; }
    const size_t kstep = (size_t)(BK * 2);
    const unsigned hstep = (unsigned)HALF * K * 2;
    const unsigned ldsw = (unsigned)wid * 1024u;
    const int aoff = lds_byte(wr * 64 + fr, fq * 8), boff = lds_byte(wc * 32 + fr, fq * 8);
#define PG8_SA(b, h) (((b) * 2 + (h)) * HTB)
#define PG8_SB(b, h) ((4 + (b) * 2 + (h)) * HTB)
#define PG8_STAGE2(bufoff, gbase, v0, v1) do { \
        __builtin_amdgcn_global_load_lds((const unsigned*)((const char*)(gbase) + (v0)), (LAS unsigned*)(lds + (bufoff) + ldsw), 16, 0, 0); \
        __builtin_amdgcn_global_load_lds((const unsigned*)((const char*)(gbase) + (v1)), (LAS unsigned*)(lds + (bufoff) + ldsw + 8192), 16, 0, 0); } while (0)
#define PG8_STAGEB(bufoff, gbase) PG8_STAGE2(bufoff, gbase, voffB[0], voffB[1])
#define PG8_STAGEA(bufoff, gbase, v0, v1) do { \
        __builtin_amdgcn_global_load_lds((const unsigned*)((const char*)(gbase) + (v0)), (LAS unsigned*)(lds + (bufoff) + ldsw), 16, 0, Sched::A_AUX); \
        __builtin_amdgcn_global_load_lds((const unsigned*)((const char*)(gbase) + (v1)), (LAS unsigned*)(lds + (bufoff) + ldsw + 8192), 16, 0, Sched::A_AUX); } while (0)
#define PG8_LDA(dst, b, h) do { _Pragma("unroll") for (int m = 0; m < 4; ++m) _Pragma("unroll") for (int k = 0; k < 2; ++k) dst[m][k] = *(const LAS bf16x8*)(lds + PG8_SA(b, h) + aoff + m * 2048 + k * 1024); } while (0)
#define PG8_LDB(dst, b, h) do { _Pragma("unroll") for (int n = 0; n < 2; ++n) _Pragma("unroll") for (int k = 0; k < 2; ++k) dst[n][k] = *(const LAS bf16x8*)(lds + PG8_SB(b, h) + boff + n * 2048 + k * 1024); } while (0)
#define PG8_MMA(ai, bj, At, Bt) do { __builtin_amdgcn_s_setprio(1); _Pragma("unroll") for (int m = 0; m < 4; ++m) _Pragma("unroll") for (int n = 0; n < 2; ++n) _Pragma("unroll") for (int k = 0; k < 2; ++k) \
        acc[ai][bj][m][n] = __builtin_amdgcn_mfma_f32_16x16x32_bf16(Bt[n][k], At[m][k], acc[ai][bj][m][n], 0, 0, 0); __builtin_amdgcn_s_setprio(0); } while (0)
#define PG8_WAIT_V(n) asm volatile("s_waitcnt vmcnt(" #n ")" ::: "memory")
#define PG8_WAIT_L(n) asm volatile("s_waitcnt lgkmcnt(" #n ")" ::: "memory")
#define PG8_BAR __builtin_amdgcn_s_barrier()
#define PG8_SCHED __builtin_amdgcn_sched_barrier(0)
    Unit cur, nxt; int ui = 0;
    if (!S.next(0, cur)) return;
    f32x4 acc[2][2][4][2];
#pragma unroll
    for (int a = 0; a < 2; ++a)
#pragma unroll
        for (int b = 0; b < 2; ++b)
#pragma unroll
            for (int m = 0; m < 4; ++m)
#pragma unroll
                for (int n = 0; n < 2; ++n) acc[a][b][m][n] = (f32x4){0.f, 0.f, 0.f, 0.f};
    bf16x8 At[4][2], B0[2][2], B1[2][2];
    unsigned oc0[2], oc1[2], on0[2], on1[2];
    if constexpr (GATHER) {
#pragma unroll
        for (int i = 0; i < 2; ++i) { unsigned r0, r1; S.rows(cur, RA[i], RA[i] + 128, r0, r1); oc0[i] = r0 * (unsigned)(K * 2) + (unsigned)CA[i] * 2u; oc1[i] = r1 * (unsigned)(K * 2) + (unsigned)CA[i] * 2u; on0[i] = oc0[i]; on1[i] = oc1[i]; }
    } else {
#pragma unroll
        for (int i = 0; i < 2; ++i) { oc0[i] = voffA[i]; oc1[i] = voffA[i] + hstep; on0[i] = oc0[i]; on1[i] = oc1[i]; }
    }
    const char* cA = cur.a; const char* cB = cur.b;
    S.a_ready(cur);
    PG8_STAGEB(PG8_SB(0, 0), cB); PG8_STAGEA(PG8_SA(0, 0), cA, oc0[0], oc0[1]); PG8_STAGEB(PG8_SB(0, 1), cB + hstep); PG8_STAGEA(PG8_SA(0, 1), cA, oc1[0], oc1[1]);
    if (wr == 1) PG8_BAR;
    PG8_WAIT_V(4); PG8_BAR;
    PG8_STAGEB(PG8_SB(1, 0), cB + kstep); PG8_STAGEA(PG8_SA(1, 0), cA + kstep, oc0[0], oc0[1]); PG8_STAGEB(PG8_SB(1, 1), cB + hstep + kstep);
    PG8_WAIT_V(6); PG8_BAR;
    for (;;) {
        const bool has_next = S.next(ui + 1, nxt);
        const char* nA = has_next ? nxt.a : cA; const char* nB = has_next ? nxt.b : cB;
        if constexpr (GATHER) {
            if (has_next) {
#pragma unroll
                for (int i = 0; i < 2; ++i) { unsigned r0, r1; S.rows(nxt, RA[i], RA[i] + 128, r0, r1); on0[i] = r0 * (unsigned)(K * 2) + (unsigned)CA[i] * 2u; on1[i] = r1 * (unsigned)(K * 2) + (unsigned)CA[i] * 2u; }
            } else {
#pragma unroll
                for (int i = 0; i < 2; ++i) { on0[i] = oc0[i]; on1[i] = oc1[i]; }
            }
        }
        for (int t = 0; t < nt; t += 2) {
            const bool last = (t == nt - 2);
            const char* a1 = cA + (size_t)(t + 1) * kstep;
            const char* a2 = last ? nA : cA + (size_t)(t + 2) * kstep; const char* b2 = last ? nB : cB + (size_t)(t + 2) * kstep;
            const char* a3 = a2 + kstep; const char* b3 = b2 + kstep;
            if (last && has_next) S.a_ready(nxt);
            unsigned p00, p01, p10, p11;
            if constexpr (GATHER) { p00 = last ? on0[0] : oc0[0]; p01 = last ? on0[1] : oc0[1]; p10 = last ? on1[0] : oc1[0]; p11 = last ? on1[1] : oc1[1]; }
            else { p00 = oc0[0]; p01 = oc0[1]; p10 = oc1[0]; p11 = oc1[1]; }
            PG8_LDB(B0, 0, 0); PG8_SCHED; PG8_LDA(At, 0, 0); PG8_STAGEA(PG8_SA(1, 1), a1, oc1[0], oc1[1]);
            PG8_WAIT_L(8); PG8_BAR; PG8_WAIT_L(0); PG8_MMA(0, 0, At, B0); PG8_BAR; PG8_SCHED;
            PG8_LDB(B1, 0, 1); PG8_STAGEB(PG8_SB(0, 0), b2);
            PG8_BAR; PG8_WAIT_L(0); PG8_MMA(0, 1, At, B1); PG8_BAR;
            PG8_LDA(At, 0, 1); PG8_STAGEA(PG8_SA(0, 0), a2, p00, p01);
            PG8_BAR; PG8_WAIT_L(0); PG8_MMA(1, 0, At, B0); PG8_BAR; PG8_SCHED;
            PG8_STAGEB(PG8_SB(0, 1), b2 + hstep);
            PG8_WAIT_V(6); PG8_BAR; PG8_MMA(1, 1, At, B1); PG8_BAR;
            PG8_LDB(B0, 1, 0); PG8_SCHED; PG8_LDA(At, 1, 0); PG8_STAGEA(PG8_SA(0, 1), a2, p10, p11);
            PG8_WAIT_L(8); PG8_BAR; PG8_WAIT_L(0); PG8_MMA(0, 0, At, B0); PG8_BAR; PG8_SCHED;
            PG8_LDB(B1, 1, 1); PG8_STAGEB(PG8_SB(1, 0), b3);
            PG8_BAR; PG8_WAIT_L(0); PG8_MMA(0, 1, At, B1); PG8_BAR;
            PG8_LDA(At, 1, 1); PG8_STAGEA(PG8_SA(1, 0), a3, p00, p01);
            PG8_BAR; PG8_WAIT_L(0); PG8_MMA(1, 0, At, B0); PG8_BAR; PG8_SCHED;
            PG8_STAGEB(PG8_SB(1, 1), b3 + hstep);
            PG8_WAIT_V(6); PG8_BAR; PG8_MMA(1, 1, At, B1); PG8_BAR;
        }
        E(acc, cur, wr, wc, fr, fq); S.done(cur);
        if (!has_next) break;
#pragma unroll
        for (int a = 0; a < 2; ++a)
#pragma unroll
            for (int b = 0; b < 2; ++b)
#pragma unroll
                for (int m = 0; m < 4; ++m)
#pragma unroll
                    for (int n = 0; n < 2; ++n) acc[a][b][m][n] = (f32x4){0.f, 0.f, 0.f, 0.f};
        cur = nxt; cA = nA; cB = nB; ++ui;
#pragma unroll
        for (int i = 0; i < 2; ++i) { oc0[i] = on0[i]; oc1[i] = on1[i]; }
    }
    PG8_WAIT_V(0);
    if (wr == 0) PG8_BAR;
    PG8_BAR;
#undef PG8_SA
#undef PG8_SB
#undef PG8_STAGE2
#undef PG8_STAGEB
#undef PG8_STAGEA
#undef PG8_LDA
#undef PG8_LDB
#undef PG8_MMA
#undef PG8_WAIT_V
#undef PG8_WAIT_L
#undef PG8_BAR
#undef PG8_SCHED
}

struct EpiBf16 {
    static constexpr bool PERM = true;
    bf16_t* O; int ldc;
    __device__ __forceinline__ void operator()(const f32x4 (&acc)[2][2][4][2], const Unit& u, int wr, int wc, int fr, int fq) const {
        const int row0 = u.pm * BM + wr * 64 + fr, col0 = u.pn * BM + wc * 32 + 8 * fq;
#pragma unroll
        for (int ai = 0; ai < 2; ++ai)
#pragma unroll
            for (int m = 0; m < 4; ++m) { bf16_t* rowp = O + (size_t)(row0 + ai * HALF + m * 16) * ldc + col0;
#pragma unroll
                for (int bj = 0; bj < 2; ++bj) { const f32x4 v0 = acc[ai][bj][m][0], v1 = acc[ai][bj][m][1];
                    u32x4 o; o.x = pk2(v0[0], v0[1]); o.y = pk2(v0[2], v0[3]); o.z = pk2(v1[0], v1[1]); o.w = pk2(v1[2], v1[3]);
                    *(u32x4*)(rowp + bj * HALF) = o; } }
    }
};
struct EpiResF32 {
    static constexpr bool PERM = false;
    float* C; const float* X; int ldc;
    __device__ __forceinline__ void operator()(const f32x4 (&acc)[2][2][4][2], const Unit& u, int wr, int wc, int fr, int fq) const {
        const int row0 = u.pm * BM + wr * 64 + fr, col0 = u.pn * BM + wc * 32 + 4 * fq;
        const __amdgpu_buffer_rsrc_t rsrc = __builtin_amdgcn_make_buffer_rsrc((void*)C, 0, NTOK * DM * 4, 0x00020000);
#pragma unroll
        for (int ai = 0; ai < 2; ++ai)
#pragma unroll
            for (int m = 0; m < 4; ++m) { const size_t ro = (size_t)(row0 + ai * HALF + m * 16) * ldc + col0;
#pragma unroll
                for (int bj = 0; bj < 2; ++bj)
#pragma unroll
                    for (int n = 0; n < 2; ++n) { const f32x4 xv = *(const f32x4*)(X + ro + bj * HALF + n * 16); const f32x4 o = acc[ai][bj][m][n] + xv;
                        __builtin_amdgcn_raw_buffer_store_b128(__builtin_bit_cast(u32x4, o), rsrc, (int)((ro + bj * HALF + n * 16) * 4), 0, 16); } }
    }
};
struct EpiResBf16 {
    static constexpr bool PERM = true;
    bf16_t* C; const float* X; int ldc;
    __device__ __forceinline__ void operator()(const f32x4 (&acc)[2][2][4][2], const Unit& u, int wr, int wc, int fr, int fq) const {
        const int row0 = u.pm * BM + wr * 64 + fr, col0 = u.pn * BM + wc * 32 + 8 * fq;
        const __amdgpu_buffer_rsrc_t rsrc = __builtin_amdgcn_make_buffer_rsrc((void*)C, 0, NTOK * DM * 2, 0x00020000);
#pragma unroll
        for (int ai = 0; ai < 2; ++ai)
#pragma unroll
            for (int m = 0; m < 4; ++m) { const size_t ro = (size_t)(row0 + ai * HALF + m * 16) * ldc + col0;
#pragma unroll
                for (int bj = 0; bj < 2; ++bj) { const f32x4 x0 = *(const f32x4*)(X + ro + bj * HALF), x1 = *(const f32x4*)(X + ro + bj * HALF + 4);
                    const f32x4 v0 = acc[ai][bj][m][0] + x0, v1 = acc[ai][bj][m][1] + x1;
                    u32x4 o; o.x = pk2(v0[0], v0[1]); o.y = pk2(v0[2], v0[3]); o.z = pk2(v1[0], v1[1]); o.w = pk2(v1[2], v1[3]);
                    __builtin_amdgcn_raw_buffer_store_b128(o, rsrc, (int)((ro + bj * HALF) * 2), 0, 16); } }
    }
};
struct PanelOrder {
    static constexpr int A_AUX = 0;
    const char* A; const char* Bt; unsigned* cnt; int K, nN, nwg, G, c;
    __device__ __forceinline__ bool next(int i, Unit& u) const {
        const int L = i * G + c; if (L >= nwg) return false;
        u.pm = L / nN; u.pn = L % nN; u.e = 0; u.mt = 0;
        u.a = A + (size_t)u.pm * 256 * K * 2; u.b = Bt + (size_t)u.pn * 256 * K * 2; return true;
    }
    __device__ __forceinline__ void rows(const Unit&, int, int, unsigned&, unsigned&) const {}
    __device__ __forceinline__ void a_ready(const Unit&) const {}
    __device__ __forceinline__ void done(const Unit& u) const {
        asm volatile("s_waitcnt vmcnt(0)" ::: "memory");
        if ((threadIdx.x & 63) == 0) __hip_atomic_fetch_add(cnt + 16 * u.pm, 1u, __ATOMIC_RELAXED, __HIP_MEMORY_SCOPE_AGENT);
    }
};
}

template <int KS>
__device__ __forceinline__ f32x4 tile_n(const LAS unsigned char* A, int lda, const LAS unsigned char* Bt, int ldb, f32x4 acc, int lane) {
    const LAS unsigned char* ap = A + (lane & 15) * lda + (lane >> 4) * 16;
    const LAS unsigned char* bp = Bt + (lane & 15) * ldb + (lane >> 4) * 16;
#pragma unroll
    for (int k = 0; k < KS; ++k) { const bf16x8 a = *(const LAS bf16x8*)(ap + k * 64), b = *(const LAS bf16x8*)(bp + k * 64); acc = __builtin_amdgcn_mfma_f32_16x16x32_bf16(a, b, acc, 0, 0, 0); }
    return acc;
}
template <int KS>
__device__ __forceinline__ f32x4 tile_s(const LAS unsigned char* A, int lda, const LAS unsigned char* Bt, int ldb, f32x4 acc, int lane) {
    const LAS unsigned char* ap = A + (lane & 15) * lda + (lane >> 4) * 16;
    const LAS unsigned char* bp = Bt + (lane & 15) * ldb + (lane >> 4) * 16;
#pragma unroll
    for (int k = 0; k < KS; ++k) { const bf16x8 a = *(const LAS bf16x8*)(ap + k * 64), b = *(const LAS bf16x8*)(bp + k * 64); acc = __builtin_amdgcn_mfma_f32_16x16x32_bf16(b, a, acc, 0, 0, 0); }
    return acc;
}
struct Frag2 { bf16x8 f[2]; };
__device__ __forceinline__ Frag2 ld_frag2(const LAS unsigned char* M, int ld, int lane) { const LAS unsigned char* p = M + (lane & 15) * ld + (lane >> 4) * 16; Frag2 r; r.f[0] = *(const LAS bf16x8*)p; r.f[1] = *(const LAS bf16x8*)(p + 64); return r; }
__device__ __forceinline__ f32x4 tile_nb(const LAS unsigned char* A, int lda, const Frag2& b, f32x4 acc, int lane) {
    const LAS unsigned char* ap = A + (lane & 15) * lda + (lane >> 4) * 16;
#pragma unroll
    for (int k = 0; k < 2; ++k) { const bf16x8 a = *(const LAS bf16x8*)(ap + k * 64); acc = __builtin_amdgcn_mfma_f32_16x16x32_bf16(a, b.f[k], acc, 0, 0, 0); }
    return acc;
}
__device__ __forceinline__ f32x4 tile_sb(const LAS unsigned char* A, int lda, const Frag2& b, f32x4 acc, int lane) {
    const LAS unsigned char* ap = A + (lane & 15) * lda + (lane >> 4) * 16;
#pragma unroll
    for (int k = 0; k < 2; ++k) { const bf16x8 a = *(const LAS bf16x8*)(ap + k * 64); acc = __builtin_amdgcn_mfma_f32_16x16x32_bf16(b.f[k], a, acc, 0, 0, 0); }
    return acc;
}
__device__ __forceinline__ void st4bf(LAS unsigned char* p, const f32x4& v) { u32x2 o; o.x = pk2(v[0], v[1]); o.y = pk2(v[2], v[3]); *(LAS u32x2*)p = o; }
__device__ __forceinline__ void st4bf_g(bf16_t* p, const f32x4& v) { u32x2 o; o.x = pk2(v[0], v[1]); o.y = pk2(v[2], v[3]); *(u32x2*)p = o; }


struct Ctx { ldsp_t lds; int tid, lane, wid, vcu, G; };

__device__ __forceinline__ void transpose_block(const float* W, int N, bf16_t* WT, int ldk, int dst_row0, int k0, int n0, LAS float* scr, int lane) {
    float tv[32];
#pragma unroll
    for (int i = 0; i < 32; ++i) { const int kk = 2 * i + (lane >> 5); tv[i] = W[(size_t)(k0 + kk) * N + n0 + (lane & 31)]; }
#pragma unroll
    for (int i = 0; i < 32; ++i) { const int kk = 2 * i + (lane >> 5); scr[kk * 33 + (lane & 31)] = tv[i]; }
    asm volatile("s_waitcnt lgkmcnt(0)" ::: "memory");
    const int c = lane & 7;
#pragma unroll
    for (int j = 0; j < 4; ++j) { const int n = (lane >> 3) + 8 * j; const LAS float* s = scr + (8 * c) * 33 + n;
        u32x4 o; o.x = pk2(s[0 * 33], s[1 * 33]); o.y = pk2(s[2 * 33], s[3 * 33]); o.z = pk2(s[4 * 33], s[5 * 33]); o.w = pk2(s[6 * 33], s[7 * 33]);
        *(u32x4*)(WT + (size_t)(dst_row0 + n) * ldk + k0 + 8 * c) = o; }
    asm volatile("s_waitcnt lgkmcnt(0)" ::: "memory");
}
__device__ __forceinline__ void rms_row_to_bf16(const float* xrow, const float* w, bf16_t* orow, int lane) {
    const f32x4* xr = (const f32x4*)xrow + lane; const f32x4* wr = (const f32x4*)w + lane;
    f32x4 v[4]; float s = 0.f;
#pragma unroll
    for (int j = 0; j < 4; ++j) { v[j] = xr[64 * j]; s += (v[j].x * v[j].x + v[j].y * v[j].y) + (v[j].z * v[j].z + v[j].w * v[j].w); }
    const float inv = rsqrtf(wave_sum(s) * (1.f / 1024.f) + 1e-6f);
    u32x2* o8 = (u32x2*)orow + lane;
#pragma unroll
    for (int j = 0; j < 4; ++j) { const f32x4 g = wr[64 * j]; u32x2 o; o.x = pk2(v[j].x * inv * g.x, v[j].y * inv * g.y); o.y = pk2(v[j].z * inv * g.z, v[j].w * inv * g.w); o8[64 * j] = o; }
}
__device__ __forceinline__ void p0_prologue(const Params& P, const Ctx& F) {
    LAS float* scr = (LAS float*)(F.lds + F.wid * 16384);
    const int gw = F.vcu * 8 + F.wid, NGW = F.G * 8;
    unsigned char* ws = P.ws;
    bf16_t* BT_RW = (bf16_t*)(ws + WS_BT_RW); bf16_t* BT_GL = (bf16_t*)(ws + WS_BT_GL); bf16_t* BT_OUT = (bf16_t*)(ws + WS_BT_OUT);
    bf16_t* LORA = (bf16_t*)(ws + WS_LORA);
    constexpr int I_IN = 16 * 109, I_OUT = 16 * 32, I_L = 16, I_G = 32;
    constexpr int NITEMS = I_IN + I_OUT + 4 * I_L + I_G;
    for (int it = gw; it < NITEMS; it += NGW) {
        int r = it;
        if (r < I_IN) { const int kb = r / 109, nb = r % 109, n0 = 32 * nb;
            if (n0 < RW_COLS) transpose_block(P.w_in, 3488, BT_RW, 1024, n0, 64 * kb, n0, scr, F.lane);
            else transpose_block(P.w_in, 3488, BT_GL, 1024, n0 - RW_COLS, 64 * kb, n0, scr, F.lane);
            continue; }
        r -= I_IN;
        if (r < I_OUT) { const int kb = r / 32, nb = r % 32; transpose_block(P.w_out, 1024, BT_OUT, 1024, 32 * nb, 64 * kb, 32 * nb, scr, F.lane); continue; }
        r -= I_OUT;
        if (r < 4 * I_L) { const int which = r / I_L, nb = r % I_L;
            const float* src = which == 0 ? P.w2_f : which == 1 ? P.w2_b : which == 2 ? P.a2_f : P.a2_b;
            transpose_block(src, 512, LORA + (size_t)which * 32768, 64, 32 * nb, 0, 32 * nb, scr, F.lane); continue; }
        r -= 4 * I_L;
        { const int kb = r / 16, nb = r % 16; transpose_block(P.g2, 512, LORA + 4 * 32768, 128, 32 * nb, 64 * kb, 32 * nb, scr, F.lane); }
    }
    { const int gt = F.vcu * 512 + F.tid, NGT = F.G * 512; const u32x4 z = {0u, 0u, 0u, 0u};
      u32x4* p1 = (u32x4*)(BT_RW + (size_t)RW_COLS * 1024); for (int i = gt; i < (2048 - RW_COLS) * 128; i += NGT) p1[i] = z;
      u32x4* p2 = (u32x4*)(BT_GL + (size_t)GL_COLS * 1024); for (int i = gt; i < (1792 - GL_COLS) * 128; i += NGT) p2[i] = z; }
    { const int gt = F.vcu * 512 + F.tid, NGT = F.G * 512; bf16_t* WrT = (bf16_t*)(ws + WS_LORA + 512 * 1024);
      for (int i = gt; i < 48 * 1024; i += NGT) { const int n = i >> 10, k = i & 1023;
          const float v = n < 4 ? P.w_coarse[k * 4 + n] : n < 36 ? P.w_fine[k * 32 + n - 4] : 0.f; WrT[i] = (bf16_t)f2bf(v); } }
    bf16_t* H = (bf16_t*)(ws + WS_H);
    for (int m = gw; m < NTOK; m += 2 * NGW) {
        const int m2 = m + NGW; const bool has2 = m2 < NTOK;
        const f32x4* xa = (const f32x4*)(P.x + (size_t)m * 1024) + F.lane; const f32x4* xb = (const f32x4*)(P.x + (size_t)(has2 ? m2 : m) * 1024) + F.lane;
        const f32x4* wr = (const f32x4*)P.ln1_w + F.lane;
        f32x4 va[4], vb[4]; float ss[2] = {0.f, 0.f};
#pragma unroll
        for (int j = 0; j < 4; ++j) { va[j] = xa[64 * j]; vb[j] = xb[64 * j]; }
#pragma unroll
        for (int j = 0; j < 4; ++j) { ss[0] += (va[j].x * va[j].x + va[j].y * va[j].y) + (va[j].z * va[j].z + va[j].w * va[j].w); ss[1] += (vb[j].x * vb[j].x + vb[j].y * vb[j].y) + (vb[j].z * vb[j].z + vb[j].w * vb[j].w); }
        wave_sum_n<2>(ss);
        const float ia = rsqrtf(ss[0] * (1.f / 1024.f) + 1e-6f), ib = rsqrtf(ss[1] * (1.f / 1024.f) + 1e-6f);
        u32x2* oa = (u32x2*)(H + (size_t)m * 1024) + F.lane; u32x2* ob = (u32x2*)(H + (size_t)m2 * 1024) + F.lane;
#pragma unroll
        for (int j = 0; j < 4; ++j) { const f32x4 g = wr[64 * j];
            u32x2 o; o.x = pk2(va[j].x * ia * g.x, va[j].y * ia * g.y); o.y = pk2(va[j].z * ia * g.z, va[j].w * ia * g.w); oa[64 * j] = o;
            if (has2) { u32x2 q; q.x = pk2(vb[j].x * ib * g.x, vb[j].y * ib * g.y); q.y = pk2(vb[j].z * ib * g.z, vb[j].w * ib * g.w); ob[64 * j] = q; } }
    }
}

__device__ __forceinline__ bf16x8 pack_step(const f32x16& x, int s) {
    u32x4 p; p.x = pk2(x[8 * s + 0], x[8 * s + 1]); p.y = pk2(x[8 * s + 2], x[8 * s + 3]); p.z = pk2(x[8 * s + 4], x[8 * s + 5]); p.w = pk2(x[8 * s + 6], x[8 * s + 7]);
    return __builtin_bit_cast(bf16x8, p);
}
#define MFMA32(a, b, c) __builtin_amdgcn_mfma_f32_32x32x16_bf16((a), (b), (c), 0, 0, 0)

constexpr size_t OUT_GQ = 0, OUT_GNT = 16 * MiB;
constexpr int RS = 144;
constexpr int RMS_ = 64 * RS;
constexpr int L_AT = 0, L_BT = RMS_, L_KT = 2 * RMS_, L_RT = 3 * RMS_, L_ATT = 4 * RMS_, L_BHT = 5 * RMS_, L_KHT = 6 * RMS_, L_VT = 7 * RMS_;
constexpr int L_U1 = 8 * RMS_;
constexpr int L_TW = L_U1, L_AL = L_U1 + RMS_, L_SG = L_U1 + 2 * RMS_, L_LW = L_SG + 64 * 272, L_AA = L_LW + 16384;
constexpr int L_T1 = L_LW, L_LAK = L_T1 + RMS_, L_RB = L_T1 + 2 * RMS_, L_RK = L_T1 + 3 * RMS_, L_EX = L_T1 + 4 * RMS_, L_WC = L_U1 + 9 * RMS_;
static_assert(L_EX + 4096 + 64 <= L_WC, "rwkv back-end LDS map");
constexpr int L_XT = 0, L_G1T = 2 * RMS_;
static_assert(L_AA + 16384 <= L_WC && L_WC + 256 <= LDS_MISC, "rwkv LDS map");
constexpr int L_PF = L_WC + 512;
constexpr int L_HS = L_WC + 1024;
static_assert(L_HS + 2048 <= LDS_MISC, "half-block sums");
static_assert(L_PF + 256 <= LDS_MISC, "prefetch sink");

struct RwRaw { u32x4 xc[4]; unsigned rr[10], rk[10], rv[10]; };
template <int DIR>
__device__ __forceinline__ void rwkv_load_lora(const Params& P, const Ctx& F, const int item, RwRaw& R) {
    constexpr int dir = DIR; const int c = (item >> 4) & 63, b = item >> 10;
    const int t0 = c * 64, tb = b * SEQ;
    const bf16_t* PA = (const bf16_t*)P.out;
#pragma unroll
    for (int it = 0; it < 4; ++it) {
        const int q = F.tid + 512 * it, j = q >> 5, ch = q & 31;
        const int col0 = ch < 8 ? 1536 + 64 * dir + 8 * ch : ch < 16 ? 1664 + 64 * dir + 8 * (ch - 8) : 1792 + 8 * (ch - 16);
        const int tn = dir ? t0 + 63 - j : t0 + j;
        R.xc[it] = *(const u32x4*)(PA + (size_t)(tb + tn) * LDA_RW + col0);
    }
}
template <int DIR>
__device__ __forceinline__ void rwkv_load_rkv(const Params& P, const Ctx& F, const int item, RwRaw& R) {
    constexpr int dir = DIR; const int h = (item >> 1) & 7, c = (item >> 4) & 63, b = item >> 10;
    const int t0 = c * 64, tb = b * SEQ;
    const bf16_t* PA = (const bf16_t*)P.out;
    const int jlo = 8 * F.wid, tlo = dir ? (t0 + 55 - jlo) : (t0 + jlo - 1), hi = h * 64 + F.lane;
#pragma unroll
    for (int q = 0; q < 10; ++q) { int tn = tlo + q; tn = tn < 0 ? 0 : (tn > SEQ - 1 ? SEQ - 1 : tn);
        const bf16_t* row = PA + (size_t)(tb + tn) * LDA_RW + hi;
        R.rr[q] = row[0]; R.rk[q] = row[512]; R.rv[q] = row[1024]; }
}
template <int DIR>
__device__ __forceinline__ void rwkv_prefetch(const Params& P, const Ctx& F, const int nitem, unsigned& sink) {
    const int h = (nitem >> 1) & 7, c = (nitem >> 4) & 63, b = nitem >> 10;
    const int t0 = c * 64, tb = b * SEQ, tid = F.tid;
    const bf16_t* PA = (const bf16_t*)P.out;
    if (tid < 198) {
        const int q = tid / 3, a = tid - 3 * q; int tn = t0 - 1 + q; tn = tn < 0 ? 0 : (tn > SEQ - 1 ? SEQ - 1 : tn);
        const bf16_t* p = PA + (size_t)(tb + tn) * LDA_RW + a * 512 + h * 64;
        { unsigned m0s; asm volatile("s_mov_b32 %0, m0\n\ts_mov_b32 m0, %2\n\ts_nop 0\n\tglobal_load_lds_dword %1, off\n\ts_mov_b32 m0, %0" : "=&s"(m0s) : "v"(p), "s"(L_PF) : "memory"); }
    }
    if (h == 0 && tid < 264) {
        const int q = tid >> 2, a = tid & 3; int tn = t0 - 1 + q; tn = tn < 0 ? 0 : (tn > SEQ - 1 ? SEQ - 1 : tn);
        const int col = a == 0 ? 1536 + 64 * DIR : a == 1 ? 1664 + 64 * DIR : 1792 + 64 * (a - 2);
        const bf16_t* p = PA + (size_t)(tb + tn) * LDA_RW + col;
        { unsigned m0s; asm volatile("s_mov_b32 %0, m0\n\ts_mov_b32 m0, %2\n\ts_nop 0\n\tglobal_load_lds_dword %1, off\n\ts_mov_b32 m0, %0" : "=&s"(m0s) : "v"(p), "s"(L_PF) : "memory"); }
    }
}
template <int DIR>
__device__ __forceinline__ void rwkv_item(const Params& P, const Ctx& F, const int item, RwRaw& R, const bool lora, const int nitem, const bool has_next, unsigned& sink) {
    const int tid = F.tid, lane = F.lane, wid = F.wid; ldsp_t lds = F.lds;
    constexpr int dir = DIR; const int h = (item >> 1) & 7, c = (item >> 4) & 63, b = item >> 10;
    const int t0 = c * 64, tb = b * SEQ;
    unsigned char* ws = P.ws;
    const int hi = h * 64 + lane;

    if (lora) rwkv_load_lora<DIR>(P, F, item, R);
    rwkv_load_rkv<DIR>(P, F, item, R);
    PROBE_BEGIN(1)
    const int rb = wid >> 1, cb0 = 2 * (wid & 1);
    const float kkw = P.k_k[hi], kaw = P.k_a[hi], rkw = P.r_k[hi];
    const float mur = P.rw_mu[hi], muk = P.rw_mu[512 + hi], muv = P.rw_mu[1024 + hi];
    float rr[8], kr[8], vr[8];
    {
        const int jlo = 8 * wid;
        const int tlo = dir ? (t0 + 55 - jlo) : (t0 + jlo - 1);
        float raw_r[10], raw_k[10], raw_v[10];
#pragma unroll
        for (int q = 0; q < 10; ++q) { const int tn = tlo + q; const bool ok = (tn >= 0) && (tn < SEQ);
            raw_r[q] = ok ? bf2f(R.rr[q]) : 0.f; raw_k[q] = ok ? bf2f(R.rk[q]) : 0.f; raw_v[q] = ok ? bf2f(R.rv[q]) : 0.f; }
#pragma unroll
        for (int jj = 0; jj < 8; ++jj) {
            const float cr = dir ? raw_r[8 - jj] : raw_r[1 + jj], pr = dir ? raw_r[7 - jj] : raw_r[jj], nr = dir ? raw_r[9 - jj] : raw_r[2 + jj];
            const float ck = dir ? raw_k[8 - jj] : raw_k[1 + jj], pk = dir ? raw_k[7 - jj] : raw_k[jj], nk = dir ? raw_k[9 - jj] : raw_k[2 + jj];
            const float cv = dir ? raw_v[8 - jj] : raw_v[1 + jj], pv = dir ? raw_v[7 - jj] : raw_v[jj], nv = dir ? raw_v[9 - jj] : raw_v[2 + jj];
            rr[jj] = cr + mur * (0.5f * (pr + nr) - cr); kr[jj] = ck + muk * (0.5f * (pk + nk) - ck); vr[jj] = cv + muv * (0.5f * (pv + nv) - cv);
        }
    }
    if (lora) {
    u32x4 xpv[4], xnv[4];
    {
        const bf16_t* PA = (const bf16_t*)P.out; const int ch = tid & 31;
        const int col0 = ch < 8 ? 1536 + 64 * dir + 8 * ch : ch < 16 ? 1664 + 64 * dir + 8 * (ch - 8) : 1792 + 8 * (ch - 16);
#pragma unroll
        for (int it = 0; it < 4; ++it) { const int j = (tid >> 5) + 16 * it, tn = dir ? t0 + 63 - j : t0 + j;
            const bf16_t* row = PA + (size_t)(tb + tn) * LDA_RW + col0;
            const bf16_t* rp = tn > 0 ? row - LDA_RW : row; const bf16_t* rn = tn < SEQ - 1 ? row + LDA_RW : row;
            xpv[it] = *(const u32x4*)rp; xnv[it] = *(const u32x4*)rn; }
    }
    {
        const int ch = tid & 31;
        const int col0 = ch < 8 ? 1536 + 64 * dir + 8 * ch : ch < 16 ? 1664 + 64 * dir + 8 * (ch - 8) : 1792 + 8 * (ch - 16);
        const float cs = ch < 8 ? 2.f : 1.f, ca = ch < 8 ? 2.f : ch < 16 ? 0.f : 1.f, cbb = ch < 8 ? -1.f : 0.f, ci = (ch >= 8 && ch < 16) ? 1.f : 0.f;
        const f32x4 m0 = *(const f32x4*)(P.rw_mu + col0), m1 = *(const f32x4*)(P.rw_mu + col0 + 4);
        const float mu[8] = {m0.x, m0.y, m0.z, m0.w, m1.x, m1.y, m1.z, m1.w};
#pragma unroll
        for (int it = 0; it < 4; ++it) {
            const int j = (tid >> 5) + 16 * it;
            {
                LAS unsigned char* dst = ch < 8 ? lds + L_TW + j * RS + ch * 16 : ch < 16 ? lds + L_AL + j * RS + (ch - 8) * 16 : lds + L_SG + j * 272 + (ch - 16) * 16;
                const int tn = dir ? t0 + 63 - j : t0 + j;
                const float mp = tn > 0 ? 0.5f : 0.f, mn = tn < SEQ - 1 ? 0.5f : 0.f;
                float fc[8], fp[8], fn[8], o[8]; unpack8(R.xc[it], fc); unpack8(xpv[it], fp); unpack8(xnv[it], fn);
#pragma unroll
                for (int e = 0; e < 8; ++e) { const float v = fc[e] + mu[e] * ((mp * fp[e] + mn * fn[e]) - fc[e]); o[e] = ca * sigmoidf_(cs * v) + cbb + ci * v; }
                *(LAS u32x4*)dst = pack8(o);
            }
            __builtin_amdgcn_sched_barrier(0);
        }
    }
    }
    bf16x8 bw[2][2], ba[2][2]; float w0v[2], a0v[2];
    {
        const bf16_t* LORA = (const bf16_t*)(ws + WS_LORA);
        const bf16_t* W2t = LORA + (size_t)dir * 32768; const bf16_t* A2t = LORA + (size_t)(2 + dir) * 32768;
        const float* w0 = dir ? P.w0_b : P.w0_f; const float* a0 = dir ? P.a0_b : P.a0_f;
#pragma unroll
        for (int t = 0; t < 2; ++t) { const int hn = h * 64 + 16 * (cb0 + t) + (lane & 15);
            w0v[t] = w0[hn]; a0v[t] = a0[hn];
#pragma unroll
            for (int kk = 0; kk < 2; ++kk) { bw[t][kk] = *(const bf16x8*)(W2t + (size_t)hn * 64 + 8 * (lane >> 4) + 32 * kk); ba[t][kk] = *(const bf16x8*)(A2t + (size_t)hn * 64 + 8 * (lane >> 4) + 32 * kk); }
        }
    }
    bf16x8 bg[2][4];
    const bool mine = ((h >> 2) == dir);
    if (mine) { const bf16_t* G2t = (const bf16_t*)(ws + WS_LORA) + (size_t)4 * 32768;
#pragma unroll
        for (int t = 0; t < 2; ++t) { const int hn = h * 64 + 16 * (cb0 + t) + (lane & 15);
#pragma unroll
            for (int kk = 0; kk < 4; ++kk) bg[t][kk] = *(const bf16x8*)(G2t + (size_t)hn * 128 + 8 * (lane >> 4) + 32 * kk); } }
    PROBE_END(1)
    if (lora) __syncthreads();
    PROBE_BEGIN(2)
    {
        bf16_t* Gout = (bf16_t*)(ws + WS_G);
#pragma unroll
        for (int t = 0; t < 2; ++t) {
            const int cb = cb0 + t, n = 16 * cb + (lane & 15), hn = h * 64 + n;
            f32x4 zw = {0.f, 0.f, 0.f, 0.f}, za = {0.f, 0.f, 0.f, 0.f};
            const LAS unsigned char* ap_w = lds + L_TW + (16 * rb + (lane & 15)) * RS + (lane >> 4) * 16;
            const LAS unsigned char* ap_a = lds + L_AL + (16 * rb + (lane & 15)) * RS + (lane >> 4) * 16;
#pragma unroll
            for (int kk = 0; kk < 2; ++kk) {
                zw = __builtin_amdgcn_mfma_f32_16x16x32_bf16(*(const LAS bf16x8*)(ap_w + kk * 64), bw[t][kk], zw, 0, 0, 0);
                za = __builtin_amdgcn_mfma_f32_16x16x32_bf16(*(const LAS bf16x8*)(ap_a + kk * 64), ba[t][kk], za, 0, 0, 0);
            }
            float hs = 0.f;
#pragma unroll
            for (int r = 0; r < 4; ++r) { const int j = 16 * rb + 4 * (lane >> 4) + r;
                const float lwv = -0.60653066f * sigmoidf_(w0v[t] + zw[r]); hs += lwv;
                *(LAS float*)(lds + L_LW + (j * 64 + n) * 4) = lwv;
                *(LAS float*)(lds + L_AA + (j * 64 + n) * 4) = sigmoidf_(a0v[t] + za[r]); }
            hs += __shfl_xor(hs, 16);
            if (((lane >> 4) & 1) == 0) *(LAS float*)(lds + L_HS + ((2 * rb + (lane >> 5)) * 64 + n) * 4) = hs;
            if (mine) {
                f32x4 zg = {0.f, 0.f, 0.f, 0.f};
                const LAS unsigned char* ap_g = lds + L_SG + (16 * rb + (lane & 15)) * 272 + (lane >> 4) * 16;
#pragma unroll
                for (int kk = 0; kk < 4; ++kk) zg = __builtin_amdgcn_mfma_f32_16x16x32_bf16(*(const LAS bf16x8*)(ap_g + kk * 64), bg[t][kk], zg, 0, 0, 0);
#pragma unroll
                for (int r = 0; r < 4; ++r) { const int j = 16 * rb + 4 * (lane >> 4) + r; Gout[(size_t)(tb + (dir ? t0 + 63 - j : t0 + j)) * 512 + hn] = (bf16_t)f2bf(zg[r]); }
            }
        }
    }
    PROBE_END(2)
    __syncthreads();
    PROBE_BEGIN(3)
    if (tid == 0) *(volatile LAS unsigned*)(lds + L_EX + 4096) = 0u;
    {
        float total = 0.f, pre = 0.f;
        { float h8[8];
#pragma unroll
          for (int q = 0; q < 8; ++q) h8[q] = *(const LAS float*)(lds + L_HS + (q * 64 + lane) * 4);
#pragma unroll
          for (int q = 0; q < 8; ++q) { if (q < wid) pre += h8[q]; else total += h8[q]; } }
        total += pre;
        __builtin_amdgcn_sched_barrier(0);
        float* BON = (float*)(ws + WS_BON); bf16_t* VS = (bf16_t*)(ws + WS_VS);
        float at_[8], bh_[8], kh_[8];
        float red[16], kd_[8], av_[8], lwv_[8];
#pragma unroll
        for (int jj = 0; jj < 8; ++jj) {
            const int j = 8 * wid + jj;
            lwv_[jj] = *(const LAS float*)(lds + L_LW + (j * 64 + lane) * 4); av_[jj] = *(const LAS float*)(lds + L_AA + (j * 64 + lane) * 4);
            const float kraw = kr[jj] * kkw;
            kd_[jj] = kr[jj] * (1.f + (av_[jj] - 1.f) * kaw);
            red[jj] = kraw * kraw; red[8 + jj] = rr[jj] * kd_[jj] * rkw;
        }
        wave_sum_n<16>(red);
#pragma unroll
        for (int jj = 0; jj < 8; ++jj) {
            const int j = 8 * wid + jj, tok = tb + (dir ? t0 + 63 - j : t0 + j);
            const float lwj = lwv_[jj], a = av_[jj];
            const float lw_prev = pre; pre += lwj; const float lw = pre;
            const float kkv = (kr[jj] * kkw) * __builtin_amdgcn_rsqf(fmaxf(red[jj], 1e-24f));
            const float kd = kd_[jj], bb = kkv * a;
            if (lane == 0) BON[((size_t)dir * NTOK + tok) * 8 + h] = red[8 + jj];
            if (mine) VS[(size_t)tok * 512 + hi] = (bf16_t)f2bf(vr[jj]);
            const float eprev = __expf(lw_prev), einv = __expf(-lw), ee = __expf(lw), eh = __expf(total - lw);
            at_[jj] = -kkv * eprev; bh_[jj] = bb * eh; kh_[jj] = kd * eh;
            *(LAS bf16_t*)(lds + L_AT + j * RS + lane * 2) = (bf16_t)f2bf(at_[jj]);
            *(LAS bf16_t*)(lds + L_BT + j * RS + lane * 2) = (bf16_t)f2bf(bb * einv);
            *(LAS bf16_t*)(lds + L_KT + j * RS + lane * 2) = (bf16_t)f2bf(kd * einv);
            *(LAS bf16_t*)(lds + L_RT + j * RS + lane * 2) = (bf16_t)f2bf(rr[jj] * ee);
        }
        *(LAS u32x4*)(lds + L_ATT + lane * RS + wid * 16) = pack8(at_);
        *(LAS u32x4*)(lds + L_BHT + lane * RS + wid * 16) = pack8(bh_);
        *(LAS u32x4*)(lds + L_KHT + lane * RS + wid * 16) = pack8(kh_);
        *(LAS u32x4*)(lds + L_VT + lane * RS + wid * 16) = pack8(vr);
        if (wid == 0) *(LAS float*)(lds + L_WC + lane * 4) = __expf(total);
    }
    PROBE_END(3)
    __syncthreads();
    if (has_next) rwkv_prefetch<DIR>(P, F, nitem, sink);
    PROBE_BEGIN(4)
    int lane_o = F.lane; asm volatile("" : "+v"(lane_o));
    const int q4 = 4 * (lane_o >> 4);
    const f32x4 zero4 = {0.f, 0.f, 0.f, 0.f};
    if (wid < 2) {
        const int r = lane_o & 31, hh = lane_o >> 5, blk = wid;
        f32x16 Lp, Lpt, Tm, Tt;
        {
            f32x16 z; for (int i = 0; i < 16; ++i) z[i] = 0.f;
            Lp = z; Lpt = z;
            const LAS unsigned char* pa = lds + L_AT + (32 * blk + r) * RS + 16 * hh; const LAS unsigned char* pb = lds + L_BT + (32 * blk + r) * RS + 16 * hh;
#pragma unroll
            for (int ks = 0; ks < 4; ++ks) { const bf16x8 fa = *(const LAS bf16x8*)(pa + 32 * ks), fb = *(const LAS bf16x8*)(pb + 32 * ks);
                Lp = MFMA32(fa, fb, Lp); Lpt = MFMA32(fb, fa, Lpt); }
#pragma unroll
            for (int i = 0; i < 16; ++i) { const int row = (i & 3) + 8 * (i >> 2) + 4 * hh;
                Lp[i] = (row > r) ? Lp[i] : 0.f; Lpt[i] = (r > row) ? Lpt[i] : 0.f;
                Tm[i] = Lp[i] + ((row == r) ? 1.f : 0.f); Tt[i] = Lpt[i] + ((row == r) ? 1.f : 0.f); }
        }
#pragma unroll
        for (int itn = 1; itn <= 5; ++itn) {
            const bf16x8 pL0 = pack_step(Lp, 0), pL1 = pack_step(Lp, 1), pLt0 = pack_step(Lpt, 0), pLt1 = pack_step(Lpt, 1);
            if (itn >= 2) { const bf16x8 pTt0 = pack_step(Tt, 0), pTt1 = pack_step(Tt, 1);
                Tm = MFMA32(pTt0, pL0, Tm); Tm = MFMA32(pTt1, pL1, Tm);
                Tt = MFMA32(pL0, pTt0, Tt); Tt = MFMA32(pL1, pTt1, Tt); }
            if (itn <= 4) { f32x16 z; for (int i = 0; i < 16; ++i) z[i] = 0.f;
                f32x16 n1 = MFMA32(pLt0, pL0, z); n1 = MFMA32(pLt1, pL1, n1);
                f32x16 n2 = MFMA32(pL0, pLt0, z); n2 = MFMA32(pL1, pLt1, n2);
                Lp = n1; Lpt = n2; }
        }
        volatile LAS unsigned* xflag = (volatile LAS unsigned*)(lds + L_EX + 4096);
        if (wid == 0) {
            LAS unsigned char* ex = lds + L_EX + lane * 64;
#pragma unroll
            for (int g = 0; g < 4; ++g) *(LAS f32x4*)(ex + 16 * g) = (f32x4){Tm[4 * g], Tm[4 * g + 1], Tm[4 * g + 2], Tm[4 * g + 3]};
            asm volatile("s_waitcnt lgkmcnt(0)" ::: "memory");
            *xflag = 1u;
#pragma unroll
            for (int g = 0; g < 4; ++g) st4bf(lds + L_T1 + r * RS + (8 * g + 4 * hh) * 2, (f32x4){Tt[4 * g], Tt[4 * g + 1], Tt[4 * g + 2], Tt[4 * g + 3]});
            const u32x4 z4 = {0u, 0u, 0u, 0u};
            *(LAS u32x4*)(lds + L_T1 + r * RS + (32 + 16 * hh) * 2) = z4; *(LAS u32x4*)(lds + L_T1 + r * RS + (32 + 16 * hh) * 2 + 16) = z4;
        } else {
            f32x16 L21; for (int i = 0; i < 16; ++i) L21[i] = 0.f;
            { const LAS unsigned char* pa = lds + L_AT + (32 + r) * RS + 16 * hh; const LAS unsigned char* pb = lds + L_BT + r * RS + 16 * hh;
#pragma unroll
              for (int ks = 0; ks < 4; ++ks) L21 = MFMA32(*(const LAS bf16x8*)(pa + 32 * ks), *(const LAS bf16x8*)(pb + 32 * ks), L21); }
            f32x16 U; for (int i = 0; i < 16; ++i) U[i] = 0.f;
            { const bf16x8 a0 = pack_step(L21, 0), a1 = pack_step(L21, 1), b0 = pack_step(Tt, 0), b1 = pack_step(Tt, 1);
              U = MFMA32(a0, b0, U); U = MFMA32(a1, b1, U); }
            asm volatile("" ::: "memory");
            while (*xflag == 0u) __builtin_amdgcn_s_sleep(1);
            asm volatile("" ::: "memory");
            f32x16 T11;
            { const LAS unsigned char* ex = lds + L_EX + lane * 64;
#pragma unroll
              for (int g = 0; g < 4; ++g) { const f32x4 v = *(const LAS f32x4*)(ex + 16 * g); T11[4 * g] = v[0]; T11[4 * g + 1] = v[1]; T11[4 * g + 2] = v[2]; T11[4 * g + 3] = v[3]; } }
            f32x16 T21t; for (int i = 0; i < 16; ++i) T21t[i] = 0.f;
            { const bf16x8 a0 = pack_step(T11, 0), a1 = pack_step(T11, 1), b0 = pack_step(U, 0), b1 = pack_step(U, 1);
              T21t = MFMA32(a0, b0, T21t); T21t = MFMA32(a1, b1, T21t); }
#pragma unroll
            for (int g = 0; g < 4; ++g) {
                st4bf(lds + L_T1 + (32 + r) * RS + (8 * g + 4 * hh) * 2, (f32x4){T21t[4 * g], T21t[4 * g + 1], T21t[4 * g + 2], T21t[4 * g + 3]});
                st4bf(lds + L_T1 + (32 + r) * RS + (32 + 8 * g + 4 * hh) * 2, (f32x4){Tt[4 * g], Tt[4 * g + 1], Tt[4 * g + 2], Tt[4 * g + 3]}); }
        }
    } else {
        const int w6 = wid - 2, prod = w6 >> 1, half = w6 & 1;
        const int offA = prod == 0 ? L_AT : L_RT, offB = prod == 1 ? L_BT : L_KT, offO = prod == 0 ? L_LAK : prod == 1 ? L_RB : L_RK;
#pragma unroll
        for (int rr2 = 0; rr2 < 2; ++rr2) { const int rbx = 2 * half + rr2, jrx = 16 * rbx + (lane_o & 15);
#pragma unroll
            for (int cb = 0; cb < 4; ++cb) {
                f32x4 v = zero4;
                if (cb <= rbx) { v = tile_s<2>(lds + offA + 16 * rbx * RS, RS, lds + offB + 16 * cb * RS, RS, zero4, lane);
#pragma unroll
                    for (int q = 0; q < 4; ++q) { const int s = 16 * cb + q4 + q; const bool keep = (prod == 0) ? (jrx > s) : (jrx >= s); v[q] = keep ? v[q] : 0.f; } }
                st4bf(lds + offO + jrx * RS + (16 * cb + q4) * 2, v);
            } }
    }
    __syncthreads();
    PROBE_END(4)
    PROBE_BEGIN(5)
    {
        bf16_t* RM = (bf16_t*)(ws + WS_RM) + (size_t)item * 4096; bf16_t* RP = (bf16_t*)(ws + WS_RP) + (size_t)item * 4096; bf16_t* RNT = (bf16_t*)(ws + WS_RNT) + (size_t)item * 4096;
        bf16_t* Y = (bf16_t*)(ws + (dir ? WS_YB : WS_YF));
        const int pg4 = 4 * ((lane_o >> 4) == 1 ? 2 : (lane_o >> 4) == 2 ? 1 : (lane_o >> 4));
        const int cbv = wid & 3;
        Frag2 fv;
        if (wid >= 4) {
            fv = ld_frag2(lds + L_VT + 16 * cbv * RS, RS, lane);
#pragma unroll
            for (int rbx = 0; rbx < 4; ++rbx) { const f32x4 g1 = tile_nb(lds + L_LAK + 16 * rbx * RS, RS, fv, zero4, lane);
                st4bf(lds + L_G1T + (16 * cbv + (lane & 15)) * RS + (16 * rbx + q4) * 2, g1); }
        }
        {
            const Frag2 fb = ld_frag2((wid < 4) ? (lds + L_ATT + 16 * cbv * RS) : (lds + L_G1T + 16 * cbv * RS), RS, lane);
#pragma unroll
            for (int rbx = 0; rbx < 4; ++rbx) { const f32x4 xv = tile_nb(lds + L_T1 + 16 * rbx * RS, RS, fb, zero4, lane);
                st4bf(lds + L_XT + (16 * wid + (lane & 15)) * RS + (16 * rbx + q4) * 2, xv); }
        }
        const Frag2 fx = ld_frag2(lds + L_XT + 16 * wid * RS, RS, lane);
        if (wid < 4) {
#pragma unroll
            for (int rbx = 0; rbx < 4; ++rbx) { const int jrx = 16 * rbx + (lane_o & 15);
                f32x4 mv = tile_sb(lds + L_BHT + 16 * rbx * RS, RS, fx, zero4, lane);
                { const float wc = *(const LAS float*)(lds + L_WC + jrx * 4);
#pragma unroll
                  for (int q = 0; q < 4; ++q) mv[q] += (jrx == 16 * cbv + q4 + q) ? wc : 0.f; }
                st4bf_g(RM + jrx * 64 + 16 * cbv + pg4, mv);
                f32x4 pv = tile_sb(lds + L_RB + 16 * rbx * RS, RS, fx, zero4, lane);
                { const u32x2 rv = *(const LAS u32x2*)(lds + L_RT + jrx * RS + (16 * cbv + q4) * 2);
                  pv[0] += bf2f(rv.x & 0xffffu); pv[1] += bf2f(rv.x >> 16); pv[2] += bf2f(rv.y & 0xffffu); pv[3] += bf2f(rv.y >> 16); }
                st4bf_g(RP + jrx * 64 + 16 * cbv + pg4, pv); }
        } else {
#pragma unroll
            for (int rbx = 0; rbx < 4; ++rbx) {
                f32x4 nv = tile_nb(lds + L_BHT + 16 * rbx * RS, RS, fx, zero4, lane);
                nv = tile_nb(lds + L_KHT + 16 * rbx * RS, RS, fv, nv, lane);
                st4bf_g(RNT + (16 * cbv + (lane & 15)) * 64 + 16 * rbx + q4, nv);
                f32x4 zv = tile_nb(lds + L_RB + 16 * rbx * RS, RS, fx, zero4, lane);
                zv = tile_nb(lds + L_RK + 16 * rbx * RS, RS, fv, zv, lane);
                { const int j0 = 16 * rbx + q4, tokb = tb + (dir ? t0 + 60 - j0 : t0 + j0);
                  const f32x4 zs = dir ? (f32x4){zv[3], zv[2], zv[1], zv[0]} : zv;
                  st4bf_g(Y + ((size_t)(tokb >> 2) * 512 + h * 64 + 16 * cbv + (lane & 15)) * 4, zs); } }
        }
    }
    PROBE_END(5)
    __syncthreads();
}

constexpr int CH_NSLOT = 16, CH_NCONS = 7;
constexpr int CH_RING = 0, CH_FLAGS = CH_NSLOT * 4096;
__device__ __forceinline__ void ch_wait_ge(volatile LAS unsigned* w, unsigned v) { asm volatile("" ::: "memory"); while (*w < v) __builtin_amdgcn_s_sleep(1); asm volatile("" ::: "memory"); }
__device__ __forceinline__ void ch_publish(ldsp_t lds, int st, int lane, const bf16x8& b00, const bf16x8& b01, const bf16x8& b10, const bf16x8& b11) {
    volatile LAS unsigned* fl = (volatile LAS unsigned*)(lds + CH_FLAGS);
    if (st >= CH_NSLOT) { const int old = st - CH_NSLOT; ch_wait_ge(fl + 16 + (old % CH_NCONS) * 16, (unsigned)(old + 1)); }
    LAS unsigned char* slot = lds + CH_RING + (st % CH_NSLOT) * 4096 + lane * 16;
    *(LAS bf16x8*)(slot) = b00; *(LAS bf16x8*)(slot + 1024) = b01; *(LAS bf16x8*)(slot + 2048) = b10; *(LAS bf16x8*)(slot + 3072) = b11;
    asm volatile("s_waitcnt lgkmcnt(0)" ::: "memory");
    fl[0] = (unsigned)(st + 1);
}
__device__ __forceinline__ void ch_consume(ldsp_t lds, int st, int cons, int lane, bf16x8& b00, bf16x8& b01, bf16x8& b10, bf16x8& b11) {
    volatile LAS unsigned* fl = (volatile LAS unsigned*)(lds + CH_FLAGS);
    ch_wait_ge(fl, (unsigned)(st + 1));
    const LAS unsigned char* slot = lds + CH_RING + (st % CH_NSLOT) * 4096 + lane * 16;
    b00 = *(const LAS bf16x8*)(slot); b01 = *(const LAS bf16x8*)(slot + 1024); b10 = *(const LAS bf16x8*)(slot + 2048); b11 = *(const LAS bf16x8*)(slot + 3072);
    asm volatile("s_waitcnt lgkmcnt(0)" ::: "memory");
    fl[16 + cons * 16] = (unsigned)(st + 1);
}
__device__ __forceinline__ void rwkv_ld_mn(const unsigned char* ws, int item, int vh, int r, int hh, bf16x8 (&Mf)[8], u32x2 (&Nf)[8]) {
    const bf16_t* RM = (const bf16_t*)(ws + WS_RM) + (size_t)item * 4096; const bf16_t* RNT = (const bf16_t*)(ws + WS_RNT) + (size_t)item * 4096;
#pragma unroll
    for (int kb = 0; kb < 2; ++kb) {
        const bf16_t* ap = RM + (32 * kb + r) * 64 + 8 * hh;
#pragma unroll
        for (int q = 0; q < 4; ++q) Mf[4 * kb + q] = *(const bf16x8*)(ap + 16 * q);
#pragma unroll
        for (int g = 0; g < 4; ++g) Nf[4 * kb + g] = *(const u32x2*)(RNT + (32 * vh + r) * 64 + 32 * kb + 8 * g + 4 * hh);
    }
}
__device__ __forceinline__ void rwkv_prod_step(ldsp_t lds, const unsigned char* ws, int b, int h, int dir, int vh, int lane, int st,
                                               f32x16& X0, f32x16& X1, const bf16x8 (&Mc)[8], const u32x2 (&Nc)[8], bf16x8 (&Mn)[8], u32x2 (&Nn)[8]) {
    const int r = lane & 31, hh = lane >> 5;
    const int stn = st < 62 ? st + 2 : 63, cn = dir ? 63 - stn : stn, itemn = ((b * 64 + cn) * 8 + h) * 2 + dir;
    rwkv_ld_mn(ws, itemn, vh, r, hh, Mn, Nn);
    const bf16x8 b00 = pack_step(X0, 0), b01 = pack_step(X0, 1), b10 = pack_step(X1, 0), b11 = pack_step(X1, 1);
    ch_publish(lds, st, lane, b00, b01, b10, b11);
    f32x16 Hn[2];
#pragma unroll
    for (int kb = 0; kb < 2; ++kb) {
#pragma unroll
        for (int g = 0; g < 4; ++g) { const u32x2 nv = Nc[4 * kb + g];
            Hn[kb][4 * g + 0] = bf2f(nv.x & 0xffffu); Hn[kb][4 * g + 1] = bf2f(nv.x >> 16); Hn[kb][4 * g + 2] = bf2f(nv.y & 0xffffu); Hn[kb][4 * g + 3] = bf2f(nv.y >> 16); }
        Hn[kb] = MFMA32(Mc[4 * kb + 0], b00, Hn[kb]);
        Hn[kb] = MFMA32(Mc[4 * kb + 1], b01, Hn[kb]);
        Hn[kb] = MFMA32(Mc[4 * kb + 2], b10, Hn[kb]);
        Hn[kb] = MFMA32(Mc[4 * kb + 3], b11, Hn[kb]);
    }
    X0 = Hn[0]; X1 = Hn[1];
}
__device__ __forceinline__ void rwkv_producer(const Params& P, ldsp_t lds, const int chain, const int lane) {
    const int vh = chain & 1, dir = (chain >> 1) & 1, h = (chain >> 2) & 7, b = chain >> 5;
    const unsigned char* ws = P.ws;
    f32x16 X0, X1;
#pragma unroll
    for (int i = 0; i < 16; ++i) { X0[i] = 0.f; X1[i] = 0.f; }
    bf16x8 MA[8], MB[8], MC[8]; u32x2 NA[8], NB[8], NC[8];
    { const int c0 = dir ? 63 : 0, c1 = dir ? 62 : 1;
      rwkv_ld_mn(ws, ((b * 64 + c0) * 8 + h) * 2 + dir, vh, lane & 31, lane >> 5, MA, NA);
      rwkv_ld_mn(ws, ((b * 64 + c1) * 8 + h) * 2 + dir, vh, lane & 31, lane >> 5, MB, NB); }
#pragma unroll 1
    for (int st = 0; st < 63; st += 3) {
        rwkv_prod_step(lds, ws, b, h, dir, vh, lane, st, X0, X1, MA, NA, MC, NC);
        rwkv_prod_step(lds, ws, b, h, dir, vh, lane, st + 1, X0, X1, MB, NB, MA, NA);
        rwkv_prod_step(lds, ws, b, h, dir, vh, lane, st + 2, X0, X1, MC, NC, MB, NB);
    }
    rwkv_prod_step(lds, ws, b, h, dir, vh, lane, 63, X0, X1, MA, NA, MC, NC);
}
struct ChOps { bf16x8 A[8]; u32x2 Z[8]; };
template <bool GLA>
__device__ __forceinline__ void ch_ld_ops(const Params& P, int chain, int st, int lane, ChOps& o) {
    const int r = lane & 31, hh = lane >> 5;
    int b, dir, item, col; const bf16_t* A; const bf16_t* Yb;
    if (GLA) { const int qt = chain & 3, hd = (chain >> 3) & 3; dir = (chain >> 2) & 1; b = chain >> 5; const int c = dir ? 63 - st : st;
        item = ((b * 64 + c) * 4 + hd) * 2 + dir; col = hd * 128 + 32 * qt + r;
        A = (const bf16_t*)((const unsigned char*)P.out + OUT_GQ) + (size_t)item * 4096;
        Yb = (const bf16_t*)(P.ws + (dir ? WS_OB : WS_OF)) + ((size_t)((b * SEQ + c * 64) >> 2) * 512 + col) * 4;
    } else { const int vh = chain & 1, h = (chain >> 2) & 7; dir = (chain >> 1) & 1; b = chain >> 5; const int c = dir ? 63 - st : st;
        item = ((b * 64 + c) * 8 + h) * 2 + dir; col = h * 64 + 32 * vh + r;
        A = (const bf16_t*)(P.ws + WS_RP) + (size_t)item * 4096;
        Yb = (const bf16_t*)(P.ws + (dir ? WS_YB : WS_YF)) + ((size_t)((b * SEQ + c * 64) >> 2) * 512 + col) * 4; }
#pragma unroll
    for (int jb = 0; jb < 2; ++jb) {
        const bf16_t* ap = A + (32 * jb + r) * 64 + 8 * hh;
#pragma unroll
        for (int q = 0; q < 4; ++q) o.A[4 * jb + q] = *(const bf16x8*)(ap + 16 * q);
#pragma unroll
        for (int g = 0; g < 4; ++g) { const int j0 = 32 * jb + 8 * g + 4 * hh, tg = (dir ? 60 - j0 : j0) >> 2; o.Z[4 * jb + g] = *(const u32x2*)(Yb + (size_t)tg * 2048); }
    }
}
template <bool GLA>
__device__ __forceinline__ void ch_out_step(const Params& P, ldsp_t lds, int chain, int cons, int st, int lane, const ChOps& o) {
    const int r = lane & 31, hh = lane >> 5;
    int b, dir, col; bf16_t* Yb;
    if (GLA) { const int qt = chain & 3, hd = (chain >> 3) & 3; dir = (chain >> 2) & 1; b = chain >> 5; const int c = dir ? 63 - st : st; col = hd * 128 + 32 * qt + r;
        Yb = (bf16_t*)(P.ws + (dir ? WS_OB : WS_OF)) + ((size_t)((b * SEQ + c * 64) >> 2) * 512 + col) * 4;
    } else { const int vh = chain & 1, h = (chain >> 2) & 7; dir = (chain >> 1) & 1; b = chain >> 5; const int c = dir ? 63 - st : st; col = h * 64 + 32 * vh + r;
        Yb = (bf16_t*)(P.ws + (dir ? WS_YB : WS_YF)) + ((size_t)((b * SEQ + c * 64) >> 2) * 512 + col) * 4; }
    bf16x8 b00, b01, b10, b11;
    ch_consume(lds, st, cons, lane, b00, b01, b10, b11);
#pragma unroll
    for (int jb = 0; jb < 2; ++jb) {
        f32x16 Yv;
#pragma unroll
        for (int g = 0; g < 4; ++g) { const u32x2 z = o.Z[4 * jb + g];
            const float p0 = bf2f(z.x & 0xffffu), p1 = bf2f(z.x >> 16), p2 = bf2f(z.y & 0xffffu), p3 = bf2f(z.y >> 16);
            Yv[4 * g + 0] = dir ? p3 : p0; Yv[4 * g + 1] = dir ? p2 : p1; Yv[4 * g + 2] = dir ? p1 : p2; Yv[4 * g + 3] = dir ? p0 : p3; }
        Yv = MFMA32(o.A[4 * jb + 0], b00, Yv);
        Yv = MFMA32(o.A[4 * jb + 1], b01, Yv);
        Yv = MFMA32(o.A[4 * jb + 2], b10, Yv);
        Yv = MFMA32(o.A[4 * jb + 3], b11, Yv);
#pragma unroll
        for (int g = 0; g < 4; ++g) { const int j0 = 32 * jb + 8 * g + 4 * hh, tg = (dir ? 60 - j0 : j0) >> 2;
            u32x2 ov; ov.x = dir ? pk2(Yv[4 * g + 3], Yv[4 * g + 2]) : pk2(Yv[4 * g + 0], Yv[4 * g + 1]); ov.y = dir ? pk2(Yv[4 * g + 1], Yv[4 * g + 0]) : pk2(Yv[4 * g + 2], Yv[4 * g + 3]);
            *(u32x2*)(Yb + (size_t)tg * 2048) = ov; }
    }
}
template <bool GLA>
__device__ __forceinline__ void chain_consumer(const Params& P, ldsp_t lds, const int chain, const int cons, const int lane) {
    ChOps OA, OB, OC;
    int st = cons;
    if (st < 64) ch_ld_ops<GLA>(P, chain, st, lane, OA);
    if (st + CH_NCONS < 64) ch_ld_ops<GLA>(P, chain, st + CH_NCONS, lane, OB);
#pragma unroll 1
    while (st < 64) {
        const int s1 = st + CH_NCONS, s2 = st + 2 * CH_NCONS, s3 = st + 3 * CH_NCONS, s4 = st + 4 * CH_NCONS;
        if (s2 < 64) ch_ld_ops<GLA>(P, chain, s2, lane, OC);
        ch_out_step<GLA>(P, lds, chain, cons, st, lane, OA);
        if (s1 >= 64) break;
        if (s3 < 64) ch_ld_ops<GLA>(P, chain, s3, lane, OA);
        ch_out_step<GLA>(P, lds, chain, cons, s1, lane, OB);
        if (s2 >= 64) break;
        if (s4 < 64) ch_ld_ops<GLA>(P, chain, s4, lane, OB);
        ch_out_step<GLA>(P, lds, chain, cons, s2, lane, OC);
        st = s3;
    }
}

constexpr int G_QT = 0, G_KT = RMS_, G_KHT = 2 * RMS_, G_VT = 3 * RMS_, G_AM = 5 * RMS_, G_GK = 6 * RMS_, G_SLOT = 6 * RMS_ + 16384 + 2048;
static_assert(2 * G_SLOT <= LDS_MISC, "gla LDS map");
struct GlaSt { float qv[8], kv[8]; };
template <int DIR>
__device__ __forceinline__ void gla_s1(const Params& P, const Ctx& F, const int item, ldsp_t lds, GlaSt& S) {
    const int lane = F.lane, wid = F.wid; constexpr int dir = DIR;
    const int hd = (item >> 1) & 3, c = (item >> 3) & 63, b = item >> 9;
    const int t0 = c * 64, tb = b * SEQ;
    const bf16_t* PB = (const bf16_t*)(P.ws + WS_PB);
    const int hi = hd * 64 + lane;
    const float* gw2 = dir ? P.gw2_b : P.gw2_f; const float* gb = dir ? P.gb_b : P.gb_f;
    float w2[16];
#pragma unroll
    for (int m = 0; m < 16; ++m) w2[m] = gw2[m * 256 + hi];
    const float gbv = gb[hi];
    float v0[8], v1[8];
    u32x4 g0a[8], g1a[8]; unsigned rq[8], rk[8], r0[8], r1[8];
#pragma unroll
    for (int jj = 0; jj < 8; ++jj) {
        const int j = 8 * wid + jj, tok = tb + (dir ? t0 + 63 - j : t0 + j);
        const bf16_t* row = PB + (size_t)tok * LDB_GL;
        g0a[jj] = *(const u32x4*)(row + 1024 + 16 * dir); g1a[jj] = *(const u32x4*)(row + 1024 + 16 * dir + 8);
        rq[jj] = row[hi]; rk[jj] = row[256 + hi]; r0[jj] = row[512 + hd * 128 + lane]; r1[jj] = row[512 + hd * 128 + 64 + lane];
    }
    __builtin_amdgcn_sched_barrier(0);
#pragma unroll
    for (int jj = 0; jj < 8; ++jj) {
        const int j = 8 * wid + jj;
        float gl[16]; { float t8[8]; unpack8(g0a[jj], t8);
#pragma unroll
            for (int e = 0; e < 8; ++e) gl[e] = t8[e];
            unpack8(g1a[jj], t8);
#pragma unroll
            for (int e = 0; e < 8; ++e) gl[8 + e] = t8[e]; }
        float z = gbv;
#pragma unroll
        for (int m = 0; m < 16; ++m) z += gl[m] * w2[m];
        const float ls = fminf(z, 0.f) - __logf(1.f + __expf(-fabsf(z)));
        *(LAS float*)(lds + G_GK + (j * 64 + lane) * 4) = ls * (1.f / 16.f);
        S.qv[jj] = bf2f(rq[jj]) * 0.125f; S.kv[jj] = bf2f(rk[jj]);
        v0[jj] = bf2f(r0[jj]); v1[jj] = bf2f(r1[jj]);
    }
    *(LAS u32x4*)(lds + G_VT + lane * RS + wid * 16) = pack8(v0);
    *(LAS u32x4*)(lds + G_VT + (64 + lane) * RS + wid * 16) = pack8(v1);
}
__device__ __forceinline__ void gla_s2(const Params& P, const Ctx& F, const int item, ldsp_t lds, const GlaSt& S) {
    const int lane = F.lane, wid = F.wid;
    float total = 0.f, pre = 0.f;
#pragma unroll 1
    for (int s0 = 0; s0 < 8; s0 += 2) { float t8[16];
#pragma unroll
        for (int u = 0; u < 16; ++u) t8[u] = *(const LAS float*)(lds + G_GK + ((8 * s0 + u) * 64 + lane) * 4);
        const float sa = ((t8[0] + t8[1]) + (t8[2] + t8[3])) + ((t8[4] + t8[5]) + (t8[6] + t8[7]));
        const float sb = ((t8[8] + t8[9]) + (t8[10] + t8[11])) + ((t8[12] + t8[13]) + (t8[14] + t8[15]));
        if (s0 < wid) pre += sa; else total += sa;
        if (s0 + 1 < wid) pre += sb; else total += sb; }
    total += pre;
    bf16_t* GQ = (bf16_t*)((unsigned char*)P.out + OUT_GQ) + (size_t)item * 4096;
    const int blk = lane >> 4, g4 = (lane >> 2) & 3, pgp = (g4 == 1) ? 2 : (g4 == 2) ? 1 : g4;
    const int pcol = 16 * blk + 4 * pgp + (lane & 3);
    float kh_[8];
#pragma unroll
    for (int jj = 0; jj < 8; ++jj) {
        const int j = 8 * wid + jj;
        pre += *(const LAS float*)(lds + G_GK + (j * 64 + lane) * 4);
        const float e = __expf(pre), einv = __expf(-pre), eh = __expf(total - pre);
        const float qs = S.qv[jj] * e;
        *(LAS bf16_t*)(lds + G_QT + j * RS + lane * 2) = (bf16_t)f2bf(qs);
        *(LAS bf16_t*)(lds + G_KT + j * RS + lane * 2) = (bf16_t)f2bf(S.kv[jj] * einv);
        kh_[jj] = S.kv[jj] * eh;
        GQ[j * 64 + pcol] = (bf16_t)f2bf(qs);
    }
    *(LAS u32x4*)(lds + G_KHT + lane * RS + wid * 16) = pack8(kh_);
    if (wid == 0) ((float*)(P.ws + WS_DEC))[(size_t)item * 64 + lane] = __expf(total);
}
__device__ __forceinline__ void gla_s3(const Ctx& F, ldsp_t lds) {
    const int lane = F.lane, wid = F.wid;
    const int rb = wid >> 1, cb0 = 2 * (wid & 1), jr = 16 * rb + (lane & 15), q4 = 4 * (lane >> 4);
    const f32x4 zero4 = {0.f, 0.f, 0.f, 0.f};
#pragma unroll
    for (int t = 0; t < 2; ++t) { const int cb = cb0 + t;
        f32x4 av = tile_s<2>(lds + G_QT + 16 * rb * RS, RS, lds + G_KT + 16 * cb * RS, RS, zero4, lane);
#pragma unroll
        for (int r = 0; r < 4; ++r) av[r] = (jr >= 16 * cb + q4 + r) ? av[r] : 0.f;
        st4bf(lds + G_AM + jr * RS + (16 * cb + q4) * 2, av); }
}
template <int DIR>
__device__ __forceinline__ void gla_s4(const Params& P, const Ctx& F, const int item, ldsp_t lds) {
    const int lane = F.lane, wid = F.wid; constexpr int dir = DIR;
    const int hd = (item >> 1) & 3, c = (item >> 3) & 63, b = item >> 9, t0 = c * 64, tb = b * SEQ;
    const int rb = wid >> 1, q4 = 4 * (lane >> 4);
    const f32x4 zero4 = {0.f, 0.f, 0.f, 0.f};
    bf16_t* O = (bf16_t*)(P.ws + (dir ? WS_OB : WS_OF));
    bf16_t* GNT = (bf16_t*)((unsigned char*)P.out + OUT_GNT) + (size_t)item * 8192;
    const int cbz0 = 4 * (wid & 1);
    const int j0 = 16 * rb + q4, tokb = tb + (dir ? t0 + 60 - j0 : t0 + j0);
#pragma unroll
    for (int t = 0; t < 4; ++t) { const int cb = cbz0 + t;
        f32x4 zv = tile_n<2>(lds + G_AM + 16 * rb * RS, RS, lds + G_VT + 16 * cb * RS, RS, zero4, lane);
        const f32x4 zs = dir ? (f32x4){zv[3], zv[2], zv[1], zv[0]} : zv;
        st4bf_g(O + ((size_t)(tokb >> 2) * 512 + hd * 128 + 16 * cb + (lane & 15)) * 4, zs);
        f32x4 nv = tile_n<2>(lds + G_KHT + 16 * rb * RS, RS, lds + G_VT + 16 * cb * RS, RS, zero4, lane);
        st4bf_g(GNT + (16 * cb + (lane & 15)) * 64 + 16 * rb + q4, nv); }
}
__device__ __forceinline__ void gla_prefetch(const Params& P, const Ctx& F, const int item, const int dir) {
    const int hd = (item >> 1) & 3, c = (item >> 3) & 63, b = item >> 9, tid = F.tid;
    if (tid < 320) {
        const int j = tid / 5, a = tid - 5 * j;
        const int col = a == 0 ? 1024 + 16 * dir : a == 1 ? hd * 64 : a == 2 ? 256 + hd * 64 : 512 + hd * 128 + 64 * (a - 3);
        const bf16_t* p = (const bf16_t*)(P.ws + WS_PB) + (size_t)(b * SEQ + c * 64 + j) * LDB_GL + col;
        { unsigned m0s; asm volatile("s_mov_b32 %0, m0\n\ts_mov_b32 m0, %2\n\ts_nop 0\n\tglobal_load_lds_dword %1, off\n\ts_mov_b32 m0, %0" : "=&s"(m0s) : "v"(p), "s"(L_PF) : "memory"); }
    }
}
template <int DIR>
__device__ __forceinline__ void gla_pair(const Params& P, const Ctx& F, const int itA, const int itB, const bool hasB) {
    ldsp_t la = F.lds, lb = F.lds + G_SLOT;
    GlaSt SA, SB;
    gla_s1<DIR>(P, F, itA, la, SA); if (hasB) gla_s1<DIR>(P, F, itB, lb, SB);
    __syncthreads();
    gla_s2(P, F, itA, la, SA); if (hasB) gla_s2(P, F, itB, lb, SB);
    __syncthreads();
    { const int nA = itA + 2 * F.G, nB = itB + 2 * F.G; if (nA < 2048) gla_prefetch(P, F, nA, DIR); if (nB < 2048) gla_prefetch(P, F, nB, DIR); }
    gla_s3(F, la); if (hasB) gla_s3(F, lb);
    __syncthreads();
    gla_s4<DIR>(P, F, itA, la); if (hasB) gla_s4<DIR>(P, F, itB, lb);
    __syncthreads();
}

__device__ __forceinline__ void gla_ld_nd(const unsigned char* ob, const unsigned char* ws, int item, int qt, int r, int hh, u32x2 (&Nf)[8], f32x4 (&Df)[8]) {
    const bf16_t* GNT = (const bf16_t*)(ob + OUT_GNT) + (size_t)item * 8192; const float* DEC = (const float*)(ws + WS_DEC) + (size_t)item * 64;
#pragma unroll
    for (int g = 0; g < 4; ++g) {
        Df[g] = *(const f32x4*)(DEC + 8 * g + 4 * hh); Df[4 + g] = *(const f32x4*)(DEC + 32 + 8 * g + 4 * hh);
        Nf[g] = *(const u32x2*)(GNT + (32 * qt + r) * 64 + 8 * g + 4 * hh); Nf[4 + g] = *(const u32x2*)(GNT + (32 * qt + r) * 64 + 32 + 8 * g + 4 * hh);
    }
}
__device__ __forceinline__ void gla_prod_step(ldsp_t lds, const unsigned char* ob, const unsigned char* ws, int b, int hd, int dir, int qt, int lane, int st,
                                              f32x16& X0, f32x16& X1, const u32x2 (&Nc)[8], const f32x4 (&Dc)[8], u32x2 (&Nn)[8], f32x4 (&Dn)[8]) {
    const int r = lane & 31, hh = lane >> 5;
    const int stn = st < 62 ? st + 2 : 63, cn = dir ? 63 - stn : stn, itemn = ((b * 64 + cn) * 4 + hd) * 2 + dir;
    gla_ld_nd(ob, ws, itemn, qt, r, hh, Nn, Dn);
    const bf16x8 b00 = pack_step(X0, 0), b01 = pack_step(X0, 1), b10 = pack_step(X1, 0), b11 = pack_step(X1, 1);
    ch_publish(lds, st, lane, b00, b01, b10, b11);
#pragma unroll
    for (int g = 0; g < 4; ++g) {
        const f32x4 d0 = Dc[g], d1 = Dc[4 + g]; const u32x2 n0 = Nc[g], n1 = Nc[4 + g];
        X0[4 * g + 0] = d0.x * X0[4 * g + 0] + bf2f(n0.x & 0xffffu); X0[4 * g + 1] = d0.y * X0[4 * g + 1] + bf2f(n0.x >> 16);
        X0[4 * g + 2] = d0.z * X0[4 * g + 2] + bf2f(n0.y & 0xffffu); X0[4 * g + 3] = d0.w * X0[4 * g + 3] + bf2f(n0.y >> 16);
        X1[4 * g + 0] = d1.x * X1[4 * g + 0] + bf2f(n1.x & 0xffffu); X1[4 * g + 1] = d1.y * X1[4 * g + 1] + bf2f(n1.x >> 16);
        X1[4 * g + 2] = d1.z * X1[4 * g + 2] + bf2f(n1.y & 0xffffu); X1[4 * g + 3] = d1.w * X1[4 * g + 3] + bf2f(n1.y >> 16);
    }
}
__device__ __forceinline__ void gla_producer(const Params& P, ldsp_t lds, const int chain, const int lane) {
    const int qt = chain & 3, dir = (chain >> 2) & 1, hd = (chain >> 3) & 3, b = chain >> 5;
    const unsigned char* ws = P.ws; const unsigned char* ob = (const unsigned char*)P.out;
    f32x16 X0, X1;
#pragma unroll
    for (int i = 0; i < 16; ++i) { X0[i] = 0.f; X1[i] = 0.f; }
    u32x2 NA[8], NB[8], NC[8]; f32x4 DA[8], DB[8], DC[8];
    { const int c0 = dir ? 63 : 0, c1 = dir ? 62 : 1;
      gla_ld_nd(ob, ws, ((b * 64 + c0) * 4 + hd) * 2 + dir, qt, lane & 31, lane >> 5, NA, DA);
      gla_ld_nd(ob, ws, ((b * 64 + c1) * 4 + hd) * 2 + dir, qt, lane & 31, lane >> 5, NB, DB); }
#pragma unroll 1
    for (int st = 0; st < 63; st += 3) {
        gla_prod_step(lds, ob, ws, b, hd, dir, qt, lane, st, X0, X1, NA, DA, NC, DC);
        gla_prod_step(lds, ob, ws, b, hd, dir, qt, lane, st + 1, X0, X1, NB, DB, NA, DA);
        gla_prod_step(lds, ob, ws, b, hd, dir, qt, lane, st + 2, X0, X1, NC, DC, NB, DB);
    }
    gla_prod_step(lds, ob, ws, b, hd, dir, qt, lane, 63, X0, X1, NA, DA, NC, DC);
}

__device__ __forceinline__ void ld_tok4(const bf16_t* base, int tok4, int lane, float (&y)[4][8]) {
    const u32x4* p = (const u32x4*)(base + ((size_t)tok4 * 512 + 8 * lane) * 4);
#pragma unroll
    for (int i = 0; i < 4; ++i) { const u32x4 v = p[i];
        y[0][2 * i] = bf2f(v.x & 0xffffu); y[1][2 * i] = bf2f(v.x >> 16); y[2][2 * i] = bf2f(v.y & 0xffffu); y[3][2 * i] = bf2f(v.y >> 16);
        y[0][2 * i + 1] = bf2f(v.z & 0xffffu); y[1][2 * i + 1] = bf2f(v.z >> 16); y[2][2 * i + 1] = bf2f(v.w & 0xffffu); y[3][2 * i + 1] = bf2f(v.w >> 16); }
}
__device__ __forceinline__ void mix_tok4_rw(const Params& P, const int tok4, const int lane) {
    unsigned char* ws = P.ws;
    const bf16_t* YF = (const bf16_t*)(ws + WS_YF); const bf16_t* YB = (const bf16_t*)(ws + WS_YB);
    const bf16_t* GG = (const bf16_t*)(ws + WS_G); const bf16_t* VS = (const bf16_t*)(ws + WS_VS);
    const float* BON = (const float*)(ws + WS_BON);
    const bf16_t* OF = (const bf16_t*)(ws + WS_OF); const bf16_t* OB = (const bf16_t*)(ws + WS_OB);
    const bf16_t* PB = (const bf16_t*)(ws + WS_PB);
    bf16_t* MIX = (bf16_t*)(ws + WS_MIX);
    {
        float ya[4][8], yb[4][8];
        ld_tok4(YF, tok4, lane, ya); ld_tok4(YB, tok4, lane, yb);
        const f32x4 w0 = *(const f32x4*)(P.ln_w + 8 * lane), w1 = *(const f32x4*)(P.ln_w + 8 * lane + 4);
        const f32x4 c0 = *(const f32x4*)(P.ln_b + 8 * lane), c1 = *(const f32x4*)(P.ln_b + 8 * lane + 4);
        const float lw[8] = {w0.x, w0.y, w0.z, w0.w, w1.x, w1.y, w1.z, w1.w}, lb[8] = {c0.x, c0.y, c0.z, c0.w, c1.x, c1.y, c1.z, c1.w};
        const int h = lane >> 3;
        u32x4 gq[4], vq[4]; float bq0[4], bq1[4];
#pragma unroll
        for (int q = 0; q < 4; ++q) { const int tok = 4 * tok4 + q; const size_t o512 = (size_t)tok * 512 + 8 * lane;
            gq[q] = *(const u32x4*)(GG + o512); vq[q] = *(const u32x4*)(VS + o512); bq0[q] = BON[(size_t)tok * 8 + h]; bq1[q] = BON[((size_t)NTOK + tok) * 8 + h]; }
#pragma unroll
        for (int q = 0; q < 4; ++q) {
            const int tok = 4 * tok4 + q;
            float y[8]; float s = 0.f;
#pragma unroll
            for (int e = 0; e < 8; ++e) { y[e] = ya[q][e] + yb[q][e]; s += y[e]; }
            s += __shfl_xor(s, 1); s += __shfl_xor(s, 2); s += __shfl_xor(s, 4);
            const float mean = s * (1.f / 64.f);
            float s2 = 0.f;
#pragma unroll
            for (int e = 0; e < 8; ++e) { y[e] -= mean; s2 += y[e] * y[e]; }
            s2 += __shfl_xor(s2, 1); s2 += __shfl_xor(s2, 2); s2 += __shfl_xor(s2, 4);
            const float rs = rsqrtf(s2 * (1.f / 64.f) + 64e-5f);
            const float bon = bq0[q] + bq1[q];
            float g[8], vs[8], o[8];
            unpack8(gq[q], g); unpack8(vq[q], vs);
#pragma unroll
            for (int e = 0; e < 8; ++e) o[e] = (y[e] * rs * lw[e] + lb[e] + bon * vs[e]) * g[e];
            *(u32x4*)(MIX + (size_t)tok * 1024 + 8 * lane) = pack8(o);
        }
    }
}
__device__ __forceinline__ void mix_tok4_gl(const Params& P, const int tok4, const int lane) {
    unsigned char* ws = P.ws;
    const bf16_t* YF = (const bf16_t*)(ws + WS_YF); const bf16_t* YB = (const bf16_t*)(ws + WS_YB);
    const bf16_t* GG = (const bf16_t*)(ws + WS_G); const bf16_t* VS = (const bf16_t*)(ws + WS_VS);
    const float* BON = (const float*)(ws + WS_BON);
    const bf16_t* OF = (const bf16_t*)(ws + WS_OF); const bf16_t* OB = (const bf16_t*)(ws + WS_OB);
    const bf16_t* PB = (const bf16_t*)(ws + WS_PB);
    bf16_t* MIX = (bf16_t*)(ws + WS_MIX);
    {
        float ya[4][8], yb[4][8];
        ld_tok4(OF, tok4, lane, ya); ld_tok4(OB, tok4, lane, yb);
        const f32x4 w0 = *(const f32x4*)(P.gnorm_w + 8 * lane), w1 = *(const f32x4*)(P.gnorm_w + 8 * lane + 4);
        const float nw[8] = {w0.x, w0.y, w0.z, w0.w, w1.x, w1.y, w1.z, w1.w};
        u32x4 oq[4];
#pragma unroll
        for (int q = 0; q < 4; ++q) oq[q] = *(const u32x4*)(PB + (size_t)(4 * tok4 + q) * LDB_GL + 1056 + 8 * lane);
#pragma unroll
        for (int q = 0; q < 4; ++q) {
            const int tok = 4 * tok4 + q;
            float y[8], og[8], o[8]; float s2 = 0.f;
#pragma unroll
            for (int e = 0; e < 8; ++e) { y[e] = ya[q][e] + yb[q][e]; s2 += y[e] * y[e]; }
            s2 += __shfl_xor(s2, 1); s2 += __shfl_xor(s2, 2); s2 += __shfl_xor(s2, 4); s2 += __shfl_xor(s2, 8);
            const float rs = rsqrtf(s2 * (1.f / 128.f) + 1e-6f);
            unpack8(oq[q], og);
#pragma unroll
            for (int e = 0; e < 8; ++e) o[e] = y[e] * rs * nw[e] * (og[e] * sigmoidf_(og[e]));
            *(u32x4*)(MIX + (size_t)tok * 1024 + 512 + 8 * lane) = pack8(o);
        }
    }
}

struct TBlk { const float* src; bf16_t* dst; const float* sc; int N, ldk; };
__device__ __forceinline__ TBlk moe_blk(const Params& P, int it) {
    bf16_t* WGU = (bf16_t*)(P.ws + WS_WGU); bf16_t* WDN = (bf16_t*)(P.ws + WS_WDN);
    const int e = it / 768, r = it % 768; TBlk t;
    if (r < 512) { const int up = r >> 8, q = r & 255, kb = q >> 4, nb = q & 15, n0 = 32 * nb;
        const float* src = (up ? P.w_up : P.w_gate) + (size_t)e * 1024 * 512;
        const int drow0 = 256 * (n0 >> 7) + (n0 & 127) + 128 * up;
        t.src = src + (size_t)(64 * kb) * 512 + n0; t.N = 512; t.dst = WGU + (size_t)e * 1024 * 1024 + (size_t)drow0 * 1024 + 64 * kb; t.ldk = 1024; t.sc = P.ln2_w + 64 * kb;
    } else { const int q = r - 512, kb = q >> 5, nb = q & 31;
        t.src = P.w_down + (size_t)e * 512 * 1024 + (size_t)(64 * kb) * 1024 + 32 * nb; t.N = 1024; t.dst = WDN + (size_t)e * 1024 * 512 + (size_t)(32 * nb) * 512 + 64 * kb; t.ldk = 512; t.sc = nullptr; }
    return t;
}
__device__ __forceinline__ void tblk_load(const TBlk& t, float (&tv)[32], int lane) {
#pragma unroll
    for (int i = 0; i < 32; ++i) { const int kk = 2 * i + (lane >> 5); tv[i] = t.src[(size_t)kk * t.N + (lane & 31)]; }
}
__device__ __forceinline__ void tblk_store(const TBlk& t, const float (&tv)[32], LAS float* scr, int lane) {
#pragma unroll
    for (int i = 0; i < 32; ++i) { const int kk = 2 * i + (lane >> 5); scr[kk * 33 + (lane & 31)] = tv[i]; }
    asm volatile("s_waitcnt lgkmcnt(0)" ::: "memory");
    const int c = lane & 7;
    f32x4 g0 = {1.f, 1.f, 1.f, 1.f}, g1 = g0;
    if (t.sc) { g0 = *(const f32x4*)(t.sc + 8 * c); g1 = *(const f32x4*)(t.sc + 8 * c + 4); }
#pragma unroll
    for (int j = 0; j < 4; ++j) { const int n = (lane >> 3) + 8 * j; const LAS float* s = scr + (8 * c) * 33 + n;
        u32x4 o; o.x = pk2(s[0 * 33] * g0.x, s[1 * 33] * g0.y); o.y = pk2(s[2 * 33] * g0.z, s[3 * 33] * g0.w); o.z = pk2(s[4 * 33] * g1.x, s[5 * 33] * g1.y); o.w = pk2(s[6 * 33] * g1.z, s[7 * 33] * g1.w);
        *(u32x4*)(t.dst + (size_t)n * t.ldk + 8 * c) = o; }
    asm volatile("s_waitcnt lgkmcnt(0)" ::: "memory");
}
__device__ __forceinline__ void p5b_convert(const Params& P, const Ctx& F, const int gw, const int NGW) {
    LAS float* scr = (LAS float*)(F.lds + F.wid * 16384);
    constexpr int NIT = NEXP * 768;
    float ta[32], tb[32];
    int it = gw;
    if (it >= NIT) return;
    TBlk A = moe_blk(P, it), B = A;
    tblk_load(A, ta, F.lane);
#pragma unroll 1
    while (true) {
        const int i1 = it + NGW, i2 = it + 2 * NGW;
        if (i1 < NIT) { B = moe_blk(P, i1); tblk_load(B, tb, F.lane); }
        tblk_store(A, ta, scr, F.lane);
        if (i1 >= NIT) break;
        if (i2 < NIT) { A = moe_blk(P, i2); tblk_load(A, ta, F.lane); }
        tblk_store(B, tb, scr, F.lane);
        if (i2 >= NIT) break;
        it = i2;
    }
}

constexpr size_t WS_WRT = WS_LORA + 512 * 1024;
constexpr int RT_XS = 2064, RT_LOG = 64 * RT_XS;
__device__ __forceinline__ void p6_router_group(const Params& P, const Ctx& F, const int grp) {
    ldsp_t lds = F.lds; const int lane = F.lane, wid = F.wid;
    unsigned* CNT = (unsigned*)(P.ws + WS_CTL) + CW_CNT;
    int* ELIST = (int*)(P.ws + WS_ELIST); float* ELW = (float*)(P.ws + WS_ELW);
    const bf16_t* WrT = (const bf16_t*)(P.ws + WS_WRT);
    {
        const int tok0 = grp * 64;
        if (F.tid < 64) {
            unsigned* pc = (unsigned*)(P.ws + WS_CTL) + CW_PN + 16 * (grp >> 2); unsigned* tmo = (unsigned*)(P.ws + WS_CTL) + CW_BAR + XB_TMO; unsigned polls = 0;
            while ((unsigned)__builtin_amdgcn_readfirstlane((int)__hip_atomic_load(pc, __ATOMIC_RELAXED, __HIP_MEMORY_SCOPE_AGENT)) < 32u) {
                __builtin_amdgcn_s_sleep(2);
                if ((++polls & 1023u) == 0u) { if (__builtin_amdgcn_readfirstlane((int)__hip_atomic_load(tmo, __ATOMIC_RELAXED, __HIP_MEMORY_SCOPE_AGENT)) != 0) break;
                    if (polls > (1u << 22)) { if (F.tid == 0) atomicAdd(tmo, 1u); break; } }
            }
            __builtin_amdgcn_fence(__ATOMIC_ACQUIRE, "agent");
            asm volatile("s_waitcnt vmcnt(0)" ::: "memory");
        }
        __syncthreads();
        PROBE_BEGIN(41)
        {
            f32x4 v[8][4]; float ss[8];
            u32x2 raw[8][4];
#pragma unroll
            for (int i = 0; i < 8; ++i) { const u32x2* xr = (const u32x2*)((const bf16_t*)(P.ws + WS_XMID) + (size_t)(tok0 + 8 * wid + i) * 1024) + lane;
#pragma unroll
                for (int j = 0; j < 4; ++j) raw[i][j] = xr[64 * j]; }
#pragma unroll
            for (int i = 0; i < 8; ++i) { float s = 0.f;
#pragma unroll
                for (int j = 0; j < 4; ++j) { v[i][j] = (f32x4){bf2f(raw[i][j].x & 0xffffu), bf2f(raw[i][j].x >> 16), bf2f(raw[i][j].y & 0xffffu), bf2f(raw[i][j].y >> 16)};
                    s += (v[i][j].x * v[i][j].x + v[i][j].y * v[i][j].y) + (v[i][j].z * v[i][j].z + v[i][j].w * v[i][j].w); }
                ss[i] = s; }
            wave_sum_n<8>(ss);
            f32x4 g[4];
#pragma unroll
            for (int j = 0; j < 4; ++j) g[j] = *((const f32x4*)P.ln2_w + lane + 64 * j);
            float* RSTD = (float*)(P.ws + WS_RSTD);
#pragma unroll
            for (int i = 0; i < 8; ++i) { const float inv = rsqrtf(ss[i] * (1.f / 1024.f) + 1e-6f); const int tl = 8 * wid + i;
                if (lane == 0) RSTD[tok0 + tl] = inv;
#pragma unroll
                for (int j = 0; j < 4; ++j) { u32x2 o; o.x = pk2(v[i][j].x * inv * g[j].x, v[i][j].y * inv * g[j].y); o.y = pk2(v[i][j].z * inv * g[j].z, v[i][j].w * inv * g[j].w);
                    *(LAS u32x2*)(lds + tl * RT_XS + (256 * j + 4 * lane) * 2) = o; } }
        }
        PROBE_END(41)
        __syncthreads();
        PROBE_BEGIN(42)
        {
            const int tt = wid >> 1, kh = wid & 1;
            f32x4 acc[3];
#pragma unroll
            for (int ct = 0; ct < 3; ++ct) acc[ct] = (f32x4){0.f, 0.f, 0.f, 0.f};
            const LAS unsigned char* ap = lds + (16 * tt + (lane & 15)) * RT_XS + (512 * kh + 8 * (lane >> 4)) * 2;
            const bf16_t* bp = WrT + (size_t)(lane & 15) * 1024 + 512 * kh + 8 * (lane >> 4);
#pragma unroll 4
            for (int ks = 0; ks < 16; ++ks) {
                const bf16x8 a = *(const LAS bf16x8*)(ap + ks * 64);
#pragma unroll
                for (int ct = 0; ct < 3; ++ct) { const bf16x8 bq = *(const bf16x8*)(bp + (size_t)ct * 16 * 1024 + ks * 32); acc[ct] = __builtin_amdgcn_mfma_f32_16x16x32_bf16(a, bq, acc[ct], 0, 0, 0); }
            }
#pragma unroll
            for (int ct = 0; ct < 3; ++ct)
#pragma unroll
                for (int r = 0; r < 4; ++r) *(LAS float*)(lds + RT_LOG + ((kh * 64 + 16 * tt + 4 * (lane >> 4) + r) * 48 + 16 * ct + (lane & 15)) * 4) = acc[ct][r];
        }
        PROBE_END(42)
        __syncthreads();
        PROBE_BEGIN(43)
        if (F.tid < 64) {
            const int tok = tok0 + F.tid;
            const LAS float* l0 = (const LAS float*)(lds + RT_LOG + (F.tid * 48) * 4); const LAS float* l1 = (const LAS float*)(lds + RT_LOG + ((64 + F.tid) * 48) * 4);
            float cl[4];
#pragma unroll
            for (int i = 0; i < 4; ++i) cl[i] = l0[i] + l1[i] + P.b_coarse[i];
            int g = 0; float cm = cl[0];
#pragma unroll
            for (int i = 1; i < 4; ++i) if (cl[i] > cm) { cm = cl[i]; g = i; }
            float cs = 0.f;
#pragma unroll
            for (int i = 0; i < 4; ++i) cs += __expf(cl[i] - cm);
            const float pg = 1.f / cs;
            float fl[8];
#pragma unroll
            for (int i = 0; i < 8; ++i) fl[i] = l0[4 + 8 * g + i] + l1[4 + 8 * g + i] + P.b_fine[8 * g + i];
            int i1 = 0; float m1 = fl[0];
#pragma unroll
            for (int i = 1; i < 8; ++i) if (fl[i] > m1) { m1 = fl[i]; i1 = i; }
            int i2 = -1; float m2 = -3.0e38f;
#pragma unroll
            for (int i = 0; i < 8; ++i) if (i != i1 && fl[i] > m2) { m2 = fl[i]; i2 = i; }
            const float e2 = __expf(m2 - m1);
            const float c1 = pg / (1.f + e2), c2 = pg * e2 / (1.f + e2);
            const int ea = 8 * g + i1, eb = 8 * g + i2;
            const unsigned sa = atomicAdd(&CNT[64 * ea], 1u); ELIST[(size_t)ea * NTOK + sa] = tok * 2; ELW[(size_t)ea * NTOK + sa] = c1;
            const unsigned sb = atomicAdd(&CNT[64 * eb], 1u); ELIST[(size_t)eb * NTOK + sb] = tok * 2 + 1; ELW[(size_t)eb * NTOK + sb] = c2;
        }
        PROBE_END(43)
        __syncthreads();
    }
}

__device__ __forceinline__ void build_group_tables(const Params& P, const Ctx& F) {
    LAS int* tab = (LAS int*)(F.lds + LDS_TAB);
    if (F.tid < 32) tab[F.tid] = (int)__hip_atomic_load((unsigned*)(P.ws + WS_CTL) + CW_CNT + 64 * F.tid, __ATOMIC_RELAXED, __HIP_MEMORY_SCOPE_AGENT);
    __syncthreads();
    if (F.tid == 0) { int s = 0; for (int e = 0; e < 32; ++e) { tab[32 + e] = s; s += (tab[e] + 255) >> 8; } tab[64] = s; }
    __syncthreads();
}
struct GroupOrder {
    static constexpr int A_AUX = 0;
    LAS const int* tab; const char* Abase; const char* Bbase; const int* elist; unsigned* cnt;
    int G, c, K;
    __device__ __forceinline__ bool next(int i, pg8::Unit& u) const {
        const int L = i * G + c, ntile = tab[64];
        if (L >= ntile * 4) return false;
        const int mg = L >> 2; u.pn = L & 3;
        int e = 0;
#pragma unroll 1
        for (int q = 1; q < 32; ++q) e = (tab[32 + q] <= mg) ? q : e;
        u.e = e; u.mt = mg - tab[32 + e]; u.pm = mg;
        u.a = Abase;
        u.b = Bbase + ((size_t)e * 1024 + 256 * u.pn) * K * 2;
        return true;
    }
    __device__ __forceinline__ void rows(const pg8::Unit& u, int R0, int R1, unsigned& r0, unsigned& r1) const {
        const int cnt_e = tab[u.e]; const int p0 = 256 * u.mt + R0, p1 = 256 * u.mt + R1;
        const int* el = elist + (size_t)u.e * NTOK;
        r0 = p0 < cnt_e ? (unsigned)(el[p0] >> 1) : 0u; r1 = p1 < cnt_e ? (unsigned)(el[p1] >> 1) : 0u;
    }
    __device__ __forceinline__ void a_ready(const pg8::Unit&) const {}
    __device__ __forceinline__ void done(const pg8::Unit& u) const {
        asm volatile("s_waitcnt vmcnt(0)" ::: "memory");
        if ((threadIdx.x & 63) == 0) __hip_atomic_fetch_add(cnt + 16 * u.pm, 1u, __ATOMIC_RELAXED, __HIP_MEMORY_SCOPE_AGENT);
    }
};
struct GroupOrderDown {
    static constexpr int A_AUX = 17;
    LAS const int* tab; const char* Abase; const char* Bbase; unsigned* cnt; unsigned* tmo;
    int G, c, K;
    __device__ __forceinline__ bool next(int i, pg8::Unit& u) const {
        const int ntile = tab[64], U = ntile * 4, r3 = U - 2 * G;
        int L;
        if (r3 > 0 && r3 < G && U <= 3 * G) { if (c < r3) { if (i > 0) return false; L = U - r3 + c; } else { L = (c - r3) + (G - r3) * i; if (L >= U - r3) return false; } }
        else { L = i * G + c; if (L >= U) return false; }
        const int mg = L >> 2; u.pn = L & 3;
        int e = 0;
#pragma unroll 1
        for (int q = 1; q < 32; ++q) e = (tab[32 + q] <= mg) ? q : e;
        u.e = e; u.mt = mg - tab[32 + e]; u.pm = mg;
        u.a = Abase + (size_t)mg * 256 * K * 2;
        u.b = Bbase + ((size_t)e * 1024 + 256 * u.pn) * K * 2;
        return true;
    }
    __device__ __forceinline__ void rows(const pg8::Unit&, int, int, unsigned&, unsigned&) const {}
    __device__ __forceinline__ void a_ready(const pg8::Unit& u) const {
        if (threadIdx.x < 64) {
            unsigned polls = 0;
            while ((unsigned)__builtin_amdgcn_readfirstlane((int)__hip_atomic_load(cnt + 16 * u.pm, __ATOMIC_RELAXED, __HIP_MEMORY_SCOPE_AGENT)) < 32u) {
                __builtin_amdgcn_s_sleep(2);
                if ((++polls & 1023u) == 0u) { if (__builtin_amdgcn_readfirstlane((int)__hip_atomic_load(tmo, __ATOMIC_RELAXED, __HIP_MEMORY_SCOPE_AGENT)) != 0) break;
                    if (polls > (1u << 22)) { if (threadIdx.x == 0) atomicAdd(tmo, 1u); break; } }
            }
            asm volatile("s_waitcnt vmcnt(0)" ::: "memory");
        }
        asm volatile("" ::: "memory"); __builtin_amdgcn_s_barrier(); asm volatile("" ::: "memory");
    }
    __device__ __forceinline__ void done(const pg8::Unit&) const {}
};
struct EpiSwiGLU {
    static constexpr bool PERM = true;
    bf16_t* ACT; LAS const int* tab; const int* elist; const float* rstd;
    __device__ __forceinline__ void operator()(const f32x4 (&acc)[2][2][4][2], const pg8::Unit& u, int wr, int wc, int fr, int fq) const {
        const int row0 = u.pm * 256 + wr * 64 + fr, col0 = u.pn * 128 + wc * 32 + 8 * fq;
        const __amdgpu_buffer_rsrc_t rsrc = __builtin_amdgcn_make_buffer_rsrc((void*)ACT, 0, 40960 * 512 * 2, 0x00020000);
        const int cnt = tab[u.e]; const int* el = elist + (size_t)u.e * NTOK;
        float rs[2][4];
#pragma unroll
        for (int ai = 0; ai < 2; ++ai)
#pragma unroll
            for (int m = 0; m < 4; ++m) { const int pos = 256 * u.mt + wr * 64 + ai * 128 + m * 16 + fr; rs[ai][m] = pos < cnt ? rstd[el[pos] >> 1] : 0.f; }
#pragma unroll
        for (int ai = 0; ai < 2; ++ai)
#pragma unroll
            for (int m = 0; m < 4; ++m) {
                float o[8]; const float s = rs[ai][m];
#pragma unroll
                for (int n = 0; n < 2; ++n)
#pragma unroll
                    for (int q = 0; q < 4; ++q) { const float gt = acc[ai][0][m][n][q] * s, up = acc[ai][1][m][n][q] * s; o[4 * n + q] = gt * sigmoidf_(gt) * up; }
                __builtin_amdgcn_raw_buffer_store_b128(pack8(o), rsrc, ((row0 + ai * 128 + m * 16) * 512 + col0) * 2, 0, 16);
            }
    }
};
struct EpiDown {
    static constexpr bool PERM = true;
    LAS const int* tab; const int* elist; const float* elw; bf16_t* YK0; bf16_t* YK1;
    __device__ __forceinline__ void operator()(const f32x4 (&acc)[2][2][4][2], const pg8::Unit& u, int wr, int wc, int fr, int fq) const {
        const int cnt = tab[u.e]; const int col0 = u.pn * 256 + wc * 32 + 8 * fq;
#pragma unroll
        for (int ai = 0; ai < 2; ++ai)
#pragma unroll
            for (int m = 0; m < 4; ++m) {
                const int pos = 256 * u.mt + ai * 128 + wr * 64 + m * 16 + fr;
                if (pos < cnt) {
                    const int en = elist[(size_t)u.e * NTOK + pos]; const float w = elw[(size_t)u.e * NTOK + pos];
                    bf16_t* rowp = ((en & 1) ? YK1 : YK0) + (size_t)(en >> 1) * 1024 + col0;
#pragma unroll
                    for (int bj = 0; bj < 2; ++bj) { const f32x4 v0 = acc[ai][bj][m][0], v1 = acc[ai][bj][m][1];
                        u32x4 o; o.x = pk2(v0[0] * w, v0[1] * w); o.y = pk2(v0[2] * w, v0[3] * w); o.z = pk2(v1[0] * w, v1[1] * w); o.w = pk2(v1[2] * w, v1[3] * w);
                        *(u32x4*)(rowp + bj * 128) = o; }
                }
            }
    }
};

__device__ __forceinline__ void final_token2(const Params& P, const int tokA, const int tokB, const bool hasB, const int lane) {
    float* ra = P.out + (size_t)tokA * 1024; float* rb = P.out + (size_t)(hasB ? tokB : tokA) * 1024;
    const bf16_t* y0 = (const bf16_t*)(P.ws + WS_YK0); const bf16_t* y1 = (const bf16_t*)(P.ws + WS_YK1);
    const size_t oa = (size_t)tokA * 1024, ob = (size_t)(hasB ? tokB : tokA) * 1024;
    const bf16_t* xm = (const bf16_t*)(P.ws + WS_XMID);
    f32x4 va[4], vb[4]; u32x2 a0[4], a1[4], b0[4], b1[4], xa[4], xb[4];
#pragma unroll
    for (int j = 0; j < 4; ++j) { xa[j] = *((const u32x2*)(xm + oa) + lane + 64 * j); xb[j] = *((const u32x2*)(xm + ob) + lane + 64 * j);
        a0[j] = *((const u32x2*)(y0 + oa) + lane + 64 * j); a1[j] = *((const u32x2*)(y1 + oa) + lane + 64 * j);
        b0[j] = *((const u32x2*)(y0 + ob) + lane + 64 * j); b1[j] = *((const u32x2*)(y1 + ob) + lane + 64 * j); }
    float ss[2] = {0.f, 0.f};
#pragma unroll
    for (int j = 0; j < 4; ++j) {
        va[j] = (f32x4){bf2f(xa[j].x & 0xffffu), bf2f(xa[j].x >> 16), bf2f(xa[j].y & 0xffffu), bf2f(xa[j].y >> 16)};
        vb[j] = (f32x4){bf2f(xb[j].x & 0xffffu), bf2f(xb[j].x >> 16), bf2f(xb[j].y & 0xffffu), bf2f(xb[j].y >> 16)};
        va[j].x += bf2f(a0[j].x & 0xffffu) + bf2f(a1[j].x & 0xffffu); va[j].y += bf2f(a0[j].x >> 16) + bf2f(a1[j].x >> 16);
        va[j].z += bf2f(a0[j].y & 0xffffu) + bf2f(a1[j].y & 0xffffu); va[j].w += bf2f(a0[j].y >> 16) + bf2f(a1[j].y >> 16);
        vb[j].x += bf2f(b0[j].x & 0xffffu) + bf2f(b1[j].x & 0xffffu); vb[j].y += bf2f(b0[j].x >> 16) + bf2f(b1[j].x >> 16);
        vb[j].z += bf2f(b0[j].y & 0xffffu) + bf2f(b1[j].y & 0xffffu); vb[j].w += bf2f(b0[j].y >> 16) + bf2f(b1[j].y >> 16);
        ss[0] += (va[j].x * va[j].x + va[j].y * va[j].y) + (va[j].z * va[j].z + va[j].w * va[j].w);
        ss[1] += (vb[j].x * vb[j].x + vb[j].y * vb[j].y) + (vb[j].z * vb[j].z + vb[j].w * vb[j].w); }
    wave_sum_n<2>(ss);
    const float ia = rsqrtf(ss[0] * (1.f / 1024.f) + 1e-6f), ib = rsqrtf(ss[1] * (1.f / 1024.f) + 1e-6f);
#pragma unroll
    for (int j = 0; j < 4; ++j) { const f32x4 g = *((const f32x4*)P.ln_f_w + lane + 64 * j);
        f32x4 o; o.x = va[j].x * ia * g.x; o.y = va[j].y * ia * g.y; o.z = va[j].z * ia * g.z; o.w = va[j].w * ia * g.w;
        *((f32x4*)ra + lane + 64 * j) = o;
        if (hasB) { f32x4 q; q.x = vb[j].x * ib * g.x; q.y = vb[j].y * ib * g.y; q.z = vb[j].z * ib * g.z; q.w = vb[j].w * ib * g.w; *((f32x4*)rb + lane + 64 * j) = q; } }
}

__global__ void __launch_bounds__(512, 2) mk_fwd(Params P) {
    extern __shared__ __attribute__((aligned(16))) unsigned char lds_raw[];
    Ctx F;
    F.lds = (ldsp_t)lds_raw;
    F.tid = threadIdx.x; F.lane = F.tid & 63; F.wid = __builtin_amdgcn_readfirstlane(F.tid >> 6);
    F.G = gridDim.x; { const int bx = blockIdx.x; F.vcu = (F.G % 8 == 0) ? (bx % 8) * (F.G / 8) + bx / 8 : bx; }
    volatile LAS unsigned* MISC = (volatile LAS unsigned*)(F.lds + LDS_MISC);
    if (F.tid < 16) MISC[F.tid] = 0u;
    __syncthreads();
    unsigned* ctl = (unsigned*)(P.ws + WS_CTL);
    const int lo = P.ph_lo, hi = P.ph_hi;
    XcdBarrier bar; bar.bar = ctl + CW_BAR; bar.x = 0; bar.st = MISC;
    if (hi - lo > 1) bar = xcd_barrier_post(ctl + CW_BAR, MISC);
#ifndef PHASE_MASK
#define PHASE_MASK 0xFFFFF
#endif
#define IN(k) (((PHASE_MASK >> (k)) & 1) && lo <= (k) && (k) < hi)
#ifndef REP_MASK
#define REP_MASK 0
#endif
#define NREP(k) (1 + ((REP_MASK >> (k)) & 1))
#define SEAM(k) do { if (IN(k) && IN((k) + 1)) xcd_barrier(bar); } while (0)
    unsigned char* ws = P.ws;
    const int gw = F.vcu * 8 + F.wid, NGW = F.G * 8;

    if (IN(0)) { PROBE_BEGIN(30) for (int rep = 0; rep < NREP(0); ++rep) { p0_prologue(P, F); __syncthreads(); } PROBE_END(30) }
    SEAM(0);
    if (IN(1)) {
        pg8::StaticOrder S; S.init(ws + WS_H, ws + WS_BT_RW, NTOK, 2048, 1024, F.G, (int)blockIdx.x);
        pg8::EpiBf16 E{(bf16_t*)P.out, LDA_RW};
        { PROBE_BEGIN(20) pg8::gemm_phase<pg8::EpiBf16, pg8::StaticOrder, false>(F.lds, 1024, S, E); PROBE_END(20) }
            {

        pg8::StaticOrder S; S.init(ws + WS_H, ws + WS_BT_GL, NTOK, 1792, 1024, F.G, (int)blockIdx.x);
        pg8::EpiBf16 E{(bf16_t*)(ws + WS_PB), LDB_GL};
        { PROBE_BEGIN(20) pg8::gemm_phase<pg8::EpiBf16, pg8::StaticOrder, false>(F.lds, 1024, S, E); PROBE_END(20) }
            }
    }
    SEAM(1);
    if (IN(2)) { PROBE_BEGIN(33)
        const int q0 = (F.vcu >> 1) * 8, qs = (F.G >> 1) * 8;
        unsigned sink = 0u;
        if (F.vcu & 1) {
            RwRaw R;
#pragma unroll 1
            for (int q = q0; q < 2048; q += qs) {
#pragma unroll 1
                for (int h = 0; h < 8; ++h) { int it = (q + h) * 2 + 1; asm volatile("" : "+s"(it));
                    const int qn = (h < 7) ? q + h + 1 : q + qs; rwkv_item<1>(P, F, it, R, h == 0, qn * 2 + 1, qn < 2048, sink); } }
        } else {
            RwRaw R;
#pragma unroll 1
            for (int q = q0; q < 2048; q += qs) {
#pragma unroll 1
                for (int h = 0; h < 8; ++h) { int it = (q + h) * 2; asm volatile("" : "+s"(it));
                    const int qn = (h < 7) ? q + h + 1 : q + qs; rwkv_item<0>(P, F, it, R, h == 0, qn * 2, qn < 2048, sink); } }
        }
        asm volatile("s_waitcnt vmcnt(0)" : "+v"(sink) :: "memory");
        PROBE_END(33) }
    SEAM(2);
    if (IN(3)) { }
    if (IN(4)) { PROBE_BEGIN(31)
        if (F.vcu & 1) { for (int it = F.vcu; it < 2048; it += 2 * F.G) gla_pair<1>(P, F, it, it + F.G, it + F.G < 2048); }
        else           { for (int it = F.vcu; it < 2048; it += 2 * F.G) gla_pair<0>(P, F, it, it + F.G, it + F.G < 2048); }
        asm volatile("s_waitcnt vmcnt(0)" ::: "memory");
        PROBE_END(31) }
    SEAM(4);
    if (IN(5)) { PROBE_BEGIN(6)
        if (F.tid < 512) *(volatile LAS unsigned*)(F.lds + CH_FLAGS + F.tid * 4) = 0u;
        __syncthreads();
        if (F.vcu < 128) { if (F.wid == 0) rwkv_producer(P, F.lds, F.vcu, F.lane); else chain_consumer<false>(P, F.lds, F.vcu, F.wid - 1, F.lane); }
        else if (F.vcu < 256) { if (F.wid == 0) gla_producer(P, F.lds, F.vcu - 128, F.lane); else chain_consumer<true>(P, F.lds, F.vcu - 128, F.wid - 1, F.lane); }
        PROBE_END(6) }
    SEAM(5);
#if PROBE_ID == 40
    for (int q = 0; q < 8; ++q) xcd_barrier(bar);
#endif
    if (IN(6)) { PROBE_BEGIN(32) for (int rep = 0; rep < NREP(6); ++rep) { for (int t4 = gw; t4 < NTOK / 4; t4 += NGW) mix_tok4_rw(P, t4, F.lane); for (int t4 = gw; t4 < NTOK / 4; t4 += NGW) mix_tok4_gl(P, t4, F.lane); } PROBE_END(32) }
    SEAM(6);
    if (IN(7)) { PROBE_BEGIN(50)
        const bool conv_first = ((F.vcu >> 2) & 1) != 0;
        if (conv_first) { PROBE_BEGIN(34) p5b_convert(P, F, F.vcu * 8 + F.wid, F.G * 8); PROBE_END(34) __syncthreads(); }
        {
            pg8::PanelOrder S{(const char*)(ws + WS_MIX), (const char*)(ws + WS_BT_OUT), ctl + CW_PN, 1024, 4, 256, F.G, F.vcu};
            pg8::EpiResBf16 E{(bf16_t*)(ws + WS_XMID), P.x, 1024};
            { PROBE_BEGIN(20) pg8::gemm_phase<pg8::EpiResBf16, pg8::PanelOrder, false>(F.lds, 1024, S, E); PROBE_END(20) }
        }
        PROBE_BEGIN(7)
        for (int grp = F.vcu; grp < NTOK / 64; grp += F.G) p6_router_group(P, F, grp);
        PROBE_END(7)
        if (!conv_first) { PROBE_BEGIN(34) p5b_convert(P, F, F.vcu * 8 + F.wid, F.G * 8); PROBE_END(34) }
    PROBE_END(50) }
    SEAM(7);
    if (IN(8)) { }
    if (IN(9)) { }
    if (IN(10)) {
        { PROBE_BEGIN(23) build_group_tables(P, F); PROBE_END(23) }
        unsigned* mtc = ctl + CW_MT;
        {
            GroupOrder S{(LAS const int*)(F.lds + LDS_TAB), (const char*)(ws + WS_XMID), (const char*)(ws + WS_WGU), (const int*)(ws + WS_ELIST), mtc, F.G, F.vcu, 1024};
            EpiSwiGLU E{(bf16_t*)P.out, (LAS const int*)(F.lds + LDS_TAB), (const int*)(ws + WS_ELIST), (const float*)(ws + WS_RSTD)};
            { PROBE_BEGIN(21) pg8::gemm_phase<EpiSwiGLU, GroupOrder, true>(F.lds, 1024, S, E); PROBE_END(21) }
        }
        {
            GroupOrderDown S{(LAS const int*)(F.lds + LDS_TAB), (const char*)P.out, (const char*)(ws + WS_WDN), mtc, ctl + CW_BAR + XB_TMO, F.G, F.vcu, 512};
            EpiDown E{(LAS const int*)(F.lds + LDS_TAB), (const int*)(ws + WS_ELIST), (const float*)(ws + WS_ELW), (bf16_t*)(ws + WS_YK0), (bf16_t*)(ws + WS_YK1)};
            { PROBE_BEGIN(22) pg8::gemm_phase<EpiDown, GroupOrderDown, false>(F.lds, 512, S, E); PROBE_END(22) }
        }
    }
    SEAM(10);
    if (IN(11)) { }
    if (IN(12)) { PROBE_BEGIN(8) for (int tok = gw; tok < NTOK; tok += 2 * NGW) final_token2(P, tok, tok + NGW, tok + NGW < NTOK, F.lane); PROBE_END(8) }
#undef IN
#undef SEAM
}

extern "C" void kernel_launch(void* const* d_in, const int* in_sizes, int n_in, void* d_out, int out_size, void* d_ws, size_t ws_size, hipStream_t stream) {
    static int grid = 0;
    if (grid == 0) {
        if (n_in != 33 || out_size != NTOK * DM || ws_size < WS_END) { fprintf(stderr, "kernel_launch: unexpected problem (n_in %d, out %d, ws %zu, need %zu)\n", n_in, out_size, ws_size, (size_t)WS_END); grid = -1; return; }
        int dev = 0, cus = 0, per_cu = 0;
        if (hipGetDevice(&dev) != hipSuccess || hipDeviceGetAttribute(&cus, hipDeviceAttributeMultiprocessorCount, dev) != hipSuccess) { grid = -1; return; }
        if (hipFuncSetAttribute((const void*)mk_fwd, hipFuncAttributeMaxDynamicSharedMemorySize, LDS_BYTES) != hipSuccess) { fprintf(stderr, "kernel_launch: hipFuncSetAttribute failed\n"); grid = -1; return; }
        if (hipOccupancyMaxActiveBlocksPerMultiprocessor(&per_cu, (const void*)mk_fwd, 512, LDS_BYTES) != hipSuccess || per_cu < 1) fprintf(stderr, "kernel_launch: occupancy query says %d\n", per_cu);
        (void)hipGetLastError();
        grid = cus;
    }
    if (grid < 0) return;
    (void)hipMemsetAsync((char*)d_ws + WS_CTL, 0, CTL_ZERO_BYTES, stream);
    Params p{};
    const float* const* in = (const float* const*)d_in;
    p.x = in[0]; p.ln1_w = in[1]; p.w_in = in[2]; p.rw_mu = in[3];
    p.w0_f = in[4]; p.w2_f = in[5]; p.w0_b = in[6]; p.w2_b = in[7];
    p.a0_f = in[8]; p.a2_f = in[9]; p.a0_b = in[10]; p.a2_b = in[11];
    p.g2 = in[12]; p.k_k = in[13]; p.k_a = in[14]; p.r_k = in[15]; p.ln_w = in[16]; p.ln_b = in[17];
    p.gw2_f = in[18]; p.gb_f = in[19]; p.gw2_b = in[20]; p.gb_b = in[21]; p.gnorm_w = in[22];
    p.w_out = in[23]; p.ln2_w = in[24]; p.w_coarse = in[25]; p.b_coarse = in[26]; p.w_fine = in[27]; p.b_fine = in[28];
    p.w_gate = in[29]; p.w_up = in[30]; p.w_down = in[31]; p.ln_f_w = in[32];
    p.out = (float*)d_out; p.ws = (unsigned char*)d_ws;
#if MK_PER_PHASE
#ifndef REP_PHASE
#define REP_PHASE -1
#endif
    for (int k = 0; k < NPH; ++k) { p.ph_lo = k; p.ph_hi = k + 1; hipLaunchKernelGGL(mk_fwd, dim3(grid), dim3(512), LDS_BYTES, stream, p);
        if (k == REP_PHASE) hipLaunchKernelGGL(mk_fwd, dim3(grid), dim3(512), LDS_BYTES, stream, p); }
#else
    p.ph_lo = 0; p.ph_hi = NPH; hipLaunchKernelGGL(mk_fwd, dim3(grid), dim3(512), LDS_BYTES, stream, p);
#endif
}
```

```cpp
#include <hip/hip_runtime.h>
#include <cstdio>
#include <cstdint>

#ifndef MK_PER_PHASE
#define MK_PER_PHASE 0
#endif

#define LAS __attribute__((address_space(3)))
#define GAS __attribute__((address_space(1)))
typedef unsigned short bf16_t;
typedef short bf16x8 __attribute__((ext_vector_type(8)));
typedef float f32x4 __attribute__((ext_vector_type(4)));
typedef float f32x16 __attribute__((ext_vector_type(16)));
typedef unsigned u32x4 __attribute__((ext_vector_type(4)));
typedef unsigned u32x2 __attribute__((ext_vector_type(2)));
typedef LAS unsigned char* ldsp_t;

constexpr int NTOK = 16384, SEQ = 4096, DM = 1024;
constexpr int LDA_RW = 2048;
constexpr int LDB_GL = 1792;
constexpr int RW_COLS = 1920, GL_COLS = 1568;
constexpr int NEXP = 32, DEXP = 512;
constexpr int NPH = 13;

constexpr size_t MiB = 1u << 20;
constexpr size_t WS_CTL = 0, CTL_ZERO_BYTES = 64 * 1024;
constexpr size_t WS_LORA = 1 * MiB;
constexpr size_t WS_BT_RW = 2 * MiB, WS_BT_GL = 6 * MiB, WS_BT_OUT = 10 * MiB;
constexpr size_t WS_BON = 12 * MiB;
constexpr size_t WS_ERS = 250 * MiB;
constexpr size_t WS_ELIST = 13 * MiB;
constexpr size_t WS_DEC = 15 * MiB;
constexpr size_t WS_H = 16 * MiB;
constexpr size_t WS_OF = 16 * MiB, WS_OB = 32 * MiB;
constexpr size_t WS_H2 = 16 * MiB;
constexpr size_t WS_RM = 48 * MiB, WS_RP = 80 * MiB, WS_RNT = 112 * MiB;
constexpr size_t WS_GQ = 48 * MiB, WS_GNT = 64 * MiB;
constexpr size_t WS_MIX = 48 * MiB;
constexpr size_t WS_YF = 144 * MiB, WS_YB = 160 * MiB, WS_G = 176 * MiB, WS_VS = 192 * MiB;
constexpr size_t WS_PB = 208 * MiB;
constexpr size_t WS_WGU = 80 * MiB, WS_WDN = 144 * MiB;
constexpr size_t WS_XMID = 176 * MiB;
constexpr size_t WS_YK0 = 48 * MiB, WS_YK1 = 216 * MiB;
constexpr size_t WS_ELW = 248 * MiB;
constexpr size_t WS_END = 264 * MiB;
constexpr int CW_CNT = 0;
constexpr int CW_BAR = 4096;
constexpr int CW_PN = 12288;
constexpr int CW_MT = 8192;

constexpr int LDS_BYTES = 160 * 1024;
constexpr int LDS_MISC = LDS_BYTES - 64;
constexpr int LDS_TAB = 131072;

#ifndef PROBE_ID
#define PROBE_ID 0
#endif
#ifndef PROBE_MULT
#define PROBE_MULT 1
#endif
#define PROBE_BEGIN(id) long long _pb_##id = 0; if (PROBE_ID == (id)) { _pb_##id = __builtin_readcyclecounter(); }
#define PROBE_END(id) if (PROBE_ID == (id)) { const long long _e = __builtin_readcyclecounter(); const long long _d = (_e - _pb_##id) * PROBE_MULT; while (__builtin_readcyclecounter() - _e < _d) __builtin_amdgcn_s_sleep(2); }
__device__ __forceinline__ float bf2f(unsigned b) { return __uint_as_float(b << 16); }
typedef __bf16 bf2_t __attribute__((ext_vector_type(2)));
typedef float f2_t __attribute__((ext_vector_type(2)));
__device__ __forceinline__ unsigned f2bf(float f) { const __bf16 b = (__bf16)f; return (unsigned)__builtin_bit_cast(unsigned short, b); }
__device__ __forceinline__ unsigned pk2(float lo, float hi) { const f2_t v = {lo, hi}; const bf2_t r = __builtin_convertvector(v, bf2_t); return __builtin_bit_cast(unsigned, r); }
template <int CTRL> __device__ __forceinline__ float dpp_mov(float x) { return __int_as_float(__builtin_amdgcn_update_dpp(0, __float_as_int(x), CTRL, 0xF, 0xF, true)); }
template <int N> __device__ __forceinline__ void wave_sum_n(float (&v)[N]) {
#pragma unroll
    for (int i = 0; i < N; ++i) v[i] += dpp_mov<0xB1>(v[i]);
#pragma unroll
    for (int i = 0; i < N; ++i) v[i] += dpp_mov<0x4E>(v[i]);
#pragma unroll
    for (int i = 0; i < N; ++i) v[i] += dpp_mov<0x141>(v[i]);
#pragma unroll
    for (int i = 0; i < N; ++i) v[i] += dpp_mov<0x140>(v[i]);
    { float t[N];
#pragma unroll
      for (int i = 0; i < N; ++i) t[i] = __int_as_float(__builtin_amdgcn_ds_swizzle(__float_as_int(v[i]), 0x401F));
#pragma unroll
      for (int i = 0; i < N; ++i) v[i] += t[i]; }
    { float t[N];
#pragma unroll
      for (int i = 0; i < N; ++i) t[i] = __shfl_xor(v[i], 32);
#pragma unroll
      for (int i = 0; i < N; ++i) v[i] += t[i]; }
}
__device__ __forceinline__ float wave_sum(float v) { float t[1] = {v}; wave_sum_n<1>(t); return t[0]; }
__device__ __forceinline__ float sigmoidf_(float x) { return __builtin_amdgcn_rcpf(1.f + __expf(-x)); }
__device__ __forceinline__ float tanhf_(float x) { return 1.f - 2.f * __builtin_amdgcn_rcpf(1.f + __expf(2.f * x)); }
__device__ __forceinline__ void unpack8(const u32x4& v, float (&o)[8]) {
    o[0] = bf2f(v.x & 0xffffu); o[1] = bf2f(v.x >> 16); o[2] = bf2f(v.y & 0xffffu); o[3] = bf2f(v.y >> 16);
    o[4] = bf2f(v.z & 0xffffu); o[5] = bf2f(v.z >> 16); o[6] = bf2f(v.w & 0xffffu); o[7] = bf2f(v.w >> 16);
}
__device__ __forceinline__ u32x4 pack8(const float (&o)[8]) {
    u32x4 v; v.x = pk2(o[0], o[1]); v.y = pk2(o[2], o[3]); v.z = pk2(o[4], o[5]); v.w = pk2(o[6], o[7]); return v;
}

#define XB_TMO      128
#define XB_XCNT(j)  (256  + 64 * (j))
#define XB_XSUB(j)  (1280 + 64 * (j))
#define XB_XGEN(j)  (2304 + 64 * (j))
#define XB_TOP      3328
#define XB_TOPGEN   3392
#define XCD_BAR_WORDS 3456
#define XB_SPIN_CAP (1u << 18)
__device__ __forceinline__ unsigned xb_ld(unsigned* p)              { return __hip_atomic_load(p, __ATOMIC_RELAXED, __HIP_MEMORY_SCOPE_AGENT); }
__device__ __forceinline__ unsigned xb_add(unsigned* p, unsigned v) { return __hip_atomic_fetch_add(p, v, __ATOMIC_RELAXED, __HIP_MEMORY_SCOPE_AGENT); }
__device__ __forceinline__ unsigned xb_xcc_id() { return (unsigned)__builtin_amdgcn_s_getreg((3 << 11) | 20) & 0xFu; }
#define XB_SPIN(cond, bar) do { unsigned _sp = 0; while (cond) { __builtin_amdgcn_s_sleep(1); \
    if ((++_sp & 255u) == 0u) { if (xb_ld(&(bar)[XB_TMO])) break; if (_sp > XB_SPIN_CAP) { atomicAdd(&(bar)[XB_TMO], 1u); break; } } } } while (0)
struct XcdBarrier { unsigned* bar; unsigned x; volatile LAS unsigned* st; };
__device__ __forceinline__ XcdBarrier xcd_barrier_post(unsigned* bar, volatile LAS unsigned* st) {
    XcdBarrier b; b.bar = bar; b.x = xb_xcc_id(); b.st = st;
    if (threadIdx.x == 0) (void)xb_add(&bar[XB_XCNT(b.x)], 1u);
    return b;
}
__device__ __forceinline__ void xcd_barrier_complete(unsigned* bar, unsigned x, unsigned& nloc, unsigned& nx) {
    const unsigned G = gridDim.x * gridDim.y * gridDim.z;
    unsigned sum, cnt, mine, sp = 0u;
    for (;;) {
        sum = 0u; cnt = 0u; mine = 0u;
#pragma unroll
        for (unsigned j = 0; j < 16; ++j) { const unsigned c = xb_ld(&bar[XB_XCNT(j)]); sum += c; cnt += (c > 0u) ? 1u : 0u; mine = (j == x) ? c : mine; }
        if (sum == G) break;
        __builtin_amdgcn_s_sleep(1);
        if ((++sp & 255u) == 0u) { if (xb_ld(&bar[XB_TMO])) break; if (sp > XB_SPIN_CAP) { atomicAdd(&bar[XB_TMO], 1u); break; } }
    }
    nloc = mine > 0u ? mine : 1u; nx = cnt > 0u ? cnt : 1u;
}
__device__ __forceinline__ void xcd_barrier(const XcdBarrier& b) {
    asm volatile("s_waitcnt vmcnt(0)" ::: "memory");
    __syncthreads();
    if (threadIdx.x == 0) {
        unsigned* bar = b.bar;
        __builtin_amdgcn_s_waitcnt(0);
        unsigned nloc = b.st[0], nx = b.st[1];
        if (nloc == 0u) { xcd_barrier_complete(bar, b.x, nloc, nx); b.st[0] = nloc; b.st[1] = nx; }
        const unsigned old = xb_add(&bar[XB_XSUB(b.x)], 1u);
        const unsigned gen = old / nloc;
        if (old + 1u == (gen + 1u) * nloc) {
            __builtin_amdgcn_fence(__ATOMIC_RELEASE, "agent");
            asm volatile("s_waitcnt vmcnt(0)" ::: "memory");
            const unsigned og = xb_add(&bar[XB_TOP], 1u);
            const unsigned tg = og / nx;
            if (og + 1u == (tg + 1u) * nx) xb_add(&bar[XB_TOPGEN], 1u);
            else XB_SPIN(xb_ld(&bar[XB_TOPGEN]) == tg, bar);
            __builtin_amdgcn_fence(__ATOMIC_ACQUIRE, "agent");
            xb_add(&bar[XB_XGEN(b.x)], 1u);
            asm volatile("s_waitcnt vmcnt(0)" ::: "memory");
        } else {
            XB_SPIN(xb_ld(&bar[XB_XGEN(b.x)]) == gen, bar);
            __builtin_amdgcn_fence(__ATOMIC_ACQUIRE, "agent");
            asm volatile("s_waitcnt vmcnt(0)" ::: "memory");
        }
    }
    __syncthreads();
}

struct Params {
    const float* x; const float* ln1_w; const float* w_in; const float* rw_mu;
    const float* w0_f; const float* w2_f; const float* w0_b; const float* w2_b;
    const float* a0_f; const float* a2_f; const float* a0_b; const float* a2_b;
    const float* g2; const float* k_k; const float* k_a; const float* r_k; const float* ln_w; const float* ln_b;
    const float* gw2_f; const float* gb_f; const float* gw2_b; const float* gb_b; const float* gnorm_w;
    const float* w_out; const float* ln2_w; const float* w_coarse; const float* b_coarse; const float* w_fine; const float* b_fine;
    const float* w_gate; const float* w_up; const float* w_down; const float* ln_f_w;
    float* out; unsigned char* ws;
    int ph_lo, ph_hi;
};

namespace pg8 {
constexpr int BM = 256, BK = 64, HALF = 128, HTB = HALF * BK * 2, STAGE_BYTES = 8 * HTB, NXCD = 8, WGM = 8;
__host__ __device__ __forceinline__ int lds_byte(int r, int c) { const int st = (r >> 4) * 2 + (c >> 5), rr = r & 15, cc = c & 31, ob = rr * 64 + cc * 2; return st * 1024 + (ob ^ (((ob >> 9) & 1) << 5)); }
__host__ __device__ __forceinline__ void stage_rc(int b, int& R, int& C) { const int st = b / 1024, sb = b % 1024, swz = sb ^ (((sb >> 9) & 1) << 5); R = (st >> 1) * 16 + swz / 64; C = (st & 1) * 32 + (swz % 64) / 2; }
__host__ __device__ __forceinline__ int perm32(int rho) { const int n = rho >> 4, i = rho & 15; return 8 * (i >> 2) + 4 * n + (i & 3); }

struct Unit { const char* a; const char* b; int pm, pn, e, mt; };

struct StaticOrder {
    static constexpr int A_AUX = 0;
    const char* A; const char* Bt; int K;
    int nM, nN, nwg, G, c;
    __device__ void init(const void* A_, const void* Bt_, int M, int N, int K_, int G_, int c_) { A = (const char*)A_; Bt = (const char*)Bt_; K = K_; nM = M / BM; nN = N / BM; nwg = nM * nN; G = G_; c = c_; }
    __device__ __forceinline__ bool next(int i, Unit& u) const {
        const long L = (long)i * G + c; if (L >= nwg) return false;
        int wgid = (int)L; { const int q = nwg / NXCD, r = nwg % NXCD, xcd = wgid % NXCD, off = wgid / NXCD; wgid = (xcd < r ? xcd * (q + 1) : r * (q + 1) + (xcd - r) * q) + off; }
        const int nig = WGM * nN, gid = wgid / nig, fm = gid * WGM, gsz = (nM - fm) < WGM ? (nM - fm) : WGM;
        u.pm = fm + ((wgid % nig) % gsz); u.pn = (wgid % nig) / gsz; u.e = 0; u.mt = 0;
        u.a = A + (size_t)u.pm * 256 * K * 2; u.b = Bt + (size_t)u.pn * 256 * K * 2; return true;
    }
    __device__ __forceinline__ void rows(const Unit&, int, int, unsigned&, unsigned&) const {}
    __device__ __forceinline__ void a_ready(const Unit&) const {}
    __device__ __forceinline__ void done(const Unit&) const {}
};

template <class Epi, class Sched, bool GATHER>
__device__ __forceinline__ void gemm_phase(ldsp_t lds, const int K, const Sched& S, const Epi& E) {
    const int tid = threadIdx.x, wid = __builtin_amdgcn_readfirstlane(tid >> 6), lane = tid & 63, wr = wid >> 2, wc = wid & 3, fr = lane & 15, fq = lane >> 4;
    const int nt = K / BK;
    unsigned voffA[2], voffB[2]; int RA[2], CA[2];
#pragma unroll
    for (int i = 0; i < 2; ++i) { int R, C; stage_rc(tid * 16 + i * 8192, R, C); const int Rb = Epi::PERM ? ((R & ~31) + perm32(R & 31)) : R;
        RA[i] = R; CA[i] = C; voffA[i] = (unsigned)(R * K + C) * 2u; voffB[i] = (unsigned)(Rb * K + C) * 2u; }
    const size_t kstep = (size_t)(BK * 2);
    const unsigned hstep = (unsigned)HALF * K * 2;
    const unsigned ldsw = (unsigned)wid * 1024u;
    const int aoff = lds_byte(wr * 64 + fr, fq * 8), boff = lds_byte(wc * 32 + fr, fq * 8);
#define PG8_SA(b, h) (((b) * 2 + (h)) * HTB)
#define PG8_SB(b, h) ((4 + (b) * 2 + (h)) * HTB)
#define PG8_STAGE2(bufoff, gbase, v0, v1) do { \
        __builtin_amdgcn_global_load_lds((const unsigned*)((const char*)(gbase) + (v0)), (LAS unsigned*)(lds + (bufoff) + ldsw), 16, 0, 0); \
        __builtin_amdgcn_global_load_lds((const unsigned*)((const char*)(gbase) + (v1)), (LAS unsigned*)(lds + (bufoff) + ldsw + 8192), 16, 0, 0); } while (0)
#define PG8_STAGEB(bufoff, gbase) PG8_STAGE2(bufoff, gbase, voffB[0], voffB[1])
#define PG8_STAGEA(bufoff, gbase, v0, v1) do { \
        __builtin_amdgcn_global_load_lds((const unsigned*)((const char*)(gbase) + (v0)), (LAS unsigned*)(lds + (bufoff) + ldsw), 16, 0, Sched::A_AUX); \
        __builtin_amdgcn_global_load_lds((const unsigned*)((const char*)(gbase) + (v1)), (LAS unsigned*)(lds + (bufoff) + ldsw + 8192), 16, 0, Sched::A_AUX); } while (0)
#define PG8_LDA(dst, b, h) do { _Pragma("unroll") for (int m = 0; m < 4; ++m) _Pragma("unroll") for (int k = 0; k < 2; ++k) dst[m][k] = *(const LAS bf16x8*)(lds + PG8_SA(b, h) + aoff + m * 2048 + k * 1024); } while (0)
#define PG8_LDB(dst, b, h) do { _Pragma("unroll") for (int n = 0; n < 2; ++n) _Pragma("unroll") for (int k = 0; k < 2; ++k) dst[n][k] = *(const LAS bf16x8*)(lds + PG8_SB(b, h) + boff + n * 2048 + k * 1024); } while (0)
#define PG8_MMA(ai, bj, At, Bt) do { __builtin_amdgcn_s_setprio(1); _Pragma("unroll") for (int m = 0; m < 4; ++m) _Pragma("unroll") for (int n = 0; n < 2; ++n) _Pragma("unroll") for (int k = 0; k < 2; ++k) \
        acc[ai][bj][m][n] = __builtin_amdgcn_mfma_f32_16x16x32_bf16(Bt[n][k], At[m][k], acc[ai][bj][m][n], 0, 0, 0); __builtin_amdgcn_s_setprio(0); } while (0)
#define PG8_WAIT_V(n) asm volatile("s_waitcnt vmcnt(" #n ")" ::: "memory")
#define PG8_WAIT_L(n) asm volatile("s_waitcnt lgkmcnt(" #n ")" ::: "memory")
#define PG8_BAR __builtin_amdgcn_s_barrier()
#define PG8_SCHED __builtin_amdgcn_sched_barrier(0)
    Unit cur, nxt; int ui = 0;
    if (!S.next(0, cur)) return;
    f32x4 acc[2][2][4][2];
#pragma unroll
    for (int a = 0; a < 2; ++a)
#pragma unroll
        for (int b = 0; b < 2; ++b)
#pragma unroll
            for (int m = 0; m < 4; ++m)
#pragma unroll
                for (int n = 0; n < 2; ++n) acc[a][b][m][n] = (f32x4){0.f, 0.f, 0.f, 0.f};
    bf16x8 At[4][2], B0[2][2], B1[2][2];
    unsigned oc0[2], oc1[2], on0[2], on1[2];
    if constexpr (GATHER) {
#pragma unroll
        for (int i = 0; i < 2; ++i) { unsigned r0, r1; S.rows(cur, RA[i], RA[i] + 128, r0, r1); oc0[i] = r0 * (unsigned)(K * 2) + (unsigned)CA[i] * 2u; oc1[i] = r1 * (unsigned)(K * 2) + (unsigned)CA[i] * 2u; on0[i] = oc0[i]; on1[i] = oc1[i]; }
    } else {
#pragma unroll
        for (int i = 0; i < 2; ++i) { oc0[i] = voffA[i]; oc1[i] = voffA[i] + hstep; on0[i] = oc0[i]; on1[i] = oc1[i]; }
    }
    const char* cA = cur.a; const char* cB = cur.b;
    S.a_ready(cur);
    PG8_STAGEB(PG8_SB(0, 0), cB); PG8_STAGEA(PG8_SA(0, 0), cA, oc0[0], oc0[1]); PG8_STAGEB(PG8_SB(0, 1), cB + hstep); PG8_STAGEA(PG8_SA(0, 1), cA, oc1[0], oc1[1]);
    if (wr == 1) PG8_BAR;
    PG8_WAIT_V(4); PG8_BAR;
    PG8_STAGEB(PG8_SB(1, 0), cB + kstep); PG8_STAGEA(PG8_SA(1, 0), cA + kstep, oc0[0], oc0[1]); PG8_STAGEB(PG8_SB(1, 1), cB + hstep + kstep);
    PG8_WAIT_V(6); PG8_BAR;
    for (;;) {
        const bool has_next = S.next(ui + 1, nxt);
        const char* nA = has_next ? nxt.a : cA; const char* nB = has_next ? nxt.b : cB;
        if constexpr (GATHER) {
            if (has_next) {
#pragma unroll
                for (int i = 0; i < 2; ++i) { unsigned r0, r1; S.rows(nxt, RA[i], RA[i] + 128, r0, r1); on0[i] = r0 * (unsigned)(K * 2) + (unsigned)CA[i] * 2u; on1[i] = r1 * (unsigned)(K * 2) + (unsigned)CA[i] * 2u; }
            } else {
#pragma unroll
                for (int i = 0; i < 2; ++i) { on0[i] = oc0[i]; on1[i] = oc1[i]; }
            }
        }
        for (int t = 0; t < nt; t += 2) {
            const bool last = (t == nt - 2);
            const char* a1 = cA + (size_t)(t + 1) * kstep;
            const char* a2 = last ? nA : cA + (size_t)(t + 2) * kstep; const char* b2 = last ? nB : cB + (size_t)(t + 2) * kstep;
            const char* a3 = a2 + kstep; const char* b3 = b2 + kstep;
            if (last && has_next) S.a_ready(nxt);
            unsigned p00, p01, p10, p11;
            if constexpr (GATHER) { p00 = last ? on0[0] : oc0[0]; p01 = last ? on0[1] : oc0[1]; p10 = last ? on1[0] : oc1[0]; p11 = last ? on1[1] : oc1[1]; }
            else { p00 = oc0[0]; p01 = oc0[1]; p10 = oc1[0]; p11 = oc1[1]; }
            PG8_LDB(B0, 0, 0); PG8_SCHED; PG8_LDA(At, 0, 0); PG8_STAGEA(PG8_SA(1, 1), a1, oc1[0], oc1[1]);
            PG8_WAIT_L(8); PG8_BAR; PG8_WAIT_L(0); PG8_MMA(0, 0, At, B0); PG8_BAR; PG8_SCHED;
            PG8_LDB(B1, 0, 1); PG8_STAGEB(PG8_SB(0, 0), b2);
            PG8_BAR; PG8_WAIT_L(0); PG8_MMA(0, 1, At, B1); PG8_BAR;
            PG8_LDA(At, 0, 1); PG8_STAGEA(PG8_SA(0, 0), a2, p00, p01);
            PG8_BAR; PG8_WAIT_L(0); PG8_MMA(1, 0, At, B0); PG8_BAR; PG8_SCHED;
            PG8_STAGEB(PG8_SB(0, 1), b2 + hstep);
            PG8_WAIT_V(6); PG8_BAR; PG8_MMA(1, 1, At, B1); PG8_BAR;
            PG8_LDB(B0, 1, 0); PG8_SCHED; PG8_LDA(At, 1, 0); PG8_STAGEA(PG8_SA(0, 1), a2, p10, p11);
            PG8_WAIT_L(8); PG8_BAR; PG8_WAIT_L(0); PG8_MMA(0, 0, At, B0); PG8_BAR; PG8_SCHED;
            PG8_LDB(B1, 1, 1); PG8_STAGEB(PG8_SB(1, 0), b3);
            PG8_BAR; PG8_WAIT_L(0); PG8_MMA(0, 1, At, B1); PG8_BAR;
            PG8_LDA(At, 1, 1); PG8_STAGEA(PG8_SA(1, 0), a3, p00, p01);
            PG8_BAR; PG8_WAIT_L(0); PG8_MMA(1, 0, At, B0); PG8_BAR; PG8_SCHED;
            PG8_STAGEB(PG8_SB(1, 1), b3 + hstep);
            PG8_WAIT_V(6); PG8_BAR; PG8_MMA(1, 1, At, B1); PG8_BAR;
        }
        E(acc, cur, wr, wc, fr, fq); S.done(cur);
        if (!has_next) break;
#pragma unroll
        for (int a = 0; a < 2; ++a)
#pragma unroll
            for (int b = 0; b < 2; ++b)
#pragma unroll
                for (int m = 0; m < 4; ++m)
#pragma unroll
                    for (int n = 0; n < 2; ++n) acc[a][b][m][n] = (f32x4){0.f, 0.f, 0.f, 0.f};
        cur = nxt; cA = nA; cB = nB; ++ui;
#pragma unroll
        for (int i = 0; i < 2; ++i) { oc0[i] = on0[i]; oc1[i] = on1[i]; }
    }
    PG8_WAIT_V(0);
    if (wr == 0) PG8_BAR;
    PG8_BAR;
#undef PG8_SA
#undef PG8_SB
#undef PG8_STAGE2
#undef PG8_STAGEB
#undef PG8_STAGEA
#undef PG8_LDA
#undef PG8_LDB
#undef PG8_MMA
#undef PG8_WAIT_V
#undef PG8_WAIT_L
#undef PG8_BAR
#undef PG8_SCHED
}

struct EpiBf16 {
    static constexpr bool PERM = true;
    bf16_t* O; int ldc;
    __device__ __forceinline__ void operator()(const f32x4 (&acc)[2][2][4][2], const Unit& u, int wr, int wc, int fr, int fq) const {
        const int row0 = u.pm * BM + wr * 64 + fr, col0 = u.pn * BM + wc * 32 + 8 * fq;
#pragma unroll
        for (int ai = 0; ai < 2; ++ai)
#pragma unroll
            for (int m = 0; m < 4; ++m) { bf16_t* rowp = O + (size_t)(row0 + ai * HALF + m * 16) * ldc + col0;
#pragma unroll
                for (int bj = 0; bj < 2; ++bj) { const f32x4 v0 = acc[ai][bj][m][0], v1 = acc[ai][bj][m][1];
                    u32x4 o; o.x = pk2(v0[0], v0[1]); o.y = pk2(v0[2], v0[3]); o.z = pk2(v1[0], v1[1]); o.w = pk2(v1[2], v1[3]);
                    *(u32x4*)(rowp + bj * HALF) = o; } }
    }
};
struct EpiResF32 {
    static constexpr bool PERM = false;
    float* C; const float* X; int ldc;
    __device__ __forceinline__ void operator()(const f32x4 (&acc)[2][2][4][2], const Unit& u, int wr, int wc, int fr, int fq) const {
        const int row0 = u.pm * BM + wr * 64 + fr, col0 = u.pn * BM + wc * 32 + 4 * fq;
        const __amdgpu_buffer_rsrc_t rsrc = __builtin_amdgcn_make_buffer_rsrc((void*)C, 0, NTOK * DM * 4, 0x00020000);
#pragma unroll
        for (int ai = 0; ai < 2; ++ai)
#pragma unroll
            for (int m = 0; m < 4; ++m) { const size_t ro = (size_t)(row0 + ai * HALF + m * 16) * ldc + col0;
#pragma unroll
                for (int bj = 0; bj < 2; ++bj)
#pragma unroll
                    for (int n = 0; n < 2; ++n) { const f32x4 xv = *(const f32x4*)(X + ro + bj * HALF + n * 16); const f32x4 o = acc[ai][bj][m][n] + xv;
                        __builtin_amdgcn_raw_buffer_store_b128(__builtin_bit_cast(u32x4, o), rsrc, (int)((ro + bj * HALF + n * 16) * 4), 0, 16); } }
    }
};
struct EpiResBf16 {
    static constexpr bool PERM = true;
    bf16_t* C; const float* X; int ldc;
    __device__ __forceinline__ void operator()(const f32x4 (&acc)[2][2][4][2], const Unit& u, int wr, int wc, int fr, int fq) const {
        const int row0 = u.pm * BM + wr * 64 + fr, col0 = u.pn * BM + wc * 32 + 8 * fq;
        const __amdgpu_buffer_rsrc_t rsrc = __builtin_amdgcn_make_buffer_rsrc((void*)C, 0, NTOK * DM * 2, 0x00020000);
#pragma unroll
        for (int ai = 0; ai < 2; ++ai)
#pragma unroll
            for (int m = 0; m < 4; ++m) { const size_t ro = (size_t)(row0 + ai * HALF + m * 16) * ldc + col0;
#pragma unroll
                for (int bj = 0; bj < 2; ++bj) { const f32x4 x0 = *(const f32x4*)(X + ro + bj * HALF), x1 = *(const f32x4*)(X + ro + bj * HALF + 4);
                    const f32x4 v0 = acc[ai][bj][m][0] + x0, v1 = acc[ai][bj][m][1] + x1;
                    u32x4 o; o.x = pk2(v0[0], v0[1]); o.y = pk2(v0[2], v0[3]); o.z = pk2(v1[0], v1[1]); o.w = pk2(v1[2], v1[3]);
                    __builtin_amdgcn_raw_buffer_store_b128(o, rsrc, (int)((ro + bj * HALF) * 2), 0, 16); } }
    }
};
struct PanelOrder {
    static constexpr int A_AUX = 0;
    const char* A; const char* Bt; unsigned* cnt; int K, nN, nwg, G, c;
    __device__ __forceinline__ bool next(int i, Unit& u) const {
        const int L = i * G + c; if (L >= nwg) return false;
        u.pm = L / nN; u.pn = L % nN; u.e = 0; u.mt = 0;
        u.a = A + (size_t)u.pm * 256 * K * 2; u.b = Bt + (size_t)u.pn * 256 * K * 2; return true;
    }
    __device__ __forceinline__ void rows(const Unit&, int, int, unsigned&, unsigned&) const {}
    __device__ __forceinline__ void a_ready(const Unit&) const {}
    __device__ __forceinline__ void done(const Unit& u) const {
        asm volatile("s_waitcnt vmcnt(0)" ::: "memory");
        if ((threadIdx.x & 63) == 0) __hip_atomic_fetch_add(cnt + 16 * u.pm, 1u, __ATOMIC_RELAXED, __HIP_MEMORY_SCOPE_AGENT);
    }
};
}

template <int KS>
__device__ __forceinline__ f32x4 tile_n(const LAS unsigned char* A, int lda, const LAS unsigned char* Bt, int ldb, f32x4 acc, int lane) {
    const LAS unsigned char* ap = A + (lane & 15) * lda + (lane >> 4) * 16;
    const LAS unsigned char* bp = Bt + (lane & 15) * ldb + (lane >> 4) * 16;
#pragma unroll
    for (int k = 0; k < KS; ++k) { const bf16x8 a = *(const LAS bf16x8*)(ap + k * 64), b = *(const LAS bf16x8*)(bp + k * 64); acc = __builtin_amdgcn_mfma_f32_16x16x32_bf16(a, b, acc, 0, 0, 0); }
    return acc;
}
template <int KS>
__device__ __forceinline__ f32x4 tile_s(const LAS unsigned char* A, int lda, const LAS unsigned char* Bt, int ldb, f32x4 acc, int lane) {
    const LAS unsigned char* ap = A + (lane & 15) * lda + (lane >> 4) * 16;
    const LAS unsigned char* bp = Bt + (lane & 15) * ldb + (lane >> 4) * 16;
#pragma unroll
    for (int k = 0; k < KS; ++k) { const bf16x8 a = *(const LAS bf16x8*)(ap + k * 64), b = *(const LAS bf16x8*)(bp + k * 64); acc = __builtin_amdgcn_mfma_f32_16x16x32_bf16(b, a, acc, 0, 0, 0); }
    return acc;
}
struct Frag2 { bf16x8 f[2]; };
__device__ __forceinline__ Frag2 ld_frag2(const LAS unsigned char* M, int ld, int lane) { const LAS unsigned char* p = M + (lane & 15) * ld + (lane >> 4) * 16; Frag2 r; r.f[0] = *(const LAS bf16x8*)p; r.f[1] = *(const LAS bf16x8*)(p + 64); return r; }
__device__ __forceinline__ f32x4 tile_nb(const LAS unsigned char* A, int lda, const Frag2& b, f32x4 acc, int lane) {
    const LAS unsigned char* ap = A + (lane & 15) * lda + (lane >> 4) * 16;
#pragma unroll
    for (int k = 0; k < 2; ++k) { const bf16x8 a = *(const LAS bf16x8*)(ap + k * 64); acc = __builtin_amdgcn_mfma_f32_16x16x32_bf16(a, b.f[k], acc, 0, 0, 0); }
    return acc;
}
__device__ __forceinline__ f32x4 tile_sb(const LAS unsigned char* A, int lda, const Frag2& b, f32x4 acc, int lane) {
    const LAS unsigned char* ap = A + (lane & 15) * lda + (lane >> 4) * 16;
#pragma unroll
    for (int k = 0; k < 2; ++k) { const bf16x8 a = *(const LAS bf16x8*)(ap + k * 64); acc = __builtin_amdgcn_mfma_f32_16x16x32_bf16(b.f[k], a, acc, 0, 0, 0); }
    return acc;
}
__device__ __forceinline__ void st4bf(LAS unsigned char* p, const f32x4& v) { u32x2 o; o.x = pk2(v[0], v[1]); o.y = pk2(v[2], v[3]); *(LAS u32x2*)p = o; }
__device__ __forceinline__ void st4bf_g(bf16_t* p, const f32x4& v) { u32x2 o; o.x = pk2(v[0], v[1]); o.y = pk2(v[2], v[3]); *(u32x2*)p = o; }


struct Ctx { ldsp_t lds; int tid, lane, wid, vcu, G; };

__device__ __forceinline__ void transpose_block(const float* W, int N, bf16_t* WT, int ldk, int dst_row0, int k0, int n0, LAS float* scr, int lane) {
    float tv[32];
#pragma unroll
    for (int i = 0; i < 32; ++i) { const int kk = 2 * i + (lane >> 5); tv[i] = W[(size_t)(k0 + kk) * N + n0 + (lane & 31)]; }
#pragma unroll
    for (int i = 0; i < 32; ++i) { const int kk = 2 * i + (lane >> 5); scr[kk * 33 + (lane & 31)] = tv[i]; }
    asm volatile("s_waitcnt lgkmcnt(0)" ::: "memory");
    const int c = lane & 7;
#pragma unroll
    for (int j = 0; j < 4; ++j) { const int n = (lane >> 3) + 8 * j; const LAS float* s = scr + (8 * c) * 33 + n;
        u32x4 o; o.x = pk2(s[0 * 33], s[1 * 33]); o.y = pk2(s[2 * 33], s[3 * 33]); o.z = pk2(s[4 * 33], s[5 * 33]); o.w = pk2(s[6 * 33], s[7 * 33]);
        *(u32x4*)(WT + (size_t)(dst_row0 + n) * ldk + k0 + 8 * c) = o; }
    asm volatile("s_waitcnt lgkmcnt(0)" ::: "memory");
}
__device__ __forceinline__ void rms_row_to_bf16(const float* xrow, const float* w, bf16_t* orow, int lane) {
    const f32x4* xr = (const f32x4*)xrow + lane; const f32x4* wr = (const f32x4*)w + lane;
    f32x4 v[4]; float s = 0.f;
#pragma unroll
    for (int j = 0; j < 4; ++j) { v[j] = xr[64 * j]; s += (v[j].x * v[j].x + v[j].y * v[j].y) + (v[j].z * v[j].z + v[j].w * v[j].w); }
    const float inv = rsqrtf(wave_sum(s) * (1.f / 1024.f) + 1e-6f);
    u32x2* o8 = (u32x2*)orow + lane;
#pragma unroll
    for (int j = 0; j < 4; ++j) { const f32x4 g = wr[64 * j]; u32x2 o; o.x = pk2(v[j].x * inv * g.x, v[j].y * inv * g.y); o.y = pk2(v[j].z * inv * g.z, v[j].w * inv * g.w); o8[64 * j] = o; }
}
__device__ __forceinline__ void p0_prologue(const Params& P, const Ctx& F) {
    LAS float* scr = (LAS float*)(F.lds + F.wid * 16384);
    const int gw = F.vcu * 8 + F.wid, NGW = F.G * 8;
    unsigned char* ws = P.ws;
    bf16_t* BT_RW = (bf16_t*)(ws + WS_BT_RW); bf16_t* BT_GL = (bf16_t*)(ws + WS_BT_GL); bf16_t* BT_OUT = (bf16_t*)(ws + WS_BT_OUT);
    bf16_t* LORA = (bf16_t*)(ws + WS_LORA);
    constexpr int I_IN = 16 * 109, I_OUT = 16 * 32, I_L = 16, I_G = 32;
    constexpr int NITEMS = I_IN + I_OUT + 4 * I_L + I_G;
    for (int it = gw; it < NITEMS; it += NGW) {
        int r = it;
        if (r < I_IN) { const int kb = r / 109, nb = r % 109, n0 = 32 * nb;
            if (n0 < RW_COLS) transpose_block(P.w_in, 3488, BT_RW, 1024, n0, 64 * kb, n0, scr, F.lane);
            else transpose_block(P.w_in, 3488, BT_GL, 1024, n0 - RW_COLS, 64 * kb, n0, scr, F.lane);
            continue; }
        r -= I_IN;
        if (r < I_OUT) { const int kb = r / 32, nb = r % 32; transpose_block(P.w_out, 1024, BT_OUT, 1024, 32 * nb, 64 * kb, 32 * nb, scr, F.lane); continue; }
        r -= I_OUT;
        if (r < 4 * I_L) { const int which = r / I_L, nb = r % I_L;
            const float* src = which == 0 ? P.w2_f : which == 1 ? P.w2_b : which == 2 ? P.a2_f : P.a2_b;
            transpose_block(src, 512, LORA + (size_t)which * 32768, 64, 32 * nb, 0, 32 * nb, scr, F.lane); continue; }
        r -= 4 * I_L;
        { const int kb = r / 16, nb = r % 16; transpose_block(P.g2, 512, LORA + 4 * 32768, 128, 32 * nb, 64 * kb, 32 * nb, scr, F.lane); }
    }
    { const int gt = F.vcu * 512 + F.tid, NGT = F.G * 512; const u32x4 z = {0u, 0u, 0u, 0u};
      u32x4* p1 = (u32x4*)(BT_RW + (size_t)RW_COLS * 1024); for (int i = gt; i < (2048 - RW_COLS) * 128; i += NGT) p1[i] = z;
      u32x4* p2 = (u32x4*)(BT_GL + (size_t)GL_COLS * 1024); for (int i = gt; i < (1792 - GL_COLS) * 128; i += NGT) p2[i] = z; }
    { const int gt = F.vcu * 512 + F.tid, NGT = F.G * 512; bf16_t* WrT = (bf16_t*)(ws + WS_LORA + 512 * 1024);
      for (int i = gt; i < 48 * 1024; i += NGT) { const int n = i >> 10, k = i & 1023;
          const float v = n < 4 ? P.w_coarse[k * 4 + n] : n < 36 ? P.w_fine[k * 32 + n - 4] : 0.f; WrT[i] = (bf16_t)f2bf(v); } }
    bf16_t* H = (bf16_t*)(ws + WS_H);
    for (int m = gw; m < NTOK; m += 2 * NGW) {
        const int m2 = m + NGW; const bool has2 = m2 < NTOK;
        const f32x4* xa = (const f32x4*)(P.x + (size_t)m * 1024) + F.lane; const f32x4* xb = (const f32x4*)(P.x + (size_t)(has2 ? m2 : m) * 1024) + F.lane;
        const f32x4* wr = (const f32x4*)P.ln1_w + F.lane;
        f32x4 va[4], vb[4]; float ss[2] = {0.f, 0.f};
#pragma unroll
        for (int j = 0; j < 4; ++j) { va[j] = xa[64 * j]; vb[j] = xb[64 * j]; }
#pragma unroll
        for (int j = 0; j < 4; ++j) { ss[0] += (va[j].x * va[j].x + va[j].y * va[j].y) + (va[j].z * va[j].z + va[j].w * va[j].w); ss[1] += (vb[j].x * vb[j].x + vb[j].y * vb[j].y) + (vb[j].z * vb[j].z + vb[j].w * vb[j].w); }
        wave_sum_n<2>(ss);
        const float ia = rsqrtf(ss[0] * (1.f / 1024.f) + 1e-6f), ib = rsqrtf(ss[1] * (1.f / 1024.f) + 1e-6f);
        u32x2* oa = (u32x2*)(H + (size_t)m * 1024) + F.lane; u32x2* ob = (u32x2*)(H + (size_t)m2 * 1024) + F.lane;
#pragma unroll
        for (int j = 0; j < 4; ++j) { const f32x4 g = wr[64 * j];
            u32x2 o; o.x = pk2(va[j].x * ia * g.x, va[j].y * ia * g.y); o.y = pk2(va[j].z * ia * g.z, va[j].w * ia * g.w); oa[64 * j] = o;
            if (has2) { u32x2 q; q.x = pk2(vb[j].x * ib * g.x, vb[j].y * ib * g.y); q.y = pk2(vb[j].z * ib * g.z, vb[j].w * ib * g.w); ob[64 * j] = q; } }
    }
}

__device__ __forceinline__ bf16x8 pack_step(const f32x16& x, int s) {
    u32x4 p; p.x = pk2(x[8 * s + 0], x[8 * s + 1]); p.y = pk2(x[8 * s + 2], x[8 * s + 3]); p.z = pk2(x[8 * s + 4], x[8 * s + 5]); p.w = pk2(x[8 * s + 6], x[8 * s + 7]);
    return __builtin_bit_cast(bf16x8, p);
}
#define MFMA32(a, b, c) __builtin_amdgcn_mfma_f32_32x32x16_bf16((a), (b), (c), 0, 0, 0)

constexpr size_t OUT_GQ = 0, OUT_GNT = 16 * MiB;
constexpr int RS = 144;
constexpr int RMS_ = 64 * RS;
constexpr int L_AT = 0, L_BT = RMS_, L_KT = 2 * RMS_, L_RT = 3 * RMS_, L_ATT = 4 * RMS_, L_BHT = 5 * RMS_, L_KHT = 6 * RMS_, L_VT = 7 * RMS_;
constexpr int L_U1 = 8 * RMS_;
constexpr int L_TW = L_U1, L_AL = L_U1 + RMS_, L_SG = L_U1 + 2 * RMS_, L_LW = L_SG + 64 * 272, L_AA = L_LW + 16384;
constexpr int L_T1 = L_LW, L_LAK = L_T1 + RMS_, L_RB = L_T1 + 2 * RMS_, L_RK = L_T1 + 3 * RMS_, L_EX = L_T1 + 4 * RMS_, L_WC = L_U1 + 9 * RMS_;
static_assert(L_EX + 4096 + 64 <= L_WC, "rwkv back-end LDS map");
constexpr int L_XT = 0, L_G1T = 2 * RMS_;
static_assert(L_AA + 16384 <= L_WC && L_WC + 256 <= LDS_MISC, "rwkv LDS map");
constexpr int L_PF = L_WC + 512;
constexpr int L_HS = L_WC + 1024;
static_assert(L_HS + 2048 <= LDS_MISC, "half-block sums");
static_assert(L_PF + 256 <= LDS_MISC, "prefetch sink");

struct RwRaw { u32x4 xc[4]; unsigned rr[10], rk[10], rv[10]; };
template <int DIR>
__device__ __forceinline__ void rwkv_load_lora(const Params& P, const Ctx& F, const int item, RwRaw& R) {
    constexpr int dir = DIR; const int c = (item >> 4) & 63, b = item >> 10;
    const int t0 = c * 64, tb = b * SEQ;
    const bf16_t* PA = (const bf16_t*)P.out;
#pragma unroll
    for (int it = 0; it < 4; ++it) {
        const int q = F.tid + 512 * it, j = q >> 5, ch = q & 31;
        const int col0 = ch < 8 ? 1536 + 64 * dir + 8 * ch : ch < 16 ? 1664 + 64 * dir + 8 * (ch - 8) : 1792 + 8 * (ch - 16);
        const int tn = dir ? t0 + 63 - j : t0 + j;
        R.xc[it] = *(const u32x4*)(PA + (size_t)(tb + tn) * LDA_RW + col0);
    }
}
template <int DIR>
__device__ __forceinline__ void rwkv_load_rkv(const Params& P, const Ctx& F, const int item, RwRaw& R) {
    constexpr int dir = DIR; const int h = (item >> 1) & 7, c = (item >> 4) & 63, b = item >> 10;
    const int t0 = c * 64, tb = b * SEQ;
    const bf16_t* PA = (const bf16_t*)P.out;
    const int jlo = 8 * F.wid, tlo = dir ? (t0 + 55 - jlo) : (t0 + jlo - 1), hi = h * 64 + F.lane;
#pragma unroll
    for (int q = 0; q < 10; ++q) { int tn = tlo + q; tn = tn < 0 ? 0 : (tn > SEQ - 1 ? SEQ - 1 : tn);
        const bf16_t* row = PA + (size_t)(tb + tn) * LDA_RW + hi;
        R.rr[q] = row[0]; R.rk[q] = row[512]; R.rv[q] = row[1024]; }
}
template <int DIR>
__device__ __forceinline__ void rwkv_prefetch(const Params& P, const Ctx& F, const int nitem, unsigned& sink) {
    const int h = (nitem >> 1) & 7, c = (nitem >> 4) & 63, b = nitem >> 10;
    const int t0 = c * 64, tb = b * SEQ, tid = F.tid;
    const bf16_t* PA = (const bf16_t*)P.out;
    if (tid < 198) {
        const int q = tid / 3, a = tid - 3 * q; int tn = t0 - 1 + q; tn = tn < 0 ? 0 : (tn > SEQ - 1 ? SEQ - 1 : tn);
        const bf16_t* p = PA + (size_t)(tb + tn) * LDA_RW + a * 512 + h * 64;
        { unsigned m0s; asm volatile("s_mov_b32 %0, m0\n\ts_mov_b32 m0, %2\n\ts_nop 0\n\tglobal_load_lds_dword %1, off\n\ts_mov_b32 m0, %0" : "=&s"(m0s) : "v"(p), "s"(L_PF) : "memory"); }
    }
    if (h == 0 && tid < 264) {
        const int q = tid >> 2, a = tid & 3; int tn = t0 - 1 + q; tn = tn < 0 ? 0 : (tn > SEQ - 1 ? SEQ - 1 : tn);
        const int col = a == 0 ? 1536 + 64 * DIR : a == 1 ? 1664 + 64 * DIR : 1792 + 64 * (a - 2);
        const bf16_t* p = PA + (size_t)(tb + tn) * LDA_RW + col;
        { unsigned m0s; asm volatile("s_mov_b32 %0, m0\n\ts_mov_b32 m0, %2\n\ts_nop 0\n\tglobal_load_lds_dword %1, off\n\ts_mov_b32 m0, %0" : "=&s"(m0s) : "v"(p), "s"(L_PF) : "memory"); }
    }
}
template <int DIR>
__device__ __forceinline__ void rwkv_item(const Params& P, const Ctx& F, const int item, RwRaw& R, const bool lora, const int nitem, const bool has_next, unsigned& sink) {
    const int tid = F.tid, lane = F.lane, wid = F.wid; ldsp_t lds = F.lds;
    constexpr int dir = DIR; const int h = (item >> 1) & 7, c = (item >> 4) & 63, b = item >> 10;
    const int t0 = c * 64, tb = b * SEQ;
    unsigned char* ws = P.ws;
    const int hi = h * 64 + lane;

    if (lora) rwkv_load_lora<DIR>(P, F, item, R);
    rwkv_load_rkv<DIR>(P, F, item, R);
    PROBE_BEGIN(1)
    const int rb = wid >> 1, cb0 = 2 * (wid & 1);
    const float kkw = P.k_k[hi], kaw = P.k_a[hi], rkw = P.r_k[hi];
    const float mur = P.rw_mu[hi], muk = P.rw_mu[512 + hi], muv = P.rw_mu[1024 + hi];
    float rr[8], kr[8], vr[8];
    {
        const int jlo = 8 * wid;
        const int tlo = dir ? (t0 + 55 - jlo) : (t0 + jlo - 1);
        float raw_r[10], raw_k[10], raw_v[10];
#pragma unroll
        for (int q = 0; q < 10; ++q) { const int tn = tlo + q; const bool ok = (tn >= 0) && (tn < SEQ);
            raw_r[q] = ok ? bf2f(R.rr[q]) : 0.f; raw_k[q] = ok ? bf2f(R.rk[q]) : 0.f; raw_v[q] = ok ? bf2f(R.rv[q]) : 0.f; }
#pragma unroll
        for (int jj = 0; jj < 8; ++jj) {
            const float cr = dir ? raw_r[8 - jj] : raw_r[1 + jj], pr = dir ? raw_r[7 - jj] : raw_r[jj], nr = dir ? raw_r[9 - jj] : raw_r[2 + jj];
            const float ck = dir ? raw_k[8 - jj] : raw_k[1 + jj], pk = dir ? raw_k[7 - jj] : raw_k[jj], nk = dir ? raw_k[9 - jj] : raw_k[2 + jj];
            const float cv = dir ? raw_v[8 - jj] : raw_v[1 + jj], pv = dir ? raw_v[7 - jj] : raw_v[jj], nv = dir ? raw_v[9 - jj] : raw_v[2 + jj];
            rr[jj] = cr + mur * (0.5f * (pr + nr) - cr); kr[jj] = ck + muk * (0.5f * (pk + nk) - ck); vr[jj] = cv + muv * (0.5f * (pv + nv) - cv);
        }
    }
    if (lora) {
    u32x4 xpv[4], xnv[4];
    {
        const bf16_t* PA = (const bf16_t*)P.out; const int ch = tid & 31;
        const int col0 = ch < 8 ? 1536 + 64 * dir + 8 * ch : ch < 16 ? 1664 + 64 * dir + 8 * (ch - 8) : 1792 + 8 * (ch - 16);
#pragma unroll
        for (int it = 0; it < 4; ++it) { const int j = (tid >> 5) + 16 * it, tn = dir ? t0 + 63 - j : t0 + j;
            const bf16_t* row = PA + (size_t)(tb + tn) * LDA_RW + col0;
            const bf16_t* rp = tn > 0 ? row - LDA_RW : row; const bf16_t* rn = tn < SEQ - 1 ? row + LDA_RW : row;
            xpv[it] = *(const u32x4*)rp; xnv[it] = *(const u32x4*)rn; }
    }
    {
        const int ch = tid & 31;
        const int col0 = ch < 8 ? 1536 + 64 * dir + 8 * ch : ch < 16 ? 1664 + 64 * dir + 8 * (ch - 8) : 1792 + 8 * (ch - 16);
        const float cs = ch < 8 ? 2.f : 1.f, ca = ch < 8 ? 2.f : ch < 16 ? 0.f : 1.f, cbb = ch < 8 ? -1.f : 0.f, ci = (ch >= 8 && ch < 16) ? 1.f : 0.f;
        const f32x4 m0 = *(const f32x4*)(P.rw_mu + col0), m1 = *(const f32x4*)(P.rw_mu + col0 + 4);
        const float mu[8] = {m0.x, m0.y, m0.z, m0.w, m1.x, m1.y, m1.z, m1.w};
#pragma unroll
        for (int it = 0; it < 4; ++it) {
            const int j = (tid >> 5) + 16 * it;
            {
                LAS unsigned char* dst = ch < 8 ? lds + L_TW + j * RS + ch * 16 : ch < 16 ? lds + L_AL + j * RS + (ch - 8) * 16 : lds + L_SG + j * 272 + (ch - 16) * 16;
                const int tn = dir ? t0 + 63 - j : t0 + j;
                const float mp = tn > 0 ? 0.5f : 0.f, mn = tn < SEQ - 1 ? 0.5f : 0.f;
                float fc[8], fp[8], fn[8], o[8]; unpack8(R.xc[it], fc); unpack8(xpv[it], fp); unpack8(xnv[it], fn);
#pragma unroll
                for (int e = 0; e < 8; ++e) { const float v = fc[e] + mu[e] * ((mp * fp[e] + mn * fn[e]) - fc[e]); o[e] = ca * sigmoidf_(cs * v) + cbb + ci * v; }
                *(LAS u32x4*)dst = pack8(o);
            }
            __builtin_amdgcn_sched_barrier(0);
        }
    }
    }
    bf16x8 bw[2][2], ba[2][2]; float w0v[2], a0v[2];
    {
        const bf16_t* LORA = (const bf16_t*)(ws + WS_LORA);
        const bf16_t* W2t = LORA + (size_t)dir * 32768; const bf16_t* A2t = LORA + (size_t)(2 + dir) * 32768;
        const float* w0 = dir ? P.w0_b : P.w0_f; const float* a0 = dir ? P.a0_b : P.a0_f;
#pragma unroll
        for (int t = 0; t < 2; ++t) { const int hn = h * 64 + 16 * (cb0 + t) + (lane & 15);
            w0v[t] = w0[hn]; a0v[t] = a0[hn];
#pragma unroll
            for (int kk = 0; kk < 2; ++kk) { bw[t][kk] = *(const bf16x8*)(W2t + (size_t)hn * 64 + 8 * (lane >> 4) + 32 * kk); ba[t][kk] = *(const bf16x8*)(A2t + (size_t)hn * 64 + 8 * (lane >> 4) + 32 * kk); }
        }
    }
    bf16x8 bg[2][4];
    const bool mine = ((h >> 2) == dir);
    if (mine) { const bf16_t* G2t = (const bf16_t*)(ws + WS_LORA) + (size_t)4 * 32768;
#pragma unroll
        for (int t = 0; t < 2; ++t) { const int hn = h * 64 + 16 * (cb0 + t) + (lane & 15);
#pragma unroll
            for (int kk = 0; kk < 4; ++kk) bg[t][kk] = *(const bf16x8*)(G2t + (size_t)hn * 128 + 8 * (lane >> 4) + 32 * kk); } }
    PROBE_END(1)
    if (lora) __syncthreads();
    PROBE_BEGIN(2)
    {
        bf16_t* Gout = (bf16_t*)(ws + WS_G);
#pragma unroll
        for (int t = 0; t < 2; ++t) {
            const int cb = cb0 + t, n = 16 * cb + (lane & 15), hn = h * 64 + n;
            f32x4 zw = {0.f, 0.f, 0.f, 0.f}, za = {0.f, 0.f, 0.f, 0.f};
            const LAS unsigned char* ap_w = lds + L_TW + (16 * rb + (lane & 15)) * RS + (lane >> 4) * 16;
            const LAS unsigned char* ap_a = lds + L_AL + (16 * rb + (lane & 15)) * RS + (lane >> 4) * 16;
#pragma unroll
            for (int kk = 0; kk < 2; ++kk) {
                zw = __builtin_amdgcn_mfma_f32_16x16x32_bf16(*(const LAS bf16x8*)(ap_w + kk * 64), bw[t][kk], zw, 0, 0, 0);
                za = __builtin_amdgcn_mfma_f32_16x16x32_bf16(*(const LAS bf16x8*)(ap_a + kk * 64), ba[t][kk], za, 0, 0, 0);
            }
            float hs = 0.f;
#pragma unroll
            for (int r = 0; r < 4; ++r) { const int j = 16 * rb + 4 * (lane >> 4) + r;
                const float lwv = -0.60653066f * sigmoidf_(w0v[t] + zw[r]); hs += lwv;
                *(LAS float*)(lds + L_LW + (j * 64 + n) * 4) = lwv;
                *(LAS float*)(lds + L_AA + (j * 64 + n) * 4) = sigmoidf_(a0v[t] + za[r]); }
            hs += __shfl_xor(hs, 16);
            if (((lane >> 4) & 1) == 0) *(LAS float*)(lds + L_HS + ((2 * rb + (lane >> 5)) * 64 + n) * 4) = hs;
            if (mine) {
                f32x4 zg = {0.f, 0.f, 0.f, 0.f};
                const LAS unsigned char* ap_g = lds + L_SG + (16 * rb + (lane & 15)) * 272 + (lane >> 4) * 16;
#pragma unroll
                for (int kk = 0; kk < 4; ++kk) zg = __builtin_amdgcn_mfma_f32_16x16x32_bf16(*(const LAS bf16x8*)(ap_g + kk * 64), bg[t][kk], zg, 0, 0, 0);
#pragma unroll
                for (int r = 0; r < 4; ++r) { const int j = 16 * rb + 4 * (lane >> 4) + r; Gout[(size_t)(tb + (dir ? t0 + 63 - j : t0 + j)) * 512 + hn] = (bf16_t)f2bf(zg[r]); }
            }
        }
    }
    PROBE_END(2)
    __syncthreads();
    PROBE_BEGIN(3)
    if (tid == 0) *(volatile LAS unsigned*)(lds + L_EX + 4096) = 0u;
    {
        float total = 0.f, pre = 0.f;
        { float h8[8];
#pragma unroll
          for (int q = 0; q < 8; ++q) h8[q] = *(const LAS float*)(lds + L_HS + (q * 64 + lane) * 4);
#pragma unroll
          for (int q = 0; q < 8; ++q) { if (q < wid) pre += h8[q]; else total += h8[q]; } }
        total += pre;
        __builtin_amdgcn_sched_barrier(0);
        float* BON = (float*)(ws + WS_BON); bf16_t* VS = (bf16_t*)(ws + WS_VS);
        float at_[8], bh_[8], kh_[8];
        float red[16], kd_[8], av_[8], lwv_[8];
#pragma unroll
        for (int jj = 0; jj < 8; ++jj) {
            const int j = 8 * wid + jj;
            lwv_[jj] = *(const LAS float*)(lds + L_LW + (j * 64 + lane) * 4); av_[jj] = *(const LAS float*)(lds + L_AA + (j * 64 + lane) * 4);
            const float kraw = kr[jj] * kkw;
            kd_[jj] = kr[jj] * (1.f + (av_[jj] - 1.f) * kaw);
            red[jj] = kraw * kraw; red[8 + jj] = rr[jj] * kd_[jj] * rkw;
        }
        wave_sum_n<16>(red);
#pragma unroll
        for (int jj = 0; jj < 8; ++jj) {
            const int j = 8 * wid + jj, tok = tb + (dir ? t0 + 63 - j : t0 + j);
            const float lwj = lwv_[jj], a = av_[jj];
            const float lw_prev = pre; pre += lwj; const float lw = pre;
            const float kkv = (kr[jj] * kkw) * __builtin_amdgcn_rsqf(fmaxf(red[jj], 1e-24f));
            const float kd = kd_[jj], bb = kkv * a;
            if (lane == 0) BON[((size_t)dir * NTOK + tok) * 8 + h] = red[8 + jj];
            if (mine) VS[(size_t)tok * 512 + hi] = (bf16_t)f2bf(vr[jj]);
            const float eprev = __expf(lw_prev), einv = __expf(-lw), ee = __expf(lw), eh = __expf(total - lw);
            at_[jj] = -kkv * eprev; bh_[jj] = bb * eh; kh_[jj] = kd * eh;
            *(LAS bf16_t*)(lds + L_AT + j * RS + lane * 2) = (bf16_t)f2bf(at_[jj]);
            *(LAS bf16_t*)(lds + L_BT + j * RS + lane * 2) = (bf16_t)f2bf(bb * einv);
            *(LAS bf16_t*)(lds + L_KT + j * RS + lane * 2) = (bf16_t)f2bf(kd * einv);
            *(LAS bf16_t*)(lds + L_RT + j * RS + lane * 2) = (bf16_t)f2bf(rr[jj] * ee);
        }
        *(LAS u32x4*)(lds + L_ATT + lane * RS + wid * 16) = pack8(at_);
        *(LAS u32x4*)(lds + L_BHT + lane * RS + wid * 16) = pack8(bh_);
        *(LAS u32x4*)(lds + L_KHT + lane * RS + wid * 16) = pack8(kh_);
        *(LAS u32x4*)(lds + L_VT + lane * RS + wid * 16) = pack8(vr);
        if (wid == 0) *(LAS float*)(lds + L_WC + lane * 4) = __expf(total);
    }
    PROBE_END(3)
    __syncthreads();
    if (has_next) rwkv_prefetch<DIR>(P, F, nitem, sink);
    PROBE_BEGIN(4)
    int lane_o = F.lane; asm volatile("" : "+v"(lane_o));
    const int q4 = 4 * (lane_o >> 4);
    const f32x4 zero4 = {0.f, 0.f, 0.f, 0.f};
    if (wid < 2) {
        const int r = lane_o & 31, hh = lane_o >> 5, blk = wid;
        f32x16 Lp, Lpt, Tm, Tt;
        {
            f32x16 z; for (int i = 0; i < 16; ++i) z[i] = 0.f;
            Lp = z; Lpt = z;
            const LAS unsigned char* pa = lds + L_AT + (32 * blk + r) * RS + 16 * hh; const LAS unsigned char* pb = lds + L_BT + (32 * blk + r) * RS + 16 * hh;
#pragma unroll
            for (int ks = 0; ks < 4; ++ks) { const bf16x8 fa = *(const LAS bf16x8*)(pa + 32 * ks), fb = *(const LAS bf16x8*)(pb + 32 * ks);
                Lp = MFMA32(fa, fb, Lp); Lpt = MFMA32(fb, fa, Lpt); }
#pragma unroll
            for (int i = 0; i < 16; ++i) { const int row = (i & 3) + 8 * (i >> 2) + 4 * hh;
                Lp[i] = (row > r) ? Lp[i] : 0.f; Lpt[i] = (r > row) ? Lpt[i] : 0.f;
                Tm[i] = Lp[i] + ((row == r) ? 1.f : 0.f); Tt[i] = Lpt[i] + ((row == r) ? 1.f : 0.f); }
        }
#pragma unroll
        for (int itn = 1; itn <= 5; ++itn) {
            const bf16x8 pL0 = pack_step(Lp, 0), pL1 = pack_step(Lp, 1), pLt0 = pack_step(Lpt, 0), pLt1 = pack_step(Lpt, 1);
            if (itn >= 2) { const bf16x8 pTt0 = pack_step(Tt, 0), pTt1 = pack_step(Tt, 1);
                Tm = MFMA32(pTt0, pL0, Tm); Tm = MFMA32(pTt1, pL1, Tm);
                Tt = MFMA32(pL0, pTt0, Tt); Tt = MFMA32(pL1, pTt1, Tt); }
            if (itn <= 4) { f32x16 z; for (int i = 0; i < 16; ++i) z[i] = 0.f;
                f32x16 n1 = MFMA32(pLt0, pL0, z); n1 = MFMA32(pLt1, pL1, n1);
                f32x16 n2 = MFMA32(pL0, pLt0, z); n2 = MFMA32(pL1, pLt1, n2);
                Lp = n1; Lpt = n2; }
        }
        volatile LAS unsigned* xflag = (volatile LAS unsigned*)(lds + L_EX + 4096);
        if (wid == 0) {
            LAS unsigned char* ex = lds + L_EX + lane * 64;
#pragma unroll
            for (int g = 0; g < 4; ++g) *(LAS f32x4*)(ex + 16 * g) = (f32x4){Tm[4 * g], Tm[4 * g + 1], Tm[4 * g + 2], Tm[4 * g + 3]};
            asm volatile("s_waitcnt lgkmcnt(0)" ::: "memory");
            *xflag = 1u;
#pragma unroll
            for (int g = 0; g < 4; ++g) st4bf(lds + L_T1 + r * RS + (8 * g + 4 * hh) * 2, (f32x4){Tt[4 * g], Tt[4 * g + 1], Tt[4 * g + 2], Tt[4 * g + 3]});
            const u32x4 z4 = {0u, 0u, 0u, 0u};
            *(LAS u32x4*)(lds + L_T1 + r * RS + (32 + 16 * hh) * 2) = z4; *(LAS u32x4*)(lds + L_T1 + r * RS + (32 + 16 * hh) * 2 + 16) = z4;
        } else {
            f32x16 L21; for (int i = 0; i < 16; ++i) L21[i] = 0.f;
            { const LAS unsigned char* pa = lds + L_AT + (32 + r) * RS + 16 * hh; const LAS unsigned char* pb = lds + L_BT + r * RS + 16 * hh;
#pragma unroll
              for (int ks = 0; ks < 4; ++ks) L21 = MFMA32(*(const LAS bf16x8*)(pa + 32 * ks), *(const LAS bf16x8*)(pb + 32 * ks), L21); }
            f32x16 U; for (int i = 0; i < 16; ++i) U[i] = 0.f;
            { const bf16x8 a0 = pack_step(L21, 0), a1 = pack_step(L21, 1), b0 = pack_step(Tt, 0), b1 = pack_step(Tt, 1);
              U = MFMA32(a0, b0, U); U = MFMA32(a1, b1, U); }
            asm volatile("" ::: "memory");
            while (*xflag == 0u) __builtin_amdgcn_s_sleep(1);
            asm volatile("" ::: "memory");
            f32x16 T11;
            { const LAS unsigned char* ex = lds + L_EX + lane * 64;
#pragma unroll
              for (int g = 0; g < 4; ++g) { const f32x4 v = *(const LAS f32x4*)(ex + 16 * g); T11[4 * g] = v[0]; T11[4 * g + 1] = v[1]; T11[4 * g + 2] = v[2]; T11[4 * g + 3] = v[3]; } }
            f32x16 T21t; for (int i = 0; i < 16; ++i) T21t[i] = 0.f;
            { const bf16x8 a0 = pack_step(T11, 0), a1 = pack_step(T11, 1), b0 = pack_step(U, 0), b1 = pack_step(U, 1);
              T21t = MFMA32(a0, b0, T21t); T21t = MFMA32(a1, b1, T21t); }
#pragma unroll
            for (int g = 0; g < 4; ++g) {
                st4bf(lds + L_T1 + (32 + r) * RS + (8 * g + 4 * hh) * 2, (f32x4){T21t[4 * g], T21t[4 * g + 1], T21t[4 * g + 2], T21t[4 * g + 3]});
                st4bf(lds + L_T1 + (32 + r) * RS + (32 + 8 * g + 4 * hh) * 2, (f32x4){Tt[4 * g], Tt[4 * g + 1], Tt[4 * g + 2], Tt[4 * g + 3]}); }
        }
    } else {
        const int w6 = wid - 2, prod = w6 >> 1, half = w6 & 1;
        const int offA = prod == 0 ? L_AT : L_RT, offB = prod == 1 ? L_BT : L_KT, offO = prod == 0 ? L_LAK : prod == 1 ? L_RB : L_RK;
#pragma unroll
        for (int rr2 = 0; rr2 < 2; ++rr2) { const int rbx = 2 * half + rr2, jrx = 16 * rbx + (lane_o & 15);
#pragma unroll
            for (int cb = 0; cb < 4; ++cb) {
                f32x4 v = zero4;
                if (cb <= rbx) { v = tile_s<2>(lds + offA + 16 * rbx * RS, RS, lds + offB + 16 * cb * RS, RS, zero4, lane);
#pragma unroll
                    for (int q = 0; q < 4; ++q) { const int s = 16 * cb + q4 + q; const bool keep = (prod == 0) ? (jrx > s) : (jrx >= s); v[q] = keep ? v[q] : 0.f; } }
                st4bf(lds + offO + jrx * RS + (16 * cb + q4) * 2, v);
            } }
    }
    __syncthreads();
    PROBE_END(4)
    PROBE_BEGIN(5)
    {
        bf16_t* RM = (bf16_t*)(ws + WS_RM) + (size_t)item * 4096; bf16_t* RP = (bf16_t*)(ws + WS_RP) + (size_t)item * 4096; bf16_t* RNT = (bf16_t*)(ws + WS_RNT) + (size_t)item * 4096;
        bf16_t* Y = (bf16_t*)(ws + (dir ? WS_YB : WS_YF));
        const int pg4 = 4 * ((lane_o >> 4) == 1 ? 2 : (lane_o >> 4) == 2 ? 1 : (lane_o >> 4));
        const int cbv = wid & 3;
        Frag2 fv;
        if (wid >= 4) {
            fv = ld_frag2(lds + L_VT + 16 * cbv * RS, RS, lane);
#pragma unroll
            for (int rbx = 0; rbx < 4; ++rbx) { const f32x4 g1 = tile_nb(lds + L_LAK + 16 * rbx * RS, RS, fv, zero4, lane);
                st4bf(lds + L_G1T + (16 * cbv + (lane & 15)) * RS + (16 * rbx + q4) * 2, g1); }
        }
        {
            const Frag2 fb = ld_frag2((wid < 4) ? (lds + L_ATT + 16 * cbv * RS) : (lds + L_G1T + 16 * cbv * RS), RS, lane);
#pragma unroll
            for (int rbx = 0; rbx < 4; ++rbx) { const f32x4 xv = tile_nb(lds + L_T1 + 16 * rbx * RS, RS, fb, zero4, lane);
                st4bf(lds + L_XT + (16 * wid + (lane & 15)) * RS + (16 * rbx + q4) * 2, xv); }
        }
        const Frag2 fx = ld_frag2(lds + L_XT + 16 * wid * RS, RS, lane);
        if (wid < 4) {
#pragma unroll
            for (int rbx = 0; rbx < 4; ++rbx) { const int jrx = 16 * rbx + (lane_o & 15);
                f32x4 mv = tile_sb(lds + L_BHT + 16 * rbx * RS, RS, fx, zero4, lane);
                { const float wc = *(const LAS float*)(lds + L_WC + jrx * 4);
#pragma unroll
                  for (int q = 0; q < 4; ++q) mv[q] += (jrx == 16 * cbv + q4 + q) ? wc : 0.f; }
                st4bf_g(RM + jrx * 64 + 16 * cbv + pg4, mv);
                f32x4 pv = tile_sb(lds + L_RB + 16 * rbx * RS, RS, fx, zero4, lane);
                { const u32x2 rv = *(const LAS u32x2*)(lds + L_RT + jrx * RS + (16 * cbv + q4) * 2);
                  pv[0] += bf2f(rv.x & 0xffffu); pv[1] += bf2f(rv.x >> 16); pv[2] += bf2f(rv.y & 0xffffu); pv[3] += bf2f(rv.y >> 16); }
                st4bf_g(RP + jrx * 64 + 16 * cbv + pg4, pv); }
        } else {
#pragma unroll
            for (int rbx = 0; rbx < 4; ++rbx) {
                f32x4 nv = tile_nb(lds + L_BHT + 16 * rbx * RS, RS, fx, zero4, lane);
                nv = tile_nb(lds + L_KHT + 16 * rbx * RS, RS, fv, nv, lane);
                st4bf_g(RNT + (16 * cbv + (lane & 15)) * 64 + 16 * rbx + q4, nv);
                f32x4 zv = tile_nb(lds + L_RB + 16 * rbx * RS, RS, fx, zero4, lane);
                zv = tile_nb(lds + L_RK + 16 * rbx * RS, RS, fv, zv, lane);
                { const int j0 = 16 * rbx + q4, tokb = tb + (dir ? t0 + 60 - j0 : t0 + j0);
                  const f32x4 zs = dir ? (f32x4){zv[3], zv[2], zv[1], zv[0]} : zv;
                  st4bf_g(Y + ((size_t)(tokb >> 2) * 512 + h * 64 + 16 * cbv + (lane & 15)) * 4, zs); } }
        }
    }
    PROBE_END(5)
    __syncthreads();
}

constexpr int CH_NSLOT = 16, CH_NCONS = 7;
constexpr int CH_RING = 0, CH_FLAGS = CH_NSLOT * 4096;
__device__ __forceinline__ void ch_wait_ge(volatile LAS unsigned* w, unsigned v) { asm volatile("" ::: "memory"); while (*w < v) __builtin_amdgcn_s_sleep(1); asm volatile("" ::: "memory"); }
__device__ __forceinline__ void ch_publish(ldsp_t lds, int st, int lane, const bf16x8& b00, const bf16x8& b01, const bf16x8& b10, const bf16x8& b11) {
    volatile LAS unsigned* fl = (volatile LAS unsigned*)(lds + CH_FLAGS);
    if (st >= CH_NSLOT) { const int old = st - CH_NSLOT; ch_wait_ge(fl + 16 + (old % CH_NCONS) * 16, (unsigned)(old + 1)); }
    LAS unsigned char* slot = lds + CH_RING + (st % CH_NSLOT) * 4096 + lane * 16;
    *(LAS bf16x8*)(slot) = b00; *(LAS bf16x8*)(slot + 1024) = b01; *(LAS bf16x8*)(slot + 2048) = b10; *(LAS bf16x8*)(slot + 3072) = b11;
    asm volatile("s_waitcnt lgkmcnt(0)" ::: "memory");
    fl[0] = (unsigned)(st + 1);
}
__device__ __forceinline__ void ch_consume(ldsp_t lds, int st, int cons, int lane, bf16x8& b00, bf16x8& b01, bf16x8& b10, bf16x8& b11) {
    volatile LAS unsigned* fl = (volatile LAS unsigned*)(lds + CH_FLAGS);
    ch_wait_ge(fl, (unsigned)(st + 1));
    const LAS unsigned char* slot = lds + CH_RING + (st % CH_NSLOT) * 4096 + lane * 16;
    b00 = *(const LAS bf16x8*)(slot); b01 = *(const LAS bf16x8*)(slot + 1024); b10 = *(const LAS bf16x8*)(slot + 2048); b11 = *(const LAS bf16x8*)(slot + 3072);
    asm volatile("s_waitcnt lgkmcnt(0)" ::: "memory");
    fl[16 + cons * 16] = (unsigned)(st + 1);
}
__device__ __forceinline__ void rwkv_ld_mn(const unsigned char* ws, int item, int vh, int r, int hh, bf16x8 (&Mf)[8], u32x2 (&Nf)[8]) {
    const bf16_t* RM = (const bf16_t*)(ws + WS_RM) + (size_t)item * 4096; const bf16_t* RNT = (const bf16_t*)(ws + WS_RNT) + (size_t)item * 4096;
#pragma unroll
    for (int kb = 0; kb < 2; ++kb) {
        const bf16_t* ap = RM + (32 * kb + r) * 64 + 8 * hh;
#pragma unroll
        for (int q = 0; q < 4; ++q) Mf[4 * kb + q] = *(const bf16x8*)(ap + 16 * q);
#pragma unroll
        for (int g = 0; g < 4; ++g) Nf[4 * kb + g] = *(const u32x2*)(RNT + (32 * vh + r) * 64 + 32 * kb + 8 * g + 4 * hh);
    }
}
__device__ __forceinline__ void rwkv_prod_step(ldsp_t lds, const unsigned char* ws, int b, int h, int dir, int vh, int lane, int st,
                                               f32x16& X0, f32x16& X1, const bf16x8 (&Mc)[8], const u32x2 (&Nc)[8], bf16x8 (&Mn)[8], u32x2 (&Nn)[8]) {
    const int r = lane & 31, hh = lane >> 5;
    const int stn = st < 62 ? st + 2 : 63, cn = dir ? 63 - stn : stn, itemn = ((b * 64 + cn) * 8 + h) * 2 + dir;
    rwkv_ld_mn(ws, itemn, vh, r, hh, Mn, Nn);
    const bf16x8 b00 = pack_step(X0, 0), b01 = pack_step(X0, 1), b10 = pack_step(X1, 0), b11 = pack_step(X1, 1);
    ch_publish(lds, st, lane, b00, b01, b10, b11);
    f32x16 Hn[2];
#pragma unroll
    for (int kb = 0; kb < 2; ++kb) {
#pragma unroll
        for (int g = 0; g < 4; ++g) { const u32x2 nv = Nc[4 * kb + g];
            Hn[kb][4 * g + 0] = bf2f(nv.x & 0xffffu); Hn[kb][4 * g + 1] = bf2f(nv.x >> 16); Hn[kb][4 * g + 2] = bf2f(nv.y & 0xffffu); Hn[kb][4 * g + 3] = bf2f(nv.y >> 16); }
        Hn[kb] = MFMA32(Mc[4 * kb + 0], b00, Hn[kb]);
        Hn[kb] = MFMA32(Mc[4 * kb + 1], b01, Hn[kb]);
        Hn[kb] = MFMA32(Mc[4 * kb + 2], b10, Hn[kb]);
        Hn[kb] = MFMA32(Mc[4 * kb + 3], b11, Hn[kb]);
    }
    X0 = Hn[0]; X1 = Hn[1];
}
__device__ __forceinline__ void rwkv_producer(const Params& P, ldsp_t lds, const int chain, const int lane) {
    const int vh = chain & 1, dir = (chain >> 1) & 1, h = (chain >> 2) & 7, b = chain >> 5;
    const unsigned char* ws = P.ws;
    f32x16 X0, X1;
#pragma unroll
    for (int i = 0; i < 16; ++i) { X0[i] = 0.f; X1[i] = 0.f; }
    bf16x8 MA[8], MB[8], MC[8]; u32x2 NA[8], NB[8], NC[8];
    { const int c0 = dir ? 63 : 0, c1 = dir ? 62 : 1;
      rwkv_ld_mn(ws, ((b * 64 + c0) * 8 + h) * 2 + dir, vh, lane & 31, lane >> 5, MA, NA);
      rwkv_ld_mn(ws, ((b * 64 + c1) * 8 + h) * 2 + dir, vh, lane & 31, lane >> 5, MB, NB); }
#pragma unroll 1
    for (int st = 0; st < 63; st += 3) {
        rwkv_prod_step(lds, ws, b, h, dir, vh, lane, st, X0, X1, MA, NA, MC, NC);
        rwkv_prod_step(lds, ws, b, h, dir, vh, lane, st + 1, X0, X1, MB, NB, MA, NA);
        rwkv_prod_step(lds, ws, b, h, dir, vh, lane, st + 2, X0, X1, MC, NC, MB, NB);
    }
    rwkv_prod_step(lds, ws, b, h, dir, vh, lane, 63, X0, X1, MA, NA, MC, NC);
}
struct ChOps { bf16x8 A[8]; u32x2 Z[8]; };
template <bool GLA>
__device__ __forceinline__ void ch_ld_ops(const Params& P, int chain, int st, int lane, ChOps& o) {
    const int r = lane & 31, hh = lane >> 5;
    int b, dir, item, col; const bf16_t* A; const bf16_t* Yb;
    if (GLA) { const int qt = chain & 3, hd = (chain >> 3) & 3; dir = (chain >> 2) & 1; b = chain >> 5; const int c = dir ? 63 - st : st;
        item = ((b * 64 + c) * 4 + hd) * 2 + dir; col = hd * 128 + 32 * qt + r;
        A = (const bf16_t*)((const unsigned char*)P.out + OUT_GQ) + (size_t)item * 4096;
        Yb = (const bf16_t*)(P.ws + (dir ? WS_OB : WS_OF)) + ((size_t)((b * SEQ + c * 64) >> 2) * 512 + col) * 4;
    } else { const int vh = chain & 1, h = (chain >> 2) & 7; dir = (chain >> 1) & 1; b = chain >> 5; const int c = dir ? 63 - st : st;
        item = ((b * 64 + c) * 8 + h) * 2 + dir; col = h * 64 + 32 * vh + r;
        A = (const bf16_t*)(P.ws + WS_RP) + (size_t)item * 4096;
        Yb = (const bf16_t*)(P.ws + (dir ? WS_YB : WS_YF)) + ((size_t)((b * SEQ + c * 64) >> 2) * 512 + col) * 4; }
#pragma unroll
    for (int jb = 0; jb < 2; ++jb) {
        const bf16_t* ap = A + (32 * jb + r) * 64 + 8 * hh;
#pragma unroll
        for (int q = 0; q < 4; ++q) o.A[4 * jb + q] = *(const bf16x8*)(ap + 16 * q);
#pragma unroll
        for (int g = 0; g < 4; ++g) { const int j0 = 32 * jb + 8 * g + 4 * hh, tg = (dir ? 60 - j0 : j0) >> 2; o.Z[4 * jb + g] = *(const u32x2*)(Yb + (size_t)tg * 2048); }
    }
}
template <bool GLA>
__device__ __forceinline__ void ch_out_step(const Params& P, ldsp_t lds, int chain, int cons, int st, int lane, const ChOps& o) {
    const int r = lane & 31, hh = lane >> 5;
    int b, dir, col; bf16_t* Yb;
    if (GLA) { const int qt = chain & 3, hd = (chain >> 3) & 3; dir = (chain >> 2) & 1; b = chain >> 5; const int c = dir ? 63 - st : st; col = hd * 128 + 32 * qt + r;
        Yb = (bf16_t*)(P.ws + (dir ? WS_OB : WS_OF)) + ((size_t)((b * SEQ + c * 64) >> 2) * 512 + col) * 4;
    } else { const int vh = chain & 1, h = (chain >> 2) & 7; dir = (chain >> 1) & 1; b = chain >> 5; const int c = dir ? 63 - st : st; col = h * 64 + 32 * vh + r;
        Yb = (bf16_t*)(P.ws + (dir ? WS_YB : WS_YF)) + ((size_t)((b * SEQ + c * 64) >> 2) * 512 + col) * 4; }
    bf16x8 b00, b01, b10, b11;
    ch_consume(lds, st, cons, lane, b00, b01, b10, b11);
#pragma unroll
    for (int jb = 0; jb < 2; ++jb) {
        f32x16 Yv;
#pragma unroll
        for (int g = 0; g < 4; ++g) { const u32x2 z = o.Z[4 * jb + g];
            const float p0 = bf2f(z.x & 0xffffu), p1 = bf2f(z.x >> 16), p2 = bf2f(z.y & 0xffffu), p3 = bf2f(z.y >> 16);
            Yv[4 * g + 0] = dir ? p3 : p0; Yv[4 * g + 1] = dir ? p2 : p1; Yv[4 * g + 2] = dir ? p1 : p2; Yv[4 * g + 3] = dir ? p0 : p3; }
        Yv = MFMA32(o.A[4 * jb + 0], b00, Yv);
        Yv = MFMA32(o.A[4 * jb + 1], b01, Yv);
        Yv = MFMA32(o.A[4 * jb + 2], b10, Yv);
        Yv = MFMA32(o.A[4 * jb + 3], b11, Yv);
#pragma unroll
        for (int g = 0; g < 4; ++g) { const int j0 = 32 * jb + 8 * g + 4 * hh, tg = (dir ? 60 - j0 : j0) >> 2;
            u32x2 ov; ov.x = dir ? pk2(Yv[4 * g + 3], Yv[4 * g + 2]) : pk2(Yv[4 * g + 0], Yv[4 * g + 1]); ov.y = dir ? pk2(Yv[4 * g + 1], Yv[4 * g + 0]) : pk2(Yv[4 * g + 2], Yv[4 * g + 3]);
            *(u32x2*)(Yb + (size_t)tg * 2048) = ov; }
    }
}
template <bool GLA>
__device__ __forceinline__ void chain_consumer(const Params& P, ldsp_t lds, const int chain, const int cons, const int lane) {
    ChOps OA, OB, OC;
    int st = cons;
    if (st < 64) ch_ld_ops<GLA>(P, chain, st, lane, OA);
    if (st + CH_NCONS < 64) ch_ld_ops<GLA>(P, chain, st + CH_NCONS, lane, OB);
#pragma unroll 1
    while (st < 64) {
        const int s1 = st + CH_NCONS, s2 = st + 2 * CH_NCONS, s3 = st + 3 * CH_NCONS, s4 = st + 4 * CH_NCONS;
        if (s2 < 64) ch_ld_ops<GLA>(P, chain, s2, lane, OC);
        ch_out_step<GLA>(P, lds, chain, cons, st, lane, OA);
        if (s1 >= 64) break;
        if (s3 < 64) ch_ld_ops<GLA>(P, chain, s3, lane, OA);
        ch_out_step<GLA>(P, lds, chain, cons, s1, lane, OB);
        if (s2 >= 64) break;
        if (s4 < 64) ch_ld_ops<GLA>(P, chain, s4, lane, OB);
        ch_out_step<GLA>(P, lds, chain, cons, s2, lane, OC);
        st = s3;
    }
}

constexpr int G_QT = 0, G_KT = RMS_, G_KHT = 2 * RMS_, G_VT = 3 * RMS_, G_AM = 5 * RMS_, G_GK = 6 * RMS_, G_SLOT = 6 * RMS_ + 16384 + 2048;
static_assert(2 * G_SLOT <= LDS_MISC, "gla LDS map");
struct GlaSt { float qv[8], kv[8]; };
template <int DIR>
__device__ __forceinline__ void gla_s1(const Params& P, const Ctx& F, const int item, ldsp_t lds, GlaSt& S) {
    const int lane = F.lane, wid = F.wid; constexpr int dir = DIR;
    const int hd = (item >> 1) & 3, c = (item >> 3) & 63, b = item >> 9;
    const int t0 = c * 64, tb = b * SEQ;
    const bf16_t* PB = (const bf16_t*)(P.ws + WS_PB);
    const int hi = hd * 64 + lane;
    const float* gw2 = dir ? P.gw2_b : P.gw2_f; const float* gb = dir ? P.gb_b : P.gb_f;
    float w2[16];
#pragma unroll
    for (int m = 0; m < 16; ++m) w2[m] = gw2[m * 256 + hi];
    const float gbv = gb[hi];
    float v0[8], v1[8];
    u32x4 g0a[8], g1a[8]; unsigned rq[8], rk[8], r0[8], r1[8];
#pragma unroll
    for (int jj = 0; jj < 8; ++jj) {
        const int j = 8 * wid + jj, tok = tb + (dir ? t0 + 63 - j : t0 + j);
        const bf16_t* row = PB + (size_t)tok * LDB_GL;
        g0a[jj] = *(const u32x4*)(row + 1024 + 16 * dir); g1a[jj] = *(const u32x4*)(row + 1024 + 16 * dir + 8);
        rq[jj] = row[hi]; rk[jj] = row[256 + hi]; r0[jj] = row[512 + hd * 128 + lane]; r1[jj] = row[512 + hd * 128 + 64 + lane];
    }
    __builtin_amdgcn_sched_barrier(0);
#pragma unroll
    for (int jj = 0; jj < 8; ++jj) {
        const int j = 8 * wid + jj;
        float gl[16]; { float t8[8]; unpack8(g0a[jj], t8);
#pragma unroll
            for (int e = 0; e < 8; ++e) gl[e] = t8[e];
            unpack8(g1a[jj], t8);
#pragma unroll
            for (int e = 0; e < 8; ++e) gl[8 + e] = t8[e]; }
        float z = gbv;
#pragma unroll
        for (int m = 0; m < 16; ++m) z += gl[m] * w2[m];
        const float ls = fminf(z, 0.f) - __logf(1.f + __expf(-fabsf(z)));
        *(LAS float*)(lds + G_GK + (j * 64 + lane) * 4) = ls * (1.f / 16.f);
        S.qv[jj] = bf2f(rq[jj]) * 0.125f; S.kv[jj] = bf2f(rk[jj]);
        v0[jj] = bf2f(r0[jj]); v1[jj] = bf2f(r1[jj]);
    }
    *(LAS u32x4*)(lds + G_VT + lane * RS + wid * 16) = pack8(v0);
    *(LAS u32x4*)(lds + G_VT + (64 + lane) * RS + wid * 16) = pack8(v1);
}
__device__ __forceinline__ void gla_s2(const Params& P, const Ctx& F, const int item, ldsp_t lds, const GlaSt& S) {
    const int lane = F.lane, wid = F.wid;
    float total = 0.f, pre = 0.f;
#pragma unroll 1
    for (int s0 = 0; s0 < 8; s0 += 2) { float t8[16];
#pragma unroll
        for (int u = 0; u < 16; ++u) t8[u] = *(const LAS float*)(lds + G_GK + ((8 * s0 + u) * 64 + lane) * 4);
        const float sa = ((t8[0] + t8[1]) + (t8[2] + t8[3])) + ((t8[4] + t8[5]) + (t8[6] + t8[7]));
        const float sb = ((t8[8] + t8[9]) + (t8[10] + t8[11])) + ((t8[12] + t8[13]) + (t8[14] + t8[15]));
        if (s0 < wid) pre += sa; else total += sa;
        if (s0 + 1 < wid) pre += sb; else total += sb; }
    total += pre;
    bf16_t* GQ = (bf16_t*)((unsigned char*)P.out + OUT_GQ) + (size_t)item * 4096;
    const int blk = lane >> 4, g4 = (lane >> 2) & 3, pgp = (g4 == 1) ? 2 : (g4 == 2) ? 1 : g4;
    const int pcol = 16 * blk + 4 * pgp + (lane & 3);
    float kh_[8];
#pragma unroll
    for (int jj = 0; jj < 8; ++jj) {
        const int j = 8 * wid + jj;
        pre += *(const LAS float*)(lds + G_GK + (j * 64 + lane) * 4);
        const float e = __expf(pre), einv = __expf(-pre), eh = __expf(total - pre);
        const float qs = S.qv[jj] * e;
        *(LAS bf16_t*)(lds + G_QT + j * RS + lane * 2) = (bf16_t)f2bf(qs);
        *(LAS bf16_t*)(lds + G_KT + j * RS + lane * 2) = (bf16_t)f2bf(S.kv[jj] * einv);
        kh_[jj] = S.kv[jj] * eh;
        GQ[j * 64 + pcol] = (bf16_t)f2bf(qs);
    }
    *(LAS u32x4*)(lds + G_KHT + lane * RS + wid * 16) = pack8(kh_);
    if (wid == 0) ((float*)(P.ws + WS_DEC))[(size_t)item * 64 + lane] = __expf(total);
}
__device__ __forceinline__ void gla_s3(const Ctx& F, ldsp_t lds) {
    const int lane = F.lane, wid = F.wid;
    const int rb = wid >> 1, cb0 = 2 * (wid & 1), jr = 16 * rb + (lane & 15), q4 = 4 * (lane >> 4);
    const f32x4 zero4 = {0.f, 0.f, 0.f, 0.f};
#pragma unroll
    for (int t = 0; t < 2; ++t) { const int cb = cb0 + t;
        f32x4 av = tile_s<2>(lds + G_QT + 16 * rb * RS, RS, lds + G_KT + 16 * cb * RS, RS, zero4, lane);
#pragma unroll
        for (int r = 0; r < 4; ++r) av[r] = (jr >= 16 * cb + q4 + r) ? av[r] : 0.f;
        st4bf(lds + G_AM + jr * RS + (16 * cb + q4) * 2, av); }
}
template <int DIR>
__device__ __forceinline__ void gla_s4(const Params& P, const Ctx& F, const int item, ldsp_t lds) {
    const int lane = F.lane, wid = F.wid; constexpr int dir = DIR;
    const int hd = (item >> 1) & 3, c = (item >> 3) & 63, b = item >> 9, t0 = c * 64, tb = b * SEQ;
    const int rb = wid >> 1, q4 = 4 * (lane >> 4);
    const f32x4 zero4 = {0.f, 0.f, 0.f, 0.f};
    bf16_t* O = (bf16_t*)(P.ws + (dir ? WS_OB : WS_OF));
    bf16_t* GNT = (bf16_t*)((unsigned char*)P.out + OUT_GNT) + (size_t)item * 8192;
    const int cbz0 = 4 * (wid & 1);
    const int j0 = 16 * rb + q4, tokb = tb + (dir ? t0 + 60 - j0 : t0 + j0);
#pragma unroll
    for (int t = 0; t < 4; ++t) { const int cb = cbz0 + t;
        f32x4 zv = tile_n<2>(lds + G_AM + 16 * rb * RS, RS, lds + G_VT + 16 * cb * RS, RS, zero4, lane);
        const f32x4 zs = dir ? (f32x4){zv[3], zv[2], zv[1], zv[0]} : zv;
        st4bf_g(O + ((size_t)(tokb >> 2) * 512 + hd * 128 + 16 * cb + (lane & 15)) * 4, zs);
        f32x4 nv = tile_n<2>(lds + G_KHT + 16 * rb * RS, RS, lds + G_VT + 16 * cb * RS, RS, zero4, lane);
        st4bf_g(GNT + (16 * cb + (lane & 15)) * 64 + 16 * rb + q4, nv); }
}
__device__ __forceinline__ void gla_prefetch(const Params& P, const Ctx& F, const int item, const int dir) {
    const int hd = (item >> 1) & 3, c = (item >> 3) & 63, b = item >> 9, tid = F.tid;
    if (tid < 320) {
        const int j = tid / 5, a = tid - 5 * j;
        const int col = a == 0 ? 1024 + 16 * dir : a == 1 ? hd * 64 : a == 2 ? 256 + hd * 64 : 512 + hd * 128 + 64 * (a - 3);
        const bf16_t* p = (const bf16_t*)(P.ws + WS_PB) + (size_t)(b * SEQ + c * 64 + j) * LDB_GL + col;
        { unsigned m0s; asm volatile("s_mov_b32 %0, m0\n\ts_mov_b32 m0, %2\n\ts_nop 0\n\tglobal_load_lds_dword %1, off\n\ts_mov_b32 m0, %0" : "=&s"(m0s) : "v"(p), "s"(L_PF) : "memory"); }
    }
}
template <int DIR>
__device__ __forceinline__ void gla_pair(const Params& P, const Ctx& F, const int itA, const int itB, const bool hasB) {
    ldsp_t la = F.lds, lb = F.lds + G_SLOT;
    GlaSt SA, SB;
    gla_s1<DIR>(P, F, itA, la, SA); if (hasB) gla_s1<DIR>(P, F, itB, lb, SB);
    __syncthreads();
    gla_s2(P, F, itA, la, SA); if (hasB) gla_s2(P, F, itB, lb, SB);
    __syncthreads();
    { const int nA = itA + 2 * F.G, nB = itB + 2 * F.G; if (nA < 2048) gla_prefetch(P, F, nA, DIR); if (nB < 2048) gla_prefetch(P, F, nB, DIR); }
    gla_s3(F, la); if (hasB) gla_s3(F, lb);
    __syncthreads();
    gla_s4<DIR>(P, F, itA, la); if (hasB) gla_s4<DIR>(P, F, itB, lb);
    __syncthreads();
}

__device__ __forceinline__ void gla_ld_nd(const unsigned char* ob, const unsigned char* ws, int item, int qt, int r, int hh, u32x2 (&Nf)[8], f32x4 (&Df)[8]) {
    const bf16_t* GNT = (const bf16_t*)(ob + OUT_GNT) + (size_t)item * 8192; const float* DEC = (const float*)(ws + WS_DEC) + (size_t)item * 64;
#pragma unroll
    for (int g = 0; g < 4; ++g) {
        Df[g] = *(const f32x4*)(DEC + 8 * g + 4 * hh); Df[4 + g] = *(const f32x4*)(DEC + 32 + 8 * g + 4 * hh);
        Nf[g] = *(const u32x2*)(GNT + (32 * qt + r) * 64 + 8 * g + 4 * hh); Nf[4 + g] = *(const u32x2*)(GNT + (32 * qt + r) * 64 + 32 + 8 * g + 4 * hh);
    }
}
__device__ __forceinline__ void gla_prod_step(ldsp_t lds, const unsigned char* ob, const unsigned char* ws, int b, int hd, int dir, int qt, int lane, int st,
                                              f32x16& X0, f32x16& X1, const u32x2 (&Nc)[8], const f32x4 (&Dc)[8], u32x2 (&Nn)[8], f32x4 (&Dn)[8]) {
    const int r = lane & 31, hh = lane >> 5;
    const int stn = st < 62 ? st + 2 : 63, cn = dir ? 63 - stn : stn, itemn = ((b * 64 + cn) * 4 + hd) * 2 + dir;
    gla_ld_nd(ob, ws, itemn, qt, r, hh, Nn, Dn);
    const bf16x8 b00 = pack_step(X0, 0), b01 = pack_step(X0, 1), b10 = pack_step(X1, 0), b11 = pack_step(X1, 1);
    ch_publish(lds, st, lane, b00, b01, b10, b11);
#pragma unroll
    for (int g = 0; g < 4; ++g) {
        const f32x4 d0 = Dc[g], d1 = Dc[4 + g]; const u32x2 n0 = Nc[g], n1 = Nc[4 + g];
        X0[4 * g + 0] = d0.x * X0[4 * g + 0] + bf2f(n0.x & 0xffffu); X0[4 * g + 1] = d0.y * X0[4 * g + 1] + bf2f(n0.x >> 16);
        X0[4 * g + 2] = d0.z * X0[4 * g + 2] + bf2f(n0.y & 0xffffu); X0[4 * g + 3] = d0.w * X0[4 * g + 3] + bf2f(n0.y >> 16);
        X1[4 * g + 0] = d1.x * X1[4 * g + 0] + bf2f(n1.x & 0xffffu); X1[4 * g + 1] = d1.y * X1[4 * g + 1] + bf2f(n1.x >> 16);
        X1[4 * g + 2] = d1.z * X1[4 * g + 2] + bf2f(n1.y & 0xffffu); X1[4 * g + 3] = d1.w * X1[4 * g + 3] + bf2f(n1.y >> 16);
    }
}
__device__ __forceinline__ void gla_producer(const Params& P, ldsp_t lds, const int chain, const int lane) {
    const int qt = chain & 3, dir = (chain >> 2) & 1, hd = (chain >> 3) & 3, b = chain >> 5;
    const unsigned char* ws = P.ws; const unsigned char* ob = (const unsigned char*)P.out;
    f32x16 X0, X1;
#pragma unroll
    for (int i = 0; i < 16; ++i) { X0[i] = 0.f; X1[i] = 0.f; }
    u32x2 NA[8], NB[8], NC[8]; f32x4 DA[8], DB[8], DC[8];
    { const int c0 = dir ? 63 : 0, c1 = dir ? 62 : 1;
      gla_ld_nd(ob, ws, ((b * 64 + c0) * 4 + hd) * 2 + dir, qt, lane & 31, lane >> 5, NA, DA);
      gla_ld_nd(ob, ws, ((b * 64 + c1) * 4 + hd) * 2 + dir, qt, lane & 31, lane >> 5, NB, DB); }
#pragma unroll 1
    for (int st = 0; st < 63; st += 3) {
        gla_prod_step(lds, ob, ws, b, hd, dir, qt, lane, st, X0, X1, NA, DA, NC, DC);
        gla_prod_step(lds, ob, ws, b, hd, dir, qt, lane, st + 1, X0, X1, NB, DB, NA, DA);
        gla_prod_step(lds, ob, ws, b, hd, dir, qt, lane, st + 2, X0, X1, NC, DC, NB, DB);
    }
    gla_prod_step(lds, ob, ws, b, hd, dir, qt, lane, 63, X0, X1, NA, DA, NC, DC);
}

__device__ __forceinline__ void ld_tok4(const bf16_t* base, int tok4, int lane, float (&y)[4][8]) {
    const u32x4* p = (const u32x4*)(base + ((size_t)tok4 * 512 + 8 * lane) * 4);
#pragma unroll
    for (int i = 0; i < 4; ++i) { const u32x4 v = p[i];
        y[0][2 * i] = bf2f(v.x & 0xffffu); y[1][2 * i] = bf2f(v.x >> 16); y[2][2 * i] = bf2f(v.y & 0xffffu); y[3][2 * i] = bf2f(v.y >> 16);
        y[0][2 * i + 1] = bf2f(v.z & 0xffffu); y[1][2 * i + 1] = bf2f(v.z >> 16); y[2][2 * i + 1] = bf2f(v.w & 0xffffu); y[3][2 * i + 1] = bf2f(v.w >> 16); }
}
__device__ __forceinline__ void mix_tok4_rw(const Params& P, const int tok4, const int lane) {
    unsigned char* ws = P.ws;
    const bf16_t* YF = (const bf16_t*)(ws + WS_YF); const bf16_t* YB = (const bf16_t*)(ws + WS_YB);
    const bf16_t* GG = (const bf16_t*)(ws + WS_G); const bf16_t* VS = (const bf16_t*)(ws + WS_VS);
    const float* BON = (const float*)(ws + WS_BON);
    const bf16_t* OF = (const bf16_t*)(ws + WS_OF); const bf16_t* OB = (const bf16_t*)(ws + WS_OB);
    const bf16_t* PB = (const bf16_t*)(ws + WS_PB);
    bf16_t* MIX = (bf16_t*)(ws + WS_MIX);
    {
        float ya[4][8], yb[4][8];
        ld_tok4(YF, tok4, lane, ya); ld_tok4(YB, tok4, lane, yb);
        const f32x4 w0 = *(const f32x4*)(P.ln_w + 8 * lane), w1 = *(const f32x4*)(P.ln_w + 8 * lane + 4);
        const f32x4 c0 = *(const f32x4*)(P.ln_b + 8 * lane), c1 = *(const f32x4*)(P.ln_b + 8 * lane + 4);
        const float lw[8] = {w0.x, w0.y, w0.z, w0.w, w1.x, w1.y, w1.z, w1.w}, lb[8] = {c0.x, c0.y, c0.z, c0.w, c1.x, c1.y, c1.z, c1.w};
        const int h = lane >> 3;
        u32x4 gq[4], vq[4]; float bq0[4], bq1[4];
#pragma unroll
        for (int q = 0; q < 4; ++q) { const int tok = 4 * tok4 + q; const size_t o512 = (size_t)tok * 512 + 8 * lane;
            gq[q] = *(const u32x4*)(GG + o512); vq[q] = *(const u32x4*)(VS + o512); bq0[q] = BON[(size_t)tok * 8 + h]; bq1[q] = BON[((size_t)NTOK + tok) * 8 + h]; }
#pragma unroll
        for (int q = 0; q < 4; ++q) {
            const int tok = 4 * tok4 + q;
            float y[8]; float s = 0.f;
#pragma unroll
            for (int e = 0; e < 8; ++e) { y[e] = ya[q][e] + yb[q][e]; s += y[e]; }
            s += __shfl_xor(s, 1); s += __shfl_xor(s, 2); s += __shfl_xor(s, 4);
            const float mean = s * (1.f / 64.f);
            float s2 = 0.f;
#pragma unroll
            for (int e = 0; e < 8; ++e) { y[e] -= mean; s2 += y[e] * y[e]; }
            s2 += __shfl_xor(s2, 1); s2 += __shfl_xor(s2, 2); s2 += __shfl_xor(s2, 4);
            const float rs = rsqrtf(s2 * (1.f / 64.f) + 64e-5f);
            const float bon = bq0[q] + bq1[q];
            float g[8], vs[8], o[8];
            unpack8(gq[q], g); unpack8(vq[q], vs);
#pragma unroll
            for (int e = 0; e < 8; ++e) o[e] = (y[e] * rs * lw[e] + lb[e] + bon * vs[e]) * g[e];
            *(u32x4*)(MIX + (size_t)tok * 1024 + 8 * lane) = pack8(o);
        }
    }
}
__device__ __forceinline__ void mix_tok4_gl(const Params& P, const int tok4, const int lane) {
    unsigned char* ws = P.ws;
    const bf16_t* YF = (const bf16_t*)(ws + WS_YF); const bf16_t* YB = (const bf16_t*)(ws + WS_YB);
    const bf16_t* GG = (const bf16_t*)(ws + WS_G); const bf16_t* VS = (const bf16_t*)(ws + WS_VS);
    const float* BON = (const float*)(ws + WS_BON);
    const bf16_t* OF = (const bf16_t*)(ws + WS_OF); const bf16_t* OB = (const bf16_t*)(ws + WS_OB);
    const bf16_t* PB = (const bf16_t*)(ws + WS_PB);
    bf16_t* MIX = (bf16_t*)(ws + WS_MIX);
    {
        float ya[4][8], yb[4][8];
        ld_tok4(OF, tok4, lane, ya); ld_tok4(OB, tok4, lane, yb);
        const f32x4 w0 = *(const f32x4*)(P.gnorm_w + 8 * lane), w1 = *(const f32x4*)(P.gnorm_w + 8 * lane + 4);
        const float nw[8] = {w0.x, w0.y, w0.z, w0.w, w1.x, w1.y, w1.z, w1.w};
        u32x4 oq[4];
#pragma unroll
        for (int q = 0; q < 4; ++q) oq[q] = *(const u32x4*)(PB + (size_t)(4 * tok4 + q) * LDB_GL + 1056 + 8 * lane);
#pragma unroll
        for (int q = 0; q < 4; ++q) {
            const int tok = 4 * tok4 + q;
            float y[8], og[8], o[8]; float s2 = 0.f;
#pragma unroll
            for (int e = 0; e < 8; ++e) { y[e] = ya[q][e] + yb[q][e]; s2 += y[e] * y[e]; }
            s2 += __shfl_xor(s2, 1); s2 += __shfl_xor(s2, 2); s2 += __shfl_xor(s2, 4); s2 += __shfl_xor(s2, 8);
            const float rs = rsqrtf(s2 * (1.f / 128.f) + 1e-6f);
            unpack8(oq[q], og);
#pragma unroll
            for (int e = 0; e < 8; ++e) o[e] = y[e] * rs * nw[e] * (og[e] * sigmoidf_(og[e]));
            *(u32x4*)(MIX + (size_t)tok * 1024 + 512 + 8 * lane) = pack8(o);
        }
    }
}

struct TBlk { const float* src; bf16_t* dst; const float* sc; int N, ldk; };
__device__ __forceinline__ TBlk moe_blk(const Params& P, int it) {
    bf16_t* WGU = (bf16_t*)(P.ws + WS_WGU); bf16_t* WDN = (bf16_t*)(P.ws + WS_WDN);
    const int e = it / 768, r = it % 768; TBlk t;
    if (r < 512) { const int up = r >> 8, q = r & 255, kb = q >> 4, nb = q & 15, n0 = 32 * nb;
        const float* src = (up ? P.w_up : P.w_gate) + (size_t)e * 1024 * 512;
        const int drow0 = 256 * (n0 >> 7) + (n0 & 127) + 128 * up;
        t.src = src + (size_t)(64 * kb) * 512 + n0; t.N = 512; t.dst = WGU + (size_t)e * 1024 * 1024 + (size_t)drow0 * 1024 + 64 * kb; t.ldk = 1024; t.sc = P.ln2_w + 64 * kb;
    } else { const int q = r - 512, kb = q >> 5, nb = q & 31;
        t.src = P.w_down + (size_t)e * 512 * 1024 + (size_t)(64 * kb) * 1024 + 32 * nb; t.N = 1024; t.dst = WDN + (size_t)e * 1024 * 512 + (size_t)(32 * nb) * 512 + 64 * kb; t.ldk = 512; t.sc = nullptr; }
    return t;
}
__device__ __forceinline__ void tblk_load(const TBlk& t, float (&tv)[32], f32x4 (&g)[2], int lane) {
#pragma unroll
    for (int i = 0; i < 32; ++i) { const int kk = 2 * i + (lane >> 5); tv[i] = t.src[(size_t)kk * t.N + (lane & 31)]; }
    g[0] = (f32x4){1.f, 1.f, 1.f, 1.f}; g[1] = g[0];
    if (t.sc) { g[0] = *(const f32x4*)(t.sc + 8 * (lane & 7)); g[1] = *(const f32x4*)(t.sc + 8 * (lane & 7) + 4); }
}
__device__ __forceinline__ void tblk_store(const TBlk& t, const float (&tv)[32], const f32x4 (&g)[2], LAS float* scr, int lane) {
#pragma unroll
    for (int i = 0; i < 32; ++i) { const int kk = 2 * i + (lane >> 5); scr[kk * 33 + (lane & 31)] = tv[i]; }
    asm volatile("s_waitcnt lgkmcnt(0)" ::: "memory");
    const int c = lane & 7;
    const f32x4 g0 = g[0], g1 = g[1];
#pragma unroll
    for (int j = 0; j < 4; ++j) { const int n = (lane >> 3) + 8 * j; const LAS float* s = scr + (8 * c) * 33 + n;
        u32x4 o; o.x = pk2(s[0 * 33] * g0.x, s[1 * 33] * g0.y); o.y = pk2(s[2 * 33] * g0.z, s[3 * 33] * g0.w); o.z = pk2(s[4 * 33] * g1.x, s[5 * 33] * g1.y); o.w = pk2(s[6 * 33] * g1.z, s[7 * 33] * g1.w);
        *(u32x4*)(t.dst + (size_t)n * t.ldk + 8 * c) = o; }
    asm volatile("s_waitcnt lgkmcnt(0)" ::: "memory");
}
__device__ __forceinline__ void p5b_convert(const Params& P, const Ctx& F, const int gw, const int NGW) {
    LAS float* scr = (LAS float*)(F.lds + F.wid * 16384);
    constexpr int NIT = NEXP * 768;
    float ta[32], tb[32]; f32x4 ga[2], gb[2];
    int it = gw;
    if (it >= NIT) return;
    TBlk A = moe_blk(P, it), B = A;
    tblk_load(A, ta, ga, F.lane);
#pragma unroll 1
    while (true) {
        const int i1 = it + NGW, i2 = it + 2 * NGW;
        if (i1 < NIT) { B = moe_blk(P, i1); tblk_load(B, tb, gb, F.lane); }
        tblk_store(A, ta, ga, scr, F.lane);
        if (i1 >= NIT) break;
        if (i2 < NIT) { A = moe_blk(P, i2); tblk_load(A, ta, ga, F.lane); }
        tblk_store(B, tb, gb, scr, F.lane);
        if (i2 >= NIT) break;
        it = i2;
    }
}

constexpr size_t WS_WRT = WS_LORA + 512 * 1024;
constexpr int RT_XS = 2064, RT_LOG = 64 * RT_XS;
__device__ __forceinline__ void p6_router_group(const Params& P, const Ctx& F, const int grp) {
    ldsp_t lds = F.lds; const int lane = F.lane, wid = F.wid;
    unsigned* CNT = (unsigned*)(P.ws + WS_CTL) + CW_CNT;
    int* ELIST = (int*)(P.ws + WS_ELIST); float* ELW = (float*)(P.ws + WS_ELW);
    const bf16_t* WrT = (const bf16_t*)(P.ws + WS_WRT);
    {
        const int tok0 = grp * 64;
        if (F.tid < 64) {
            unsigned* pc = (unsigned*)(P.ws + WS_CTL) + CW_PN + 16 * (grp >> 2); unsigned* tmo = (unsigned*)(P.ws + WS_CTL) + CW_BAR + XB_TMO; unsigned polls = 0;
            while ((unsigned)__builtin_amdgcn_readfirstlane((int)__hip_atomic_load(pc, __ATOMIC_RELAXED, __HIP_MEMORY_SCOPE_AGENT)) < 32u) {
                __builtin_amdgcn_s_sleep(2);
                if ((++polls & 1023u) == 0u) { if (__builtin_amdgcn_readfirstlane((int)__hip_atomic_load(tmo, __ATOMIC_RELAXED, __HIP_MEMORY_SCOPE_AGENT)) != 0) break;
                    if (polls > (1u << 22)) { if (F.tid == 0) atomicAdd(tmo, 1u); break; } }
            }
            __builtin_amdgcn_fence(__ATOMIC_ACQUIRE, "agent");
            asm volatile("s_waitcnt vmcnt(0)" ::: "memory");
        }
        __syncthreads();
        PROBE_BEGIN(41)
        {
            f32x4 v[8][4]; float ss[8];
            u32x2 raw[8][4];
#pragma unroll
            for (int i = 0; i < 8; ++i) { const u32x2* xr = (const u32x2*)((const bf16_t*)(P.ws + WS_XMID) + (size_t)(tok0 + 8 * wid + i) * 1024) + lane;
#pragma unroll
                for (int j = 0; j < 4; ++j) raw[i][j] = xr[64 * j]; }
#pragma unroll
            for (int i = 0; i < 8; ++i) { float s = 0.f;
#pragma unroll
                for (int j = 0; j < 4; ++j) { v[i][j] = (f32x4){bf2f(raw[i][j].x & 0xffffu), bf2f(raw[i][j].x >> 16), bf2f(raw[i][j].y & 0xffffu), bf2f(raw[i][j].y >> 16)};
                    s += (v[i][j].x * v[i][j].x + v[i][j].y * v[i][j].y) + (v[i][j].z * v[i][j].z + v[i][j].w * v[i][j].w); }
                ss[i] = s; }
            wave_sum_n<8>(ss);
            f32x4 g[4];
#pragma unroll
            for (int j = 0; j < 4; ++j) g[j] = *((const f32x4*)P.ln2_w + lane + 64 * j);
#pragma unroll
            for (int i = 0; i < 8; ++i) { const float inv = rsqrtf(ss[i] * (1.f / 1024.f) + 1e-6f); const int tl = 8 * wid + i;
                if (lane == 0) *(LAS float*)(lds + RT_LOG + 2 * 64 * 48 * 4 + tl * 4) = inv;
#pragma unroll
                for (int j = 0; j < 4; ++j) { u32x2 o; o.x = pk2(v[i][j].x * inv * g[j].x, v[i][j].y * inv * g[j].y); o.y = pk2(v[i][j].z * inv * g[j].z, v[i][j].w * inv * g[j].w);
                    *(LAS u32x2*)(lds + tl * RT_XS + (256 * j + 4 * lane) * 2) = o; } }
        }
        PROBE_END(41)
        __syncthreads();
        PROBE_BEGIN(42)
        {
            const int tt = wid >> 1, kh = wid & 1;
            f32x4 acc[3];
#pragma unroll
            for (int ct = 0; ct < 3; ++ct) acc[ct] = (f32x4){0.f, 0.f, 0.f, 0.f};
            const LAS unsigned char* ap = lds + (16 * tt + (lane & 15)) * RT_XS + (512 * kh + 8 * (lane >> 4)) * 2;
            const bf16_t* bp = WrT + (size_t)(lane & 15) * 1024 + 512 * kh + 8 * (lane >> 4);
#pragma unroll 4
            for (int ks = 0; ks < 16; ++ks) {
                const bf16x8 a = *(const LAS bf16x8*)(ap + ks * 64);
#pragma unroll
                for (int ct = 0; ct < 3; ++ct) { const bf16x8 bq = *(const bf16x8*)(bp + (size_t)ct * 16 * 1024 + ks * 32); acc[ct] = __builtin_amdgcn_mfma_f32_16x16x32_bf16(a, bq, acc[ct], 0, 0, 0); }
            }
#pragma unroll
            for (int ct = 0; ct < 3; ++ct)
#pragma unroll
                for (int r = 0; r < 4; ++r) *(LAS float*)(lds + RT_LOG + ((kh * 64 + 16 * tt + 4 * (lane >> 4) + r) * 48 + 16 * ct + (lane & 15)) * 4) = acc[ct][r];
        }
        PROBE_END(42)
        __syncthreads();
        PROBE_BEGIN(43)
        if (F.tid < 64) {
            const int tok = tok0 + F.tid;
            const LAS float* l0 = (const LAS float*)(lds + RT_LOG + (F.tid * 48) * 4); const LAS float* l1 = (const LAS float*)(lds + RT_LOG + ((64 + F.tid) * 48) * 4);
            float cl[4];
#pragma unroll
            for (int i = 0; i < 4; ++i) cl[i] = l0[i] + l1[i] + P.b_coarse[i];
            int g = 0; float cm = cl[0];
#pragma unroll
            for (int i = 1; i < 4; ++i) if (cl[i] > cm) { cm = cl[i]; g = i; }
            float cs = 0.f;
#pragma unroll
            for (int i = 0; i < 4; ++i) cs += __expf(cl[i] - cm);
            const float pg = 1.f / cs;
            float fl[8];
#pragma unroll
            for (int i = 0; i < 8; ++i) fl[i] = l0[4 + 8 * g + i] + l1[4 + 8 * g + i] + P.b_fine[8 * g + i];
            int i1 = 0; float m1 = fl[0];
#pragma unroll
            for (int i = 1; i < 8; ++i) if (fl[i] > m1) { m1 = fl[i]; i1 = i; }
            int i2 = -1; float m2 = -3.0e38f;
#pragma unroll
            for (int i = 0; i < 8; ++i) if (i != i1 && fl[i] > m2) { m2 = fl[i]; i2 = i; }
            const float e2 = __expf(m2 - m1);
            const float c1 = pg / (1.f + e2), c2 = pg * e2 / (1.f + e2);
            const int ea = 8 * g + i1, eb = 8 * g + i2;
            const float rsv = *(const LAS float*)(lds + RT_LOG + 2 * 64 * 48 * 4 + F.tid * 4);
            float* ERS = (float*)(P.ws + WS_ERS);
            const unsigned sa = atomicAdd(&CNT[64 * ea], 1u); ELIST[(size_t)ea * NTOK + sa] = tok * 2; ELW[(size_t)ea * NTOK + sa] = c1; ERS[(size_t)ea * NTOK + sa] = rsv;
            const unsigned sb = atomicAdd(&CNT[64 * eb], 1u); ELIST[(size_t)eb * NTOK + sb] = tok * 2 + 1; ELW[(size_t)eb * NTOK + sb] = c2; ERS[(size_t)eb * NTOK + sb] = rsv;
        }
        PROBE_END(43)
        __syncthreads();
    }
}

__device__ __forceinline__ void build_group_tables(const Params& P, const Ctx& F) {
    LAS int* tab = (LAS int*)(F.lds + LDS_TAB);
    if (F.tid < 32) tab[F.tid] = (int)__hip_atomic_load((unsigned*)(P.ws + WS_CTL) + CW_CNT + 64 * F.tid, __ATOMIC_RELAXED, __HIP_MEMORY_SCOPE_AGENT);
    __syncthreads();
    if (F.tid == 0) { int s = 0; for (int e = 0; e < 32; ++e) { tab[32 + e] = s; s += (tab[e] + 255) >> 8; } tab[64] = s; }
    __syncthreads();
}
struct GroupOrder {
    static constexpr int A_AUX = 0;
    LAS const int* tab; const char* Abase; const char* Bbase; const int* elist; unsigned* cnt;
    int G, c, K;
    __device__ __forceinline__ bool next(int i, pg8::Unit& u) const {
        const int L = i * G + c, ntile = tab[64];
        if (L >= ntile * 4) return false;
        const int mg = L >> 2; u.pn = L & 3;
        int e = 0;
#pragma unroll 1
        for (int q = 1; q < 32; ++q) e = (tab[32 + q] <= mg) ? q : e;
        u.e = e; u.mt = mg - tab[32 + e]; u.pm = mg;
        u.a = Abase;
        u.b = Bbase + ((size_t)e * 1024 + 256 * u.pn) * K * 2;
        return true;
    }
    __device__ __forceinline__ void rows(const pg8::Unit& u, int R0, int R1, unsigned& r0, unsigned& r1) const {
        const int cnt_e = tab[u.e]; const int p0 = 256 * u.mt + R0, p1 = 256 * u.mt + R1;
        const int* el = elist + (size_t)u.e * NTOK;
        r0 = p0 < cnt_e ? (unsigned)(el[p0] >> 1) : 0u; r1 = p1 < cnt_e ? (unsigned)(el[p1] >> 1) : 0u;
    }
    __device__ __forceinline__ void a_ready(const pg8::Unit&) const {}
    __device__ __forceinline__ void done(const pg8::Unit& u) const {
        asm volatile("s_waitcnt vmcnt(0)" ::: "memory");
        if ((threadIdx.x & 63) == 0) __hip_atomic_fetch_add(cnt + 16 * u.pm, 1u, __ATOMIC_RELAXED, __HIP_MEMORY_SCOPE_AGENT);
    }
};
struct GroupOrderDown {
    static constexpr int A_AUX = 17;
    LAS const int* tab; const char* Abase; const char* Bbase; unsigned* cnt; unsigned* tmo;
    int G, c, K;
    __device__ __forceinline__ bool next(int i, pg8::Unit& u) const {
        const int ntile = tab[64], U = ntile * 4, r3 = U - 2 * G;
        int L;
        if (r3 > 0 && r3 < G && U <= 3 * G) { if (c < r3) { if (i > 0) return false; L = U - r3 + c; } else { L = (c - r3) + (G - r3) * i; if (L >= U - r3) return false; } }
        else { L = i * G + c; if (L >= U) return false; }
        const int mg = L >> 2; u.pn = L & 3;
        int e = 0;
#pragma unroll 1
        for (int q = 1; q < 32; ++q) e = (tab[32 + q] <= mg) ? q : e;
        u.e = e; u.mt = mg - tab[32 + e]; u.pm = mg;
        u.a = Abase + (size_t)mg * 256 * K * 2;
        u.b = Bbase + ((size_t)e * 1024 + 256 * u.pn) * K * 2;
        return true;
    }
    __device__ __forceinline__ void rows(const pg8::Unit&, int, int, unsigned&, unsigned&) const {}
    __device__ __forceinline__ void a_ready(const pg8::Unit& u) const {
        if (threadIdx.x < 64) {
            unsigned polls = 0;
            while ((unsigned)__builtin_amdgcn_readfirstlane((int)__hip_atomic_load(cnt + 16 * u.pm, __ATOMIC_RELAXED, __HIP_MEMORY_SCOPE_AGENT)) < 32u) {
                __builtin_amdgcn_s_sleep(2);
                if ((++polls & 1023u) == 0u) { if (__builtin_amdgcn_readfirstlane((int)__hip_atomic_load(tmo, __ATOMIC_RELAXED, __HIP_MEMORY_SCOPE_AGENT)) != 0) break;
                    if (polls > (1u << 22)) { if (threadIdx.x == 0) atomicAdd(tmo, 1u); break; } }
            }
            asm volatile("s_waitcnt vmcnt(0)" ::: "memory");
        }
        asm volatile("" ::: "memory"); __builtin_amdgcn_s_barrier(); asm volatile("" ::: "memory");
    }
    __device__ __forceinline__ void done(const pg8::Unit&) const {}
};
struct EpiSwiGLU {
    static constexpr bool PERM = true;
    bf16_t* ACT; LAS const int* tab; const int* elist; const float* rstd;
    __device__ __forceinline__ void operator()(const f32x4 (&acc)[2][2][4][2], const pg8::Unit& u, int wr, int wc, int fr, int fq) const {
        const int row0 = u.pm * 256 + wr * 64 + fr, col0 = u.pn * 128 + wc * 32 + 8 * fq;
        const __amdgpu_buffer_rsrc_t rsrc = __builtin_amdgcn_make_buffer_rsrc((void*)ACT, 0, 40960 * 512 * 2, 0x00020000);
        const int cnt = tab[u.e]; const float* ers = rstd + (size_t)u.e * NTOK;
        float rs[2][4];
#pragma unroll
        for (int ai = 0; ai < 2; ++ai)
#pragma unroll
            for (int m = 0; m < 4; ++m) { const int pos = 256 * u.mt + wr * 64 + ai * 128 + m * 16 + fr; rs[ai][m] = pos < cnt ? ers[pos] : 0.f; }
#pragma unroll
        for (int ai = 0; ai < 2; ++ai)
#pragma unroll
            for (int m = 0; m < 4; ++m) {
                float o[8]; const float s = rs[ai][m];
#pragma unroll
                for (int n = 0; n < 2; ++n)
#pragma unroll
                    for (int q = 0; q < 4; ++q) { const float gt = acc[ai][0][m][n][q] * s, up = acc[ai][1][m][n][q] * s; o[4 * n + q] = gt * sigmoidf_(gt) * up; }
                __builtin_amdgcn_raw_buffer_store_b128(pack8(o), rsrc, ((row0 + ai * 128 + m * 16) * 512 + col0) * 2, 0, 16);
            }
    }
};
struct EpiDown {
    static constexpr bool PERM = true;
    LAS const int* tab; const int* elist; const float* elw; bf16_t* YK0; bf16_t* YK1;
    __device__ __forceinline__ void operator()(const f32x4 (&acc)[2][2][4][2], const pg8::Unit& u, int wr, int wc, int fr, int fq) const {
        const int cnt = tab[u.e]; const int col0 = u.pn * 256 + wc * 32 + 8 * fq;
#pragma unroll
        for (int ai = 0; ai < 2; ++ai)
#pragma unroll
            for (int m = 0; m < 4; ++m) {
                const int pos = 256 * u.mt + ai * 128 + wr * 64 + m * 16 + fr;
                if (pos < cnt) {
                    const int en = elist[(size_t)u.e * NTOK + pos]; const float w = elw[(size_t)u.e * NTOK + pos];
                    bf16_t* rowp = ((en & 1) ? YK1 : YK0) + (size_t)(en >> 1) * 1024 + col0;
#pragma unroll
                    for (int bj = 0; bj < 2; ++bj) { const f32x4 v0 = acc[ai][bj][m][0], v1 = acc[ai][bj][m][1];
                        u32x4 o; o.x = pk2(v0[0] * w, v0[1] * w); o.y = pk2(v0[2] * w, v0[3] * w); o.z = pk2(v1[0] * w, v1[1] * w); o.w = pk2(v1[2] * w, v1[3] * w);
                        *(u32x4*)(rowp + bj * 128) = o; }
                }
            }
    }
};

__device__ __forceinline__ void final_token2(const Params& P, const int tokA, const int tokB, const bool hasB, const int lane) {
    float* ra = P.out + (size_t)tokA * 1024; float* rb = P.out + (size_t)(hasB ? tokB : tokA) * 1024;
    const bf16_t* y0 = (const bf16_t*)(P.ws + WS_YK0); const bf16_t* y1 = (const bf16_t*)(P.ws + WS_YK1);
    const size_t oa = (size_t)tokA * 1024, ob = (size_t)(hasB ? tokB : tokA) * 1024;
    const bf16_t* xm = (const bf16_t*)(P.ws + WS_XMID);
    f32x4 va[4], vb[4]; u32x2 a0[4], a1[4], b0[4], b1[4], xa[4], xb[4];
#pragma unroll
    for (int j = 0; j < 4; ++j) { xa[j] = *((const u32x2*)(xm + oa) + lane + 64 * j); xb[j] = *((const u32x2*)(xm + ob) + lane + 64 * j);
        a0[j] = *((const u32x2*)(y0 + oa) + lane + 64 * j); a1[j] = *((const u32x2*)(y1 + oa) + lane + 64 * j);
        b0[j] = *((const u32x2*)(y0 + ob) + lane + 64 * j); b1[j] = *((const u32x2*)(y1 + ob) + lane + 64 * j); }
    float ss[2] = {0.f, 0.f};
#pragma unroll
    for (int j = 0; j < 4; ++j) {
        va[j] = (f32x4){bf2f(xa[j].x & 0xffffu), bf2f(xa[j].x >> 16), bf2f(xa[j].y & 0xffffu), bf2f(xa[j].y >> 16)};
        vb[j] = (f32x4){bf2f(xb[j].x & 0xffffu), bf2f(xb[j].x >> 16), bf2f(xb[j].y & 0xffffu), bf2f(xb[j].y >> 16)};
        va[j].x += bf2f(a0[j].x & 0xffffu) + bf2f(a1[j].x & 0xffffu); va[j].y += bf2f(a0[j].x >> 16) + bf2f(a1[j].x >> 16);
        va[j].z += bf2f(a0[j].y & 0xffffu) + bf2f(a1[j].y & 0xffffu); va[j].w += bf2f(a0[j].y >> 16) + bf2f(a1[j].y >> 16);
        vb[j].x += bf2f(b0[j].x & 0xffffu) + bf2f(b1[j].x & 0xffffu); vb[j].y += bf2f(b0[j].x >> 16) + bf2f(b1[j].x >> 16);
        vb[j].z += bf2f(b0[j].y & 0xffffu) + bf2f(b1[j].y & 0xffffu); vb[j].w += bf2f(b0[j].y >> 16) + bf2f(b1[j].y >> 16);
        ss[0] += (va[j].x * va[j].x + va[j].y * va[j].y) + (va[j].z * va[j].z + va[j].w * va[j].w);
        ss[1] += (vb[j].x * vb[j].x + vb[j].y * vb[j].y) + (vb[j].z * vb[j].z + vb[j].w * vb[j].w); }
    wave_sum_n<2>(ss);
    const float ia = rsqrtf(ss[0] * (1.f / 1024.f) + 1e-6f), ib = rsqrtf(ss[1] * (1.f / 1024.f) + 1e-6f);
#pragma unroll
    for (int j = 0; j < 4; ++j) { const f32x4 g = *((const f32x4*)P.ln_f_w + lane + 64 * j);
        f32x4 o; o.x = va[j].x * ia * g.x; o.y = va[j].y * ia * g.y; o.z = va[j].z * ia * g.z; o.w = va[j].w * ia * g.w;
        *((f32x4*)ra + lane + 64 * j) = o;
        if (hasB) { f32x4 q; q.x = vb[j].x * ib * g.x; q.y = vb[j].y * ib * g.y; q.z = vb[j].z * ib * g.z; q.w = vb[j].w * ib * g.w; *((f32x4*)rb + lane + 64 * j) = q; } }
}

__global__ void __launch_bounds__(512, 2) mk_fwd(Params P) {
    extern __shared__ __attribute__((aligned(16))) unsigned char lds_raw[];
    Ctx F;
    F.lds = (ldsp_t)lds_raw;
    F.tid = threadIdx.x; F.lane = F.tid & 63; F.wid = __builtin_amdgcn_readfirstlane(F.tid >> 6);
    F.G = gridDim.x; { const int bx = blockIdx.x; F.vcu = (F.G % 8 == 0) ? (bx % 8) * (F.G / 8) + bx / 8 : bx; }
    volatile LAS unsigned* MISC = (volatile LAS unsigned*)(F.lds + LDS_MISC);
    if (F.tid < 16) MISC[F.tid] = 0u;
    __syncthreads();
    unsigned* ctl = (unsigned*)(P.ws + WS_CTL);
    const int lo = P.ph_lo, hi = P.ph_hi;
    XcdBarrier bar; bar.bar = ctl + CW_BAR; bar.x = 0; bar.st = MISC;
    if (hi - lo > 1) bar = xcd_barrier_post(ctl + CW_BAR, MISC);
#ifndef PHASE_MASK
#define PHASE_MASK 0xFFFFF
#endif
#define IN(k) (((PHASE_MASK >> (k)) & 1) && lo <= (k) && (k) < hi)
#ifndef REP_MASK
#define REP_MASK 0
#endif
#define NREP(k) (1 + ((REP_MASK >> (k)) & 1))
#define SEAM(k) do { if (IN(k) && IN((k) + 1)) xcd_barrier(bar); } while (0)
    unsigned char* ws = P.ws;
    const int gw = F.vcu * 8 + F.wid, NGW = F.G * 8;

    if (IN(0)) { PROBE_BEGIN(30) for (int rep = 0; rep < NREP(0); ++rep) { p0_prologue(P, F); __syncthreads(); } PROBE_END(30) }
    SEAM(0);
    if (IN(1)) {
        pg8::StaticOrder S; S.init(ws + WS_H, ws + WS_BT_RW, NTOK, 2048, 1024, F.G, (int)blockIdx.x);
        pg8::EpiBf16 E{(bf16_t*)P.out, LDA_RW};
        { PROBE_BEGIN(20) pg8::gemm_phase<pg8::EpiBf16, pg8::StaticOrder, false>(F.lds, 1024, S, E); PROBE_END(20) }
            {

        pg8::StaticOrder S; S.init(ws + WS_H, ws + WS_BT_GL, NTOK, 1792, 1024, F.G, (int)blockIdx.x);
        pg8::EpiBf16 E{(bf16_t*)(ws + WS_PB), LDB_GL};
        { PROBE_BEGIN(20) pg8::gemm_phase<pg8::EpiBf16, pg8::StaticOrder, false>(F.lds, 1024, S, E); PROBE_END(20) }
            }
    }
    SEAM(1);
    if (IN(2)) { PROBE_BEGIN(33)
        const int q0 = (F.vcu >> 1) * 8, qs = (F.G >> 1) * 8;
        unsigned sink = 0u;
        if (F.vcu & 1) {
            RwRaw R;
#pragma unroll 1
            for (int q = q0; q < 2048; q += qs) {
#pragma unroll 1
                for (int h = 0; h < 8; ++h) { int it = (q + h) * 2 + 1; asm volatile("" : "+s"(it));
                    const int qn = (h < 7) ? q + h + 1 : q + qs; rwkv_item<1>(P, F, it, R, h == 0, qn * 2 + 1, qn < 2048, sink); } }
        } else {
            RwRaw R;
#pragma unroll 1
            for (int q = q0; q < 2048; q += qs) {
#pragma unroll 1
                for (int h = 0; h < 8; ++h) { int it = (q + h) * 2; asm volatile("" : "+s"(it));
                    const int qn = (h < 7) ? q + h + 1 : q + qs; rwkv_item<0>(P, F, it, R, h == 0, qn * 2, qn < 2048, sink); } }
        }
        asm volatile("s_waitcnt vmcnt(0)" : "+v"(sink) :: "memory");
        PROBE_END(33) }
    SEAM(2);
    if (IN(3)) { }
    if (IN(4)) { PROBE_BEGIN(31)
        if (F.vcu & 1) { for (int it = F.vcu; it < 2048; it += 2 * F.G) gla_pair<1>(P, F, it, it + F.G, it + F.G < 2048); }
        else           { for (int it = F.vcu; it < 2048; it += 2 * F.G) gla_pair<0>(P, F, it, it + F.G, it + F.G < 2048); }
        asm volatile("s_waitcnt vmcnt(0)" ::: "memory");
        PROBE_END(31) }
    SEAM(4);
    if (IN(5)) { PROBE_BEGIN(6)
        if (F.tid < 512) *(volatile LAS unsigned*)(F.lds + CH_FLAGS + F.tid * 4) = 0u;
        __syncthreads();
        if (F.vcu < 128) { if (F.wid == 0) rwkv_producer(P, F.lds, F.vcu, F.lane); else chain_consumer<false>(P, F.lds, F.vcu, F.wid - 1, F.lane); }
        else if (F.vcu < 256) { if (F.wid == 0) gla_producer(P, F.lds, F.vcu - 128, F.lane); else chain_consumer<true>(P, F.lds, F.vcu - 128, F.wid - 1, F.lane); }
        PROBE_END(6) }
    SEAM(5);
#if PROBE_ID == 40
    for (int q = 0; q < 8; ++q) xcd_barrier(bar);
#endif
    if (IN(6)) { PROBE_BEGIN(32) for (int rep = 0; rep < NREP(6); ++rep) { for (int t4 = gw; t4 < NTOK / 4; t4 += NGW) mix_tok4_rw(P, t4, F.lane); for (int t4 = gw; t4 < NTOK / 4; t4 += NGW) mix_tok4_gl(P, t4, F.lane); } PROBE_END(32) }
    SEAM(6);
    if (IN(7)) { PROBE_BEGIN(50)
        const bool conv_first = ((F.vcu >> 2) & 1) != 0;
        if (conv_first) { PROBE_BEGIN(34) p5b_convert(P, F, F.vcu * 8 + F.wid, F.G * 8); PROBE_END(34) __syncthreads(); }
        {
            pg8::PanelOrder S{(const char*)(ws + WS_MIX), (const char*)(ws + WS_BT_OUT), ctl + CW_PN, 1024, 4, 256, F.G, F.vcu};
            pg8::EpiResBf16 E{(bf16_t*)(ws + WS_XMID), P.x, 1024};
            { PROBE_BEGIN(20) pg8::gemm_phase<pg8::EpiResBf16, pg8::PanelOrder, false>(F.lds, 1024, S, E); PROBE_END(20) }
        }
        PROBE_BEGIN(7)
        for (int grp = F.vcu; grp < NTOK / 64; grp += F.G) p6_router_group(P, F, grp);
        PROBE_END(7)
        if (!conv_first) { PROBE_BEGIN(34) p5b_convert(P, F, F.vcu * 8 + F.wid, F.G * 8); PROBE_END(34) }
    PROBE_END(50) }
    SEAM(7);
    if (IN(8)) { }
    if (IN(9)) { }
    if (IN(10)) {
        { PROBE_BEGIN(23) build_group_tables(P, F); PROBE_END(23) }
        unsigned* mtc = ctl + CW_MT;
        {
            GroupOrder S{(LAS const int*)(F.lds + LDS_TAB), (const char*)(ws + WS_XMID), (const char*)(ws + WS_WGU), (const int*)(ws + WS_ELIST), mtc, F.G, F.vcu, 1024};
            EpiSwiGLU E{(bf16_t*)P.out, (LAS const int*)(F.lds + LDS_TAB), (const int*)(ws + WS_ELIST), (const float*)(ws + WS_ERS)};
            { PROBE_BEGIN(21) pg8::gemm_phase<EpiSwiGLU, GroupOrder, true>(F.lds, 1024, S, E); PROBE_END(21) }
        }
        {
            GroupOrderDown S{(LAS const int*)(F.lds + LDS_TAB), (const char*)P.out, (const char*)(ws + WS_WDN), mtc, ctl + CW_BAR + XB_TMO, F.G, F.vcu, 512};
            EpiDown E{(LAS const int*)(F.lds + LDS_TAB), (const int*)(ws + WS_ELIST), (const float*)(ws + WS_ELW), (bf16_t*)(ws + WS_YK0), (bf16_t*)(ws + WS_YK1)};
            { PROBE_BEGIN(22) pg8::gemm_phase<EpiDown, GroupOrderDown, false>(F.lds, 512, S, E); PROBE_END(22) }
        }
    }
    SEAM(10);
    if (IN(11)) { }
    if (IN(12)) { PROBE_BEGIN(8) for (int tok = gw; tok < NTOK; tok += 2 * NGW) final_token2(P, tok, tok + NGW, tok + NGW < NTOK, F.lane); PROBE_END(8) }
#undef IN
#undef SEAM
}

extern "C" void kernel_launch(void* const* d_in, const int* in_sizes, int n_in, void* d_out, int out_size, void* d_ws, size_t ws_size, hipStream_t stream) {
    static int grid = 0;
    if (grid == 0) {
        if (n_in != 33 || out_size != NTOK * DM || ws_size < WS_END) { fprintf(stderr, "kernel_launch: unexpected problem (n_in %d, out %d, ws %zu, need %zu)\n", n_in, out_size, ws_size, (size_t)WS_END); grid = -1; return; }
        int dev = 0, cus = 0, per_cu = 0;
        if (hipGetDevice(&dev) != hipSuccess || hipDeviceGetAttribute(&cus, hipDeviceAttributeMultiprocessorCount, dev) != hipSuccess) { grid = -1; return; }
        if (hipFuncSetAttribute((const void*)mk_fwd, hipFuncAttributeMaxDynamicSharedMemorySize, LDS_BYTES) != hipSuccess) { fprintf(stderr, "kernel_launch: hipFuncSetAttribute failed\n"); grid = -1; return; }
        if (hipOccupancyMaxActiveBlocksPerMultiprocessor(&per_cu, (const void*)mk_fwd, 512, LDS_BYTES) != hipSuccess || per_cu < 1) fprintf(stderr, "kernel_launch: occupancy query says %d\n", per_cu);
        (void)hipGetLastError();
        grid = cus;
    }
    if (grid < 0) return;
    (void)hipMemsetAsync((char*)d_ws + WS_CTL, 0, CTL_ZERO_BYTES, stream);
    Params p{};
    const float* const* in = (const float* const*)d_in;
    p.x = in[0]; p.ln1_w = in[1]; p.w_in = in[2]; p.rw_mu = in[3];
    p.w0_f = in[4]; p.w2_f = in[5]; p.w0_b = in[6]; p.w2_b = in[7];
    p.a0_f = in[8]; p.a2_f = in[9]; p.a0_b = in[10]; p.a2_b = in[11];
    p.g2 = in[12]; p.k_k = in[13]; p.k_a = in[14]; p.r_k = in[15]; p.ln_w = in[16]; p.ln_b = in[17];
    p.gw2_f = in[18]; p.gb_f = in[19]; p.gw2_b = in[20]; p.gb_b = in[21]; p.gnorm_w = in[22];
    p.w_out = in[23]; p.ln2_w = in[24]; p.w_coarse = in[25]; p.b_coarse = in[26]; p.w_fine = in[27]; p.b_fine = in[28];
    p.w_gate = in[29]; p.w_up = in[30]; p.w_down = in[31]; p.ln_f_w = in[32];
    p.out = (float*)d_out; p.ws = (unsigned char*)d_ws;
#if MK_PER_PHASE
#ifndef REP_PHASE
#define REP_PHASE -1
#endif
    for (int k = 0; k < NPH; ++k) { p.ph_lo = k; p.ph_hi = k + 1; hipLaunchKernelGGL(mk_fwd, dim3(grid), dim3(512), LDS_BYTES, stream, p);
        if (k == REP_PHASE) hipLaunchKernelGGL(mk_fwd, dim3(grid), dim3(512), LDS_BYTES, stream, p); }
#else
    p.ph_lo = 0; p.ph_hi = NPH; hipLaunchKernelGGL(mk_fwd, dim3(grid), dim3(512), LDS_BYTES, stream, p);
#endif
}
```

```cpp
#include <hip/hip_runtime.h>
#include <cstdio>
#include <cstdint>

#ifndef MK_PER_PHASE
#define MK_PER_PHASE 0
#endif

#define LAS __attribute__((address_space(3)))
#define GAS __attribute__((address_space(1)))
typedef unsigned short bf16_t;
typedef short bf16x8 __attribute__((ext_vector_type(8)));
typedef float f32x4 __attribute__((ext_vector_type(4)));
typedef float f32x16 __attribute__((ext_vector_type(16)));
typedef unsigned u32x4 __attribute__((ext_vector_type(4)));
typedef unsigned u32x2 __attribute__((ext_vector_type(2)));
typedef LAS unsigned char* ldsp_t;

constexpr int NTOK = 16384, SEQ = 4096, DM = 1024;
constexpr int LDA_RW = 2048;
constexpr int LDB_GL = 1792;
constexpr int RW_COLS = 1920, GL_COLS = 1568;
constexpr int NEXP = 32, DEXP = 512;
constexpr int NPH = 13;

constexpr size_t MiB = 1u << 20;
constexpr size_t WS_CTL = 0, CTL_ZERO_BYTES = 64 * 1024;
constexpr size_t WS_LORA = 1 * MiB;
constexpr size_t WS_BT_RW = 2 * MiB, WS_BT_GL = 6 * MiB, WS_BT_OUT = 10 * MiB;
constexpr size_t WS_BON = 12 * MiB;
constexpr size_t WS_ELIST = 13 * MiB;
constexpr size_t WS_DEC = 15 * MiB;
constexpr size_t WS_H = 16 * MiB;
constexpr size_t WS_OF = 16 * MiB, WS_OB = 32 * MiB;
constexpr size_t WS_H2 = 16 * MiB;
constexpr size_t WS_RM = 48 * MiB, WS_RP = 80 * MiB, WS_RNT = 112 * MiB;
constexpr size_t WS_GQ = 48 * MiB, WS_GNT = 64 * MiB;
constexpr size_t WS_MIX = 48 * MiB;
constexpr size_t WS_YF = 144 * MiB, WS_YB = 160 * MiB, WS_G = 176 * MiB, WS_VS = 192 * MiB;
constexpr size_t WS_PB = 208 * MiB;
constexpr size_t WS_WGU = 80 * MiB, WS_WDN = 144 * MiB;
constexpr size_t WS_XMID = 176 * MiB;
constexpr size_t WS_YK0 = 48 * MiB, WS_YK1 = 216 * MiB;
constexpr size_t WS_ELW = 248 * MiB;
constexpr size_t WS_END = 264 * MiB;
constexpr int CW_CNT = 0;
constexpr int CW_BAR = 4096;
constexpr int CW_PN = 12288;
constexpr int CW_MT = 8192;

constexpr int LDS_BYTES = 160 * 1024;
constexpr int LDS_MISC = LDS_BYTES - 64;
constexpr int LDS_TAB = 131072;

#ifndef PROBE_ID
#define PROBE_ID 0
#endif
#ifndef PROBE_MULT
#define PROBE_MULT 1
#endif
#define PROBE_BEGIN(id) long long _pb_##id = 0; if (PROBE_ID == (id)) { _pb_##id = __builtin_readcyclecounter(); }
#define PROBE_END(id) if (PROBE_ID == (id)) { const long long _e = __builtin_readcyclecounter(); const long long _d = (_e - _pb_##id) * PROBE_MULT; while (__builtin_readcyclecounter() - _e < _d) __builtin_amdgcn_s_sleep(2); }
__device__ __forceinline__ float bf2f(unsigned b) { return __uint_as_float(b << 16); }
typedef __bf16 bf2_t __attribute__((ext_vector_type(2)));
typedef float f2_t __attribute__((ext_vector_type(2)));
__device__ __forceinline__ unsigned f2bf(float f) { const __bf16 b = (__bf16)f; return (unsigned)__builtin_bit_cast(unsigned short, b); }
__device__ __forceinline__ unsigned pk2(float lo, float hi) { const f2_t v = {lo, hi}; const bf2_t r = __builtin_convertvector(v, bf2_t); return __builtin_bit_cast(unsigned, r); }
template <int CTRL> __device__ __forceinline__ float dpp_mov(float x) { return __int_as_float(__builtin_amdgcn_update_dpp(0, __float_as_int(x), CTRL, 0xF, 0xF, true)); }
template <int N> __device__ __forceinline__ void wave_sum_n(float (&v)[N]) {
#pragma unroll
    for (int i = 0; i < N; ++i) v[i] += dpp_mov<0xB1>(v[i]);
#pragma unroll
    for (int i = 0; i < N; ++i) v[i] += dpp_mov<0x4E>(v[i]);
#pragma unroll
    for (int i = 0; i < N; ++i) v[i] += dpp_mov<0x141>(v[i]);
#pragma unroll
    for (int i = 0; i < N; ++i) v[i] += dpp_mov<0x140>(v[i]);
    { float t[N];
#pragma unroll
      for (int i = 0; i < N; ++i) t[i] = __int_as_float(__builtin_amdgcn_ds_swizzle(__float_as_int(v[i]), 0x401F));
#pragma unroll
      for (int i = 0; i < N; ++i) v[i] += t[i]; }
    { float t[N];
#pragma unroll
      for (int i = 0; i < N; ++i) t[i] = __shfl_xor(v[i], 32);
#pragma unroll
      for (int i = 0; i < N; ++i) v[i] += t[i]; }
}
__device__ __forceinline__ float wave_sum(float v) { float t[1] = {v}; wave_sum_n<1>(t); return t[0]; }
__device__ __forceinline__ float sigmoidf_(float x) { return __builtin_amdgcn_rcpf(1.f + __expf(-x)); }
__device__ __forceinline__ float tanhf_(float x) { return 1.f - 2.f * __builtin_amdgcn_rcpf(1.f + __expf(2.f * x)); }
__device__ __forceinline__ void unpack8(const u32x4& v, float (&o)[8]) {
    o[0] = bf2f(v.x & 0xffffu); o[1] = bf2f(v.x >> 16); o[2] = bf2f(v.y & 0xffffu); o[3] = bf2f(v.y >> 16);
    o[4] = bf2f(v.z & 0xffffu); o[5] = bf2f(v.z >> 16); o[6] = bf2f(v.w & 0xffffu); o[7] = bf2f(v.w >> 16);
}
__device__ __forceinline__ u32x4 pack8(const float (&o)[8]) {
    u32x4 v; v.x = pk2(o[0], o[1]); v.y = pk2(o[2], o[3]); v.z = pk2(o[4], o[5]); v.w = pk2(o[6], o[7]); return v;
}

#define XB_TMO      128
#define XB_XCNT(j)  (256  + 64 * (j))
#define XB_XSUB(j)  (1280 + 64 * (j))
#define XB_XGEN(j)  (2304 + 64 * (j))
#define XB_TOP      3328
#define XB_TOPGEN   3392
#define XCD_BAR_WORDS 3456
#define XB_SPIN_CAP (1u << 18)
__device__ __forceinline__ unsigned xb_ld(unsigned* p)              { return __hip_atomic_load(p, __ATOMIC_RELAXED, __HIP_MEMORY_SCOPE_AGENT); }
__device__ __forceinline__ unsigned xb_add(unsigned* p, unsigned v) { return __hip_atomic_fetch_add(p, v, __ATOMIC_RELAXED, __HIP_MEMORY_SCOPE_AGENT); }
__device__ __forceinline__ unsigned xb_xcc_id() { return (unsigned)__builtin_amdgcn_s_getreg((3 << 11) | 20) & 0xFu; }
#define XB_SPIN(cond, bar) do { unsigned _sp = 0; while (cond) { __builtin_amdgcn_s_sleep(1); \
    if ((++_sp & 255u) == 0u) { if (xb_ld(&(bar)[XB_TMO])) break; if (_sp > XB_SPIN_CAP) { atomicAdd(&(bar)[XB_TMO], 1u); break; } } } } while (0)
struct XcdBarrier { unsigned* bar; unsigned x; volatile LAS unsigned* st; };
__device__ __forceinline__ XcdBarrier xcd_barrier_post(unsigned* bar, volatile LAS unsigned* st) {
    XcdBarrier b; b.bar = bar; b.x = xb_xcc_id(); b.st = st;
    if (threadIdx.x == 0) (void)xb_add(&bar[XB_XCNT(b.x)], 1u);
    return b;
}
__device__ __forceinline__ void xcd_barrier_complete(unsigned* bar, unsigned x, unsigned& nloc, unsigned& nx) {
    const unsigned G = gridDim.x * gridDim.y * gridDim.z;
    unsigned sum, cnt, mine, sp = 0u;
    for (;;) {
        sum = 0u; cnt = 0u; mine = 0u;
#pragma unroll
        for (unsigned j = 0; j < 16; ++j) { const unsigned c = xb_ld(&bar[XB_XCNT(j)]); sum += c; cnt += (c > 0u) ? 1u : 0u; mine = (j == x) ? c : mine; }
        if (sum == G) break;
        __builtin_amdgcn_s_sleep(1);
        if ((++sp & 255u) == 0u) { if (xb_ld(&bar[XB_TMO])) break; if (sp > XB_SPIN_CAP) { atomicAdd(&bar[XB_TMO], 1u); break; } }
    }
    nloc = mine > 0u ? mine : 1u; nx = cnt > 0u ? cnt : 1u;
}
__device__ __forceinline__ void xcd_barrier(const XcdBarrier& b) {
    asm volatile("s_waitcnt vmcnt(0)" ::: "memory");
    __syncthreads();
    if (threadIdx.x == 0) {
        unsigned* bar = b.bar;
        __builtin_amdgcn_s_waitcnt(0);
        unsigned nloc = b.st[0], nx = b.st[1];
        if (nloc == 0u) { xcd_barrier_complete(bar, b.x, nloc, nx); b.st[0] = nloc; b.st[1] = nx; }
        const unsigned old = xb_add(&bar[XB_XSUB(b.x)], 1u);
        const unsigned gen = old / nloc;
        if (old + 1u == (gen + 1u) * nloc) {
            __builtin_amdgcn_fence(__ATOMIC_RELEASE, "agent");
            asm volatile("s_waitcnt vmcnt(0)" ::: "memory");
            const unsigned og = xb_add(&bar[XB_TOP], 1u);
            const unsigned tg = og / nx;
            if (og + 1u == (tg + 1u) * nx) xb_add(&bar[XB_TOPGEN], 1u);
            else XB_SPIN(xb_ld(&bar[XB_TOPGEN]) == tg, bar);
            __builtin_amdgcn_fence(__ATOMIC_ACQUIRE, "agent");
            xb_add(&bar[XB_XGEN(b.x)], 1u);
            asm volatile("s_waitcnt vmcnt(0)" ::: "memory");
        } else {
            XB_SPIN(xb_ld(&bar[XB_XGEN(b.x)]) == gen, bar);
            __builtin_amdgcn_fence(__ATOMIC_ACQUIRE, "agent");
            asm volatile("s_waitcnt vmcnt(0)" ::: "memory");
        }
    }
    __syncthreads();
}

struct Params {
    const float* x; const float* ln1_w; const float* w_in; const float* rw_mu;
    const float* w0_f; const float* w2_f; const float* w0_b; const float* w2_b;
    const float* a0_f; const float* a2_f; const float* a0_b; const float* a2_b;
    const float* g2; const float* k_k; const float* k_a; const float* r_k; const float* ln_w; const float* ln_b;
    const float* gw2_f; const float* gb_f; const float* gw2_b; const float* gb_b; const float* gnorm_w;
    const float* w_out; const float* ln2_w; const float* w_coarse; const float* b_coarse; const float* w_fine; const float* b_fine;
    const float* w_gate; const float* w_up; const float* w_down; const float* ln_f_w;
    float* out; unsigned char* ws;
    int ph_lo, ph_hi;
};

namespace pg8 {
constexpr int BM = 256, BK = 64, HALF = 128, HTB = HALF * BK * 2, STAGE_BYTES = 8 * HTB, NXCD = 8, WGM = 8;
__host__ __device__ __forceinline__ int lds_byte(int r, int c) { const int st = (r >> 4) * 2 + (c >> 5), rr = r & 15, cc = c & 31, ob = rr * 64 + cc * 2; return st * 1024 + (ob ^ (((ob >> 9) & 1) << 5)); }
__host__ __device__ __forceinline__ void stage_rc(int b, int& R, int& C) { const int st = b / 1024, sb = b % 1024, swz = sb ^ (((sb >> 9) & 1) << 5); R = (st >> 1) * 16 + swz / 64; C = (st & 1) * 32 + (swz % 64) / 2; }
__host__ __device__ __forceinline__ int perm32(int rho) { const int n = rho >> 4, i = rho & 15; return 8 * (i >> 2) + 4 * n + (i & 3); }

struct Unit { const char* a; const char* b; int pm, pn, e, mt; };

struct StaticOrder {
    static constexpr int A_AUX = 0;
    const char* A; const char* Bt; int K;
    int nM, nN, nwg, G, c;
    __device__ void init(const void* A_, const void* Bt_, int M, int N, int K_, int G_, int c_) { A = (const char*)A_; Bt = (const char*)Bt_; K = K_; nM = M / BM; nN = N / BM; nwg = nM * nN; G = G_; c = c_; }
    __device__ __forceinline__ bool next(int i, Unit& u) const {
        const long L = (long)i * G + c; if (L >= nwg) return false;
        int wgid = (int)L; { const int q = nwg / NXCD, r = nwg % NXCD, xcd = wgid % NXCD, off = wgid / NXCD; wgid = (xcd < r ? xcd * (q + 1) : r * (q + 1) + (xcd - r) * q) + off; }
        const int nig = WGM * nN, gid = wgid / nig, fm = gid * WGM, gsz = (nM - fm) < WGM ? (nM - fm) : WGM;
        u.pm = fm + ((wgid % nig) % gsz); u.pn = (wgid % nig) / gsz; u.e = 0; u.mt = 0;
        u.a = A + (size_t)u.pm * 256 * K * 2; u.b = Bt + (size_t)u.pn * 256 * K * 2; return true;
    }
    __device__ __forceinline__ void rows(const Unit&, int, int, unsigned&, unsigned&) const {}
    __device__ __forceinline__ void a_ready(const Unit&) const {}
    __device__ __forceinline__ void done(const Unit&) const {}
};

template <class Epi, class Sched, bool GATHER>
__device__ __forceinline__ void gemm_phase(ldsp_t lds, const int K, const Sched& S, const Epi& E) {
    const int tid = threadIdx.x, wid = __builtin_amdgcn_readfirstlane(tid >> 6), lane = tid & 63, wr = wid >> 2, wc = wid & 3, fr = lane & 15, fq = lane >> 4;
    const int nt = K / BK;
    unsigned voffA[2], voffB[2]; int RA[2], CA[2];
#pragma unroll
    for (int i = 0; i < 2; ++i) { int R, C; stage_rc(tid * 16 + i * 8192, R, C); const int Rb = Epi::PERM ? ((R & ~31) + perm32(R & 31)) : R;
        RA[i] = R; CA[i] = C; voffA[i] = (unsigned)(R * K + C) * 2u; voffB[i] = (unsigned)(Rb * K + C) * 2u; }
    const size_t kstep = (size_t)(BK * 2);
    const unsigned hstep = (unsigned)HALF * K * 2;
    const unsigned ldsw = (unsigned)wid * 1024u;
    const int aoff = lds_byte(wr * 64 + fr, fq * 8), boff = lds_byte(wc * 32 + fr, fq * 8);
#define PG8_SA(b, h) (((b) * 2 + (h)) * HTB)
#define PG8_SB(b, h) ((4 + (b) * 2 + (h)) * HTB)
#define PG8_STAGE2(bufoff, gbase, v0, v1) do { \
        __builtin_amdgcn_global_load_lds((const unsigned*)((const char*)(gbase) + (v0)), (LAS unsigned*)(lds + (bufoff) + ldsw), 16, 0, 0); \
        __builtin_amdgcn_global_load_lds((const unsigned*)((const char*)(gbase) + (v1)), (LAS unsigned*)(lds + (bufoff) + ldsw + 8192), 16, 0, 0); } while (0)
#define PG8_STAGEB(bufoff, gbase) PG8_STAGE2(bufoff, gbase, voffB[0], voffB[1])
#define PG8_STAGEA(bufoff, gbase, v0, v1) do { \
        __builtin_amdgcn_global_load_lds((const unsigned*)((const char*)(gbase) + (v0)), (LAS unsigned*)(lds + (bufoff) + ldsw), 16, 0, Sched::A_AUX); \
        __builtin_amdgcn_global_load_lds((const unsigned*)((const char*)(gbase) + (v1)), (LAS unsigned*)(lds + (bufoff) + ldsw + 8192), 16, 0, Sched::A_AUX); } while (0)
#define PG8_LDA(dst, b, h) do { _Pragma("unroll") for (int m = 0; m < 4; ++m) _Pragma("unroll") for (int k = 0; k < 2; ++k) dst[m][k] = *(const LAS bf16x8*)(lds + PG8_SA(b, h) + aoff + m * 2048 + k * 1024); } while (0)
#define PG8_LDB(dst, b, h) do { _Pragma("unroll") for (int n = 0; n < 2; ++n) _Pragma("unroll") for (int k = 0; k < 2; ++k) dst[n][k] = *(const LAS bf16x8*)(lds + PG8_SB(b, h) + boff + n * 2048 + k * 1024); } while (0)
#define PG8_MMA(ai, bj, At, Bt) do { __builtin_amdgcn_s_setprio(1); _Pragma("unroll") for (int m = 0; m < 4; ++m) _Pragma("unroll") for (int n = 0; n < 2; ++n) _Pragma("unroll") for (int k = 0; k < 2; ++k) \
        acc[ai][bj][m][n] = __builtin_amdgcn_mfma_f32_16x16x32_bf16(Bt[n][k], At[m][k], acc[ai][bj][m][n], 0, 0, 0); __builtin_amdgcn_s_setprio(0); } while (0)
#define PG8_WAIT_V(n) asm volatile("s_waitcnt vmcnt(" #n ")" ::: "memory")
#define PG8_WAIT_L(n) asm volatile("s_waitcnt lgkmcnt(" #n ")" ::: "memory")
#define PG8_BAR __builtin_amdgcn_s_barrier()
#define PG8_SCHED __builtin_amdgcn_sched_barrier(0)
    Unit cur, nxt; int ui = 0;
    if (!S.next(0, cur)) return;
    f32x4 acc[2][2][4][2];
#pragma unroll
    for (int a = 0; a < 2; ++a)
#pragma unroll
        for (int b = 0; b < 2; ++b)
#pragma unroll
            for (int m = 0; m < 4; ++m)
#pragma unroll
                for (int n = 0; n < 2; ++n) acc[a][b][m][n] = (f32x4){0.f, 0.f, 0.f, 0.f};
    bf16x8 At[4][2], B0[2][2], B1[2][2];
    unsigned oc0[2], oc1[2], on0[2], on1[2];
    if constexpr (GATHER) {
#pragma unroll
        for (int i = 0; i < 2; ++i) { unsigned r0, r1; S.rows(cur, RA[i], RA[i] + 128, r0, r1); oc0[i] = r0 * (unsigned)(K * 2) + (unsigned)CA[i] * 2u; oc1[i] = r1 * (unsigned)(K * 2) + (unsigned)CA[i] * 2u; on0[i] = oc0[i]; on1[i] = oc1[i]; }
    } else {
#pragma unroll
        for (int i = 0; i < 2; ++i) { oc0[i] = voffA[i]; oc1[i] = voffA[i] + hstep; on0[i] = oc0[i]; on1[i] = oc1[i]; }
    }
    const char* cA = cur.a; const char* cB = cur.b;
    S.a_ready(cur);
    PG8_STAGEB(PG8_SB(0, 0), cB); PG8_STAGEA(PG8_SA(0, 0), cA, oc0[0], oc0[1]); PG8_STAGEB(PG8_SB(0, 1), cB + hstep); PG8_STAGEA(PG8_SA(0, 1), cA, oc1[0], oc1[1]);
    if (wr == 1) PG8_BAR;
    PG8_WAIT_V(4); PG8_BAR;
    PG8_STAGEB(PG8_SB(1, 0), cB + kstep); PG8_STAGEA(PG8_SA(1, 0), cA + kstep, oc0[0], oc0[1]); PG8_STAGEB(PG8_SB(1, 1), cB + hstep + kstep);
    PG8_WAIT_V(6); PG8_BAR;
    for (;;) {
        const bool has_next = S.next(ui + 1, nxt);
        const char* nA = has_next ? nxt.a : cA; const char* nB = has_next ? nxt.b : cB;
        if constexpr (GATHER) {
            if (has_next) {
#pragma unroll
                for (int i = 0; i < 2; ++i) { unsigned r0, r1; S.rows(nxt, RA[i], RA[i] + 128, r0, r1); on0[i] = r0 * (unsigned)(K * 2) + (unsigned)CA[i] * 2u; on1[i] = r1 * (unsigned)(K * 2) + (unsigned)CA[i] * 2u; }
            } else {
#pragma unroll
                for (int i = 0; i < 2; ++i) { on0[i] = oc0[i]; on1[i] = oc1[i]; }
            }
        }
        for (int t = 0; t < nt; t += 2) {
            const bool last = (t == nt - 2);
            const char* a1 = cA + (size_t)(t + 1) * kstep;
            const char* a2 = last ? nA : cA + (size_t)(t + 2) * kstep; const char* b2 = last ? nB : cB + (size_t)(t + 2) * kstep;
            const char* a3 = a2 + kstep; const char* b3 = b2 + kstep;
            if (last && has_next) S.a_ready(nxt);
            unsigned p00, p01, p10, p11;
            if constexpr (GATHER) { p00 = last ? on0[0] : oc0[0]; p01 = last ? on0[1] : oc0[1]; p10 = last ? on1[0] : oc1[0]; p11 = last ? on1[1] : oc1[1]; }
            else { p00 = oc0[0]; p01 = oc0[1]; p10 = oc1[0]; p11 = oc1[1]; }
            PG8_LDB(B0, 0, 0); PG8_SCHED; PG8_LDA(At, 0, 0); PG8_STAGEA(PG8_SA(1, 1), a1, oc1[0], oc1[1]);
            PG8_WAIT_L(8); PG8_BAR; PG8_WAIT_L(0); PG8_MMA(0, 0, At, B0); PG8_BAR; PG8_SCHED;
            PG8_LDB(B1, 0, 1); PG8_STAGEB(PG8_SB(0, 0), b2);
            PG8_BAR; PG8_WAIT_L(0); PG8_MMA(0, 1, At, B1); PG8_BAR;
            PG8_LDA(At, 0, 1); PG8_STAGEA(PG8_SA(0, 0), a2, p00, p01);
            PG8_BAR; PG8_WAIT_L(0); PG8_MMA(1, 0, At, B0); PG8_BAR; PG8_SCHED;
            PG8_STAGEB(PG8_SB(0, 1), b2 + hstep);
            PG8_WAIT_V(6); PG8_BAR; PG8_MMA(1, 1, At, B1); PG8_BAR;
            PG8_LDB(B0, 1, 0); PG8_SCHED; PG8_LDA(At, 1, 0); PG8_STAGEA(PG8_SA(0, 1), a2, p10, p11);
            PG8_WAIT_L(8); PG8_BAR; PG8_WAIT_L(0); PG8_MMA(0, 0, At, B0); PG8_BAR; PG8_SCHED;
            PG8_LDB(B1, 1, 1); PG8_STAGEB(PG8_SB(1, 0), b3);
            PG8_BAR; PG8_WAIT_L(0); PG8_MMA(0, 1, At, B1); PG8_BAR;
            PG8_LDA(At, 1, 1); PG8_STAGEA(PG8_SA(1, 0), a3, p00, p01);
            PG8_BAR; PG8_WAIT_L(0); PG8_MMA(1, 0, At, B0); PG8_BAR; PG8_SCHED;
            PG8_STAGEB(PG8_SB(1, 1), b3 + hstep);
            PG8_WAIT_V(6); PG8_BAR; PG8_MMA(1, 1, At, B1); PG8_BAR;
        }
        E(acc, cur, wr, wc, fr, fq); S.done(cur);
        if (!has_next) break;
#pragma unroll
        for (int a = 0; a < 2; ++a)
#pragma unroll
            for (int b = 0; b < 2; ++b)
#pragma unroll
                for (int m = 0; m < 4; ++m)
#pragma unroll
                    for (int n = 0; n < 2; ++n) acc[a][b][m][n] = (f32x4){0.f, 0.f, 0.f, 0.f};
        cur = nxt; cA = nA; cB = nB; ++ui;
#pragma unroll
        for (int i = 0; i < 2; ++i) { oc0[i] = on0[i]; oc1[i] = on1[i]; }
    }
    PG8_WAIT_V(0);
    if (wr == 0) PG8_BAR;
    PG8_BAR;
#undef PG8_SA
#undef PG8_SB
#undef PG8_STAGE2
#undef PG8_STAGEB
#undef PG8_STAGEA
#undef PG8_LDA
#undef PG8_LDB
#undef PG8_MMA
#undef PG8_WAIT_V
#undef PG8_WAIT_L
#undef PG8_BAR
#undef PG8_SCHED
}

struct EpiBf16 {
    static constexpr bool PERM = true;
    bf16_t* O; int ldc, ncols;
    __device__ __forceinline__ void operator()(const f32x4 (&acc)[2][2][4][2], const Unit& u, int wr, int wc, int fr, int fq) const {
        const int row0 = u.pm * BM + wr * 64 + fr, col0 = u.pn * BM + wc * 32 + 8 * fq;
#pragma unroll
        for (int ai = 0; ai < 2; ++ai)
#pragma unroll
            for (int m = 0; m < 4; ++m) { bf16_t* rowp = O + (size_t)(row0 + ai * HALF + m * 16) * ldc + col0;
#pragma unroll
                for (int bj = 0; bj < 2; ++bj) { const f32x4 v0 = acc[ai][bj][m][0], v1 = acc[ai][bj][m][1];
                    u32x4 o; o.x = pk2(v0[0], v0[1]); o.y = pk2(v0[2], v0[3]); o.z = pk2(v1[0], v1[1]); o.w = pk2(v1[2], v1[3]);
                    if (col0 + bj * HALF < ncols) *(u32x4*)(rowp + bj * HALF) = o; } }
    }
};
struct EpiResF32 {
    static constexpr bool PERM = false;
    float* C; const float* X; int ldc;
    __device__ __forceinline__ void operator()(const f32x4 (&acc)[2][2][4][2], const Unit& u, int wr, int wc, int fr, int fq) const {
        const int row0 = u.pm * BM + wr * 64 + fr, col0 = u.pn * BM + wc * 32 + 4 * fq;
        const __amdgpu_buffer_rsrc_t rsrc = __builtin_amdgcn_make_buffer_rsrc((void*)C, 0, NTOK * DM * 4, 0x00020000);
#pragma unroll
        for (int ai = 0; ai < 2; ++ai)
#pragma unroll
            for (int m = 0; m < 4; ++m) { const size_t ro = (size_t)(row0 + ai * HALF + m * 16) * ldc + col0;
#pragma unroll
                for (int bj = 0; bj < 2; ++bj)
#pragma unroll
                    for (int n = 0; n < 2; ++n) { const f32x4 xv = *(const f32x4*)(X + ro + bj * HALF + n * 16); const f32x4 o = acc[ai][bj][m][n] + xv;
                        __builtin_amdgcn_raw_buffer_store_b128(__builtin_bit_cast(u32x4, o), rsrc, (int)((ro + bj * HALF + n * 16) * 4), 0, 16); } }
    }
};
struct EpiResBf16 {
    static constexpr bool PERM = true;
    bf16_t* C; const float* X; int ldc;
    __device__ __forceinline__ void operator()(const f32x4 (&acc)[2][2][4][2], const Unit& u, int wr, int wc, int fr, int fq) const {
        const int row0 = u.pm * BM + wr * 64 + fr, col0 = u.pn * BM + wc * 32 + 8 * fq;
        const __amdgpu_buffer_rsrc_t rsrc = __builtin_amdgcn_make_buffer_rsrc((void*)C, 0, NTOK * DM * 2, 0x00020000);
#pragma unroll
        for (int ai = 0; ai < 2; ++ai)
#pragma unroll
            for (int m = 0; m < 4; ++m) { const size_t ro = (size_t)(row0 + ai * HALF + m * 16) * ldc + col0;
#pragma unroll
                for (int bj = 0; bj < 2; ++bj) { const f32x4 x0 = *(const f32x4*)(X + ro + bj * HALF), x1 = *(const f32x4*)(X + ro + bj * HALF + 4);
                    const f32x4 v0 = acc[ai][bj][m][0] + x0, v1 = acc[ai][bj][m][1] + x1;
                    u32x4 o; o.x = pk2(v0[0], v0[1]); o.y = pk2(v0[2], v0[3]); o.z = pk2(v1[0], v1[1]); o.w = pk2(v1[2], v1[3]);
                    __builtin_amdgcn_raw_buffer_store_b128(o, rsrc, (int)((ro + bj * HALF) * 2), 0, 16); } }
    }
};
struct PanelOrder {
    static constexpr int A_AUX = 0;
    const char* A; const char* Bt; unsigned* cnt; int K, nN, nwg, G, c;
    __device__ __forceinline__ bool next(int i, Unit& u) const {
        const int L = i * G + c; if (L >= nwg) return false;
        u.pm = L / nN; u.pn = L % nN; u.e = 0; u.mt = 0;
        u.a = A + (size_t)u.pm * 256 * K * 2; u.b = Bt + (size_t)u.pn * 256 * K * 2; return true;
    }
    __device__ __forceinline__ void rows(const Unit&, int, int, unsigned&, unsigned&) const {}
    __device__ __forceinline__ void a_ready(const Unit&) const {}
    __device__ __forceinline__ void done(const Unit& u) const {
        asm volatile("s_waitcnt vmcnt(0)" ::: "memory");
        if ((threadIdx.x & 63) == 0) __hip_atomic_fetch_add(cnt + 16 * u.pm, 1u, __ATOMIC_RELAXED, __HIP_MEMORY_SCOPE_AGENT);
    }
};
}

template <int KS>
__device__ __forceinline__ f32x4 tile_n(const LAS unsigned char* A, int lda, const LAS unsigned char* Bt, int ldb, f32x4 acc, int lane) {
    const LAS unsigned char* ap = A + (lane & 15) * lda + (lane >> 4) * 16;
    const LAS unsigned char* bp = Bt + (lane & 15) * ldb + (lane >> 4) * 16;
#pragma unroll
    for (int k = 0; k < KS; ++k) { const bf16x8 a = *(const LAS bf16x8*)(ap + k * 64), b = *(const LAS bf16x8*)(bp + k * 64); acc = __builtin_amdgcn_mfma_f32_16x16x32_bf16(a, b, acc, 0, 0, 0); }
    return acc;
}
template <int KS>
__device__ __forceinline__ f32x4 tile_s(const LAS unsigned char* A, int lda, const LAS unsigned char* Bt, int ldb, f32x4 acc, int lane) {
    const LAS unsigned char* ap = A + (lane & 15) * lda + (lane >> 4) * 16;
    const LAS unsigned char* bp = Bt + (lane & 15) * ldb + (lane >> 4) * 16;
#pragma unroll
    for (int k = 0; k < KS; ++k) { const bf16x8 a = *(const LAS bf16x8*)(ap + k * 64), b = *(const LAS bf16x8*)(bp + k * 64); acc = __builtin_amdgcn_mfma_f32_16x16x32_bf16(b, a, acc, 0, 0, 0); }
    return acc;
}
struct Frag2 { bf16x8 f[2]; };
__device__ __forceinline__ Frag2 ld_frag2(const LAS unsigned char* M, int ld, int lane) { const LAS unsigned char* p = M + (lane & 15) * ld + (lane >> 4) * 16; Frag2 r; r.f[0] = *(const LAS bf16x8*)p; r.f[1] = *(const LAS bf16x8*)(p + 64); return r; }
__device__ __forceinline__ f32x4 tile_nb(const LAS unsigned char* A, int lda, const Frag2& b, f32x4 acc, int lane) {
    const LAS unsigned char* ap = A + (lane & 15) * lda + (lane >> 4) * 16;
#pragma unroll
    for (int k = 0; k < 2; ++k) { const bf16x8 a = *(const LAS bf16x8*)(ap + k * 64); acc = __builtin_amdgcn_mfma_f32_16x16x32_bf16(a, b.f[k], acc, 0, 0, 0); }
    return acc;
}
__device__ __forceinline__ f32x4 tile_sb(const LAS unsigned char* A, int lda, const Frag2& b, f32x4 acc, int lane) {
    const LAS unsigned char* ap = A + (lane & 15) * lda + (lane >> 4) * 16;
#pragma unroll
    for (int k = 0; k < 2; ++k) { const bf16x8 a = *(const LAS bf16x8*)(ap + k * 64); acc = __builtin_amdgcn_mfma_f32_16x16x32_bf16(b.f[k], a, acc, 0, 0, 0); }
    return acc;
}
__device__ __forceinline__ void st4bf(LAS unsigned char* p, const f32x4& v) { u32x2 o; o.x = pk2(v[0], v[1]); o.y = pk2(v[2], v[3]); *(LAS u32x2*)p = o; }
__device__ __forceinline__ void st4bf_g(bf16_t* p, const f32x4& v) { u32x2 o; o.x = pk2(v[0], v[1]); o.y = pk2(v[2], v[3]); *(u32x2*)p = o; }


struct Ctx { ldsp_t lds; int tid, lane, wid, vcu, G; };

__device__ __forceinline__ void transpose_block(const float* W, int N, bf16_t* WT, int ldk, int dst_row0, int k0, int n0, LAS float* scr, int lane) {
    float tv[32];
#pragma unroll
    for (int i = 0; i < 32; ++i) { const int kk = 2 * i + (lane >> 5); tv[i] = W[(size_t)(k0 + kk) * N + n0 + (lane & 31)]; }
#pragma unroll
    for (int i = 0; i < 32; ++i) { const int kk = 2 * i + (lane >> 5); scr[kk * 33 + (lane & 31)] = tv[i]; }
    asm volatile("s_waitcnt lgkmcnt(0)" ::: "memory");
    const int c = lane & 7;
#pragma unroll
    for (int j = 0; j < 4; ++j) { const int n = (lane >> 3) + 8 * j; const LAS float* s = scr + (8 * c) * 33 + n;
        u32x4 o; o.x = pk2(s[0 * 33], s[1 * 33]); o.y = pk2(s[2 * 33], s[3 * 33]); o.z = pk2(s[4 * 33], s[5 * 33]); o.w = pk2(s[6 * 33], s[7 * 33]);
        *(u32x4*)(WT + (size_t)(dst_row0 + n) * ldk + k0 + 8 * c) = o; }
    asm volatile("s_waitcnt lgkmcnt(0)" ::: "memory");
}
__device__ __forceinline__ void rms_row_to_bf16(const float* xrow, const float* w, bf16_t* orow, int lane) {
    const f32x4* xr = (const f32x4*)xrow + lane; const f32x4* wr = (const f32x4*)w + lane;
    f32x4 v[4]; float s = 0.f;
#pragma unroll
    for (int j = 0; j < 4; ++j) { v[j] = xr[64 * j]; s += (v[j].x * v[j].x + v[j].y * v[j].y) + (v[j].z * v[j].z + v[j].w * v[j].w); }
    const float inv = rsqrtf(wave_sum(s) * (1.f / 1024.f) + 1e-6f);
    u32x2* o8 = (u32x2*)orow + lane;
#pragma unroll
    for (int j = 0; j < 4; ++j) { const f32x4 g = wr[64 * j]; u32x2 o; o.x = pk2(v[j].x * inv * g.x, v[j].y * inv * g.y); o.y = pk2(v[j].z * inv * g.z, v[j].w * inv * g.w); o8[64 * j] = o; }
}
__device__ __forceinline__ void p0_prologue(const Params& P, const Ctx& F) {
    LAS float* scr = (LAS float*)(F.lds + F.wid * 16384);
    const int gw = F.vcu * 8 + F.wid, NGW = F.G * 8;
    unsigned char* ws = P.ws;
    bf16_t* BT_RW = (bf16_t*)(ws + WS_BT_RW); bf16_t* BT_GL = (bf16_t*)(ws + WS_BT_GL); bf16_t* BT_OUT = (bf16_t*)(ws + WS_BT_OUT);
    bf16_t* LORA = (bf16_t*)(ws + WS_LORA);
    constexpr int I_IN = 16 * 109, I_OUT = 16 * 32, I_L = 16, I_G = 32;
    constexpr int NITEMS = I_IN + I_OUT + 4 * I_L + I_G;
    for (int it = gw; it < NITEMS; it += NGW) {
        int r = it;
        if (r < I_IN) { const int kb = r / 109, nb = r % 109, n0 = 32 * nb;
            if (n0 < RW_COLS) transpose_block(P.w_in, 3488, BT_RW, 1024, n0, 64 * kb, n0, scr, F.lane);
            else transpose_block(P.w_in, 3488, BT_GL, 1024, n0 - RW_COLS, 64 * kb, n0, scr, F.lane);
            continue; }
        r -= I_IN;
        if (r < I_OUT) { const int kb = r / 32, nb = r % 32; transpose_block(P.w_out, 1024, BT_OUT, 1024, 32 * nb, 64 * kb, 32 * nb, scr, F.lane); continue; }
        r -= I_OUT;
        if (r < 4 * I_L) { const int which = r / I_L, nb = r % I_L;
            const float* src = which == 0 ? P.w2_f : which == 1 ? P.w2_b : which == 2 ? P.a2_f : P.a2_b;
            transpose_block(src, 512, LORA + (size_t)which * 32768, 64, 32 * nb, 0, 32 * nb, scr, F.lane); continue; }
        r -= 4 * I_L;
        { const int kb = r / 16, nb = r % 16; transpose_block(P.g2, 512, LORA + 4 * 32768, 128, 32 * nb, 64 * kb, 32 * nb, scr, F.lane); }
    }
    { const int gt = F.vcu * 512 + F.tid, NGT = F.G * 512; const u32x4 z = {0u, 0u, 0u, 0u};
      u32x4* p1 = (u32x4*)(BT_RW + (size_t)RW_COLS * 1024); for (int i = gt; i < (2048 - RW_COLS) * 128; i += NGT) p1[i] = z;
      u32x4* p2 = (u32x4*)(BT_GL + (size_t)GL_COLS * 1024); for (int i = gt; i < (1792 - GL_COLS) * 128; i += NGT) p2[i] = z; }
    { const int gt = F.vcu * 512 + F.tid, NGT = F.G * 512; bf16_t* WrT = (bf16_t*)(ws + WS_LORA + 512 * 1024);
      for (int i = gt; i < 48 * 1024; i += NGT) { const int n = i >> 10, k = i & 1023;
          const float v = n < 4 ? P.w_coarse[k * 4 + n] : n < 36 ? P.w_fine[k * 32 + n - 4] : 0.f; WrT[i] = (bf16_t)f2bf(v); } }
    bf16_t* H = (bf16_t*)(ws + WS_H);
    for (int m = gw; m < NTOK; m += 2 * NGW) {
        const int m2 = m + NGW; const bool has2 = m2 < NTOK;
        const f32x4* xa = (const f32x4*)(P.x + (size_t)m * 1024) + F.lane; const f32x4* xb = (const f32x4*)(P.x + (size_t)(has2 ? m2 : m) * 1024) + F.lane;
        const f32x4* wr = (const f32x4*)P.ln1_w + F.lane;
        f32x4 va[4], vb[4]; float ss[2] = {0.f, 0.f};
#pragma unroll
        for (int j = 0; j < 4; ++j) { va[j] = xa[64 * j]; vb[j] = xb[64 * j]; }
#pragma unroll
        for (int j = 0; j < 4; ++j) { ss[0] += (va[j].x * va[j].x + va[j].y * va[j].y) + (va[j].z * va[j].z + va[j].w * va[j].w); ss[1] += (vb[j].x * vb[j].x + vb[j].y * vb[j].y) + (vb[j].z * vb[j].z + vb[j].w * vb[j].w); }
        wave_sum_n<2>(ss);
        const float ia = rsqrtf(ss[0] * (1.f / 1024.f) + 1e-6f), ib = rsqrtf(ss[1] * (1.f / 1024.f) + 1e-6f);
        u32x2* oa = (u32x2*)(H + (size_t)m * 1024) + F.lane; u32x2* ob = (u32x2*)(H + (size_t)m2 * 1024) + F.lane;
#pragma unroll
        for (int j = 0; j < 4; ++j) { const f32x4 g = wr[64 * j];
            u32x2 o; o.x = pk2(va[j].x * ia * g.x, va[j].y * ia * g.y); o.y = pk2(va[j].z * ia * g.z, va[j].w * ia * g.w); oa[64 * j] = o;
            if (has2) { u32x2 q; q.x = pk2(vb[j].x * ib * g.x, vb[j].y * ib * g.y); q.y = pk2(vb[j].z * ib * g.z, vb[j].w * ib * g.w); ob[64 * j] = q; } }
    }
}

__device__ __forceinline__ bf16x8 pack_step(const f32x16& x, int s) {
    u32x4 p; p.x = pk2(x[8 * s + 0], x[8 * s + 1]); p.y = pk2(x[8 * s + 2], x[8 * s + 3]); p.z = pk2(x[8 * s + 4], x[8 * s + 5]); p.w = pk2(x[8 * s + 6], x[8 * s + 7]);
    return __builtin_bit_cast(bf16x8, p);
}
#define MFMA32(a, b, c) __builtin_amdgcn_mfma_f32_32x32x16_bf16((a), (b), (c), 0, 0, 0)

constexpr size_t OUT_GQ = 0, OUT_GNT = 16 * MiB;
constexpr int RS = 144;
constexpr int RMS_ = 64 * RS;
constexpr int L_AT = 0, L_BT = RMS_, L_KT = 2 * RMS_, L_RT = 3 * RMS_, L_ATT = 4 * RMS_, L_BHT = 5 * RMS_, L_KHT = 6 * RMS_, L_VT = 7 * RMS_;
constexpr int L_U1 = 8 * RMS_;
constexpr int L_TW = L_U1, L_AL = L_U1 + RMS_, L_SG = L_U1 + 2 * RMS_, L_LW = L_SG + 64 * 272, L_AA = L_LW + 16384;
constexpr int L_T1 = L_LW, L_LAK = L_T1 + RMS_, L_RB = L_T1 + 2 * RMS_, L_RK = L_T1 + 3 * RMS_, L_EX = L_T1 + 4 * RMS_, L_WC = L_U1 + 9 * RMS_;
static_assert(L_EX + 4096 + 64 <= L_WC, "rwkv back-end LDS map");
constexpr int L_XT = 0, L_G1T = 2 * RMS_;
static_assert(L_AA + 16384 <= L_WC && L_WC + 256 <= LDS_MISC, "rwkv LDS map");
constexpr int L_PF = L_WC + 512;
constexpr int L_HS = L_WC + 1024;
static_assert(L_HS + 2048 <= LDS_MISC, "half-block sums");
static_assert(L_PF + 256 <= LDS_MISC, "prefetch sink");

struct RwRaw { u32x4 xc[4]; unsigned rr[10], rk[10], rv[10]; };
template <int DIR>
__device__ __forceinline__ void rwkv_load_lora(const Params& P, const Ctx& F, const int item, RwRaw& R) {
    constexpr int dir = DIR; const int c = (item >> 4) & 63, b = item >> 10;
    const int t0 = c * 64, tb = b * SEQ;
    const bf16_t* PA = (const bf16_t*)P.out;
#pragma unroll
    for (int it = 0; it < 4; ++it) {
        const int q = F.tid + 512 * it, j = q >> 5, ch = q & 31;
        const int col0 = ch < 8 ? 1536 + 64 * dir + 8 * ch : ch < 16 ? 1664 + 64 * dir + 8 * (ch - 8) : 1792 + 8 * (ch - 16);
        const int tn = dir ? t0 + 63 - j : t0 + j;
        R.xc[it] = *(const u32x4*)(PA + (size_t)(tb + tn) * LDA_RW + col0);
    }
}
template <int DIR>
__device__ __forceinline__ void rwkv_load_rkv(const Params& P, const Ctx& F, const int item, RwRaw& R) {
    constexpr int dir = DIR; const int h = (item >> 1) & 7, c = (item >> 4) & 63, b = item >> 10;
    const int t0 = c * 64, tb = b * SEQ;
    const bf16_t* PA = (const bf16_t*)P.out;
    const int jlo = 8 * F.wid, tlo = dir ? (t0 + 55 - jlo) : (t0 + jlo - 1), hi = h * 64 + F.lane;
#pragma unroll
    for (int q = 0; q < 10; ++q) { int tn = tlo + q; tn = tn < 0 ? 0 : (tn > SEQ - 1 ? SEQ - 1 : tn);
        const bf16_t* row = PA + (size_t)(tb + tn) * LDA_RW + hi;
        R.rr[q] = row[0]; R.rk[q] = row[512]; R.rv[q] = row[1024]; }
}
template <int DIR>
__device__ __forceinline__ void rwkv_prefetch(const Params& P, const Ctx& F, const int nitem, unsigned& sink) {
    const int h = (nitem >> 1) & 7, c = (nitem >> 4) & 63, b = nitem >> 10;
    const int t0 = c * 64, tb = b * SEQ, tid = F.tid;
    const bf16_t* PA = (const bf16_t*)P.out;
    if (tid < 198) {
        const int q = tid / 3, a = tid - 3 * q; int tn = t0 - 1 + q; tn = tn < 0 ? 0 : (tn > SEQ - 1 ? SEQ - 1 : tn);
        const bf16_t* p = PA + (size_t)(tb + tn) * LDA_RW + a * 512 + h * 64;
        { unsigned m0s; asm volatile("s_mov_b32 %0, m0\n\ts_mov_b32 m0, %2\n\ts_nop 0\n\tglobal_load_lds_dword %1, off\n\ts_mov_b32 m0, %0" : "=&s"(m0s) : "v"(p), "s"(L_PF) : "memory"); }
    }
    if (h == 0 && tid < 264) {
        const int q = tid >> 2, a = tid & 3; int tn = t0 - 1 + q; tn = tn < 0 ? 0 : (tn > SEQ - 1 ? SEQ - 1 : tn);
        const int col = a == 0 ? 1536 + 64 * DIR : a == 1 ? 1664 + 64 * DIR : 1792 + 64 * (a - 2);
        const bf16_t* p = PA + (size_t)(tb + tn) * LDA_RW + col;
        { unsigned m0s; asm volatile("s_mov_b32 %0, m0\n\ts_mov_b32 m0, %2\n\ts_nop 0\n\tglobal_load_lds_dword %1, off\n\ts_mov_b32 m0, %0" : "=&s"(m0s) : "v"(p), "s"(L_PF) : "memory"); }
    }
}
template <int DIR>
__device__ __forceinline__ void rwkv_item(const Params& P, const Ctx& F, const int item, RwRaw& R, const bool lora, const int nitem, const bool has_next, unsigned& sink) {
    const int tid = F.tid, lane = F.lane, wid = F.wid; ldsp_t lds = F.lds;
    constexpr int dir = DIR; const int h = (item >> 1) & 7, c = (item >> 4) & 63, b = item >> 10;
    const int t0 = c * 64, tb = b * SEQ;
    unsigned char* ws = P.ws;
    const int hi = h * 64 + lane;

    if (lora) rwkv_load_lora<DIR>(P, F, item, R);
    rwkv_load_rkv<DIR>(P, F, item, R);
    PROBE_BEGIN(1)
    const int rb = wid >> 1, cb0 = 2 * (wid & 1);
    const float kkw = P.k_k[hi], kaw = P.k_a[hi], rkw = P.r_k[hi];
    const float mur = P.rw_mu[hi], muk = P.rw_mu[512 + hi], muv = P.rw_mu[1024 + hi];
    float rr[8], kr[8], vr[8];
    {
        const int jlo = 8 * wid;
        const int tlo = dir ? (t0 + 55 - jlo) : (t0 + jlo - 1);
        float raw_r[10], raw_k[10], raw_v[10];
#pragma unroll
        for (int q = 0; q < 10; ++q) { const int tn = tlo + q; const bool ok = (tn >= 0) && (tn < SEQ);
            raw_r[q] = ok ? bf2f(R.rr[q]) : 0.f; raw_k[q] = ok ? bf2f(R.rk[q]) : 0.f; raw_v[q] = ok ? bf2f(R.rv[q]) : 0.f; }
#pragma unroll
        for (int jj = 0; jj < 8; ++jj) {
            const float cr = dir ? raw_r[8 - jj] : raw_r[1 + jj], pr = dir ? raw_r[7 - jj] : raw_r[jj], nr = dir ? raw_r[9 - jj] : raw_r[2 + jj];
            const float ck = dir ? raw_k[8 - jj] : raw_k[1 + jj], pk = dir ? raw_k[7 - jj] : raw_k[jj], nk = dir ? raw_k[9 - jj] : raw_k[2 + jj];
            const float cv = dir ? raw_v[8 - jj] : raw_v[1 + jj], pv = dir ? raw_v[7 - jj] : raw_v[jj], nv = dir ? raw_v[9 - jj] : raw_v[2 + jj];
            rr[jj] = cr + mur * (0.5f * (pr + nr) - cr); kr[jj] = ck + muk * (0.5f * (pk + nk) - ck); vr[jj] = cv + muv * (0.5f * (pv + nv) - cv);
        }
    }
    if (lora) {
    u32x4 xpv[4], xnv[4];
    {
        const bf16_t* PA = (const bf16_t*)P.out; const int ch = tid & 31;
        const int col0 = ch < 8 ? 1536 + 64 * dir + 8 * ch : ch < 16 ? 1664 + 64 * dir + 8 * (ch - 8) : 1792 + 8 * (ch - 16);
#pragma unroll
        for (int it = 0; it < 4; ++it) { const int j = (tid >> 5) + 16 * it, tn = dir ? t0 + 63 - j : t0 + j;
            const bf16_t* row = PA + (size_t)(tb + tn) * LDA_RW + col0;
            const bf16_t* rp = tn > 0 ? row - LDA_RW : row; const bf16_t* rn = tn < SEQ - 1 ? row + LDA_RW : row;
            xpv[it] = *(const u32x4*)rp; xnv[it] = *(const u32x4*)rn; }
    }
    {
        const int ch = tid & 31;
        const int col0 = ch < 8 ? 1536 + 64 * dir + 8 * ch : ch < 16 ? 1664 + 64 * dir + 8 * (ch - 8) : 1792 + 8 * (ch - 16);
        const float cs = ch < 8 ? 2.f : 1.f, ca = ch < 8 ? 2.f : ch < 16 ? 0.f : 1.f, cbb = ch < 8 ? -1.f : 0.f, ci = (ch >= 8 && ch < 16) ? 1.f : 0.f;
        const f32x4 m0 = *(const f32x4*)(P.rw_mu + col0), m1 = *(const f32x4*)(P.rw_mu + col0 + 4);
        const float mu[8] = {m0.x, m0.y, m0.z, m0.w, m1.x, m1.y, m1.z, m1.w};
#pragma unroll
        for (int it = 0; it < 4; ++it) {
            const int j = (tid >> 5) + 16 * it;
            {
                LAS unsigned char* dst = ch < 8 ? lds + L_TW + j * RS + ch * 16 : ch < 16 ? lds + L_AL + j * RS + (ch - 8) * 16 : lds + L_SG + j * 272 + (ch - 16) * 16;
                const int tn = dir ? t0 + 63 - j : t0 + j;
                const float mp = tn > 0 ? 0.5f : 0.f, mn = tn < SEQ - 1 ? 0.5f : 0.f;
                float fc[8], fp[8], fn[8], o[8]; unpack8(R.xc[it], fc); unpack8(xpv[it], fp); unpack8(xnv[it], fn);
#pragma unroll
                for (int e = 0; e < 8; ++e) { const float v = fc[e] + mu[e] * ((mp * fp[e] + mn * fn[e]) - fc[e]); o[e] = ca * sigmoidf_(cs * v) + cbb + ci * v; }
                *(LAS u32x4*)dst = pack8(o);
            }
            __builtin_amdgcn_sched_barrier(0);
        }
    }
    }
    bf16x8 bw[2][2], ba[2][2]; float w0v[2], a0v[2];
    {
        const bf16_t* LORA = (const bf16_t*)(ws + WS_LORA);
        const bf16_t* W2t = LORA + (size_t)dir * 32768; const bf16_t* A2t = LORA + (size_t)(2 + dir) * 32768;
        const float* w0 = dir ? P.w0_b : P.w0_f; const float* a0 = dir ? P.a0_b : P.a0_f;
#pragma unroll
        for (int t = 0; t < 2; ++t) { const int hn = h * 64 + 16 * (cb0 + t) + (lane & 15);
            w0v[t] = w0[hn]; a0v[t] = a0[hn];
#pragma unroll
            for (int kk = 0; kk < 2; ++kk) { bw[t][kk] = *(const bf16x8*)(W2t + (size_t)hn * 64 + 8 * (lane >> 4) + 32 * kk); ba[t][kk] = *(const bf16x8*)(A2t + (size_t)hn * 64 + 8 * (lane >> 4) + 32 * kk); }
        }
    }
    bf16x8 bg[2][4];
    const bool mine = ((h >> 2) == dir);
    if (mine) { const bf16_t* G2t = (const bf16_t*)(ws + WS_LORA) + (size_t)4 * 32768;
#pragma unroll
        for (int t = 0; t < 2; ++t) { const int hn = h * 64 + 16 * (cb0 + t) + (lane & 15);
#pragma unroll
            for (int kk = 0; kk < 4; ++kk) bg[t][kk] = *(const bf16x8*)(G2t + (size_t)hn * 128 + 8 * (lane >> 4) + 32 * kk); } }
    PROBE_END(1)
    if (lora) __syncthreads();
    PROBE_BEGIN(2)
    {
        bf16_t* Gout = (bf16_t*)(ws + WS_G);
#pragma unroll
        for (int t = 0; t < 2; ++t) {
            const int cb = cb0 + t, n = 16 * cb + (lane & 15), hn = h * 64 + n;
            f32x4 zw = {0.f, 0.f, 0.f, 0.f}, za = {0.f, 0.f, 0.f, 0.f};
            const LAS unsigned char* ap_w = lds + L_TW + (16 * rb + (lane & 15)) * RS + (lane >> 4) * 16;
            const LAS unsigned char* ap_a = lds + L_AL + (16 * rb + (lane & 15)) * RS + (lane >> 4) * 16;
#pragma unroll
            for (int kk = 0; kk < 2; ++kk) {
                zw = __builtin_amdgcn_mfma_f32_16x16x32_bf16(*(const LAS bf16x8*)(ap_w + kk * 64), bw[t][kk], zw, 0, 0, 0);
                za = __builtin_amdgcn_mfma_f32_16x16x32_bf16(*(const LAS bf16x8*)(ap_a + kk * 64), ba[t][kk], za, 0, 0, 0);
            }
            float hs = 0.f;
#pragma unroll
            for (int r = 0; r < 4; ++r) { const int j = 16 * rb + 4 * (lane >> 4) + r;
                const float lwv = -0.60653066f * sigmoidf_(w0v[t] + zw[r]); hs += lwv;
                *(LAS float*)(lds + L_LW + (j * 64 + n) * 4) = lwv;
                *(LAS float*)(lds + L_AA + (j * 64 + n) * 4) = sigmoidf_(a0v[t] + za[r]); }
            hs += __shfl_xor(hs, 16);
            if (((lane >> 4) & 1) == 0) *(LAS float*)(lds + L_HS + ((2 * rb + (lane >> 5)) * 64 + n) * 4) = hs;
            if (mine) {
                f32x4 zg = {0.f, 0.f, 0.f, 0.f};
                const LAS unsigned char* ap_g = lds + L_SG + (16 * rb + (lane & 15)) * 272 + (lane >> 4) * 16;
#pragma unroll
                for (int kk = 0; kk < 4; ++kk) zg = __builtin_amdgcn_mfma_f32_16x16x32_bf16(*(const LAS bf16x8*)(ap_g + kk * 64), bg[t][kk], zg, 0, 0, 0);
#pragma unroll
                for (int r = 0; r < 4; ++r) { const int j = 16 * rb + 4 * (lane >> 4) + r; Gout[(size_t)(tb + (dir ? t0 + 63 - j : t0 + j)) * 512 + hn] = (bf16_t)f2bf(zg[r]); }
            }
        }
    }
    PROBE_END(2)
    __syncthreads();
    PROBE_BEGIN(3)
    if (tid == 0) *(volatile LAS unsigned*)(lds + L_EX + 4096) = 0u;
    {
        float total = 0.f, pre = 0.f;
        { float h8[8];
#pragma unroll
          for (int q = 0; q < 8; ++q) h8[q] = *(const LAS float*)(lds + L_HS + (q * 64 + lane) * 4);
#pragma unroll
          for (int q = 0; q < 8; ++q) { if (q < wid) pre += h8[q]; else total += h8[q]; } }
        total += pre;
        __builtin_amdgcn_sched_barrier(0);
        float* BON = (float*)(ws + WS_BON); bf16_t* VS = (bf16_t*)(ws + WS_VS);
        float at_[8], bh_[8], kh_[8];
        float red[16], kd_[8], av_[8], lwv_[8];
#pragma unroll
        for (int jj = 0; jj < 8; ++jj) {
            const int j = 8 * wid + jj;
            lwv_[jj] = *(const LAS float*)(lds + L_LW + (j * 64 + lane) * 4); av_[jj] = *(const LAS float*)(lds + L_AA + (j * 64 + lane) * 4);
            const float kraw = kr[jj] * kkw;
            kd_[jj] = kr[jj] * (1.f + (av_[jj] - 1.f) * kaw);
            red[jj] = kraw * kraw; red[8 + jj] = rr[jj] * kd_[jj] * rkw;
        }
        wave_sum_n<16>(red);
#pragma unroll
        for (int jj = 0; jj < 8; ++jj) {
            const int j = 8 * wid + jj, tok = tb + (dir ? t0 + 63 - j : t0 + j);
            const float lwj = lwv_[jj], a = av_[jj];
            const float lw_prev = pre; pre += lwj; const float lw = pre;
            const float kkv = (kr[jj] * kkw) * __builtin_amdgcn_rsqf(fmaxf(red[jj], 1e-24f));
            const float kd = kd_[jj], bb = kkv * a;
            if (lane == 0) BON[((size_t)dir * NTOK + tok) * 8 + h] = red[8 + jj];
            if (mine) VS[(size_t)tok * 512 + hi] = (bf16_t)f2bf(vr[jj]);
            const float eprev = __expf(lw_prev), einv = __expf(-lw), ee = __expf(lw), eh = __expf(total - lw);
            at_[jj] = -kkv * eprev; bh_[jj] = bb * eh; kh_[jj] = kd * eh;
            *(LAS bf16_t*)(lds + L_AT + j * RS + lane * 2) = (bf16_t)f2bf(at_[jj]);
            *(LAS bf16_t*)(lds + L_BT + j * RS + lane * 2) = (bf16_t)f2bf(bb * einv);
            *(LAS bf16_t*)(lds + L_KT + j * RS + lane * 2) = (bf16_t)f2bf(kd * einv);
            *(LAS bf16_t*)(lds + L_RT + j * RS + lane * 2) = (bf16_t)f2bf(rr[jj] * ee);
        }
        *(LAS u32x4*)(lds + L_ATT + lane * RS + wid * 16) = pack8(at_);
        *(LAS u32x4*)(lds + L_BHT + lane * RS + wid * 16) = pack8(bh_);
        *(LAS u32x4*)(lds + L_KHT + lane * RS + wid * 16) = pack8(kh_);
        *(LAS u32x4*)(lds + L_VT + lane * RS + wid * 16) = pack8(vr);
        if (wid == 0) *(LAS float*)(lds + L_WC + lane * 4) = __expf(total);
    }
    PROBE_END(3)
    __syncthreads();
    if (has_next) rwkv_prefetch<DIR>(P, F, nitem, sink);
    PROBE_BEGIN(4)
    int lane_o = F.lane; asm volatile("" : "+v"(lane_o));
    const int q4 = 4 * (lane_o >> 4);
    const f32x4 zero4 = {0.f, 0.f, 0.f, 0.f};
    if (wid < 2) {
        const int r = lane_o & 31, hh = lane_o >> 5, blk = wid;
        f32x16 Lp, Lpt, Tm, Tt;
        {
            f32x16 z; for (int i = 0; i < 16; ++i) z[i] = 0.f;
            Lp = z; Lpt = z;
            const LAS unsigned char* pa = lds + L_AT + (32 * blk + r) * RS + 16 * hh; const LAS unsigned char* pb = lds + L_BT + (32 * blk + r) * RS + 16 * hh;
#pragma unroll
            for (int ks = 0; ks < 4; ++ks) { const bf16x8 fa = *(const LAS bf16x8*)(pa + 32 * ks), fb = *(const LAS bf16x8*)(pb + 32 * ks);
                Lp = MFMA32(fa, fb, Lp); Lpt = MFMA32(fb, fa, Lpt); }
#pragma unroll
            for (int i = 0; i < 16; ++i) { const int row = (i & 3) + 8 * (i >> 2) + 4 * hh;
                Lp[i] = (row > r) ? Lp[i] : 0.f; Lpt[i] = (r > row) ? Lpt[i] : 0.f;
                Tm[i] = Lp[i] + ((row == r) ? 1.f : 0.f); Tt[i] = Lpt[i] + ((row == r) ? 1.f : 0.f); }
        }
#pragma unroll
        for (int itn = 1; itn <= 5; ++itn) {
            const bf16x8 pL0 = pack_step(Lp, 0), pL1 = pack_step(Lp, 1), pLt0 = pack_step(Lpt, 0), pLt1 = pack_step(Lpt, 1);
            if (itn >= 2) { const bf16x8 pTt0 = pack_step(Tt, 0), pTt1 = pack_step(Tt, 1);
                Tm = MFMA32(pTt0, pL0, Tm); Tm = MFMA32(pTt1, pL1, Tm);
                Tt = MFMA32(pL0, pTt0, Tt); Tt = MFMA32(pL1, pTt1, Tt); }
            if (itn <= 4) { f32x16 z; for (int i = 0; i < 16; ++i) z[i] = 0.f;
                f32x16 n1 = MFMA32(pLt0, pL0, z); n1 = MFMA32(pLt1, pL1, n1);
                f32x16 n2 = MFMA32(pL0, pLt0, z); n2 = MFMA32(pL1, pLt1, n2);
                Lp = n1; Lpt = n2; }
        }
        volatile LAS unsigned* xflag = (volatile LAS unsigned*)(lds + L_EX + 4096);
        if (wid == 0) {
            LAS unsigned char* ex = lds + L_EX + lane * 64;
#pragma unroll
            for (int g = 0; g < 4; ++g) *(LAS f32x4*)(ex + 16 * g) = (f32x4){Tm[4 * g], Tm[4 * g + 1], Tm[4 * g + 2], Tm[4 * g + 3]};
            asm volatile("s_waitcnt lgkmcnt(0)" ::: "memory");
            *xflag = 1u;
#pragma unroll
            for (int g = 0; g < 4; ++g) st4bf(lds + L_T1 + r * RS + (8 * g + 4 * hh) * 2, (f32x4){Tt[4 * g], Tt[4 * g + 1], Tt[4 * g + 2], Tt[4 * g + 3]});
            const u32x4 z4 = {0u, 0u, 0u, 0u};
            *(LAS u32x4*)(lds + L_T1 + r * RS + (32 + 16 * hh) * 2) = z4; *(LAS u32x4*)(lds + L_T1 + r * RS + (32 + 16 * hh) * 2 + 16) = z4;
        } else {
            f32x16 L21; for (int i = 0; i < 16; ++i) L21[i] = 0.f;
            { const LAS unsigned char* pa = lds + L_AT + (32 + r) * RS + 16 * hh; const LAS unsigned char* pb = lds + L_BT + r * RS + 16 * hh;
#pragma unroll
              for (int ks = 0; ks < 4; ++ks) L21 = MFMA32(*(const LAS bf16x8*)(pa + 32 * ks), *(const LAS bf16x8*)(pb + 32 * ks), L21); }
            f32x16 U; for (int i = 0; i < 16; ++i) U[i] = 0.f;
            { const bf16x8 a0 = pack_step(L21, 0), a1 = pack_step(L21, 1), b0 = pack_step(Tt, 0), b1 = pack_step(Tt, 1);
              U = MFMA32(a0, b0, U); U = MFMA32(a1, b1, U); }
            asm volatile("" ::: "memory");
            while (*xflag == 0u) __builtin_amdgcn_s_sleep(1);
            asm volatile("" ::: "memory");
            f32x16 T11;
            { const LAS unsigned char* ex = lds + L_EX + lane * 64;
#pragma unroll
              for (int g = 0; g < 4; ++g) { const f32x4 v = *(const LAS f32x4*)(ex + 16 * g); T11[4 * g] = v[0]; T11[4 * g + 1] = v[1]; T11[4 * g + 2] = v[2]; T11[4 * g + 3] = v[3]; } }
            f32x16 T21t; for (int i = 0; i < 16; ++i) T21t[i] = 0.f;
            { const bf16x8 a0 = pack_step(T11, 0), a1 = pack_step(T11, 1), b0 = pack_step(U, 0), b1 = pack_step(U, 1);
              T21t = MFMA32(a0, b0, T21t); T21t = MFMA32(a1, b1, T21t); }
#pragma unroll
            for (int g = 0; g < 4; ++g) {
                st4bf(lds + L_T1 + (32 + r) * RS + (8 * g + 4 * hh) * 2, (f32x4){T21t[4 * g], T21t[4 * g + 1], T21t[4 * g + 2], T21t[4 * g + 3]});
                st4bf(lds + L_T1 + (32 + r) * RS + (32 + 8 * g + 4 * hh) * 2, (f32x4){Tt[4 * g], Tt[4 * g + 1], Tt[4 * g + 2], Tt[4 * g + 3]}); }
        }
    } else {
        const int w6 = wid - 2, prod = w6 >> 1, half = w6 & 1;
        const int offA = prod == 0 ? L_AT : L_RT, offB = prod == 1 ? L_BT : L_KT, offO = prod == 0 ? L_LAK : prod == 1 ? L_RB : L_RK;
#pragma unroll
        for (int rr2 = 0; rr2 < 2; ++rr2) { const int rbx = 2 * half + rr2, jrx = 16 * rbx + (lane_o & 15);
#pragma unroll
            for (int cb = 0; cb < 4; ++cb) {
                f32x4 v = zero4;
                if (cb <= rbx) { v = tile_s<2>(lds + offA + 16 * rbx * RS, RS, lds + offB + 16 * cb * RS, RS, zero4, lane);
#pragma unroll
                    for (int q = 0; q < 4; ++q) { const int s = 16 * cb + q4 + q; const bool keep = (prod == 0) ? (jrx > s) : (jrx >= s); v[q] = keep ? v[q] : 0.f; } }
                st4bf(lds + offO + jrx * RS + (16 * cb + q4) * 2, v);
            } }
    }
    __syncthreads();
    PROBE_END(4)
    PROBE_BEGIN(5)
    {
        bf16_t* RM = (bf16_t*)(ws + WS_RM) + (size_t)item * 4096; bf16_t* RP = (bf16_t*)(ws + WS_RP) + (size_t)item * 4096; bf16_t* RNT = (bf16_t*)(ws + WS_RNT) + (size_t)item * 4096;
        bf16_t* Y = (bf16_t*)(ws + (dir ? WS_YB : WS_YF));
        const int pg4 = 4 * ((lane_o >> 4) == 1 ? 2 : (lane_o >> 4) == 2 ? 1 : (lane_o >> 4));
        const int cbv = wid & 3;
        Frag2 fv;
        if (wid >= 4) {
            fv = ld_frag2(lds + L_VT + 16 * cbv * RS, RS, lane);
#pragma unroll
            for (int rbx = 0; rbx < 4; ++rbx) { const f32x4 g1 = tile_nb(lds + L_LAK + 16 * rbx * RS, RS, fv, zero4, lane);
                st4bf(lds + L_G1T + (16 * cbv + (lane & 15)) * RS + (16 * rbx + q4) * 2, g1); }
        }
        {
            const Frag2 fb = ld_frag2((wid < 4) ? (lds + L_ATT + 16 * cbv * RS) : (lds + L_G1T + 16 * cbv * RS), RS, lane);
#pragma unroll
            for (int rbx = 0; rbx < 4; ++rbx) { const f32x4 xv = tile_nb(lds + L_T1 + 16 * rbx * RS, RS, fb, zero4, lane);
                st4bf(lds + L_XT + (16 * wid + (lane & 15)) * RS + (16 * rbx + q4) * 2, xv); }
        }
        const Frag2 fx = ld_frag2(lds + L_XT + 16 * wid * RS, RS, lane);
        if (wid < 4) {
#pragma unroll
            for (int rbx = 0; rbx < 4; ++rbx) { const int jrx = 16 * rbx + (lane_o & 15);
                f32x4 mv = tile_sb(lds + L_BHT + 16 * rbx * RS, RS, fx, zero4, lane);
                { const float wc = *(const LAS float*)(lds + L_WC + jrx * 4);
#pragma unroll
                  for (int q = 0; q < 4; ++q) mv[q] += (jrx == 16 * cbv + q4 + q) ? wc : 0.f; }
                st4bf_g(RM + jrx * 64 + 16 * cbv + pg4, mv);
                f32x4 pv = tile_sb(lds + L_RB + 16 * rbx * RS, RS, fx, zero4, lane);
                { const u32x2 rv = *(const LAS u32x2*)(lds + L_RT + jrx * RS + (16 * cbv + q4) * 2);
                  pv[0] += bf2f(rv.x & 0xffffu); pv[1] += bf2f(rv.x >> 16); pv[2] += bf2f(rv.y & 0xffffu); pv[3] += bf2f(rv.y >> 16); }
                st4bf_g(RP + jrx * 64 + 16 * cbv + pg4, pv); }
        } else {
#pragma unroll
            for (int rbx = 0; rbx < 4; ++rbx) {
                f32x4 nv = tile_nb(lds + L_BHT + 16 * rbx * RS, RS, fx, zero4, lane);
                nv = tile_nb(lds + L_KHT + 16 * rbx * RS, RS, fv, nv, lane);
                st4bf_g(RNT + (16 * cbv + (lane & 15)) * 64 + 16 * rbx + q4, nv);
                f32x4 zv = tile_nb(lds + L_RB + 16 * rbx * RS, RS, fx, zero4, lane);
                zv = tile_nb(lds + L_RK + 16 * rbx * RS, RS, fv, zv, lane);
                { const int j0 = 16 * rbx + q4, tokb = tb + (dir ? t0 + 60 - j0 : t0 + j0);
                  const f32x4 zs = dir ? (f32x4){zv[3], zv[2], zv[1], zv[0]} : zv;
                  st4bf_g(Y + ((size_t)(tokb >> 2) * 512 + h * 64 + 16 * cbv + (lane & 15)) * 4, zs); } }
        }
    }
    PROBE_END(5)
    __syncthreads();
}

constexpr int CH_NSLOT = 16, CH_NCONS = 7;
constexpr int CH_RING = 0, CH_FLAGS = CH_NSLOT * 4096;
__device__ __forceinline__ void ch_wait_ge(volatile LAS unsigned* w, unsigned v) { asm volatile("" ::: "memory"); while (*w < v) __builtin_amdgcn_s_sleep(1); asm volatile("" ::: "memory"); }
__device__ __forceinline__ void ch_publish(ldsp_t lds, int st, int lane, const bf16x8& b00, const bf16x8& b01, const bf16x8& b10, const bf16x8& b11) {
    volatile LAS unsigned* fl = (volatile LAS unsigned*)(lds + CH_FLAGS);
    if (st >= CH_NSLOT) { const int old = st - CH_NSLOT; ch_wait_ge(fl + 16 + (old % CH_NCONS) * 16, (unsigned)(old + 1)); }
    LAS unsigned char* slot = lds + CH_RING + (st % CH_NSLOT) * 4096 + lane * 16;
    *(LAS bf16x8*)(slot) = b00; *(LAS bf16x8*)(slot + 1024) = b01; *(LAS bf16x8*)(slot + 2048) = b10; *(LAS bf16x8*)(slot + 3072) = b11;
    asm volatile("s_waitcnt lgkmcnt(0)" ::: "memory");
    fl[0] = (unsigned)(st + 1);
}
__device__ __forceinline__ void ch_consume(ldsp_t lds, int st, int cons, int lane, bf16x8& b00, bf16x8& b01, bf16x8& b10, bf16x8& b11) {
    volatile LAS unsigned* fl = (volatile LAS unsigned*)(lds + CH_FLAGS);
    ch_wait_ge(fl, (unsigned)(st + 1));
    const LAS unsigned char* slot = lds + CH_RING + (st % CH_NSLOT) * 4096 + lane * 16;
    b00 = *(const LAS bf16x8*)(slot); b01 = *(const LAS bf16x8*)(slot + 1024); b10 = *(const LAS bf16x8*)(slot + 2048); b11 = *(const LAS bf16x8*)(slot + 3072);
    asm volatile("s_waitcnt lgkmcnt(0)" ::: "memory");
    fl[16 + cons * 16] = (unsigned)(st + 1);
}
__device__ __forceinline__ void rwkv_ld_mn(const unsigned char* ws, int item, int vh, int r, int hh, bf16x8 (&Mf)[8], u32x2 (&Nf)[8]) {
    const bf16_t* RM = (const bf16_t*)(ws + WS_RM) + (size_t)item * 4096; const bf16_t* RNT = (const bf16_t*)(ws + WS_RNT) + (size_t)item * 4096;
#pragma unroll
    for (int kb = 0; kb < 2; ++kb) {
        const bf16_t* ap = RM + (32 * kb + r) * 64 + 8 * hh;
#pragma unroll
        for (int q = 0; q < 4; ++q) Mf[4 * kb + q] = *(const bf16x8*)(ap + 16 * q);
#pragma unroll
        for (int g = 0; g < 4; ++g) Nf[4 * kb + g] = *(const u32x2*)(RNT + (32 * vh + r) * 64 + 32 * kb + 8 * g + 4 * hh);
    }
}
__device__ __forceinline__ void rwkv_prod_step(ldsp_t lds, const unsigned char* ws, int b, int h, int dir, int vh, int lane, int st,
                                               f32x16& X0, f32x16& X1, const bf16x8 (&Mc)[8], const u32x2 (&Nc)[8], bf16x8 (&Mn)[8], u32x2 (&Nn)[8]) {
    const int r = lane & 31, hh = lane >> 5;
    const int stn = st < 62 ? st + 2 : 63, cn = dir ? 63 - stn : stn, itemn = ((b * 64 + cn) * 8 + h) * 2 + dir;
    rwkv_ld_mn(ws, itemn, vh, r, hh, Mn, Nn);
    const bf16x8 b00 = pack_step(X0, 0), b01 = pack_step(X0, 1), b10 = pack_step(X1, 0), b11 = pack_step(X1, 1);
    ch_publish(lds, st, lane, b00, b01, b10, b11);
    f32x16 Hn[2];
#pragma unroll
    for (int kb = 0; kb < 2; ++kb) {
#pragma unroll
        for (int g = 0; g < 4; ++g) { const u32x2 nv = Nc[4 * kb + g];
            Hn[kb][4 * g + 0] = bf2f(nv.x & 0xffffu); Hn[kb][4 * g + 1] = bf2f(nv.x >> 16); Hn[kb][4 * g + 2] = bf2f(nv.y & 0xffffu); Hn[kb][4 * g + 3] = bf2f(nv.y >> 16); }
        Hn[kb] = MFMA32(Mc[4 * kb + 0], b00, Hn[kb]);
        Hn[kb] = MFMA32(Mc[4 * kb + 1], b01, Hn[kb]);
        Hn[kb] = MFMA32(Mc[4 * kb + 2], b10, Hn[kb]);
        Hn[kb] = MFMA32(Mc[4 * kb + 3], b11, Hn[kb]);
    }
    X0 = Hn[0]; X1 = Hn[1];
}
__device__ __forceinline__ void rwkv_producer(const Params& P, ldsp_t lds, const int chain, const int lane) {
    const int vh = chain & 1, dir = (chain >> 1) & 1, h = (chain >> 2) & 7, b = chain >> 5;
    const unsigned char* ws = P.ws;
    f32x16 X0, X1;
#pragma unroll
    for (int i = 0; i < 16; ++i) { X0[i] = 0.f; X1[i] = 0.f; }
    bf16x8 MA[8], MB[8], MC[8]; u32x2 NA[8], NB[8], NC[8];
    { const int c0 = dir ? 63 : 0, c1 = dir ? 62 : 1;
      rwkv_ld_mn(ws, ((b * 64 + c0) * 8 + h) * 2 + dir, vh, lane & 31, lane >> 5, MA, NA);
      rwkv_ld_mn(ws, ((b * 64 + c1) * 8 + h) * 2 + dir, vh, lane & 31, lane >> 5, MB, NB); }
#pragma unroll 1
    for (int st = 0; st < 63; st += 3) {
        rwkv_prod_step(lds, ws, b, h, dir, vh, lane, st, X0, X1, MA, NA, MC, NC);
        rwkv_prod_step(lds, ws, b, h, dir, vh, lane, st + 1, X0, X1, MB, NB, MA, NA);
        rwkv_prod_step(lds, ws, b, h, dir, vh, lane, st + 2, X0, X1, MC, NC, MB, NB);
    }
    rwkv_prod_step(lds, ws, b, h, dir, vh, lane, 63, X0, X1, MA, NA, MC, NC);
}
struct ChOps { bf16x8 A[8]; u32x2 Z[8]; };
template <bool GLA>
__device__ __forceinline__ void ch_ld_ops(const Params& P, int chain, int st, int lane, ChOps& o) {
    const int r = lane & 31, hh = lane >> 5;
    int b, dir, item, col; const bf16_t* A; const bf16_t* Yb;
    if (GLA) { const int qt = chain & 3, hd = (chain >> 3) & 3; dir = (chain >> 2) & 1; b = chain >> 5; const int c = dir ? 63 - st : st;
        item = ((b * 64 + c) * 4 + hd) * 2 + dir; col = hd * 128 + 32 * qt + r;
        A = (const bf16_t*)((const unsigned char*)P.out + OUT_GQ) + (size_t)item * 4096;
        Yb = (const bf16_t*)(P.ws + (dir ? WS_OB : WS_OF)) + ((size_t)((b * SEQ + c * 64) >> 2) * 512 + col) * 4;
    } else { const int vh = chain & 1, h = (chain >> 2) & 7; dir = (chain >> 1) & 1; b = chain >> 5; const int c = dir ? 63 - st : st;
        item = ((b * 64 + c) * 8 + h) * 2 + dir; col = h * 64 + 32 * vh + r;
        A = (const bf16_t*)(P.ws + WS_RP) + (size_t)item * 4096;
        Yb = (const bf16_t*)(P.ws + (dir ? WS_YB : WS_YF)) + ((size_t)((b * SEQ + c * 64) >> 2) * 512 + col) * 4; }
#pragma unroll
    for (int jb = 0; jb < 2; ++jb) {
        const bf16_t* ap = A + (32 * jb + r) * 64 + 8 * hh;
#pragma unroll
        for (int q = 0; q < 4; ++q) o.A[4 * jb + q] = *(const bf16x8*)(ap + 16 * q);
#pragma unroll
        for (int g = 0; g < 4; ++g) { const int j0 = 32 * jb + 8 * g + 4 * hh, tg = (dir ? 60 - j0 : j0) >> 2; o.Z[4 * jb + g] = *(const u32x2*)(Yb + (size_t)tg * 2048); }
    }
}
template <bool GLA>
__device__ __forceinline__ void ch_out_step(const Params& P, ldsp_t lds, int chain, int cons, int st, int lane, const ChOps& o) {
    const int r = lane & 31, hh = lane >> 5;
    int b, dir, col; bf16_t* Yb;
    if (GLA) { const int qt = chain & 3, hd = (chain >> 3) & 3; dir = (chain >> 2) & 1; b = chain >> 5; const int c = dir ? 63 - st : st; col = hd * 128 + 32 * qt + r;
        Yb = (bf16_t*)(P.ws + (dir ? WS_OB : WS_OF)) + ((size_t)((b * SEQ + c * 64) >> 2) * 512 + col) * 4;
    } else { const int vh = chain & 1, h = (chain >> 2) & 7; dir = (chain >> 1) & 1; b = chain >> 5; const int c = dir ? 63 - st : st; col = h * 64 + 32 * vh + r;
        Yb = (bf16_t*)(P.ws + (dir ? WS_YB : WS_YF)) + ((size_t)((b * SEQ + c * 64) >> 2) * 512 + col) * 4; }
    bf16x8 b00, b01, b10, b11;
    ch_consume(lds, st, cons, lane, b00, b01, b10, b11);
#pragma unroll
    for (int jb = 0; jb < 2; ++jb) {
        f32x16 Yv;
#pragma unroll
        for (int g = 0; g < 4; ++g) { const u32x2 z = o.Z[4 * jb + g];
            const float p0 = bf2f(z.x & 0xffffu), p1 = bf2f(z.x >> 16), p2 = bf2f(z.y & 0xffffu), p3 = bf2f(z.y >> 16);
            Yv[4 * g + 0] = dir ? p3 : p0; Yv[4 * g + 1] = dir ? p2 : p1; Yv[4 * g + 2] = dir ? p1 : p2; Yv[4 * g + 3] = dir ? p0 : p3; }
        Yv = MFMA32(o.A[4 * jb + 0], b00, Yv);
        Yv = MFMA32(o.A[4 * jb + 1], b01, Yv);
        Yv = MFMA32(o.A[4 * jb + 2], b10, Yv);
        Yv = MFMA32(o.A[4 * jb + 3], b11, Yv);
#pragma unroll
        for (int g = 0; g < 4; ++g) { const int j0 = 32 * jb + 8 * g + 4 * hh, tg = (dir ? 60 - j0 : j0) >> 2;
            u32x2 ov; ov.x = dir ? pk2(Yv[4 * g + 3], Yv[4 * g + 2]) : pk2(Yv[4 * g + 0], Yv[4 * g + 1]); ov.y = dir ? pk2(Yv[4 * g + 1], Yv[4 * g + 0]) : pk2(Yv[4 * g + 2], Yv[4 * g + 3]);
            *(u32x2*)(Yb + (size_t)tg * 2048) = ov; }
    }
}
template <bool GLA>
__device__ __forceinline__ void chain_consumer(const Params& P, ldsp_t lds, const int chain, const int cons, const int lane) {
    ChOps OA, OB, OC;
    int st = cons;
    if (st < 64) ch_ld_ops<GLA>(P, chain, st, lane, OA);
    if (st + CH_NCONS < 64) ch_ld_ops<GLA>(P, chain, st + CH_NCONS, lane, OB);
#pragma unroll 1
    while (st < 64) {
        const int s1 = st + CH_NCONS, s2 = st + 2 * CH_NCONS, s3 = st + 3 * CH_NCONS, s4 = st + 4 * CH_NCONS;
        if (s2 < 64) ch_ld_ops<GLA>(P, chain, s2, lane, OC);
        ch_out_step<GLA>(P, lds, chain, cons, st, lane, OA);
        if (s1 >= 64) break;
        if (s3 < 64) ch_ld_ops<GLA>(P, chain, s3, lane, OA);
        ch_out_step<GLA>(P, lds, chain, cons, s1, lane, OB);
        if (s2 >= 64) break;
        if (s4 < 64) ch_ld_ops<GLA>(P, chain, s4, lane, OB);
        ch_out_step<GLA>(P, lds, chain, cons, s2, lane, OC);
        st = s3;
    }
}

constexpr int G_QT = 0, G_KT = RMS_, G_KHT = 2 * RMS_, G_VT = 3 * RMS_, G_AM = 5 * RMS_, G_GK = 6 * RMS_, G_SLOT = 6 * RMS_ + 16384 + 2048;
static_assert(2 * G_SLOT <= LDS_MISC, "gla LDS map");
struct GlaSt { float qv[8], kv[8]; };
template <int DIR>
__device__ __forceinline__ void gla_s1(const Params& P, const Ctx& F, const int item, ldsp_t lds, GlaSt& S) {
    const int lane = F.lane, wid = F.wid; constexpr int dir = DIR;
    const int hd = (item >> 1) & 3, c = (item >> 3) & 63, b = item >> 9;
    const int t0 = c * 64, tb = b * SEQ;
    const bf16_t* PB = (const bf16_t*)(P.ws + WS_PB);
    const int hi = hd * 64 + lane;
    const float* gw2 = dir ? P.gw2_b : P.gw2_f; const float* gb = dir ? P.gb_b : P.gb_f;
    float w2[16];
#pragma unroll
    for (int m = 0; m < 16; ++m) w2[m] = gw2[m * 256 + hi];
    const float gbv = gb[hi];
    float v0[8], v1[8];
    u32x4 g0a[8], g1a[8]; unsigned rq[8], rk[8], r0[8], r1[8];
#pragma unroll
    for (int jj = 0; jj < 8; ++jj) {
        const int j = 8 * wid + jj, tok = tb + (dir ? t0 + 63 - j : t0 + j);
        const bf16_t* row = PB + (size_t)tok * LDB_GL;
        g0a[jj] = *(const u32x4*)(row + 1024 + 16 * dir); g1a[jj] = *(const u32x4*)(row + 1024 + 16 * dir + 8);
        rq[jj] = row[hi]; rk[jj] = row[256 + hi]; r0[jj] = row[512 + hd * 128 + lane]; r1[jj] = row[512 + hd * 128 + 64 + lane];
    }
    __builtin_amdgcn_sched_barrier(0);
#pragma unroll
    for (int jj = 0; jj < 8; ++jj) {
        const int j = 8 * wid + jj;
        float gl[16]; { float t8[8]; unpack8(g0a[jj], t8);
#pragma unroll
            for (int e = 0; e < 8; ++e) gl[e] = t8[e];
            unpack8(g1a[jj], t8);
#pragma unroll
            for (int e = 0; e < 8; ++e) gl[8 + e] = t8[e]; }
        float z = gbv;
#pragma unroll
        for (int m = 0; m < 16; ++m) z += gl[m] * w2[m];
        const float ls = fminf(z, 0.f) - __logf(1.f + __expf(-fabsf(z)));
        *(LAS float*)(lds + G_GK + (j * 64 + lane) * 4) = ls * (1.f / 16.f);
        S.qv[jj] = bf2f(rq[jj]) * 0.125f; S.kv[jj] = bf2f(rk[jj]);
        v0[jj] = bf2f(r0[jj]); v1[jj] = bf2f(r1[jj]);
    }
    *(LAS u32x4*)(lds + G_VT + lane * RS + wid * 16) = pack8(v0);
    *(LAS u32x4*)(lds + G_VT + (64 + lane) * RS + wid * 16) = pack8(v1);
}
__device__ __forceinline__ void gla_s2(const Params& P, const Ctx& F, const int item, ldsp_t lds, const GlaSt& S) {
    const int lane = F.lane, wid = F.wid;
    float total = 0.f, pre = 0.f;
#pragma unroll 1
    for (int s0 = 0; s0 < 8; s0 += 2) { float t8[16];
#pragma unroll
        for (int u = 0; u < 16; ++u) t8[u] = *(const LAS float*)(lds + G_GK + ((8 * s0 + u) * 64 + lane) * 4);
        const float sa = ((t8[0] + t8[1]) + (t8[2] + t8[3])) + ((t8[4] + t8[5]) + (t8[6] + t8[7]));
        const float sb = ((t8[8] + t8[9]) + (t8[10] + t8[11])) + ((t8[12] + t8[13]) + (t8[14] + t8[15]));
        if (s0 < wid) pre += sa; else total += sa;
        if (s0 + 1 < wid) pre += sb; else total += sb; }
    total += pre;
    bf16_t* GQ = (bf16_t*)((unsigned char*)P.out + OUT_GQ) + (size_t)item * 4096;
    const int blk = lane >> 4, g4 = (lane >> 2) & 3, pgp = (g4 == 1) ? 2 : (g4 == 2) ? 1 : g4;
    const int pcol = 16 * blk + 4 * pgp + (lane & 3);
    float kh_[8];
#pragma unroll
    for (int jj = 0; jj < 8; ++jj) {
        const int j = 8 * wid + jj;
        pre += *(const LAS float*)(lds + G_GK + (j * 64 + lane) * 4);
        const float e = __expf(pre), einv = __expf(-pre), eh = __expf(total - pre);
        const float qs = S.qv[jj] * e;
        *(LAS bf16_t*)(lds + G_QT + j * RS + lane * 2) = (bf16_t)f2bf(qs);
        *(LAS bf16_t*)(lds + G_KT + j * RS + lane * 2) = (bf16_t)f2bf(S.kv[jj] * einv);
        kh_[jj] = S.kv[jj] * eh;
        GQ[j * 64 + pcol] = (bf16_t)f2bf(qs);
    }
    *(LAS u32x4*)(lds + G_KHT + lane * RS + wid * 16) = pack8(kh_);
    if (wid == 0) ((float*)(P.ws + WS_DEC))[(size_t)item * 64 + lane] = __expf(total);
}
__device__ __forceinline__ void gla_s3(const Ctx& F, ldsp_t lds) {
    const int lane = F.lane, wid = F.wid;
    const int rb = wid >> 1, cb0 = 2 * (wid & 1), jr = 16 * rb + (lane & 15), q4 = 4 * (lane >> 4);
    const f32x4 zero4 = {0.f, 0.f, 0.f, 0.f};
#pragma unroll
    for (int t = 0; t < 2; ++t) { const int cb = cb0 + t;
        f32x4 av = tile_s<2>(lds + G_QT + 16 * rb * RS, RS, lds + G_KT + 16 * cb * RS, RS, zero4, lane);
#pragma unroll
        for (int r = 0; r < 4; ++r) av[r] = (jr >= 16 * cb + q4 + r) ? av[r] : 0.f;
        st4bf(lds + G_AM + jr * RS + (16 * cb + q4) * 2, av); }
}
template <int DIR>
__device__ __forceinline__ void gla_s4(const Params& P, const Ctx& F, const int item, ldsp_t lds) {
    const int lane = F.lane, wid = F.wid; constexpr int dir = DIR;
    const int hd = (item >> 1) & 3, c = (item >> 3) & 63, b = item >> 9, t0 = c * 64, tb = b * SEQ;
    const int rb = wid >> 1, q4 = 4 * (lane >> 4);
    const f32x4 zero4 = {0.f, 0.f, 0.f, 0.f};
    bf16_t* O = (bf16_t*)(P.ws + (dir ? WS_OB : WS_OF));
    bf16_t* GNT = (bf16_t*)((unsigned char*)P.out + OUT_GNT) + (size_t)item * 8192;
    const int cbz0 = 4 * (wid & 1);
    const int j0 = 16 * rb + q4, tokb = tb + (dir ? t0 + 60 - j0 : t0 + j0);
#pragma unroll
    for (int t = 0; t < 4; ++t) { const int cb = cbz0 + t;
        f32x4 zv = tile_n<2>(lds + G_AM + 16 * rb * RS, RS, lds + G_VT + 16 * cb * RS, RS, zero4, lane);
        const f32x4 zs = dir ? (f32x4){zv[3], zv[2], zv[1], zv[0]} : zv;
        st4bf_g(O + ((size_t)(tokb >> 2) * 512 + hd * 128 + 16 * cb + (lane & 15)) * 4, zs);
        f32x4 nv = tile_n<2>(lds + G_KHT + 16 * rb * RS, RS, lds + G_VT + 16 * cb * RS, RS, zero4, lane);
        st4bf_g(GNT + (16 * cb + (lane & 15)) * 64 + 16 * rb + q4, nv); }
}
__device__ __forceinline__ void gla_prefetch(const Params& P, const Ctx& F, const int item, const int dir) {
    const int hd = (item >> 1) & 3, c = (item >> 3) & 63, b = item >> 9, tid = F.tid;
    if (tid < 320) {
        const int j = tid / 5, a = tid - 5 * j;
        const int col = a == 0 ? 1024 + 16 * dir : a == 1 ? hd * 64 : a == 2 ? 256 + hd * 64 : 512 + hd * 128 + 64 * (a - 3);
        const bf16_t* p = (const bf16_t*)(P.ws + WS_PB) + (size_t)(b * SEQ + c * 64 + j) * LDB_GL + col;
        { unsigned m0s; asm volatile("s_mov_b32 %0, m0\n\ts_mov_b32 m0, %2\n\ts_nop 0\n\tglobal_load_lds_dword %1, off\n\ts_mov_b32 m0, %0" : "=&s"(m0s) : "v"(p), "s"(L_PF) : "memory"); }
    }
}
template <int DIR>
__device__ __forceinline__ void gla_pair(const Params& P, const Ctx& F, const int itA, const int itB, const bool hasB) {
    ldsp_t la = F.lds, lb = F.lds + G_SLOT;
    GlaSt SA, SB;
    gla_s1<DIR>(P, F, itA, la, SA); if (hasB) gla_s1<DIR>(P, F, itB, lb, SB);
    __syncthreads();
    gla_s2(P, F, itA, la, SA); if (hasB) gla_s2(P, F, itB, lb, SB);
    __syncthreads();
    { const int nA = itA + 2 * F.G, nB = itB + 2 * F.G; if (nA < 2048) gla_prefetch(P, F, nA, DIR); if (nB < 2048) gla_prefetch(P, F, nB, DIR); }
    gla_s3(F, la); if (hasB) gla_s3(F, lb);
    __syncthreads();
    gla_s4<DIR>(P, F, itA, la); if (hasB) gla_s4<DIR>(P, F, itB, lb);
    __syncthreads();
}

__device__ __forceinline__ void gla_ld_nd(const unsigned char* ob, const unsigned char* ws, int item, int qt, int r, int hh, u32x2 (&Nf)[8], f32x4 (&Df)[8]) {
    const bf16_t* GNT = (const bf16_t*)(ob + OUT_GNT) + (size_t)item * 8192; const float* DEC = (const float*)(ws + WS_DEC) + (size_t)item * 64;
#pragma unroll
    for (int g = 0; g < 4; ++g) {
        Df[g] = *(const f32x4*)(DEC + 8 * g + 4 * hh); Df[4 + g] = *(const f32x4*)(DEC + 32 + 8 * g + 4 * hh);
        Nf[g] = *(const u32x2*)(GNT + (32 * qt + r) * 64 + 8 * g + 4 * hh); Nf[4 + g] = *(const u32x2*)(GNT + (32 * qt + r) * 64 + 32 + 8 * g + 4 * hh);
    }
}
__device__ __forceinline__ void gla_prod_step(ldsp_t lds, const unsigned char* ob, const unsigned char* ws, int b, int hd, int dir, int qt, int lane, int st,
                                              f32x16& X0, f32x16& X1, const u32x2 (&Nc)[8], const f32x4 (&Dc)[8], u32x2 (&Nn)[8], f32x4 (&Dn)[8]) {
    const int r = lane & 31, hh = lane >> 5;
    const int stn = st < 62 ? st + 2 : 63, cn = dir ? 63 - stn : stn, itemn = ((b * 64 + cn) * 4 + hd) * 2 + dir;
    gla_ld_nd(ob, ws, itemn, qt, r, hh, Nn, Dn);
    const bf16x8 b00 = pack_step(X0, 0), b01 = pack_step(X0, 1), b10 = pack_step(X1, 0), b11 = pack_step(X1, 1);
    ch_publish(lds, st, lane, b00, b01, b10, b11);
#pragma unroll
    for (int g = 0; g < 4; ++g) {
        const f32x4 d0 = Dc[g], d1 = Dc[4 + g]; const u32x2 n0 = Nc[g], n1 = Nc[4 + g];
        X0[4 * g + 0] = d0.x * X0[4 * g + 0] + bf2f(n0.x & 0xffffu); X0[4 * g + 1] = d0.y * X0[4 * g + 1] + bf2f(n0.x >> 16);
        X0[4 * g + 2] = d0.z * X0[4 * g + 2] + bf2f(n0.y & 0xffffu); X0[4 * g + 3] = d0.w * X0[4 * g + 3] + bf2f(n0.y >> 16);
        X1[4 * g + 0] = d1.x * X1[4 * g + 0] + bf2f(n1.x & 0xffffu); X1[4 * g + 1] = d1.y * X1[4 * g + 1] + bf2f(n1.x >> 16);
        X1[4 * g + 2] = d1.z * X1[4 * g + 2] + bf2f(n1.y & 0xffffu); X1[4 * g + 3] = d1.w * X1[4 * g + 3] + bf2f(n1.y >> 16);
    }
}
__device__ __forceinline__ void gla_producer(const Params& P, ldsp_t lds, const int chain, const int lane) {
    const int qt = chain & 3, dir = (chain >> 2) & 1, hd = (chain >> 3) & 3, b = chain >> 5;
    const unsigned char* ws = P.ws; const unsigned char* ob = (const unsigned char*)P.out;
    f32x16 X0, X1;
#pragma unroll
    for (int i = 0; i < 16; ++i) { X0[i] = 0.f; X1[i] = 0.f; }
    u32x2 NA[8], NB[8], NC[8]; f32x4 DA[8], DB[8], DC[8];
    { const int c0 = dir ? 63 : 0, c1 = dir ? 62 : 1;
      gla_ld_nd(ob, ws, ((b * 64 + c0) * 4 + hd) * 2 + dir, qt, lane & 31, lane >> 5, NA, DA);
      gla_ld_nd(ob, ws, ((b * 64 + c1) * 4 + hd) * 2 + dir, qt, lane & 31, lane >> 5, NB, DB); }
#pragma unroll 1
    for (int st = 0; st < 63; st += 3) {
        gla_prod_step(lds, ob, ws, b, hd, dir, qt, lane, st, X0, X1, NA, DA, NC, DC);
        gla_prod_step(lds, ob, ws, b, hd, dir, qt, lane, st + 1, X0, X1, NB, DB, NA, DA);
        gla_prod_step(lds, ob, ws, b, hd, dir, qt, lane, st + 2, X0, X1, NC, DC, NB, DB);
    }
    gla_prod_step(lds, ob, ws, b, hd, dir, qt, lane, 63, X0, X1, NA, DA, NC, DC);
}

__device__ __forceinline__ void ld_tok4(const bf16_t* base, int tok4, int lane, float (&y)[4][8]) {
    const u32x4* p = (const u32x4*)(base + ((size_t)tok4 * 512 + 8 * lane) * 4);
#pragma unroll
    for (int i = 0; i < 4; ++i) { const u32x4 v = p[i];
        y[0][2 * i] = bf2f(v.x & 0xffffu); y[1][2 * i] = bf2f(v.x >> 16); y[2][2 * i] = bf2f(v.y & 0xffffu); y[3][2 * i] = bf2f(v.y >> 16);
        y[0][2 * i + 1] = bf2f(v.z & 0xffffu); y[1][2 * i + 1] = bf2f(v.z >> 16); y[2][2 * i + 1] = bf2f(v.w & 0xffffu); y[3][2 * i + 1] = bf2f(v.w >> 16); }
}
__device__ __forceinline__ void mix_tok4_rw(const Params& P, const int tok4, const int lane) {
    unsigned char* ws = P.ws;
    const bf16_t* YF = (const bf16_t*)(ws + WS_YF); const bf16_t* YB = (const bf16_t*)(ws + WS_YB);
    const bf16_t* GG = (const bf16_t*)(ws + WS_G); const bf16_t* VS = (const bf16_t*)(ws + WS_VS);
    const float* BON = (const float*)(ws + WS_BON);
    const bf16_t* OF = (const bf16_t*)(ws + WS_OF); const bf16_t* OB = (const bf16_t*)(ws + WS_OB);
    const bf16_t* PB = (const bf16_t*)(ws + WS_PB);
    bf16_t* MIX = (bf16_t*)(ws + WS_MIX);
    {
        float ya[4][8], yb[4][8];
        ld_tok4(YF, tok4, lane, ya); ld_tok4(YB, tok4, lane, yb);
        const f32x4 w0 = *(const f32x4*)(P.ln_w + 8 * lane), w1 = *(const f32x4*)(P.ln_w + 8 * lane + 4);
        const f32x4 c0 = *(const f32x4*)(P.ln_b + 8 * lane), c1 = *(const f32x4*)(P.ln_b + 8 * lane + 4);
        const float lw[8] = {w0.x, w0.y, w0.z, w0.w, w1.x, w1.y, w1.z, w1.w}, lb[8] = {c0.x, c0.y, c0.z, c0.w, c1.x, c1.y, c1.z, c1.w};
        const int h = lane >> 3;
        u32x4 gq[4], vq[4]; float bq0[4], bq1[4];
#pragma unroll
        for (int q = 0; q < 4; ++q) { const int tok = 4 * tok4 + q; const size_t o512 = (size_t)tok * 512 + 8 * lane;
            gq[q] = *(const u32x4*)(GG + o512); vq[q] = *(const u32x4*)(VS + o512); bq0[q] = BON[(size_t)tok * 8 + h]; bq1[q] = BON[((size_t)NTOK + tok) * 8 + h]; }
#pragma unroll
        for (int q = 0; q < 4; ++q) {
            const int tok = 4 * tok4 + q;
            float y[8]; float s = 0.f;
#pragma unroll
            for (int e = 0; e < 8; ++e) { y[e] = ya[q][e] + yb[q][e]; s += y[e]; }
            s += __shfl_xor(s, 1); s += __shfl_xor(s, 2); s += __shfl_xor(s, 4);
            const float mean = s * (1.f / 64.f);
            float s2 = 0.f;
#pragma unroll
            for (int e = 0; e < 8; ++e) { y[e] -= mean; s2 += y[e] * y[e]; }
            s2 += __shfl_xor(s2, 1); s2 += __shfl_xor(s2, 2); s2 += __shfl_xor(s2, 4);
            const float rs = rsqrtf(s2 * (1.f / 64.f) + 64e-5f);
            const float bon = bq0[q] + bq1[q];
            float g[8], vs[8], o[8];
            unpack8(gq[q], g); unpack8(vq[q], vs);
#pragma unroll
            for (int e = 0; e < 8; ++e) o[e] = (y[e] * rs * lw[e] + lb[e] + bon * vs[e]) * g[e];
            *(u32x4*)(MIX + (size_t)tok * 1024 + 8 * lane) = pack8(o);
        }
    }
}
__device__ __forceinline__ void mix_tok4_gl(const Params& P, const int tok4, const int lane) {
    unsigned char* ws = P.ws;
    const bf16_t* YF = (const bf16_t*)(ws + WS_YF); const bf16_t* YB = (const bf16_t*)(ws + WS_YB);
    const bf16_t* GG = (const bf16_t*)(ws + WS_G); const bf16_t* VS = (const bf16_t*)(ws + WS_VS);
    const float* BON = (const float*)(ws + WS_BON);
    const bf16_t* OF = (const bf16_t*)(ws + WS_OF); const bf16_t* OB = (const bf16_t*)(ws + WS_OB);
    const bf16_t* PB = (const bf16_t*)(ws + WS_PB);
    bf16_t* MIX = (bf16_t*)(ws + WS_MIX);
    {
        float ya[4][8], yb[4][8];
        ld_tok4(OF, tok4, lane, ya); ld_tok4(OB, tok4, lane, yb);
        const f32x4 w0 = *(const f32x4*)(P.gnorm_w + 8 * lane), w1 = *(const f32x4*)(P.gnorm_w + 8 * lane + 4);
        const float nw[8] = {w0.x, w0.y, w0.z, w0.w, w1.x, w1.y, w1.z, w1.w};
        u32x4 oq[4];
#pragma unroll
        for (int q = 0; q < 4; ++q) oq[q] = *(const u32x4*)(PB + (size_t)(4 * tok4 + q) * LDB_GL + 1056 + 8 * lane);
#pragma unroll
        for (int q = 0; q < 4; ++q) {
            const int tok = 4 * tok4 + q;
            float y[8], og[8], o[8]; float s2 = 0.f;
#pragma unroll
            for (int e = 0; e < 8; ++e) { y[e] = ya[q][e] + yb[q][e]; s2 += y[e] * y[e]; }
            s2 += __shfl_xor(s2, 1); s2 += __shfl_xor(s2, 2); s2 += __shfl_xor(s2, 4); s2 += __shfl_xor(s2, 8);
            const float rs = rsqrtf(s2 * (1.f / 128.f) + 1e-6f);
            unpack8(oq[q], og);
#pragma unroll
            for (int e = 0; e < 8; ++e) o[e] = y[e] * rs * nw[e] * (og[e] * sigmoidf_(og[e]));
            *(u32x4*)(MIX + (size_t)tok * 1024 + 512 + 8 * lane) = pack8(o);
        }
    }
}

struct TBlk { const float* src; bf16_t* dst; int N, ldk; };
__device__ __forceinline__ TBlk moe_blk(const Params& P, int it) {
    bf16_t* WGU = (bf16_t*)(P.ws + WS_WGU); bf16_t* WDN = (bf16_t*)(P.ws + WS_WDN);
    const int e = it / 768, r = it % 768; TBlk t;
    if (r < 512) { const int up = r >> 8, q = r & 255, kb = q >> 4, nb = q & 15, n0 = 32 * nb;
        const float* src = (up ? P.w_up : P.w_gate) + (size_t)e * 1024 * 512;
        const int drow0 = 256 * (n0 >> 7) + (n0 & 127) + 128 * up;
        t.src = src + (size_t)(64 * kb) * 512 + n0; t.N = 512; t.dst = WGU + (size_t)e * 1024 * 1024 + (size_t)drow0 * 1024 + 64 * kb; t.ldk = 1024;
    } else { const int q = r - 512, kb = q >> 5, nb = q & 31;
        t.src = P.w_down + (size_t)e * 512 * 1024 + (size_t)(64 * kb) * 1024 + 32 * nb; t.N = 1024; t.dst = WDN + (size_t)e * 1024 * 512 + (size_t)(32 * nb) * 512 + 64 * kb; t.ldk = 512; }
    return t;
}
__device__ __forceinline__ void tblk_load(const TBlk& t, float (&tv)[32], int lane) {
#pragma unroll
    for (int i = 0; i < 32; ++i) { const int kk = 2 * i + (lane >> 5); tv[i] = t.src[(size_t)kk * t.N + (lane & 31)]; }
}
__device__ __forceinline__ void tblk_store(const TBlk& t, const float (&tv)[32], LAS float* scr, int lane) {
#pragma unroll
    for (int i = 0; i < 32; ++i) { const int kk = 2 * i + (lane >> 5); scr[kk * 33 + (lane & 31)] = tv[i]; }
    asm volatile("s_waitcnt lgkmcnt(0)" ::: "memory");
    const int c = lane & 7;
#pragma unroll
    for (int j = 0; j < 4; ++j) { const int n = (lane >> 3) + 8 * j; const LAS float* s = scr + (8 * c) * 33 + n;
        u32x4 o; o.x = pk2(s[0 * 33], s[1 * 33]); o.y = pk2(s[2 * 33], s[3 * 33]); o.z = pk2(s[4 * 33], s[5 * 33]); o.w = pk2(s[6 * 33], s[7 * 33]);
        *(u32x4*)(t.dst + (size_t)n * t.ldk + 8 * c) = o; }
    asm volatile("s_waitcnt lgkmcnt(0)" ::: "memory");
}
__device__ __forceinline__ void p5b_convert(const Params& P, const Ctx& F, const int gw, const int NGW) {
    LAS float* scr = (LAS float*)(F.lds + F.wid * 16384);
    constexpr int NIT = NEXP * 768;
    float ta[32], tb[32];
    int it = gw;
    if (it >= NIT) return;
    TBlk A = moe_blk(P, it), B = A;
    tblk_load(A, ta, F.lane);
#pragma unroll 1
    while (true) {
        const int i1 = it + NGW, i2 = it + 2 * NGW;
        if (i1 < NIT) { B = moe_blk(P, i1); tblk_load(B, tb, F.lane); }
        tblk_store(A, ta, scr, F.lane);
        if (i1 >= NIT) break;
        if (i2 < NIT) { A = moe_blk(P, i2); tblk_load(A, ta, F.lane); }
        tblk_store(B, tb, scr, F.lane);
        if (i2 >= NIT) break;
        it = i2;
    }
}

constexpr size_t WS_WRT = WS_LORA + 512 * 1024;
constexpr int RT_XS = 2064, RT_LOG = 64 * RT_XS;
__device__ __forceinline__ void p6_router_group(const Params& P, const Ctx& F, const int grp) {
    ldsp_t lds = F.lds; const int lane = F.lane, wid = F.wid;
    unsigned* CNT = (unsigned*)(P.ws + WS_CTL) + CW_CNT;
    int* ELIST = (int*)(P.ws + WS_ELIST); float* ELW = (float*)(P.ws + WS_ELW);
    bf16_t* H2 = (bf16_t*)(P.ws + WS_H2);
    const bf16_t* WrT = (const bf16_t*)(P.ws + WS_WRT);
    {
        const int tok0 = grp * 64;
        if (F.tid < 64) {
            unsigned* pc = (unsigned*)(P.ws + WS_CTL) + CW_PN + 16 * (grp >> 2); unsigned* tmo = (unsigned*)(P.ws + WS_CTL) + CW_BAR + XB_TMO; unsigned polls = 0;
            while ((unsigned)__builtin_amdgcn_readfirstlane((int)__hip_atomic_load(pc, __ATOMIC_RELAXED, __HIP_MEMORY_SCOPE_AGENT)) < 32u) {
                __builtin_amdgcn_s_sleep(2);
                if ((++polls & 1023u) == 0u) { if (__builtin_amdgcn_readfirstlane((int)__hip_atomic_load(tmo, __ATOMIC_RELAXED, __HIP_MEMORY_SCOPE_AGENT)) != 0) break;
                    if (polls > (1u << 22)) { if (F.tid == 0) atomicAdd(tmo, 1u); break; } }
            }
            __builtin_amdgcn_fence(__ATOMIC_ACQUIRE, "agent");
            asm volatile("s_waitcnt vmcnt(0)" ::: "memory");
        }
        __syncthreads();
        PROBE_BEGIN(41)
        {
            f32x4 v[8][4]; float ss[8];
            u32x2 raw[8][4];
#pragma unroll
            for (int i = 0; i < 8; ++i) { const u32x2* xr = (const u32x2*)((const bf16_t*)(P.ws + WS_XMID) + (size_t)(tok0 + 8 * wid + i) * 1024) + lane;
#pragma unroll
                for (int j = 0; j < 4; ++j) raw[i][j] = xr[64 * j]; }
#pragma unroll
            for (int i = 0; i < 8; ++i) { float s = 0.f;
#pragma unroll
                for (int j = 0; j < 4; ++j) { v[i][j] = (f32x4){bf2f(raw[i][j].x & 0xffffu), bf2f(raw[i][j].x >> 16), bf2f(raw[i][j].y & 0xffffu), bf2f(raw[i][j].y >> 16)};
                    s += (v[i][j].x * v[i][j].x + v[i][j].y * v[i][j].y) + (v[i][j].z * v[i][j].z + v[i][j].w * v[i][j].w); }
                ss[i] = s; }
            wave_sum_n<8>(ss);
            f32x4 g[4];
#pragma unroll
            for (int j = 0; j < 4; ++j) g[j] = *((const f32x4*)P.ln2_w + lane + 64 * j);
#pragma unroll
            for (int i = 0; i < 8; ++i) { const float inv = rsqrtf(ss[i] * (1.f / 1024.f) + 1e-6f); const int tl = 8 * wid + i;
                u32x2* o8 = (u32x2*)(H2 + (size_t)(tok0 + tl) * 1024) + lane;
#pragma unroll
                for (int j = 0; j < 4; ++j) { u32x2 o; o.x = pk2(v[i][j].x * inv * g[j].x, v[i][j].y * inv * g[j].y); o.y = pk2(v[i][j].z * inv * g[j].z, v[i][j].w * inv * g[j].w);
                    o8[64 * j] = o; *(LAS u32x2*)(lds + tl * RT_XS + (256 * j + 4 * lane) * 2) = o; } }
        }
        PROBE_END(41)
        __syncthreads();
        PROBE_BEGIN(42)
        {
            const int tt = wid >> 1, kh = wid & 1;
            f32x4 acc[3];
#pragma unroll
            for (int ct = 0; ct < 3; ++ct) acc[ct] = (f32x4){0.f, 0.f, 0.f, 0.f};
            const LAS unsigned char* ap = lds + (16 * tt + (lane & 15)) * RT_XS + (512 * kh + 8 * (lane >> 4)) * 2;
            const bf16_t* bp = WrT + (size_t)(lane & 15) * 1024 + 512 * kh + 8 * (lane >> 4);
#pragma unroll 4
            for (int ks = 0; ks < 16; ++ks) {
                const bf16x8 a = *(const LAS bf16x8*)(ap + ks * 64);
#pragma unroll
                for (int ct = 0; ct < 3; ++ct) { const bf16x8 bq = *(const bf16x8*)(bp + (size_t)ct * 16 * 1024 + ks * 32); acc[ct] = __builtin_amdgcn_mfma_f32_16x16x32_bf16(a, bq, acc[ct], 0, 0, 0); }
            }
#pragma unroll
            for (int ct = 0; ct < 3; ++ct)
#pragma unroll
                for (int r = 0; r < 4; ++r) *(LAS float*)(lds + RT_LOG + ((kh * 64 + 16 * tt + 4 * (lane >> 4) + r) * 48 + 16 * ct + (lane & 15)) * 4) = acc[ct][r];
        }
        PROBE_END(42)
        __syncthreads();
        PROBE_BEGIN(43)
        if (F.tid < 64) {
            const int tok = tok0 + F.tid;
            const LAS float* l0 = (const LAS float*)(lds + RT_LOG + (F.tid * 48) * 4); const LAS float* l1 = (const LAS float*)(lds + RT_LOG + ((64 + F.tid) * 48) * 4);
            float cl[4];
#pragma unroll
            for (int i = 0; i < 4; ++i) cl[i] = l0[i] + l1[i] + P.b_coarse[i];
            int g = 0; float cm = cl[0];
#pragma unroll
            for (int i = 1; i < 4; ++i) if (cl[i] > cm) { cm = cl[i]; g = i; }
            float cs = 0.f;
#pragma unroll
            for (int i = 0; i < 4; ++i) cs += __expf(cl[i] - cm);
            const float pg = 1.f / cs;
            float fl[8];
#pragma unroll
            for (int i = 0; i < 8; ++i) fl[i] = l0[4 + 8 * g + i] + l1[4 + 8 * g + i] + P.b_fine[8 * g + i];
            int i1 = 0; float m1 = fl[0];
#pragma unroll
            for (int i = 1; i < 8; ++i) if (fl[i] > m1) { m1 = fl[i]; i1 = i; }
            int i2 = -1; float m2 = -3.0e38f;
#pragma unroll
            for (int i = 0; i < 8; ++i) if (i != i1 && fl[i] > m2) { m2 = fl[i]; i2 = i; }
            const float e2 = __expf(m2 - m1);
            const float c1 = pg / (1.f + e2), c2 = pg * e2 / (1.f + e2);
            const int ea = 8 * g + i1, eb = 8 * g + i2;
            const unsigned sa = atomicAdd(&CNT[64 * ea], 1u); ELIST[(size_t)ea * NTOK + sa] = tok * 2; ELW[(size_t)ea * NTOK + sa] = c1;
            const unsigned sb = atomicAdd(&CNT[64 * eb], 1u); ELIST[(size_t)eb * NTOK + sb] = tok * 2 + 1; ELW[(size_t)eb * NTOK + sb] = c2;
        }
        PROBE_END(43)
        __syncthreads();
    }
}

__device__ __forceinline__ void build_group_tables(const Params& P, const Ctx& F) {
    LAS int* tab = (LAS int*)(F.lds + LDS_TAB);
    if (F.tid < 32) tab[F.tid] = (int)__hip_atomic_load((unsigned*)(P.ws + WS_CTL) + CW_CNT + 64 * F.tid, __ATOMIC_RELAXED, __HIP_MEMORY_SCOPE_AGENT);
    __syncthreads();
    if (F.tid == 0) { int s = 0; for (int e = 0; e < 32; ++e) { tab[32 + e] = s; s += (tab[e] + 255) >> 8; } tab[64] = s; }
    __syncthreads();
}
struct GroupOrder {
    static constexpr int A_AUX = 0;
    LAS const int* tab; const char* Abase; const char* Bbase; const int* elist; unsigned* cnt;
    int G, c, K;
    __device__ __forceinline__ bool next(int i, pg8::Unit& u) const {
        const int L = i * G + c, ntile = tab[64];
        if (L >= ntile * 4) return false;
        const int mg = L >> 2; u.pn = L & 3;
        int e = 0;
#pragma unroll 1
        for (int q = 1; q < 32; ++q) e = (tab[32 + q] <= mg) ? q : e;
        u.e = e; u.mt = mg - tab[32 + e]; u.pm = mg;
        u.a = Abase;
        u.b = Bbase + ((size_t)e * 1024 + 256 * u.pn) * K * 2;
        return true;
    }
    __device__ __forceinline__ void rows(const pg8::Unit& u, int R0, int R1, unsigned& r0, unsigned& r1) const {
        const int cnt_e = tab[u.e]; const int p0 = 256 * u.mt + R0, p1 = 256 * u.mt + R1;
        const int* el = elist + (size_t)u.e * NTOK;
        r0 = p0 < cnt_e ? (unsigned)(el[p0] >> 1) : 0u; r1 = p1 < cnt_e ? (unsigned)(el[p1] >> 1) : 0u;
    }
    __device__ __forceinline__ void a_ready(const pg8::Unit&) const {}
    __device__ __forceinline__ void done(const pg8::Unit& u) const {
        asm volatile("s_waitcnt vmcnt(0)" ::: "memory");
        if ((threadIdx.x & 63) == 0) __hip_atomic_fetch_add(cnt + 16 * u.pm, 1u, __ATOMIC_RELAXED, __HIP_MEMORY_SCOPE_AGENT);
    }
};
struct GroupOrderDown {
    static constexpr int A_AUX = 17;
    LAS const int* tab; const char* Abase; const char* Bbase; unsigned* cnt; unsigned* tmo;
    int G, c, K;
    __device__ __forceinline__ bool next(int i, pg8::Unit& u) const {
        const int ntile = tab[64], U = ntile * 4, r3 = U - 2 * G;
        int L;
        if (r3 > 0 && r3 < G && U <= 3 * G) { if (c < r3) { if (i > 0) return false; L = U - r3 + c; } else { L = (c - r3) + (G - r3) * i; if (L >= U - r3) return false; } }
        else { L = i * G + c; if (L >= U) return false; }
        const int mg = L >> 2; u.pn = L & 3;
        int e = 0;
#pragma unroll 1
        for (int q = 1; q < 32; ++q) e = (tab[32 + q] <= mg) ? q : e;
        u.e = e; u.mt = mg - tab[32 + e]; u.pm = mg;
        u.a = Abase + (size_t)mg * 256 * K * 2;
        u.b = Bbase + ((size_t)e * 1024 + 256 * u.pn) * K * 2;
        return true;
    }
    __device__ __forceinline__ void rows(const pg8::Unit&, int, int, unsigned&, unsigned&) const {}
    __device__ __forceinline__ void a_ready(const pg8::Unit& u) const {
        if (threadIdx.x < 64) {
            unsigned polls = 0;
            while ((unsigned)__builtin_amdgcn_readfirstlane((int)__hip_atomic_load(cnt + 16 * u.pm, __ATOMIC_RELAXED, __HIP_MEMORY_SCOPE_AGENT)) < 32u) {
                __builtin_amdgcn_s_sleep(2);
                if ((++polls & 1023u) == 0u) { if (__builtin_amdgcn_readfirstlane((int)__hip_atomic_load(tmo, __ATOMIC_RELAXED, __HIP_MEMORY_SCOPE_AGENT)) != 0) break;
                    if (polls > (1u << 22)) { if (threadIdx.x == 0) atomicAdd(tmo, 1u); break; } }
            }
            asm volatile("s_waitcnt vmcnt(0)" ::: "memory");
        }
        asm volatile("" ::: "memory"); __builtin_amdgcn_s_barrier(); asm volatile("" ::: "memory");
    }
    __device__ __forceinline__ void done(const pg8::Unit&) const {}
};
struct EpiSwiGLU {
    static constexpr bool PERM = true;
    bf16_t* ACT;
    __device__ __forceinline__ void operator()(const f32x4 (&acc)[2][2][4][2], const pg8::Unit& u, int wr, int wc, int fr, int fq) const {
        const int row0 = u.pm * 256 + wr * 64 + fr, col0 = u.pn * 128 + wc * 32 + 8 * fq;
        const __amdgpu_buffer_rsrc_t rsrc = __builtin_amdgcn_make_buffer_rsrc((void*)ACT, 0, 40960 * 512 * 2, 0x00020000);
#pragma unroll
        for (int ai = 0; ai < 2; ++ai)
#pragma unroll
            for (int m = 0; m < 4; ++m) {
                float o[8];
#pragma unroll
                for (int n = 0; n < 2; ++n)
#pragma unroll
                    for (int q = 0; q < 4; ++q) { const float gt = acc[ai][0][m][n][q], up = acc[ai][1][m][n][q]; o[4 * n + q] = gt * sigmoidf_(gt) * up; }
                __builtin_amdgcn_raw_buffer_store_b128(pack8(o), rsrc, ((row0 + ai * 128 + m * 16) * 512 + col0) * 2, 0, 16);
            }
    }
};
struct EpiDown {
    static constexpr bool PERM = true;
    LAS const int* tab; const int* elist; const float* elw; bf16_t* YK0; bf16_t* YK1;
    __device__ __forceinline__ void operator()(const f32x4 (&acc)[2][2][4][2], const pg8::Unit& u, int wr, int wc, int fr, int fq) const {
        const int cnt = tab[u.e]; const int col0 = u.pn * 256 + wc * 32 + 8 * fq;
#pragma unroll
        for (int ai = 0; ai < 2; ++ai)
#pragma unroll
            for (int m = 0; m < 4; ++m) {
                const int pos = 256 * u.mt + ai * 128 + wr * 64 + m * 16 + fr;
                if (pos < cnt) {
                    const int en = elist[(size_t)u.e * NTOK + pos]; const float w = elw[(size_t)u.e * NTOK + pos];
                    bf16_t* rowp = ((en & 1) ? YK1 : YK0) + (size_t)(en >> 1) * 1024 + col0;
#pragma unroll
                    for (int bj = 0; bj < 2; ++bj) { const f32x4 v0 = acc[ai][bj][m][0], v1 = acc[ai][bj][m][1];
                        u32x4 o; o.x = pk2(v0[0] * w, v0[1] * w); o.y = pk2(v0[2] * w, v0[3] * w); o.z = pk2(v1[0] * w, v1[1] * w); o.w = pk2(v1[2] * w, v1[3] * w);
                        *(u32x4*)(rowp + bj * 128) = o; }
                }
            }
    }
};

__device__ __forceinline__ void final_token2(const Params& P, const int tokA, const int tokB, const bool hasB, const int lane) {
    float* ra = P.out + (size_t)tokA * 1024; float* rb = P.out + (size_t)(hasB ? tokB : tokA) * 1024;
    const bf16_t* y0 = (const bf16_t*)(P.ws + WS_YK0); const bf16_t* y1 = (const bf16_t*)(P.ws + WS_YK1);
    const size_t oa = (size_t)tokA * 1024, ob = (size_t)(hasB ? tokB : tokA) * 1024;
    const bf16_t* xm = (const bf16_t*)(P.ws + WS_XMID);
    f32x4 va[4], vb[4]; u32x2 a0[4], a1[4], b0[4], b1[4], xa[4], xb[4];
#pragma unroll
    for (int j = 0; j < 4; ++j) { xa[j] = *((const u32x2*)(xm + oa) + lane + 64 * j); xb[j] = *((const u32x2*)(xm + ob) + lane + 64 * j);
        a0[j] = *((const u32x2*)(y0 + oa) + lane + 64 * j); a1[j] = *((const u32x2*)(y1 + oa) + lane + 64 * j);
        b0[j] = *((const u32x2*)(y0 + ob) + lane + 64 * j); b1[j] = *((const u32x2*)(y1 + ob) + lane + 64 * j); }
    float ss[2] = {0.f, 0.f};
#pragma unroll
    for (int j = 0; j < 4; ++j) {
        va[j] = (f32x4){bf2f(xa[j].x & 0xffffu), bf2f(xa[j].x >> 16), bf2f(xa[j].y & 0xffffu), bf2f(xa[j].y >> 16)};
        vb[j] = (f32x4){bf2f(xb[j].x & 0xffffu), bf2f(xb[j].x >> 16), bf2f(xb[j].y & 0xffffu), bf2f(xb[j].y >> 16)};
        va[j].x += bf2f(a0[j].x & 0xffffu) + bf2f(a1[j].x & 0xffffu); va[j].y += bf2f(a0[j].x >> 16) + bf2f(a1[j].x >> 16);
        va[j].z += bf2f(a0[j].y & 0xffffu) + bf2f(a1[j].y & 0xffffu); va[j].w += bf2f(a0[j].y >> 16) + bf2f(a1[j].y >> 16);
        vb[j].x += bf2f(b0[j].x & 0xffffu) + bf2f(b1[j].x & 0xffffu); vb[j].y += bf2f(b0[j].x >> 16) + bf2f(b1[j].x >> 16);
        vb[j].z += bf2f(b0[j].y & 0xffffu) + bf2f(b1[j].y & 0xffffu); vb[j].w += bf2f(b0[j].y >> 16) + bf2f(b1[j].y >> 16);
        ss[0] += (va[j].x * va[j].x + va[j].y * va[j].y) + (va[j].z * va[j].z + va[j].w * va[j].w);
        ss[1] += (vb[j].x * vb[j].x + vb[j].y * vb[j].y) + (vb[j].z * vb[j].z + vb[j].w * vb[j].w); }
    wave_sum_n<2>(ss);
    const float ia = rsqrtf(ss[0] * (1.f / 1024.f) + 1e-6f), ib = rsqrtf(ss[1] * (1.f / 1024.f) + 1e-6f);
#pragma unroll
    for (int j = 0; j < 4; ++j) { const f32x4 g = *((const f32x4*)P.ln_f_w + lane + 64 * j);
        f32x4 o; o.x = va[j].x * ia * g.x; o.y = va[j].y * ia * g.y; o.z = va[j].z * ia * g.z; o.w = va[j].w * ia * g.w;
        *((f32x4*)ra + lane + 64 * j) = o;
        if (hasB) { f32x4 q; q.x = vb[j].x * ib * g.x; q.y = vb[j].y * ib * g.y; q.z = vb[j].z * ib * g.z; q.w = vb[j].w * ib * g.w; *((f32x4*)rb + lane + 64 * j) = q; } }
}

__global__ void __launch_bounds__(512, 2) mk_fwd(Params P) {
    extern __shared__ __attribute__((aligned(16))) unsigned char lds_raw[];
    Ctx F;
    F.lds = (ldsp_t)lds_raw;
    F.tid = threadIdx.x; F.lane = F.tid & 63; F.wid = __builtin_amdgcn_readfirstlane(F.tid >> 6);
    F.G = gridDim.x; { const int bx = blockIdx.x; F.vcu = (F.G % 8 == 0) ? (bx % 8) * (F.G / 8) + bx / 8 : bx; }
    volatile LAS unsigned* MISC = (volatile LAS unsigned*)(F.lds + LDS_MISC);
    if (F.tid < 16) MISC[F.tid] = 0u;
    __syncthreads();
    unsigned* ctl = (unsigned*)(P.ws + WS_CTL);
    const int lo = P.ph_lo, hi = P.ph_hi;
    XcdBarrier bar; bar.bar = ctl + CW_BAR; bar.x = 0; bar.st = MISC;
    if (hi - lo > 1) bar = xcd_barrier_post(ctl + CW_BAR, MISC);
#ifndef PHASE_MASK
#define PHASE_MASK 0xFFFFF
#endif
#define IN(k) (((PHASE_MASK >> (k)) & 1) && lo <= (k) && (k) < hi)
#ifndef REP_MASK
#define REP_MASK 0
#endif
#define NREP(k) (1 + ((REP_MASK >> (k)) & 1))
#define SEAM(k) do { if (IN(k) && IN((k) + 1)) xcd_barrier(bar); } while (0)
    unsigned char* ws = P.ws;
    const int gw = F.vcu * 8 + F.wid, NGW = F.G * 8;

    if (IN(0)) { PROBE_BEGIN(30) for (int rep = 0; rep < NREP(0); ++rep) { p0_prologue(P, F); __syncthreads(); } PROBE_END(30) }
    SEAM(0);
    if (IN(1)) {
        pg8::StaticOrder S; S.init(ws + WS_H, ws + WS_BT_RW, NTOK, 2048, 1024, F.G, (int)blockIdx.x);
        pg8::EpiBf16 E{(bf16_t*)P.out, LDA_RW, RW_COLS};
        { PROBE_BEGIN(20) pg8::gemm_phase<pg8::EpiBf16, pg8::StaticOrder, false>(F.lds, 1024, S, E); PROBE_END(20) }
            {

        pg8::StaticOrder S; S.init(ws + WS_H, ws + WS_BT_GL, NTOK, 1792, 1024, F.G, (int)blockIdx.x);
        pg8::EpiBf16 E{(bf16_t*)(ws + WS_PB), LDB_GL, GL_COLS};
        { PROBE_BEGIN(20) pg8::gemm_phase<pg8::EpiBf16, pg8::StaticOrder, false>(F.lds, 1024, S, E); PROBE_END(20) }
            }
    }
    SEAM(1);
    if (IN(2)) { PROBE_BEGIN(33)
        const int q0 = (F.vcu >> 1) * 8, qs = (F.G >> 1) * 8;
        unsigned sink = 0u;
        if (F.vcu & 1) {
            RwRaw R;
#pragma unroll 1
            for (int q = q0; q < 2048; q += qs) {
#pragma unroll 1
                for (int h = 0; h < 8; ++h) { int it = (q + h) * 2 + 1; asm volatile("" : "+s"(it));
                    const int qn = (h < 7) ? q + h + 1 : q + qs; rwkv_item<1>(P, F, it, R, h == 0, qn * 2 + 1, qn < 2048, sink); } }
        } else {
            RwRaw R;
#pragma unroll 1
            for (int q = q0; q < 2048; q += qs) {
#pragma unroll 1
                for (int h = 0; h < 8; ++h) { int it = (q + h) * 2; asm volatile("" : "+s"(it));
                    const int qn = (h < 7) ? q + h + 1 : q + qs; rwkv_item<0>(P, F, it, R, h == 0, qn * 2, qn < 2048, sink); } }
        }
        asm volatile("s_waitcnt vmcnt(0)" : "+v"(sink) :: "memory");
        PROBE_END(33) }
    SEAM(2);
    if (IN(3)) { }
    if (IN(4)) { PROBE_BEGIN(31)
        if (F.vcu & 1) { for (int it = F.vcu; it < 2048; it += 2 * F.G) gla_pair<1>(P, F, it, it + F.G, it + F.G < 2048); }
        else           { for (int it = F.vcu; it < 2048; it += 2 * F.G) gla_pair<0>(P, F, it, it + F.G, it + F.G < 2048); }
        asm volatile("s_waitcnt vmcnt(0)" ::: "memory");
        PROBE_END(31) }
    SEAM(4);
    if (IN(5)) { PROBE_BEGIN(6)
        if (F.tid < 512) *(volatile LAS unsigned*)(F.lds + CH_FLAGS + F.tid * 4) = 0u;
        __syncthreads();
        if (F.vcu < 128) { if (F.wid == 0) rwkv_producer(P, F.lds, F.vcu, F.lane); else chain_consumer<false>(P, F.lds, F.vcu, F.wid - 1, F.lane); }
        else if (F.vcu < 256) { if (F.wid == 0) gla_producer(P, F.lds, F.vcu - 128, F.lane); else chain_consumer<true>(P, F.lds, F.vcu - 128, F.wid - 1, F.lane); }
        PROBE_END(6) }
    SEAM(5);
#if PROBE_ID == 40
    for (int q = 0; q < 8; ++q) xcd_barrier(bar);
#endif
    if (IN(6)) { PROBE_BEGIN(32) for (int rep = 0; rep < NREP(6); ++rep) { for (int t4 = gw; t4 < NTOK / 4; t4 += NGW) mix_tok4_rw(P, t4, F.lane); for (int t4 = gw; t4 < NTOK / 4; t4 += NGW) mix_tok4_gl(P, t4, F.lane); } PROBE_END(32) }
    SEAM(6);
    if (IN(7)) { PROBE_BEGIN(50)
        const bool conv_first = ((F.vcu >> 2) & 1) != 0;
        if (conv_first) { PROBE_BEGIN(34) p5b_convert(P, F, F.vcu * 8 + F.wid, F.G * 8); PROBE_END(34) __syncthreads(); }
        {
            pg8::PanelOrder S{(const char*)(ws + WS_MIX), (const char*)(ws + WS_BT_OUT), ctl + CW_PN, 1024, 4, 256, F.G, F.vcu};
            pg8::EpiResBf16 E{(bf16_t*)(ws + WS_XMID), P.x, 1024};
            { PROBE_BEGIN(20) pg8::gemm_phase<pg8::EpiResBf16, pg8::PanelOrder, false>(F.lds, 1024, S, E); PROBE_END(20) }
        }
        PROBE_BEGIN(7)
        for (int grp = F.vcu; grp < NTOK / 64; grp += F.G) p6_router_group(P, F, grp);
        PROBE_END(7)
        if (!conv_first) { PROBE_BEGIN(34) p5b_convert(P, F, F.vcu * 8 + F.wid, F.G * 8); PROBE_END(34) }
    PROBE_END(50) }
    SEAM(7);
    if (IN(8)) { }
    if (IN(9)) { }
    if (IN(10)) {
        { PROBE_BEGIN(23) build_group_tables(P, F); PROBE_END(23) }
        unsigned* mtc = ctl + CW_MT;
        {
            GroupOrder S{(LAS const int*)(F.lds + LDS_TAB), (const char*)(ws + WS_H2), (const char*)(ws + WS_WGU), (const int*)(ws + WS_ELIST), mtc, F.G, F.vcu, 1024};
            EpiSwiGLU E{(bf16_t*)P.out};
            { PROBE_BEGIN(21) pg8::gemm_phase<EpiSwiGLU, GroupOrder, true>(F.lds, 1024, S, E); PROBE_END(21) }
        }
        {
            GroupOrderDown S{(LAS const int*)(F.lds + LDS_TAB), (const char*)P.out, (const char*)(ws + WS_WDN), mtc, ctl + CW_BAR + XB_TMO, F.G, F.vcu, 512};
            EpiDown E{(LAS const int*)(F.lds + LDS_TAB), (const int*)(ws + WS_ELIST), (const float*)(ws + WS_ELW), (bf16_t*)(ws + WS_YK0), (bf16_t*)(ws + WS_YK1)};
            { PROBE_BEGIN(22) pg8::gemm_phase<EpiDown, GroupOrderDown, false>(F.lds, 512, S, E); PROBE_END(22) }
        }
    }
    SEAM(10);
    if (IN(11)) { }
    if (IN(12)) { PROBE_BEGIN(8) for (int tok = gw; tok < NTOK; tok += 2 * NGW) final_token2(P, tok, tok + NGW, tok + NGW < NTOK, F.lane); PROBE_END(8) }
#undef IN
#undef SEAM
}

extern "C" void kernel_launch(void* const* d_in, const int* in_sizes, int n_in, void* d_out, int out_size, void* d_ws, size_t ws_size, hipStream_t stream) {
    static int grid = 0;
    if (grid == 0) {
        if (n_in != 33 || out_size != NTOK * DM || ws_size < WS_END) { fprintf(stderr, "kernel_launch: unexpected problem (n_in %d, out %d, ws %zu, need %zu)\n", n_in, out_size, ws_size, (size_t)WS_END); grid = -1; return; }
        int dev = 0, cus = 0, per_cu = 0;
        if (hipGetDevice(&dev) != hipSuccess || hipDeviceGetAttribute(&cus, hipDeviceAttributeMultiprocessorCount, dev) != hipSuccess) { grid = -1; return; }
        if (hipFuncSetAttribute((const void*)mk_fwd, hipFuncAttributeMaxDynamicSharedMemorySize, LDS_BYTES) != hipSuccess) { fprintf(stderr, "kernel_launch: hipFuncSetAttribute failed\n"); grid = -1; return; }
        if (hipOccupancyMaxActiveBlocksPerMultiprocessor(&per_cu, (const void*)mk_fwd, 512, LDS_BYTES) != hipSuccess || per_cu < 1) fprintf(stderr, "kernel_launch: occupancy query says %d\n", per_cu);
        (void)hipGetLastError();
        grid = cus;
    }
    if (grid < 0) return;
    (void)hipMemsetAsync((char*)d_ws + WS_CTL, 0, CTL_ZERO_BYTES, stream);
    Params p{};
    const float* const* in = (const float* const*)d_in;
    p.x = in[0]; p.ln1_w = in[1]; p.w_in = in[2]; p.rw_mu = in[3];
    p.w0_f = in[4]; p.w2_f = in[5]; p.w0_b = in[6]; p.w2_b = in[7];
    p.a0_f = in[8]; p.a2_f = in[9]; p.a0_b = in[10]; p.a2_b = in[11];
    p.g2 = in[12]; p.k_k = in[13]; p.k_a = in[14]; p.r_k = in[15]; p.ln_w = in[16]; p.ln_b = in[17];
    p.gw2_f = in[18]; p.gb_f = in[19]; p.gw2_b = in[20]; p.gb_b = in[21]; p.gnorm_w = in[22];
    p.w_out = in[23]; p.ln2_w = in[24]; p.w_coarse = in[25]; p.b_coarse = in[26]; p.w_fine = in[27]; p.b_fine = in[28];
    p.w_gate = in[29]; p.w_up = in[30]; p.w_down = in[31]; p.ln_f_w = in[32];
    p.out = (float*)d_out; p.ws = (unsigned char*)d_ws;
#if MK_PER_PHASE
#ifndef REP_PHASE
#define REP_PHASE -1
#endif
    for (int k = 0; k < NPH; ++k) { p.ph_lo = k; p.ph_hi = k + 1; hipLaunchKernelGGL(mk_fwd, dim3(grid), dim3(512), LDS_BYTES, stream, p);
        if (k == REP_PHASE) hipLaunchKernelGGL(mk_fwd, dim3(grid), dim3(512), LDS_BYTES, stream, p); }
#else
    p.ph_lo = 0; p.ph_hi = NPH; hipLaunchKernelGGL(mk_fwd, dim3(grid), dim3(512), LDS_BYTES, stream, p);
#endif
}
```

```cpp
#include <hip/hip_runtime.h>
#include <cstdio>
#include <cstdint>

#ifndef MK_PER_PHASE
#define MK_PER_PHASE 0
#endif

#define LAS __attribute__((address_space(3)))
#define GAS __attribute__((address_space(1)))
typedef unsigned short bf16_t;
typedef short bf16x8 __attribute__((ext_vector_type(8)));
typedef float f32x4 __attribute__((ext_vector_type(4)));
typedef float f32x16 __attribute__((ext_vector_type(16)));
typedef unsigned u32x4 __attribute__((ext_vector_type(4)));
typedef unsigned u32x2 __attribute__((ext_vector_type(2)));
typedef LAS unsigned char* ldsp_t;

constexpr int NTOK = 16384, SEQ = 4096, DM = 1024;
constexpr int LDA_RW = 2048;
constexpr int LDB_GL = 1792;
constexpr int RW_COLS = 1920, GL_COLS = 1568;
constexpr int NEXP = 32, DEXP = 512;
constexpr int NPH = 13;

constexpr size_t MiB = 1u << 20;
constexpr size_t WS_CTL = 0, CTL_ZERO_BYTES = 64 * 1024;
constexpr size_t WS_LORA = 1 * MiB;
constexpr size_t WS_BT_RW = 2 * MiB, WS_BT_GL = 6 * MiB, WS_BT_OUT = 10 * MiB;
constexpr size_t WS_BON = 12 * MiB;
constexpr size_t WS_ELIST = 13 * MiB;
constexpr size_t WS_DEC = 15 * MiB;
constexpr size_t WS_H = 16 * MiB;
constexpr size_t WS_OF = 16 * MiB, WS_OB = 32 * MiB;
constexpr size_t WS_H2 = 16 * MiB;
constexpr size_t WS_RM = 48 * MiB, WS_RP = 80 * MiB, WS_RNT = 112 * MiB;
constexpr size_t WS_GQ = 48 * MiB, WS_GNT = 64 * MiB;
constexpr size_t WS_MIX = 48 * MiB;
constexpr size_t WS_YF = 144 * MiB, WS_YB = 160 * MiB, WS_G = 176 * MiB, WS_VS = 192 * MiB;
constexpr size_t WS_PB = 208 * MiB;
constexpr size_t WS_WGU = 80 * MiB, WS_WDN = 144 * MiB;
constexpr size_t WS_XMID = 176 * MiB;
constexpr size_t WS_YK0 = 48 * MiB, WS_YK1 = 216 * MiB;
constexpr size_t WS_ELW = 248 * MiB;
constexpr size_t WS_END = 264 * MiB;
constexpr int CW_CNT = 0;
constexpr int CW_BAR = 4096;
constexpr int CW_PN = 12288;
constexpr int CW_RW = 14336;
constexpr int CW_MT = 8192;

constexpr int LDS_BYTES = 160 * 1024;
constexpr int LDS_MISC = LDS_BYTES - 64;
constexpr int LDS_TAB = 131072;

#ifndef PROBE_ID
#define PROBE_ID 0
#endif
#ifndef PROBE_MULT
#define PROBE_MULT 1
#endif
#define PROBE_BEGIN(id) long long _pb_##id = 0; if (PROBE_ID == (id)) { _pb_##id = __builtin_readcyclecounter(); }
#define PROBE_END(id) if (PROBE_ID == (id)) { const long long _e = __builtin_readcyclecounter(); const long long _d = (_e - _pb_##id) * PROBE_MULT; while (__builtin_readcyclecounter() - _e < _d) __builtin_amdgcn_s_sleep(2); }
__device__ __forceinline__ float bf2f(unsigned b) { return __uint_as_float(b << 16); }
typedef __bf16 bf2_t __attribute__((ext_vector_type(2)));
typedef float f2_t __attribute__((ext_vector_type(2)));
__device__ __forceinline__ unsigned f2bf(float f) { const __bf16 b = (__bf16)f; return (unsigned)__builtin_bit_cast(unsigned short, b); }
__device__ __forceinline__ unsigned pk2(float lo, float hi) { const f2_t v = {lo, hi}; const bf2_t r = __builtin_convertvector(v, bf2_t); return __builtin_bit_cast(unsigned, r); }
template <int CTRL> __device__ __forceinline__ float dpp_mov(float x) { return __int_as_float(__builtin_amdgcn_update_dpp(0, __float_as_int(x), CTRL, 0xF, 0xF, true)); }
template <int N> __device__ __forceinline__ void wave_sum_n(float (&v)[N]) {
#pragma unroll
    for (int i = 0; i < N; ++i) v[i] += dpp_mov<0xB1>(v[i]);
#pragma unroll
    for (int i = 0; i < N; ++i) v[i] += dpp_mov<0x4E>(v[i]);
#pragma unroll
    for (int i = 0; i < N; ++i) v[i] += dpp_mov<0x141>(v[i]);
#pragma unroll
    for (int i = 0; i < N; ++i) v[i] += dpp_mov<0x140>(v[i]);
    { float t[N];
#pragma unroll
      for (int i = 0; i < N; ++i) t[i] = __int_as_float(__builtin_amdgcn_ds_swizzle(__float_as_int(v[i]), 0x401F));
#pragma unroll
      for (int i = 0; i < N; ++i) v[i] += t[i]; }
    { float t[N];
#pragma unroll
      for (int i = 0; i < N; ++i) t[i] = __shfl_xor(v[i], 32);
#pragma unroll
      for (int i = 0; i < N; ++i) v[i] += t[i]; }
}
__device__ __forceinline__ float wave_sum(float v) { float t[1] = {v}; wave_sum_n<1>(t); return t[0]; }
__device__ __forceinline__ void wave_sum16_rows(const float (&v)[16], float (&u)[4]) {
    float w[8];
#pragma unroll
    for (int i = 0; i < 8; ++i) { const auto s = __builtin_amdgcn_permlane32_swap(__float_as_uint(v[i]), __float_as_uint(v[i + 8]), false, false); w[i] = __uint_as_float(s[0]) + __uint_as_float(s[1]); }
#pragma unroll
    for (int i = 0; i < 4; ++i) { const auto s = __builtin_amdgcn_permlane16_swap(__float_as_uint(w[i]), __float_as_uint(w[i + 4]), false, false); u[i] = __uint_as_float(s[0]) + __uint_as_float(s[1]); }
#pragma unroll
    for (int i = 0; i < 4; ++i) u[i] += dpp_mov<0xB1>(u[i]);
#pragma unroll
    for (int i = 0; i < 4; ++i) u[i] += dpp_mov<0x4E>(u[i]);
#pragma unroll
    for (int i = 0; i < 4; ++i) u[i] += dpp_mov<0x141>(u[i]);
#pragma unroll
    for (int i = 0; i < 4; ++i) u[i] += dpp_mov<0x140>(u[i]);
}
__device__ __forceinline__ float sigmoidf_(float x) { return __builtin_amdgcn_rcpf(1.f + __expf(-x)); }
__device__ __forceinline__ float tanhf_(float x) { return 1.f - 2.f * __builtin_amdgcn_rcpf(1.f + __expf(2.f * x)); }
__device__ __forceinline__ void unpack8(const u32x4& v, float (&o)[8]) {
    o[0] = bf2f(v.x & 0xffffu); o[1] = bf2f(v.x >> 16); o[2] = bf2f(v.y & 0xffffu); o[3] = bf2f(v.y >> 16);
    o[4] = bf2f(v.z & 0xffffu); o[5] = bf2f(v.z >> 16); o[6] = bf2f(v.w & 0xffffu); o[7] = bf2f(v.w >> 16);
}
__device__ __forceinline__ u32x4 pack8(const float (&o)[8]) {
    u32x4 v; v.x = pk2(o[0], o[1]); v.y = pk2(o[2], o[3]); v.z = pk2(o[4], o[5]); v.w = pk2(o[6], o[7]); return v;
}

#define XB_TMO      128
#define XB_XCNT(j)  (256  + 64 * (j))
#define XB_XSUB(j)  (1280 + 64 * (j))
#define XB_XGEN(j)  (2304 + 64 * (j))
#define XB_TOP      3328
#define XB_TOPGEN   3392
#define XCD_BAR_WORDS 3456
#define XB_SPIN_CAP (1u << 18)
__device__ __forceinline__ unsigned xb_ld(unsigned* p)              { return __hip_atomic_load(p, __ATOMIC_RELAXED, __HIP_MEMORY_SCOPE_AGENT); }
__device__ __forceinline__ unsigned xb_add(unsigned* p, unsigned v) { return __hip_atomic_fetch_add(p, v, __ATOMIC_RELAXED, __HIP_MEMORY_SCOPE_AGENT); }
__device__ __forceinline__ unsigned xb_xcc_id() { return (unsigned)__builtin_amdgcn_s_getreg((3 << 11) | 20) & 0xFu; }
#define XB_SPIN(cond, bar) do { unsigned _sp = 0; while (cond) { __builtin_amdgcn_s_sleep(1); \
    if ((++_sp & 255u) == 0u) { if (xb_ld(&(bar)[XB_TMO])) break; if (_sp > XB_SPIN_CAP) { atomicAdd(&(bar)[XB_TMO], 1u); break; } } } } while (0)
struct XcdBarrier { unsigned* bar; unsigned x; volatile LAS unsigned* st; };
__device__ __forceinline__ XcdBarrier xcd_barrier_post(unsigned* bar, volatile LAS unsigned* st) {
    XcdBarrier b; b.bar = bar; b.x = xb_xcc_id(); b.st = st;
    if (threadIdx.x == 0) (void)xb_add(&bar[XB_XCNT(b.x)], 1u);
    return b;
}
__device__ __forceinline__ void xcd_barrier_complete(unsigned* bar, unsigned x, unsigned& nloc, unsigned& nx) {
    const unsigned G = gridDim.x * gridDim.y * gridDim.z;
    unsigned sum, cnt, mine, sp = 0u;
    for (;;) {
        sum = 0u; cnt = 0u; mine = 0u;
#pragma unroll
        for (unsigned j = 0; j < 16; ++j) { const unsigned c = xb_ld(&bar[XB_XCNT(j)]); sum += c; cnt += (c > 0u) ? 1u : 0u; mine = (j == x) ? c : mine; }
        if (sum == G) break;
        __builtin_amdgcn_s_sleep(1);
        if ((++sp & 255u) == 0u) { if (xb_ld(&bar[XB_TMO])) break; if (sp > XB_SPIN_CAP) { atomicAdd(&bar[XB_TMO], 1u); break; } }
    }
    nloc = mine > 0u ? mine : 1u; nx = cnt > 0u ? cnt : 1u;
}
__device__ __forceinline__ void xcd_barrier(const XcdBarrier& b) {
    asm volatile("s_waitcnt vmcnt(0)" ::: "memory");
    __syncthreads();
    if (threadIdx.x == 0) {
        unsigned* bar = b.bar;
        __builtin_amdgcn_s_waitcnt(0);
        unsigned nloc = b.st[0], nx = b.st[1];
        if (nloc == 0u) { xcd_barrier_complete(bar, b.x, nloc, nx); b.st[0] = nloc; b.st[1] = nx; }
        const unsigned old = xb_add(&bar[XB_XSUB(b.x)], 1u);
        const unsigned gen = old / nloc;
        if (old + 1u == (gen + 1u) * nloc) {
            __builtin_amdgcn_fence(__ATOMIC_RELEASE, "agent");
            asm volatile("s_waitcnt vmcnt(0)" ::: "memory");
            const unsigned og = xb_add(&bar[XB_TOP], 1u);
            const unsigned tg = og / nx;
            if (og + 1u == (tg + 1u) * nx) xb_add(&bar[XB_TOPGEN], 1u);
            else XB_SPIN(xb_ld(&bar[XB_TOPGEN]) == tg, bar);
            __builtin_amdgcn_fence(__ATOMIC_ACQUIRE, "agent");
            xb_add(&bar[XB_XGEN(b.x)], 1u);
            asm volatile("s_waitcnt vmcnt(0)" ::: "memory");
        } else {
            XB_SPIN(xb_ld(&bar[XB_XGEN(b.x)]) == gen, bar);
            __builtin_amdgcn_fence(__ATOMIC_ACQUIRE, "agent");
            asm volatile("s_waitcnt vmcnt(0)" ::: "memory");
        }
    }
    __syncthreads();
}

struct Params {
    const float* x; const float* ln1_w; const float* w_in; const float* rw_mu;
    const float* w0_f; const float* w2_f; const float* w0_b; const float* w2_b;
    const float* a0_f; const float* a2_f; const float* a0_b; const float* a2_b;
    const float* g2; const float* k_k; const float* k_a; const float* r_k; const float* ln_w; const float* ln_b;
    const float* gw2_f; const float* gb_f; const float* gw2_b; const float* gb_b; const float* gnorm_w;
    const float* w_out; const float* ln2_w; const float* w_coarse; const float* b_coarse; const float* w_fine; const float* b_fine;
    const float* w_gate; const float* w_up; const float* w_down; const float* ln_f_w;
    float* out; unsigned char* ws;
    int ph_lo, ph_hi;
};

namespace pg8 {
constexpr int BM = 256, BK = 64, HALF = 128, HTB = HALF * BK * 2, STAGE_BYTES = 8 * HTB, NXCD = 8, WGM = 2;
__host__ __device__ __forceinline__ int lds_byte(int r, int c) { const int st = (r >> 4) * 2 + (c >> 5), rr = r & 15, cc = c & 31, ob = rr * 64 + cc * 2; return st * 1024 + (ob ^ (((ob >> 9) & 1) << 5)); }
__host__ __device__ __forceinline__ void stage_rc(int b, int& R, int& C) { const int st = b / 1024, sb = b % 1024, swz = sb ^ (((sb >> 9) & 1) << 5); R = (st >> 1) * 16 + swz / 64; C = (st & 1) * 32 + (swz % 64) / 2; }
__host__ __device__ __forceinline__ int perm32(int rho) { const int n = rho >> 4, i = rho & 15; return 8 * (i >> 2) + 4 * n + (i & 3); }

struct Unit { const char* a; const char* b; int pm, pn, e, mt, qi; };

struct StaticOrder {
    static constexpr int A_AUX = 0; static constexpr bool LAZY = false;
    const char* A; const char* Bt; int K;
    int nM, nN, nwg, G, c;
    __device__ void init(const void* A_, const void* Bt_, int M, int N, int K_, int G_, int c_) { A = (const char*)A_; Bt = (const char*)Bt_; K = K_; nM = M / BM; nN = N / BM; nwg = nM * nN; G = G_; c = c_; }
    __device__ __forceinline__ bool next(int i, Unit& u) const {
        const long L = (long)i * G + c; if (L >= nwg) return false;
        int wgid = (int)L; { const int q = nwg / NXCD, r = nwg % NXCD, xcd = wgid % NXCD, off = wgid / NXCD; wgid = (xcd < r ? xcd * (q + 1) : r * (q + 1) + (xcd - r) * q) + off; }
        const int nig = WGM * nN, gid = wgid / nig, fm = gid * WGM, gsz = (nM - fm) < WGM ? (nM - fm) : WGM;
        u.pm = fm + ((wgid % nig) % gsz); u.pn = (wgid % nig) / gsz; u.e = 0; u.mt = 0;
        u.a = A + (size_t)u.pm * 256 * K * 2; u.b = Bt + (size_t)u.pn * 256 * K * 2; return true;
    }
    __device__ __forceinline__ void rows(const Unit&, int, int, unsigned&, unsigned&) const {}
    __device__ __forceinline__ void a_ready(const Unit&) const {}
    __device__ __forceinline__ void done(const Unit&) const {}
};

struct StaticOrderPub : StaticOrder {
    static constexpr bool LAZY = true;
    unsigned* cnt;
    __device__ __forceinline__ void arrive(int pm) const { if ((threadIdx.x & 63) == 0) __hip_atomic_fetch_add(cnt + 16 * pm, 1u, __ATOMIC_RELAXED, __HIP_MEMORY_SCOPE_AGENT); }
    __device__ __forceinline__ void done(const Unit& u) const {
        asm volatile("s_waitcnt vmcnt(0)" ::: "memory");
        if ((threadIdx.x & 63) == 0) __hip_atomic_fetch_add(cnt + 16 * u.pm, 1u, __ATOMIC_RELAXED, __HIP_MEMORY_SCOPE_AGENT);
    }
};
template <class Epi, class Sched, bool GATHER>
__device__ __forceinline__ void gemm_phase(ldsp_t lds, const int K, const Sched& S, const Epi& E) {
    const int tid = threadIdx.x, wid = __builtin_amdgcn_readfirstlane(tid >> 6), lane = tid & 63, wr = wid >> 2, wc = wid & 3, fr = lane & 15, fq = lane >> 4;
    const int nt = K / BK;
    unsigned voffA[2], voffB[2]; int RA[2], CA[2];
#pragma unroll
    for (int i = 0; i < 2; ++i) { int R, C; stage_rc(tid * 16 + i * 8192, R, C); const int Rb = Epi::PERM ? ((R & ~31) + perm32(R & 31)) : R;
        RA[i] = R; CA[i] = C; voffA[i] = (unsigned)(R * K + C) * 2u; voffB[i] = (unsigned)(Rb * K + C) * 2u; }
    const size_t kstep = (size_t)(BK * 2);
    const unsigned hstep = (unsigned)HALF * K * 2;
    const unsigned ldsw = (unsigned)wid * 1024u;
    const int aoff = lds_byte(wr * 64 + fr, fq * 8), boff = lds_byte(wc * 32 + fr, fq * 8);
#define PG8_SA(b, h) (((b) * 2 + (h)) * HTB)
#define PG8_SB(b, h) ((4 + (b) * 2 + (h)) * HTB)
#define PG8_STAGE2(bufoff, gbase, v0, v1) do { \
        __builtin_amdgcn_global_load_lds((const unsigned*)((const char*)(gbase) + (v0)), (LAS unsigned*)(lds + (bufoff) + ldsw), 16, 0, 0); \
        __builtin_amdgcn_global_load_lds((const unsigned*)((const char*)(gbase) + (v1)), (LAS unsigned*)(lds + (bufoff) + ldsw + 8192), 16, 0, 0); } while (0)
#define PG8_STAGEB(bufoff, gbase) PG8_STAGE2(bufoff, gbase, voffB[0], voffB[1])
#define PG8_STAGEA(bufoff, gbase, v0, v1) do { \
        __builtin_amdgcn_global_load_lds((const unsigned*)((const char*)(gbase) + (v0)), (LAS unsigned*)(lds + (bufoff) + ldsw), 16, 0, Sched::A_AUX); \
        __builtin_amdgcn_global_load_lds((const unsigned*)((const char*)(gbase) + (v1)), (LAS unsigned*)(lds + (bufoff) + ldsw + 8192), 16, 0, Sched::A_AUX); } while (0)
#define PG8_LDA(dst, b, h) do { _Pragma("unroll") for (int m = 0; m < 4; ++m) _Pragma("unroll") for (int k = 0; k < 2; ++k) dst[m][k] = *(const LAS bf16x8*)(lds + PG8_SA(b, h) + aoff + m * 2048 + k * 1024); } while (0)
#define PG8_LDB(dst, b, h) do { _Pragma("unroll") for (int n = 0; n < 2; ++n) _Pragma("unroll") for (int k = 0; k < 2; ++k) dst[n][k] = *(const LAS bf16x8*)(lds + PG8_SB(b, h) + boff + n * 2048 + k * 1024); } while (0)
#define PG8_MMA(ai, bj, At, Bt) do { __builtin_amdgcn_s_setprio(1); _Pragma("unroll") for (int m = 0; m < 4; ++m) _Pragma("unroll") for (int n = 0; n < 2; ++n) _Pragma("unroll") for (int k = 0; k < 2; ++k) \
        acc[ai][bj][m][n] = __builtin_amdgcn_mfma_f32_16x16x32_bf16(Bt[n][k], At[m][k], acc[ai][bj][m][n], 0, 0, 0); __builtin_amdgcn_s_setprio(0); } while (0)
#define PG8_WAIT_V(n) asm volatile("s_waitcnt vmcnt(" #n ")" ::: "memory")
#define PG8_WAIT_L(n) asm volatile("s_waitcnt lgkmcnt(" #n ")" ::: "memory")
#define PG8_BAR __builtin_amdgcn_s_barrier()
#define PG8_SCHED __builtin_amdgcn_sched_barrier(0)
    Unit cur, nxt; int ui = 0; int pend = -1;
    if (!S.next(0, cur)) return;
    f32x4 acc[2][2][4][2];
#pragma unroll
    for (int a = 0; a < 2; ++a)
#pragma unroll
        for (int b = 0; b < 2; ++b)
#pragma unroll
            for (int m = 0; m < 4; ++m)
#pragma unroll
                for (int n = 0; n < 2; ++n) acc[a][b][m][n] = (f32x4){0.f, 0.f, 0.f, 0.f};
    bf16x8 At[4][2], B0[2][2], B1[2][2];
    unsigned oc0[2], oc1[2], on0[2], on1[2];
    if constexpr (GATHER) {
#pragma unroll
        for (int i = 0; i < 2; ++i) { unsigned r0, r1; S.rows(cur, RA[i], RA[i] + 128, r0, r1); oc0[i] = r0 * (unsigned)(K * 2) + (unsigned)CA[i] * 2u; oc1[i] = r1 * (unsigned)(K * 2) + (unsigned)CA[i] * 2u; on0[i] = oc0[i]; on1[i] = oc1[i]; }
    } else {
#pragma unroll
        for (int i = 0; i < 2; ++i) { oc0[i] = voffA[i]; oc1[i] = voffA[i] + hstep; on0[i] = oc0[i]; on1[i] = oc1[i]; }
    }
    const char* cA = cur.a; const char* cB = cur.b;
    S.a_ready(cur);
    PG8_STAGEB(PG8_SB(0, 0), cB); PG8_STAGEA(PG8_SA(0, 0), cA, oc0[0], oc0[1]); PG8_STAGEB(PG8_SB(0, 1), cB + hstep); PG8_STAGEA(PG8_SA(0, 1), cA, oc1[0], oc1[1]);
    if (wr == 1) PG8_BAR;
    PG8_WAIT_V(4); PG8_BAR;
    PG8_STAGEB(PG8_SB(1, 0), cB + kstep); PG8_STAGEA(PG8_SA(1, 0), cA + kstep, oc0[0], oc0[1]); PG8_STAGEB(PG8_SB(1, 1), cB + hstep + kstep);
    PG8_WAIT_V(6); PG8_BAR;
    for (;;) {
        const bool has_next = S.next(ui + 1, nxt);
        const char* nA = has_next ? nxt.a : cA; const char* nB = has_next ? nxt.b : cB;
        if constexpr (GATHER) {
            if (has_next) {
#pragma unroll
                for (int i = 0; i < 2; ++i) { unsigned r0, r1; S.rows(nxt, RA[i], RA[i] + 128, r0, r1); on0[i] = r0 * (unsigned)(K * 2) + (unsigned)CA[i] * 2u; on1[i] = r1 * (unsigned)(K * 2) + (unsigned)CA[i] * 2u; }
            } else {
#pragma unroll
                for (int i = 0; i < 2; ++i) { on0[i] = oc0[i]; on1[i] = oc1[i]; }
            }
        }
        for (int t = 0; t < nt; t += 2) {
            const bool last = (t == nt - 2);
            const char* a1 = cA + (size_t)(t + 1) * kstep;
            const char* a2 = last ? nA : cA + (size_t)(t + 2) * kstep; const char* b2 = last ? nB : cB + (size_t)(t + 2) * kstep;
            const char* a3 = a2 + kstep; const char* b3 = b2 + kstep;
            if (last && has_next) S.a_ready(nxt);
            unsigned p00, p01, p10, p11;
            if constexpr (GATHER) { p00 = last ? on0[0] : oc0[0]; p01 = last ? on0[1] : oc0[1]; p10 = last ? on1[0] : oc1[0]; p11 = last ? on1[1] : oc1[1]; }
            else { p00 = oc0[0]; p01 = oc0[1]; p10 = oc1[0]; p11 = oc1[1]; }
            PG8_LDB(B0, 0, 0); PG8_SCHED; PG8_LDA(At, 0, 0); PG8_STAGEA(PG8_SA(1, 1), a1, oc1[0], oc1[1]);
            PG8_WAIT_L(8); PG8_BAR; PG8_WAIT_L(0); PG8_MMA(0, 0, At, B0); PG8_BAR; PG8_SCHED;
            PG8_LDB(B1, 0, 1); PG8_STAGEB(PG8_SB(0, 0), b2);
            PG8_BAR; PG8_WAIT_L(0); PG8_MMA(0, 1, At, B1); PG8_BAR;
            PG8_LDA(At, 0, 1); PG8_STAGEA(PG8_SA(0, 0), a2, p00, p01);
            PG8_BAR; PG8_WAIT_L(0); PG8_MMA(1, 0, At, B0); PG8_BAR; PG8_SCHED;
            PG8_STAGEB(PG8_SB(0, 1), b2 + hstep);
            PG8_WAIT_V(6); PG8_BAR; PG8_MMA(1, 1, At, B1); PG8_BAR;
            PG8_LDB(B0, 1, 0); PG8_SCHED; PG8_LDA(At, 1, 0); PG8_STAGEA(PG8_SA(0, 1), a2, p10, p11);
            PG8_WAIT_L(8); PG8_BAR; PG8_WAIT_L(0); PG8_MMA(0, 0, At, B0); PG8_BAR; PG8_SCHED;
            PG8_LDB(B1, 1, 1); PG8_STAGEB(PG8_SB(1, 0), b3);
            PG8_BAR; PG8_WAIT_L(0); PG8_MMA(0, 1, At, B1); PG8_BAR;
            PG8_LDA(At, 1, 1); PG8_STAGEA(PG8_SA(1, 0), a3, p00, p01);
            PG8_BAR; PG8_WAIT_L(0); PG8_MMA(1, 0, At, B0); PG8_BAR; PG8_SCHED;
            PG8_STAGEB(PG8_SB(1, 1), b3 + hstep);
            PG8_WAIT_V(6); PG8_BAR; PG8_MMA(1, 1, At, B1); PG8_BAR;
        }
        E(acc, cur, wr, wc, fr, fq);
        if constexpr (Sched::LAZY) {
            if (has_next) { if (pend >= 0) { asm volatile("s_waitcnt vmcnt(0)" ::: "memory"); S.arrive(pend); } pend = cur.pm; }
            else { asm volatile("s_waitcnt vmcnt(0)" ::: "memory"); if (pend >= 0) S.arrive(pend); S.arrive(cur.pm); pend = -1; }
        } else S.done(cur);
        if (!has_next) break;
#pragma unroll
        for (int a = 0; a < 2; ++a)
#pragma unroll
            for (int b = 0; b < 2; ++b)
#pragma unroll
                for (int m = 0; m < 4; ++m)
#pragma unroll
                    for (int n = 0; n < 2; ++n) acc[a][b][m][n] = (f32x4){0.f, 0.f, 0.f, 0.f};
        cur = nxt; cA = nA; cB = nB; ++ui;
#pragma unroll
        for (int i = 0; i < 2; ++i) { oc0[i] = on0[i]; oc1[i] = on1[i]; }
    }
    PG8_WAIT_V(0);
    if (wr == 0) PG8_BAR;
    PG8_BAR;
#undef PG8_SA
#undef PG8_SB
#undef PG8_STAGE2
#undef PG8_STAGEB
#undef PG8_STAGEA
#undef PG8_LDA
#undef PG8_LDB
#undef PG8_MMA
#undef PG8_WAIT_V
#undef PG8_WAIT_L
#undef PG8_BAR
#undef PG8_SCHED
}

struct EpiBf16 {
    static constexpr bool PERM = true;
    bf16_t* O; int ldc, ncols;
    __device__ __forceinline__ void operator()(const f32x4 (&acc)[2][2][4][2], const Unit& u, int wr, int wc, int fr, int fq) const {
        const int row0 = u.pm * BM + wr * 64 + fr, col0 = u.pn * BM + wc * 32 + 8 * fq;
#pragma unroll
        for (int ai = 0; ai < 2; ++ai)
#pragma unroll
            for (int m = 0; m < 4; ++m) { bf16_t* rowp = O + (size_t)(row0 + ai * HALF + m * 16) * ldc + col0;
#pragma unroll
                for (int bj = 0; bj < 2; ++bj) { const f32x4 v0 = acc[ai][bj][m][0], v1 = acc[ai][bj][m][1];
                    u32x4 o; o.x = pk2(v0[0], v0[1]); o.y = pk2(v0[2], v0[3]); o.z = pk2(v1[0], v1[1]); o.w = pk2(v1[2], v1[3]);
                    if (col0 + bj * HALF < ncols) *(u32x4*)(rowp + bj * HALF) = o; } }
    }
};
struct EpiBf16WT {
    static constexpr bool PERM = true;
    bf16_t* O; int ldc; unsigned nbytes;
    __device__ __forceinline__ void operator()(const f32x4 (&acc)[2][2][4][2], const Unit& u, int wr, int wc, int fr, int fq) const {
        const int row0 = u.pm * BM + wr * 64 + fr, col0 = u.pn * BM + wc * 32 + 8 * fq;
        const __amdgpu_buffer_rsrc_t rsrc = __builtin_amdgcn_make_buffer_rsrc((void*)O, 0, nbytes, 0x00020000);
#pragma unroll
        for (int ai = 0; ai < 2; ++ai)
#pragma unroll
            for (int m = 0; m < 4; ++m) { const size_t ro = (size_t)(row0 + ai * HALF + m * 16) * ldc + col0;
#pragma unroll
                for (int bj = 0; bj < 2; ++bj) { const f32x4 v0 = acc[ai][bj][m][0], v1 = acc[ai][bj][m][1];
                    u32x4 o; o.x = pk2(v0[0], v0[1]); o.y = pk2(v0[2], v0[3]); o.z = pk2(v1[0], v1[1]); o.w = pk2(v1[2], v1[3]);
                    __builtin_amdgcn_raw_buffer_store_b128(o, rsrc, (int)((ro + bj * HALF) * 2), 0, 16); } }
    }
};
struct EpiResF32 {
    static constexpr bool PERM = false;
    float* C; const float* X; int ldc;
    __device__ __forceinline__ void operator()(const f32x4 (&acc)[2][2][4][2], const Unit& u, int wr, int wc, int fr, int fq) const {
        const int row0 = u.pm * BM + wr * 64 + fr, col0 = u.pn * BM + wc * 32 + 4 * fq;
        const __amdgpu_buffer_rsrc_t rsrc = __builtin_amdgcn_make_buffer_rsrc((void*)C, 0, NTOK * DM * 4, 0x00020000);
#pragma unroll
        for (int ai = 0; ai < 2; ++ai)
#pragma unroll
            for (int m = 0; m < 4; ++m) { const size_t ro = (size_t)(row0 + ai * HALF + m * 16) * ldc + col0;
#pragma unroll
                for (int bj = 0; bj < 2; ++bj)
#pragma unroll
                    for (int n = 0; n < 2; ++n) { const f32x4 xv = *(const f32x4*)(X + ro + bj * HALF + n * 16); const f32x4 o = acc[ai][bj][m][n] + xv;
                        __builtin_amdgcn_raw_buffer_store_b128(__builtin_bit_cast(u32x4, o), rsrc, (int)((ro + bj * HALF + n * 16) * 4), 0, 16); } }
    }
};
struct EpiResBf16 {
    static constexpr bool PERM = true;
    bf16_t* C; const float* X; int ldc;
    __device__ __forceinline__ void operator()(const f32x4 (&acc)[2][2][4][2], const Unit& u, int wr, int wc, int fr, int fq) const {
        const int row0 = u.pm * BM + wr * 64 + fr, col0 = u.pn * BM + wc * 32 + 8 * fq;
        const __amdgpu_buffer_rsrc_t rsrc = __builtin_amdgcn_make_buffer_rsrc((void*)C, 0, NTOK * DM * 2, 0x00020000);
#pragma unroll
        for (int ai = 0; ai < 2; ++ai) {
            f32x4 xv[4][2][2];
#pragma unroll
            for (int m = 0; m < 4; ++m) { const size_t ro = (size_t)(row0 + ai * HALF + m * 16) * ldc + col0;
#pragma unroll
                for (int bj = 0; bj < 2; ++bj) { xv[m][bj][0] = *(const f32x4*)(X + ro + bj * HALF); xv[m][bj][1] = *(const f32x4*)(X + ro + bj * HALF + 4); } }
            __builtin_amdgcn_sched_barrier(0);
#pragma unroll
            for (int m = 0; m < 4; ++m) { const size_t ro = (size_t)(row0 + ai * HALF + m * 16) * ldc + col0;
#pragma unroll
                for (int bj = 0; bj < 2; ++bj) {
                    const f32x4 v0 = acc[ai][bj][m][0] + xv[m][bj][0], v1 = acc[ai][bj][m][1] + xv[m][bj][1];
                    u32x4 o; o.x = pk2(v0[0], v0[1]); o.y = pk2(v0[2], v0[3]); o.z = pk2(v1[0], v1[1]); o.w = pk2(v1[2], v1[3]);
                    __builtin_amdgcn_raw_buffer_store_b128(o, rsrc, (int)((ro + bj * HALF) * 2), 0, 16); } }
            __builtin_amdgcn_sched_barrier(0);
        }
    }
};
struct PanelOrder {
    static constexpr int A_AUX = 0; static constexpr bool LAZY = false;
    const char* A; const char* Bt; unsigned* cnt; int K, nN, nwg, G, c;
    __device__ __forceinline__ bool next(int i, Unit& u) const {
        const int L = i * G + c; if (L >= nwg) return false;
        u.pm = L / nN; u.pn = L % nN; u.e = 0; u.mt = 0;
        u.a = A + (size_t)u.pm * 256 * K * 2; u.b = Bt + (size_t)u.pn * 256 * K * 2; return true;
    }
    __device__ __forceinline__ void rows(const Unit&, int, int, unsigned&, unsigned&) const {}
    __device__ __forceinline__ void a_ready(const Unit&) const {}
    __device__ __forceinline__ void done(const Unit& u) const {
        asm volatile("s_waitcnt vmcnt(0)" ::: "memory");
        if ((threadIdx.x & 63) == 0) __hip_atomic_fetch_add(cnt + 16 * u.pm, 1u, __ATOMIC_RELAXED, __HIP_MEMORY_SCOPE_AGENT);
    }
};
}

template <int KS>
__device__ __forceinline__ f32x4 tile_n(const LAS unsigned char* A, int lda, const LAS unsigned char* Bt, int ldb, f32x4 acc, int lane) {
    const LAS unsigned char* ap = A + (lane & 15) * lda + (lane >> 4) * 16;
    const LAS unsigned char* bp = Bt + (lane & 15) * ldb + (lane >> 4) * 16;
#pragma unroll
    for (int k = 0; k < KS; ++k) { const bf16x8 a = *(const LAS bf16x8*)(ap + k * 64), b = *(const LAS bf16x8*)(bp + k * 64); acc = __builtin_amdgcn_mfma_f32_16x16x32_bf16(a, b, acc, 0, 0, 0); }
    return acc;
}
template <int KS>
__device__ __forceinline__ f32x4 tile_s(const LAS unsigned char* A, int lda, const LAS unsigned char* Bt, int ldb, f32x4 acc, int lane) {
    const LAS unsigned char* ap = A + (lane & 15) * lda + (lane >> 4) * 16;
    const LAS unsigned char* bp = Bt + (lane & 15) * ldb + (lane >> 4) * 16;
#pragma unroll
    for (int k = 0; k < KS; ++k) { const bf16x8 a = *(const LAS bf16x8*)(ap + k * 64), b = *(const LAS bf16x8*)(bp + k * 64); acc = __builtin_amdgcn_mfma_f32_16x16x32_bf16(b, a, acc, 0, 0, 0); }
    return acc;
}
struct Frag2 { bf16x8 f[2]; };
__device__ __forceinline__ Frag2 ld_frag2(const LAS unsigned char* M, int ld, int lane) { const LAS unsigned char* p = M + (lane & 15) * ld + (lane >> 4) * 16; Frag2 r; r.f[0] = *(const LAS bf16x8*)p; r.f[1] = *(const LAS bf16x8*)(p + 64); return r; }
__device__ __forceinline__ f32x4 tile_nb(const LAS unsigned char* A, int lda, const Frag2& b, f32x4 acc, int lane) {
    const LAS unsigned char* ap = A + (lane & 15) * lda + (lane >> 4) * 16;
#pragma unroll
    for (int k = 0; k < 2; ++k) { const bf16x8 a = *(const LAS bf16x8*)(ap + k * 64); acc = __builtin_amdgcn_mfma_f32_16x16x32_bf16(a, b.f[k], acc, 0, 0, 0); }
    return acc;
}
__device__ __forceinline__ f32x4 tile_sb(const LAS unsigned char* A, int lda, const Frag2& b, f32x4 acc, int lane) {
    const LAS unsigned char* ap = A + (lane & 15) * lda + (lane >> 4) * 16;
#pragma unroll
    for (int k = 0; k < 2; ++k) { const bf16x8 a = *(const LAS bf16x8*)(ap + k * 64); acc = __builtin_amdgcn_mfma_f32_16x16x32_bf16(b.f[k], a, acc, 0, 0, 0); }
    return acc;
}
__device__ __forceinline__ void st4bf(LAS unsigned char* p, const f32x4& v) { u32x2 o; o.x = pk2(v[0], v[1]); o.y = pk2(v[2], v[3]); *(LAS u32x2*)p = o; }
__device__ __forceinline__ void st4bf_g(bf16_t* p, const f32x4& v) { u32x2 o; o.x = pk2(v[0], v[1]); o.y = pk2(v[2], v[3]); *(u32x2*)p = o; }


struct Ctx { ldsp_t lds; int tid, lane, wid, vcu, G; };

__device__ __forceinline__ void transpose_block(const float* W, int N, bf16_t* WT, int ldk, int dst_row0, int k0, int n0, LAS float* scr, int lane) {
    float tv[32];
#pragma unroll
    for (int i = 0; i < 32; ++i) { const int kk = 2 * i + (lane >> 5); tv[i] = W[(size_t)(k0 + kk) * N + n0 + (lane & 31)]; }
#pragma unroll
    for (int i = 0; i < 32; ++i) { const int kk = 2 * i + (lane >> 5); scr[kk * 33 + (lane & 31)] = tv[i]; }
    asm volatile("s_waitcnt lgkmcnt(0)" ::: "memory");
    const int c = lane & 7;
#pragma unroll
    for (int j = 0; j < 4; ++j) { const int n = (lane >> 3) + 8 * j; const LAS float* s = scr + (8 * c) * 33 + n;
        u32x4 o; o.x = pk2(s[0 * 33], s[1 * 33]); o.y = pk2(s[2 * 33], s[3 * 33]); o.z = pk2(s[4 * 33], s[5 * 33]); o.w = pk2(s[6 * 33], s[7 * 33]);
        *(u32x4*)(WT + (size_t)(dst_row0 + n) * ldk + k0 + 8 * c) = o; }
    asm volatile("s_waitcnt lgkmcnt(0)" ::: "memory");
}
__device__ __forceinline__ void rms_row_to_bf16(const float* xrow, const float* w, bf16_t* orow, int lane) {
    const f32x4* xr = (const f32x4*)xrow + lane; const f32x4* wr = (const f32x4*)w + lane;
    f32x4 v[4]; float s = 0.f;
#pragma unroll
    for (int j = 0; j < 4; ++j) { v[j] = xr[64 * j]; s += (v[j].x * v[j].x + v[j].y * v[j].y) + (v[j].z * v[j].z + v[j].w * v[j].w); }
    const float inv = rsqrtf(wave_sum(s) * (1.f / 1024.f) + 1e-6f);
    u32x2* o8 = (u32x2*)orow + lane;
#pragma unroll
    for (int j = 0; j < 4; ++j) { const f32x4 g = wr[64 * j]; u32x2 o; o.x = pk2(v[j].x * inv * g.x, v[j].y * inv * g.y); o.y = pk2(v[j].z * inv * g.z, v[j].w * inv * g.w); o8[64 * j] = o; }
}
__device__ __forceinline__ void p0_prologue(const Params& P, const Ctx& F) {
    LAS float* scr = (LAS float*)(F.lds + F.wid * 16384);
    const int gw = F.vcu * 8 + F.wid, NGW = F.G * 8;
    unsigned char* ws = P.ws;
    bf16_t* BT_RW = (bf16_t*)(ws + WS_BT_RW); bf16_t* BT_GL = (bf16_t*)(ws + WS_BT_GL); bf16_t* BT_OUT = (bf16_t*)(ws + WS_BT_OUT);
    bf16_t* LORA = (bf16_t*)(ws + WS_LORA);
    constexpr int I_IN = 16 * 109, I_OUT = 16 * 32, I_L = 16, I_G = 32;
    constexpr int NITEMS = I_IN + I_OUT + 4 * I_L + I_G;
    for (int it = gw; it < NITEMS; it += NGW) {
        int r = it;
        if (r < I_IN) { const int kb = r / 109, nb = r % 109, n0 = 32 * nb;
            if (n0 < RW_COLS) transpose_block(P.w_in, 3488, BT_RW, 1024, n0, 64 * kb, n0, scr, F.lane);
            else transpose_block(P.w_in, 3488, BT_GL, 1024, n0 - RW_COLS, 64 * kb, n0, scr, F.lane);
            continue; }
        r -= I_IN;
        if (r < I_OUT) { const int kb = r / 32, nb = r % 32; transpose_block(P.w_out, 1024, BT_OUT, 1024, 32 * nb, 64 * kb, 32 * nb, scr, F.lane); continue; }
        r -= I_OUT;
        if (r < 4 * I_L) { const int which = r / I_L, nb = r % I_L;
            const float* src = which == 0 ? P.w2_f : which == 1 ? P.w2_b : which == 2 ? P.a2_f : P.a2_b;
            transpose_block(src, 512, LORA + (size_t)which * 32768, 64, 32 * nb, 0, 32 * nb, scr, F.lane); continue; }
        r -= 4 * I_L;
        { const int kb = r / 16, nb = r % 16; transpose_block(P.g2, 512, LORA + 4 * 32768, 128, 32 * nb, 64 * kb, 32 * nb, scr, F.lane); }
    }
    { const int gt = F.vcu * 512 + F.tid, NGT = F.G * 512; const u32x4 z = {0u, 0u, 0u, 0u};
      u32x4* p1 = (u32x4*)(BT_RW + (size_t)RW_COLS * 1024); for (int i = gt; i < (2048 - RW_COLS) * 128; i += NGT) p1[i] = z;
      u32x4* p2 = (u32x4*)(BT_GL + (size_t)GL_COLS * 1024); for (int i = gt; i < (1792 - GL_COLS) * 128; i += NGT) p2[i] = z; }
    { const int gt = F.vcu * 512 + F.tid, NGT = F.G * 512; bf16_t* GW2T = (bf16_t*)(ws + WS_LORA + 640 * 1024);
      for (int i = gt; i < 2 * 256 * 16; i += NGT) { const int d = i >> 12, ch = (i >> 4) & 255, m = i & 15; GW2T[i] = (bf16_t)f2bf((d ? P.gw2_b : P.gw2_f)[m * 256 + ch]); } }
    { const int gt = F.vcu * 512 + F.tid, NGT = F.G * 512; bf16_t* WrT = (bf16_t*)(ws + WS_LORA + 512 * 1024);
      for (int i = gt; i < 48 * 1024; i += NGT) { const int n = i >> 10, k = i & 1023;
          const float v = n < 4 ? P.w_coarse[k * 4 + n] : n < 36 ? P.w_fine[k * 32 + n - 4] : 0.f; WrT[i] = (bf16_t)f2bf(v); } }
    bf16_t* H = (bf16_t*)(ws + WS_H);
    f32x4 gw4[4];
#pragma unroll
    for (int j = 0; j < 4; ++j) gw4[j] = *((const f32x4*)P.ln1_w + F.lane + 64 * j);
    for (int m = gw; m < NTOK; m += 2 * NGW) {
        const int m2 = m + NGW; const bool has2 = m2 < NTOK;
        const f32x4* xa = (const f32x4*)(P.x + (size_t)m * 1024) + F.lane; const f32x4* xb = (const f32x4*)(P.x + (size_t)(has2 ? m2 : m) * 1024) + F.lane;
        f32x4 va[4], vb[4]; float ss[2] = {0.f, 0.f};
#pragma unroll
        for (int j = 0; j < 4; ++j) { va[j] = xa[64 * j]; vb[j] = xb[64 * j]; }
#pragma unroll
        for (int j = 0; j < 4; ++j) { ss[0] += (va[j].x * va[j].x + va[j].y * va[j].y) + (va[j].z * va[j].z + va[j].w * va[j].w); ss[1] += (vb[j].x * vb[j].x + vb[j].y * vb[j].y) + (vb[j].z * vb[j].z + vb[j].w * vb[j].w); }
        wave_sum_n<2>(ss);
        const float ia = rsqrtf(ss[0] * (1.f / 1024.f) + 1e-6f), ib = rsqrtf(ss[1] * (1.f / 1024.f) + 1e-6f);
        u32x2* oa = (u32x2*)(H + (size_t)m * 1024) + F.lane; u32x2* ob = (u32x2*)(H + (size_t)m2 * 1024) + F.lane;
#pragma unroll
        for (int j = 0; j < 4; ++j) { const f32x4 g = gw4[j];
            u32x2 o; o.x = pk2(va[j].x * ia * g.x, va[j].y * ia * g.y); o.y = pk2(va[j].z * ia * g.z, va[j].w * ia * g.w); oa[64 * j] = o;
            if (has2) { u32x2 q; q.x = pk2(vb[j].x * ib * g.x, vb[j].y * ib * g.y); q.y = pk2(vb[j].z * ib * g.z, vb[j].w * ib * g.w); ob[64 * j] = q; } }
    }
}

__device__ __forceinline__ bf16x8 pack_step(const f32x16& x, int s) {
    u32x4 p; p.x = pk2(x[8 * s + 0], x[8 * s + 1]); p.y = pk2(x[8 * s + 2], x[8 * s + 3]); p.z = pk2(x[8 * s + 4], x[8 * s + 5]); p.w = pk2(x[8 * s + 6], x[8 * s + 7]);
    return __builtin_bit_cast(bf16x8, p);
}
#define MFMA32(a, b, c) __builtin_amdgcn_mfma_f32_32x32x16_bf16((a), (b), (c), 0, 0, 0)

constexpr size_t OUT_GQ = 0, OUT_GNT = 16 * MiB;
constexpr int RS = 144;
constexpr int RMS_ = 64 * RS;
constexpr int L_AT = 0, L_BT = RMS_, L_KT = 2 * RMS_, L_RT = 3 * RMS_, L_ATT = 4 * RMS_, L_BHT = 5 * RMS_, L_KHT = 6 * RMS_, L_VT = 7 * RMS_;
constexpr int L_U1 = 8 * RMS_;
constexpr int L_TW = L_U1, L_AL = L_U1 + RMS_, L_SG = L_U1 + 2 * RMS_, L_LW = L_SG + 64 * 272, L_AA = L_LW + 16384;
constexpr int L_T1 = L_LW, L_LAK = L_T1 + RMS_, L_RB = L_T1 + 2 * RMS_, L_RK = L_T1 + 3 * RMS_, L_EX = L_T1 + 4 * RMS_, L_WC = L_U1 + 9 * RMS_;
static_assert(L_EX + 4096 + 64 <= L_WC, "rwkv back-end LDS map");
constexpr int L_XT = 0, L_G1T = 2 * RMS_;
static_assert(L_AA + 16384 <= L_WC && L_WC + 256 <= LDS_MISC, "rwkv LDS map");
constexpr int L_PF = L_WC + 512;
constexpr int L_HS = L_WC + 1024;
static_assert(L_HS + 2048 <= LDS_MISC, "half-block sums");
static_assert(L_PF + 256 <= LDS_MISC, "prefetch sink");

struct RwRaw { u32x4 xc[4]; unsigned rr[10], rk[10], rv[10]; };
template <int DIR>
__device__ __forceinline__ void rwkv_load_lora(const Params& P, const Ctx& F, const int item, RwRaw& R) {
    constexpr int dir = DIR; const int c = (item >> 4) & 63, b = item >> 10;
    const int t0 = c * 64, tb = b * SEQ;
    const bf16_t* PA = (const bf16_t*)P.out;
#pragma unroll
    for (int it = 0; it < 4; ++it) {
        const int q = F.tid + 512 * it, j = q >> 5, ch = q & 31;
        const int col0 = ch < 8 ? 1536 + 64 * dir + 8 * ch : ch < 16 ? 1664 + 64 * dir + 8 * (ch - 8) : 1792 + 8 * (ch - 16);
        const int tn = dir ? t0 + 63 - j : t0 + j;
        R.xc[it] = *(const u32x4*)(PA + (size_t)(tb + tn) * LDA_RW + col0);
    }
}
template <int DIR>
__device__ __forceinline__ void rwkv_load_rkv(const Params& P, const Ctx& F, const int item, RwRaw& R) {
    constexpr int dir = DIR; const int h = (item >> 1) & 7, c = (item >> 4) & 63, b = item >> 10;
    const int t0 = c * 64, tb = b * SEQ;
    const bf16_t* PA = (const bf16_t*)P.out;
    const int jlo = 8 * F.wid, tlo = dir ? (t0 + 55 - jlo) : (t0 + jlo - 1), hi = h * 64 + F.lane;
#pragma unroll
    for (int q = 0; q < 10; ++q) { int tn = tlo + q; tn = tn < 0 ? 0 : (tn > SEQ - 1 ? SEQ - 1 : tn);
        const bf16_t* row = PA + (size_t)(tb + tn) * LDA_RW + hi;
        R.rr[q] = row[0]; R.rk[q] = row[512]; R.rv[q] = row[1024]; }
}
template <int DIR>
__device__ __forceinline__ void rwkv_prefetch(const Params& P, const Ctx& F, const int nitem, unsigned& sink) {
    const int h = (nitem >> 1) & 7, c = (nitem >> 4) & 63, b = nitem >> 10;
    const int t0 = c * 64, tb = b * SEQ, tid = F.tid;
    const bf16_t* PA = (const bf16_t*)P.out;
    if (tid < 198) {
        const int q = tid / 3, a = tid - 3 * q; int tn = t0 - 1 + q; tn = tn < 0 ? 0 : (tn > SEQ - 1 ? SEQ - 1 : tn);
        const bf16_t* p = PA + (size_t)(tb + tn) * LDA_RW + a * 512 + h * 64;
        { unsigned m0s; asm volatile("s_mov_b32 %0, m0\n\ts_mov_b32 m0, %2\n\ts_nop 0\n\tglobal_load_lds_dword %1, off\n\ts_mov_b32 m0, %0" : "=&s"(m0s) : "v"(p), "s"(L_PF) : "memory"); }
    }
    if (h == 0 && tid < 264) {
        const int q = tid >> 2, a = tid & 3; int tn = t0 - 1 + q; tn = tn < 0 ? 0 : (tn > SEQ - 1 ? SEQ - 1 : tn);
        const int col = a == 0 ? 1536 + 64 * DIR : a == 1 ? 1664 + 64 * DIR : 1792 + 64 * (a - 2);
        const bf16_t* p = PA + (size_t)(tb + tn) * LDA_RW + col;
        { unsigned m0s; asm volatile("s_mov_b32 %0, m0\n\ts_mov_b32 m0, %2\n\ts_nop 0\n\tglobal_load_lds_dword %1, off\n\ts_mov_b32 m0, %0" : "=&s"(m0s) : "v"(p), "s"(L_PF) : "memory"); }
    }
}
template <int DIR>
__device__ __forceinline__ void rwkv_item(const Params& P, const Ctx& F, const int item, RwRaw& R, const bool lora, const int nitem, const bool has_next, unsigned& sink) {
    const int tid = F.tid, lane = F.lane, wid = F.wid; ldsp_t lds = F.lds;
    constexpr int dir = DIR; const int h = (item >> 1) & 7, c = (item >> 4) & 63, b = item >> 10;
    const int t0 = c * 64, tb = b * SEQ;
    unsigned char* ws = P.ws;
    const int hi = h * 64 + lane;

    if (lora) rwkv_load_lora<DIR>(P, F, item, R);
    rwkv_load_rkv<DIR>(P, F, item, R);
    PROBE_BEGIN(1)
    const int rb = wid >> 1, cb0 = 2 * (wid & 1);
    bf16x8 bw[2][2], ba[2][2]; float w0v[2], a0v[2];
    {
        const bf16_t* LORA = (const bf16_t*)(ws + WS_LORA);
        const bf16_t* W2t = LORA + (size_t)dir * 32768; const bf16_t* A2t = LORA + (size_t)(2 + dir) * 32768;
        const float* w0 = dir ? P.w0_b : P.w0_f; const float* a0 = dir ? P.a0_b : P.a0_f;
#pragma unroll
        for (int t = 0; t < 2; ++t) { const int hn = h * 64 + 16 * (cb0 + t) + (lane & 15);
            w0v[t] = w0[hn]; a0v[t] = a0[hn];
#pragma unroll
            for (int kk = 0; kk < 2; ++kk) { bw[t][kk] = *(const bf16x8*)(W2t + (size_t)hn * 64 + 8 * (lane >> 4) + 32 * kk); ba[t][kk] = *(const bf16x8*)(A2t + (size_t)hn * 64 + 8 * (lane >> 4) + 32 * kk); }
        }
    }
    __builtin_amdgcn_sched_barrier(0);
    const float kkw = P.k_k[hi], kaw = P.k_a[hi], rkw = P.r_k[hi];
    const float mur = P.rw_mu[hi], muk = P.rw_mu[512 + hi], muv = P.rw_mu[1024 + hi];
    float rr[8], kr[8], vr[8];
    {
        const int jlo = 8 * wid;
        const int tlo = dir ? (t0 + 55 - jlo) : (t0 + jlo - 1);
        float raw_r[10], raw_k[10], raw_v[10];
#pragma unroll
        for (int q = 0; q < 10; ++q) { const int tn = tlo + q; const bool ok = (tn >= 0) && (tn < SEQ);
            if (q == 0 || q == 9) { raw_r[q] = ok ? bf2f(R.rr[q]) : 0.f; raw_k[q] = ok ? bf2f(R.rk[q]) : 0.f; raw_v[q] = ok ? bf2f(R.rv[q]) : 0.f; }
            else { raw_r[q] = bf2f(R.rr[q]); raw_k[q] = bf2f(R.rk[q]); raw_v[q] = bf2f(R.rv[q]); } }
#pragma unroll
        for (int jj = 0; jj < 8; ++jj) {
            const float cr = dir ? raw_r[8 - jj] : raw_r[1 + jj], pr = dir ? raw_r[7 - jj] : raw_r[jj], nr = dir ? raw_r[9 - jj] : raw_r[2 + jj];
            const float ck = dir ? raw_k[8 - jj] : raw_k[1 + jj], pk = dir ? raw_k[7 - jj] : raw_k[jj], nk = dir ? raw_k[9 - jj] : raw_k[2 + jj];
            const float cv = dir ? raw_v[8 - jj] : raw_v[1 + jj], pv = dir ? raw_v[7 - jj] : raw_v[jj], nv = dir ? raw_v[9 - jj] : raw_v[2 + jj];
            rr[jj] = cr + mur * (0.5f * (pr + nr) - cr); kr[jj] = ck + muk * (0.5f * (pk + nk) - ck); vr[jj] = cv + muv * (0.5f * (pv + nv) - cv);
        }
    }
    if (lora) {
    u32x4 xpv[4], xnv[4];
    {
        const bf16_t* PA = (const bf16_t*)P.out; const int ch = tid & 31;
        const int col0 = ch < 8 ? 1536 + 64 * dir + 8 * ch : ch < 16 ? 1664 + 64 * dir + 8 * (ch - 8) : 1792 + 8 * (ch - 16);
#pragma unroll
        for (int it = 0; it < 4; ++it) { const int j = (tid >> 5) + 16 * it, tn = dir ? t0 + 63 - j : t0 + j;
            const bf16_t* row = PA + (size_t)(tb + tn) * LDA_RW + col0;
            const bf16_t* rp = tn > 0 ? row - LDA_RW : row; const bf16_t* rn = tn < SEQ - 1 ? row + LDA_RW : row;
            xpv[it] = *(const u32x4*)rp; xnv[it] = *(const u32x4*)rn; }
    }
    {
        const int ch = tid & 31;
        const int col0 = ch < 8 ? 1536 + 64 * dir + 8 * ch : ch < 16 ? 1664 + 64 * dir + 8 * (ch - 8) : 1792 + 8 * (ch - 16);
        const float cs = ch < 8 ? 2.f : 1.f, ca = ch < 8 ? 2.f : ch < 16 ? 0.f : 1.f, cbb = ch < 8 ? -1.f : 0.f, ci = (ch >= 8 && ch < 16) ? 1.f : 0.f;
        const f32x4 m0 = *(const f32x4*)(P.rw_mu + col0), m1 = *(const f32x4*)(P.rw_mu + col0 + 4);
        const float mu[8] = {m0.x, m0.y, m0.z, m0.w, m1.x, m1.y, m1.z, m1.w};
#pragma unroll
        for (int it = 0; it < 4; ++it) {
            const int j = (tid >> 5) + 16 * it;
            {
                LAS unsigned char* dst = ch < 8 ? lds + L_TW + j * RS + ch * 16 : ch < 16 ? lds + L_AL + j * RS + (ch - 8) * 16 : lds + L_SG + j * 272 + (ch - 16) * 16;
                const int tn = dir ? t0 + 63 - j : t0 + j;
                const float mp = tn > 0 ? 0.5f : 0.f, mn = tn < SEQ - 1 ? 0.5f : 0.f;
                float fc[8], fp[8], fn[8], o[8]; unpack8(R.xc[it], fc); unpack8(xpv[it], fp); unpack8(xnv[it], fn);
#pragma unroll
                for (int e = 0; e < 8; ++e) { const float v = fc[e] + mu[e] * ((mp * fp[e] + mn * fn[e]) - fc[e]); o[e] = ca * sigmoidf_(cs * v) + cbb + ci * v; }
                *(LAS u32x4*)dst = pack8(o);
            }
            __builtin_amdgcn_sched_barrier(0);
        }
    }
    }
    const bool mine = ((h >> 2) == dir);
    PROBE_END(1)
    if (lora) __syncthreads();
    PROBE_BEGIN(2)
    {
        bf16_t* Gout = (bf16_t*)(ws + WS_G);
        const LAS unsigned char* ap_w = lds + L_TW + (16 * rb + (lane & 15)) * RS + (lane >> 4) * 16;
        const LAS unsigned char* ap_a = lds + L_AL + (16 * rb + (lane & 15)) * RS + (lane >> 4) * 16;
        const bf16x8 fw0 = *(const LAS bf16x8*)(ap_w), fw1 = *(const LAS bf16x8*)(ap_w + 64), fa0 = *(const LAS bf16x8*)(ap_a), fa1 = *(const LAS bf16x8*)(ap_a + 64);
        f32x4 zw[2], za[2];
#pragma unroll
        for (int t = 0; t < 2; ++t) { const f32x4 z4 = {0.f, 0.f, 0.f, 0.f};
            zw[t] = __builtin_amdgcn_mfma_f32_16x16x32_bf16(fw0, bw[t][0], z4, 0, 0, 0); za[t] = __builtin_amdgcn_mfma_f32_16x16x32_bf16(fa0, ba[t][0], z4, 0, 0, 0);
            zw[t] = __builtin_amdgcn_mfma_f32_16x16x32_bf16(fw1, bw[t][1], zw[t], 0, 0, 0); za[t] = __builtin_amdgcn_mfma_f32_16x16x32_bf16(fa1, ba[t][1], za[t], 0, 0, 0); }
        bf16x8 bg[2][4]; bf16x8 fg[4];
        if (mine) { const bf16_t* G2t = (const bf16_t*)(ws + WS_LORA) + (size_t)4 * 32768;
            const LAS unsigned char* ap_g = lds + L_SG + (16 * rb + (lane & 15)) * 272 + (lane >> 4) * 16;
#pragma unroll
            for (int t = 0; t < 2; ++t) { const int hn = h * 64 + 16 * (cb0 + t) + (lane & 15);
#pragma unroll
                for (int kk = 0; kk < 4; ++kk) bg[t][kk] = *(const bf16x8*)(G2t + (size_t)hn * 128 + 8 * (lane >> 4) + 32 * kk); }
#pragma unroll
            for (int kk = 0; kk < 4; ++kk) fg[kk] = *(const LAS bf16x8*)(ap_g + kk * 64); }
        __builtin_amdgcn_sched_barrier(0);
#pragma unroll
        for (int t = 0; t < 2; ++t) {
            const int cb = cb0 + t, n = 16 * cb + (lane & 15);
            float hs = 0.f;
#pragma unroll
            for (int r = 0; r < 4; ++r) { const int j = 16 * rb + 4 * (lane >> 4) + r;
                const float lwv = -0.60653066f * sigmoidf_(w0v[t] + zw[t][r]); hs += lwv;
                *(LAS float*)(lds + L_LW + (j * 64 + n) * 4) = lwv;
                *(LAS float*)(lds + L_AA + (j * 64 + n) * 4) = sigmoidf_(a0v[t] + za[t][r]); }
            hs += __shfl_xor(hs, 16);
            if (((lane >> 4) & 1) == 0) *(LAS float*)(lds + L_HS + ((2 * rb + (lane >> 5)) * 64 + n) * 4) = hs;
        }
        __builtin_amdgcn_sched_barrier(0);
        if (mine) {
#pragma unroll
            for (int t = 0; t < 2; ++t) { const int hn = h * 64 + 16 * (cb0 + t) + (lane & 15);
                f32x4 zg = {0.f, 0.f, 0.f, 0.f};
#pragma unroll
                for (int kk = 0; kk < 4; ++kk) zg = __builtin_amdgcn_mfma_f32_16x16x32_bf16(fg[kk], bg[t][kk], zg, 0, 0, 0);
#pragma unroll
                for (int r = 0; r < 4; ++r) { const int j = 16 * rb + 4 * (lane >> 4) + r; Gout[(size_t)(tb + (dir ? t0 + 63 - j : t0 + j)) * 512 + hn] = (bf16_t)f2bf(zg[r]); } }
        }
    }
    PROBE_END(2)
    __syncthreads();
    PROBE_BEGIN(3)
    if (tid == 0) *(volatile LAS unsigned*)(lds + L_EX + 4096) = 0u;
    {
        float total = 0.f, pre = 0.f;
        { float h8[8];
#pragma unroll
          for (int q = 0; q < 8; ++q) h8[q] = *(const LAS float*)(lds + L_HS + (q * 64 + lane) * 4);
#pragma unroll
          for (int q = 0; q < 8; ++q) { if (q < wid) pre += h8[q]; else total += h8[q]; } }
        total += pre;
        __builtin_amdgcn_sched_barrier(0);
        float* BON = (float*)(ws + WS_BON); bf16_t* VS = (bf16_t*)(ws + WS_VS);
        float at_[8], bh_[8], kh_[8];
        float red[16], kd_[8], av_[8], lwv_[8];
#pragma unroll
        for (int jj = 0; jj < 8; ++jj) {
            const int j = 8 * wid + jj;
            lwv_[jj] = *(const LAS float*)(lds + L_LW + (j * 64 + lane) * 4); av_[jj] = *(const LAS float*)(lds + L_AA + (j * 64 + lane) * 4);
        }
#pragma unroll
        for (int jp = 0; jp < 4; ++jp) {
            const f2_t krv = (f2_t){kr[2 * jp], kr[2 * jp + 1]}, rrv = (f2_t){rr[2 * jp], rr[2 * jp + 1]}, a2 = (f2_t){av_[2 * jp], av_[2 * jp + 1]};
            const f2_t kraw = krv * kkw, kdv = krv * (1.f + (a2 - 1.f) * kaw), r0 = kraw * kraw, r1 = rrv * kdv * rkw;
            kd_[2 * jp] = kdv.x; kd_[2 * jp + 1] = kdv.y; red[2 * jp] = r0.x; red[2 * jp + 1] = r0.y; red[8 + 2 * jp] = r1.x; red[8 + 2 * jp + 1] = r1.y;
        }
        float u4[4]; wave_sum16_rows(red, u4);
#pragma unroll
        for (int i = 0; i < 4; ++i) { red[i] = __int_as_float(__builtin_amdgcn_readlane(__float_as_int(u4[i]), 0)); red[4 + i] = __int_as_float(__builtin_amdgcn_readlane(__float_as_int(u4[i]), 16)); }
        if (lane == 32 || lane == 48) {
#pragma unroll
            for (int i = 0; i < 4; ++i) { const int j = 8 * wid + i + (lane == 48 ? 4 : 0), tok = tb + (dir ? t0 + 63 - j : t0 + j);
                BON[((size_t)dir * NTOK + tok) * 8 + h] = u4[i]; }
        }
        {
            constexpr float L2E = 1.44269504f;
            float pre2 = pre * L2E; const float total2 = total * L2E;
#pragma unroll
            for (int jp = 0; jp < 4; ++jp) {
                const int j0 = 8 * wid + 2 * jp;
                const f2_t lwj2 = (f2_t){lwv_[2 * jp], lwv_[2 * jp + 1]} * L2E, a2 = (f2_t){av_[2 * jp], av_[2 * jp + 1]};
                const float q0 = pre2, q1 = q0 + lwj2.x, q2 = q1 + lwj2.y; pre2 = q2;
                const f2_t krv = (f2_t){kr[2 * jp], kr[2 * jp + 1]}, rrv = (f2_t){rr[2 * jp], rr[2 * jp + 1]}, kdv = (f2_t){kd_[2 * jp], kd_[2 * jp + 1]};
                const f2_t rsv = (f2_t){__builtin_amdgcn_rsqf(fmaxf(red[2 * jp], 1e-24f)), __builtin_amdgcn_rsqf(fmaxf(red[2 * jp + 1], 1e-24f))};
                const f2_t kkv = krv * kkw * rsv, bb = kkv * a2;
                const f2_t eprev = (f2_t){__builtin_amdgcn_exp2f(q0), __builtin_amdgcn_exp2f(q1)}, einv = (f2_t){__builtin_amdgcn_exp2f(-q1), __builtin_amdgcn_exp2f(-q2)};
                const f2_t ee = (f2_t){__builtin_amdgcn_exp2f(q1), __builtin_amdgcn_exp2f(q2)}, eh = (f2_t){__builtin_amdgcn_exp2f(total2 - q1), __builtin_amdgcn_exp2f(total2 - q2)};
                const f2_t atv = -kkv * eprev, bhv = bb * eh, khv = kdv * eh, btv = bb * einv, ktv = kdv * einv, rtv = rrv * ee;
                at_[2 * jp] = atv.x; at_[2 * jp + 1] = atv.y; bh_[2 * jp] = bhv.x; bh_[2 * jp + 1] = bhv.y; kh_[2 * jp] = khv.x; kh_[2 * jp + 1] = khv.y;
#pragma unroll
                for (int u = 0; u < 2; ++u) { const int j = j0 + u, tok = tb + (dir ? t0 + 63 - j : t0 + j);
                    if (mine) VS[(size_t)tok * 512 + hi] = (bf16_t)f2bf(vr[2 * jp + u]);
                    const unsigned pab = pk2(u ? atv.y : atv.x, u ? btv.y : btv.x), pkr = pk2(u ? ktv.y : ktv.x, u ? rtv.y : rtv.x);
                    *(LAS bf16_t*)(lds + L_AT + j * RS + lane * 2) = (bf16_t)(pab & 0xffffu);
                    *(LAS bf16_t*)(lds + L_BT + j * RS + lane * 2) = (bf16_t)(pab >> 16);
                    *(LAS bf16_t*)(lds + L_KT + j * RS + lane * 2) = (bf16_t)(pkr & 0xffffu);
                    *(LAS bf16_t*)(lds + L_RT + j * RS + lane * 2) = (bf16_t)(pkr >> 16); }
            }
        }
        *(LAS u32x4*)(lds + L_ATT + lane * RS + wid * 16) = pack8(at_);
        *(LAS u32x4*)(lds + L_BHT + lane * RS + wid * 16) = pack8(bh_);
        *(LAS u32x4*)(lds + L_KHT + lane * RS + wid * 16) = pack8(kh_);
        *(LAS u32x4*)(lds + L_VT + lane * RS + wid * 16) = pack8(vr);
        if (wid == 0) *(LAS float*)(lds + L_WC + lane * 4) = __expf(total);
    }
    PROBE_END(3)
    __syncthreads();
    if (has_next) rwkv_prefetch<DIR>(P, F, nitem, sink);
    PROBE_BEGIN(4)
    int lane_o = F.lane; asm volatile("" : "+v"(lane_o));
    const int q4 = 4 * (lane_o >> 4);
    const f32x4 zero4 = {0.f, 0.f, 0.f, 0.f};
    if (wid < 2) {
        const int r = lane_o & 31, hh = lane_o >> 5, blk = wid;
        f32x16 Lp, Lpt, Tm, Tt;
        {
            f32x16 z; for (int i = 0; i < 16; ++i) z[i] = 0.f;
            Lp = z; Lpt = z;
            const LAS unsigned char* pa = lds + L_AT + (32 * blk + r) * RS + 16 * hh; const LAS unsigned char* pb = lds + L_BT + (32 * blk + r) * RS + 16 * hh;
#pragma unroll
            for (int ks = 0; ks < 4; ++ks) { const bf16x8 fa = *(const LAS bf16x8*)(pa + 32 * ks), fb = *(const LAS bf16x8*)(pb + 32 * ks);
                Lp = MFMA32(fa, fb, Lp); Lpt = MFMA32(fb, fa, Lpt); }
#pragma unroll
            for (int i = 0; i < 16; ++i) { const int row = (i & 3) + 8 * (i >> 2) + 4 * hh;
                Lp[i] = (row > r) ? Lp[i] : 0.f; Lpt[i] = (r > row) ? Lpt[i] : 0.f;
                Tm[i] = Lp[i] + ((row == r) ? 1.f : 0.f); Tt[i] = Lpt[i] + ((row == r) ? 1.f : 0.f); }
        }
#pragma unroll
        for (int itn = 1; itn <= 5; ++itn) {
            const bf16x8 pL0 = pack_step(Lp, 0), pL1 = pack_step(Lp, 1), pLt0 = pack_step(Lpt, 0), pLt1 = pack_step(Lpt, 1);
            if (itn >= 2) { const bf16x8 pTt0 = pack_step(Tt, 0), pTt1 = pack_step(Tt, 1);
                Tm = MFMA32(pTt0, pL0, Tm); Tm = MFMA32(pTt1, pL1, Tm);
                Tt = MFMA32(pL0, pTt0, Tt); Tt = MFMA32(pL1, pTt1, Tt); }
            if (itn <= 4) { f32x16 z; for (int i = 0; i < 16; ++i) z[i] = 0.f;
                f32x16 n1 = MFMA32(pLt0, pL0, z); n1 = MFMA32(pLt1, pL1, n1);
                f32x16 n2 = MFMA32(pL0, pLt0, z); n2 = MFMA32(pL1, pLt1, n2);
                Lp = n1; Lpt = n2; }
        }
        volatile LAS unsigned* xflag = (volatile LAS unsigned*)(lds + L_EX + 4096);
        if (wid == 0) {
            LAS unsigned char* ex = lds + L_EX + lane * 64;
#pragma unroll
            for (int g = 0; g < 4; ++g) *(LAS f32x4*)(ex + 16 * g) = (f32x4){Tm[4 * g], Tm[4 * g + 1], Tm[4 * g + 2], Tm[4 * g + 3]};
            asm volatile("s_waitcnt lgkmcnt(0)" ::: "memory");
            *xflag = 1u;
#pragma unroll
            for (int g = 0; g < 4; ++g) st4bf(lds + L_T1 + r * RS + (8 * g + 4 * hh) * 2, (f32x4){Tt[4 * g], Tt[4 * g + 1], Tt[4 * g + 2], Tt[4 * g + 3]});
            const u32x4 z4 = {0u, 0u, 0u, 0u};
            *(LAS u32x4*)(lds + L_T1 + r * RS + (32 + 16 * hh) * 2) = z4; *(LAS u32x4*)(lds + L_T1 + r * RS + (32 + 16 * hh) * 2 + 16) = z4;
        } else {
            f32x16 L21; for (int i = 0; i < 16; ++i) L21[i] = 0.f;
            { const LAS unsigned char* pa = lds + L_AT + (32 + r) * RS + 16 * hh; const LAS unsigned char* pb = lds + L_BT + r * RS + 16 * hh;
#pragma unroll
              for (int ks = 0; ks < 4; ++ks) L21 = MFMA32(*(const LAS bf16x8*)(pa + 32 * ks), *(const LAS bf16x8*)(pb + 32 * ks), L21); }
            f32x16 U; for (int i = 0; i < 16; ++i) U[i] = 0.f;
            { const bf16x8 a0 = pack_step(L21, 0), a1 = pack_step(L21, 1), b0 = pack_step(Tt, 0), b1 = pack_step(Tt, 1);
              U = MFMA32(a0, b0, U); U = MFMA32(a1, b1, U); }
            asm volatile("" ::: "memory");
            while (*xflag == 0u) __builtin_amdgcn_s_sleep(1);
            asm volatile("" ::: "memory");
            f32x16 T11;
            { const LAS unsigned char* ex = lds + L_EX + lane * 64;
#pragma unroll
              for (int g = 0; g < 4; ++g) { const f32x4 v = *(const LAS f32x4*)(ex + 16 * g); T11[4 * g] = v[0]; T11[4 * g + 1] = v[1]; T11[4 * g + 2] = v[2]; T11[4 * g + 3] = v[3]; } }
            f32x16 T21t; for (int i = 0; i < 16; ++i) T21t[i] = 0.f;
            { const bf16x8 a0 = pack_step(T11, 0), a1 = pack_step(T11, 1), b0 = pack_step(U, 0), b1 = pack_step(U, 1);
              T21t = MFMA32(a0, b0, T21t); T21t = MFMA32(a1, b1, T21t); }
#pragma unroll
            for (int g = 0; g < 4; ++g) {
                st4bf(lds + L_T1 + (32 + r) * RS + (8 * g + 4 * hh) * 2, (f32x4){T21t[4 * g], T21t[4 * g + 1], T21t[4 * g + 2], T21t[4 * g + 3]});
                st4bf(lds + L_T1 + (32 + r) * RS + (32 + 8 * g + 4 * hh) * 2, (f32x4){Tt[4 * g], Tt[4 * g + 1], Tt[4 * g + 2], Tt[4 * g + 3]}); }
        }
    } else {
        const int w6 = wid - 2, prod = w6 >> 1, half = w6 & 1;
        const int offA = prod == 0 ? L_AT : L_RT, offB = prod == 1 ? L_BT : L_KT, offO = prod == 0 ? L_LAK : prod == 1 ? L_RB : L_RK;
#pragma unroll
        for (int rr2 = 0; rr2 < 2; ++rr2) { const int rbx = 2 * half + rr2, jrx = 16 * rbx + (lane_o & 15);
#pragma unroll
            for (int cb = 0; cb < 4; ++cb) {
                f32x4 v = zero4;
                if (cb <= rbx) { v = tile_s<2>(lds + offA + 16 * rbx * RS, RS, lds + offB + 16 * cb * RS, RS, zero4, lane);
#pragma unroll
                    for (int q = 0; q < 4; ++q) { const int s = 16 * cb + q4 + q; const bool keep = (prod == 0) ? (jrx > s) : (jrx >= s); v[q] = keep ? v[q] : 0.f; } }
                st4bf(lds + offO + jrx * RS + (16 * cb + q4) * 2, v);
            } }
    }
    __syncthreads();
    PROBE_END(4)
    PROBE_BEGIN(5)
    {
        bf16_t* RM = (bf16_t*)(ws + WS_RM) + (size_t)item * 4096; bf16_t* RP = (bf16_t*)(ws + WS_RP) + (size_t)item * 4096; bf16_t* RNT = (bf16_t*)(ws + WS_RNT) + (size_t)item * 4096;
        bf16_t* Y = (bf16_t*)(ws + (dir ? WS_YB : WS_YF));
        const int pg4 = 4 * ((lane_o >> 4) == 1 ? 2 : (lane_o >> 4) == 2 ? 1 : (lane_o >> 4));
        const int cbv = wid & 3;
        Frag2 fv;
        if (wid >= 4) {
            fv = ld_frag2(lds + L_VT + 16 * cbv * RS, RS, lane);
#pragma unroll
            for (int rbx = 0; rbx < 4; ++rbx) { const f32x4 g1 = tile_nb(lds + L_LAK + 16 * rbx * RS, RS, fv, zero4, lane);
                st4bf(lds + L_G1T + (16 * cbv + (lane & 15)) * RS + (16 * rbx + q4) * 2, g1); }
        }
        {
            const Frag2 fb = ld_frag2((wid < 4) ? (lds + L_ATT + 16 * cbv * RS) : (lds + L_G1T + 16 * cbv * RS), RS, lane);
#pragma unroll
            for (int rbx = 0; rbx < 4; ++rbx) { const f32x4 xv = tile_nb(lds + L_T1 + 16 * rbx * RS, RS, fb, zero4, lane);
                st4bf(lds + L_XT + (16 * wid + (lane & 15)) * RS + (16 * rbx + q4) * 2, xv); }
        }
        const Frag2 fx = ld_frag2(lds + L_XT + 16 * wid * RS, RS, lane);
        if (wid < 4) {
#pragma unroll
            for (int rbx = 0; rbx < 4; ++rbx) { const int jrx = 16 * rbx + (lane_o & 15);
                f32x4 mv = tile_sb(lds + L_BHT + 16 * rbx * RS, RS, fx, zero4, lane);
                { const float wc = *(const LAS float*)(lds + L_WC + jrx * 4);
#pragma unroll
                  for (int q = 0; q < 4; ++q) mv[q] += (jrx == 16 * cbv + q4 + q) ? wc : 0.f; }
                st4bf_g(RM + jrx * 64 + 16 * cbv + pg4, mv);
                f32x4 pv = tile_sb(lds + L_RB + 16 * rbx * RS, RS, fx, zero4, lane);
                { const u32x2 rv = *(const LAS u32x2*)(lds + L_RT + jrx * RS + (16 * cbv + q4) * 2);
                  pv[0] += bf2f(rv.x & 0xffffu); pv[1] += bf2f(rv.x >> 16); pv[2] += bf2f(rv.y & 0xffffu); pv[3] += bf2f(rv.y >> 16); }
                st4bf_g(RP + jrx * 64 + 16 * cbv + pg4, pv); }
        } else {
#pragma unroll
            for (int rbx = 0; rbx < 4; ++rbx) {
                f32x4 nv = tile_nb(lds + L_BHT + 16 * rbx * RS, RS, fx, zero4, lane);
                nv = tile_nb(lds + L_KHT + 16 * rbx * RS, RS, fv, nv, lane);
                st4bf_g(RNT + (16 * cbv + (lane & 15)) * 64 + 16 * rbx + q4, nv);
                f32x4 zv = tile_nb(lds + L_RB + 16 * rbx * RS, RS, fx, zero4, lane);
                zv = tile_nb(lds + L_RK + 16 * rbx * RS, RS, fv, zv, lane);
                { const int j0 = 16 * rbx + q4, tokb = tb + (dir ? t0 + 60 - j0 : t0 + j0);
                  const f32x4 zs = dir ? (f32x4){zv[3], zv[2], zv[1], zv[0]} : zv;
                  st4bf_g(Y + ((size_t)(tokb >> 2) * 512 + h * 64 + 16 * cbv + (lane & 15)) * 4, zs); } }
        }
    }
    PROBE_END(5)
    __syncthreads();
}

constexpr int CH_NSLOT = 16, CH_NCONS = 7;
constexpr int CH_RING = 0, CH_FLAGS = CH_NSLOT * 4096;
__device__ __forceinline__ void ch_wait_ge(volatile LAS unsigned* w, unsigned v) { asm volatile("" ::: "memory"); while (*w < v) __builtin_amdgcn_s_sleep(1); asm volatile("" ::: "memory"); }
__device__ __forceinline__ void ch_publish(ldsp_t lds, int st, int lane, const bf16x8& b00, const bf16x8& b01, const bf16x8& b10, const bf16x8& b11) {
    volatile LAS unsigned* fl = (volatile LAS unsigned*)(lds + CH_FLAGS);
    if (st >= CH_NSLOT) { const int old = st - CH_NSLOT; ch_wait_ge(fl + 16 + (old % CH_NCONS) * 16, (unsigned)(old + 1)); }
    LAS unsigned char* slot = lds + CH_RING + (st % CH_NSLOT) * 4096 + lane * 16;
    *(LAS bf16x8*)(slot) = b00; *(LAS bf16x8*)(slot + 1024) = b01; *(LAS bf16x8*)(slot + 2048) = b10; *(LAS bf16x8*)(slot + 3072) = b11;
    asm volatile("s_waitcnt lgkmcnt(0)" ::: "memory");
    fl[0] = (unsigned)(st + 1);
}
__device__ __forceinline__ void ch_consume(ldsp_t lds, int st, int cons, int lane, bf16x8& b00, bf16x8& b01, bf16x8& b10, bf16x8& b11) {
    volatile LAS unsigned* fl = (volatile LAS unsigned*)(lds + CH_FLAGS);
    ch_wait_ge(fl, (unsigned)(st + 1));
    const LAS unsigned char* slot = lds + CH_RING + (st % CH_NSLOT) * 4096 + lane * 16;
    b00 = *(const LAS bf16x8*)(slot); b01 = *(const LAS bf16x8*)(slot + 1024); b10 = *(const LAS bf16x8*)(slot + 2048); b11 = *(const LAS bf16x8*)(slot + 3072);
    asm volatile("s_waitcnt lgkmcnt(0)" ::: "memory");
    fl[16 + cons * 16] = (unsigned)(st + 1);
}
__device__ __forceinline__ void rwkv_ld_mn(const unsigned char* ws, int item, int vh, int r, int hh, bf16x8 (&Mf)[8], u32x2 (&Nf)[8]) {
    const bf16_t* RM = (const bf16_t*)(ws + WS_RM) + (size_t)item * 4096; const bf16_t* RNT = (const bf16_t*)(ws + WS_RNT) + (size_t)item * 4096;
#pragma unroll
    for (int kb = 0; kb < 2; ++kb) {
        const bf16_t* ap = RM + (32 * kb + r) * 64 + 8 * hh;
#pragma unroll
        for (int q = 0; q < 4; ++q) Mf[4 * kb + q] = *(const bf16x8*)(ap + 16 * q);
#pragma unroll
        for (int g = 0; g < 4; ++g) Nf[4 * kb + g] = *(const u32x2*)(RNT + (32 * vh + r) * 64 + 32 * kb + 8 * g + 4 * hh);
    }
}
__device__ __forceinline__ void rwkv_prod_step(ldsp_t lds, const unsigned char* ws, int b, int h, int dir, int vh, int lane, int st,
                                               f32x16& X0, f32x16& X1, const bf16x8 (&Mc)[8], const u32x2 (&Nc)[8], bf16x8 (&Mn)[8], u32x2 (&Nn)[8]) {
    const int r = lane & 31, hh = lane >> 5;
    const int stn = st < 62 ? st + 2 : 63, cn = dir ? 63 - stn : stn, itemn = ((b * 64 + cn) * 8 + h) * 2 + dir;
    rwkv_ld_mn(ws, itemn, vh, r, hh, Mn, Nn);
    const bf16x8 b00 = pack_step(X0, 0), b01 = pack_step(X0, 1), b10 = pack_step(X1, 0), b11 = pack_step(X1, 1);
    ch_publish(lds, st, lane, b00, b01, b10, b11);
    f32x16 Hn[2];
#pragma unroll
    for (int kb = 0; kb < 2; ++kb) {
#pragma unroll
        for (int g = 0; g < 4; ++g) { const u32x2 nv = Nc[4 * kb + g];
            Hn[kb][4 * g + 0] = bf2f(nv.x & 0xffffu); Hn[kb][4 * g + 1] = bf2f(nv.x >> 16); Hn[kb][4 * g + 2] = bf2f(nv.y & 0xffffu); Hn[kb][4 * g + 3] = bf2f(nv.y >> 16); }
        Hn[kb] = MFMA32(Mc[4 * kb + 0], b00, Hn[kb]);
        Hn[kb] = MFMA32(Mc[4 * kb + 1], b01, Hn[kb]);
        Hn[kb] = MFMA32(Mc[4 * kb + 2], b10, Hn[kb]);
        Hn[kb] = MFMA32(Mc[4 * kb + 3], b11, Hn[kb]);
    }
    X0 = Hn[0]; X1 = Hn[1];
}
__device__ __forceinline__ void rwkv_producer(const Params& P, ldsp_t lds, const int chain, const int lane) {
    const int vh = chain & 1, dir = (chain >> 1) & 1, h = (chain >> 2) & 7, b = chain >> 5;
    const unsigned char* ws = P.ws;
    f32x16 X0, X1;
#pragma unroll
    for (int i = 0; i < 16; ++i) { X0[i] = 0.f; X1[i] = 0.f; }
    bf16x8 MA[8], MB[8], MC[8]; u32x2 NA[8], NB[8], NC[8];
    { const int c0 = dir ? 63 : 0, c1 = dir ? 62 : 1;
      rwkv_ld_mn(ws, ((b * 64 + c0) * 8 + h) * 2 + dir, vh, lane & 31, lane >> 5, MA, NA);
      rwkv_ld_mn(ws, ((b * 64 + c1) * 8 + h) * 2 + dir, vh, lane & 31, lane >> 5, MB, NB); }
#pragma unroll 1
    for (int st = 0; st < 63; st += 3) {
        rwkv_prod_step(lds, ws, b, h, dir, vh, lane, st, X0, X1, MA, NA, MC, NC);
        rwkv_prod_step(lds, ws, b, h, dir, vh, lane, st + 1, X0, X1, MB, NB, MA, NA);
        rwkv_prod_step(lds, ws, b, h, dir, vh, lane, st + 2, X0, X1, MC, NC, MB, NB);
    }
    rwkv_prod_step(lds, ws, b, h, dir, vh, lane, 63, X0, X1, MA, NA, MC, NC);
}
struct ChOps { bf16x8 A[8]; u32x2 Z[8]; };
template <bool GLA>
__device__ __forceinline__ void ch_ld_ops(const Params& P, int chain, int st, int lane, ChOps& o) {
    const int r = lane & 31, hh = lane >> 5;
    int b, dir, item, col; const bf16_t* A; const bf16_t* Yb;
    if (GLA) { const int qt = chain & 3, hd = (chain >> 3) & 3; dir = (chain >> 2) & 1; b = chain >> 5; const int c = dir ? 63 - st : st;
        item = ((b * 64 + c) * 4 + hd) * 2 + dir; col = hd * 128 + 32 * qt + r;
        A = (const bf16_t*)((const unsigned char*)P.out + OUT_GQ) + (size_t)item * 4096;
        Yb = (const bf16_t*)(P.ws + (dir ? WS_OB : WS_OF)) + ((size_t)((b * SEQ + c * 64) >> 2) * 512 + col) * 4;
    } else { const int vh = chain & 1, h = (chain >> 2) & 7; dir = (chain >> 1) & 1; b = chain >> 5; const int c = dir ? 63 - st : st;
        item = ((b * 64 + c) * 8 + h) * 2 + dir; col = h * 64 + 32 * vh + r;
        A = (const bf16_t*)(P.ws + WS_RP) + (size_t)item * 4096;
        Yb = (const bf16_t*)(P.ws + (dir ? WS_YB : WS_YF)) + ((size_t)((b * SEQ + c * 64) >> 2) * 512 + col) * 4; }
#pragma unroll
    for (int jb = 0; jb < 2; ++jb) {
        const bf16_t* ap = A + (32 * jb + r) * 64 + 8 * hh;
#pragma unroll
        for (int q = 0; q < 4; ++q) o.A[4 * jb + q] = *(const bf16x8*)(ap + 16 * q);
#pragma unroll
        for (int g = 0; g < 4; ++g) { const int j0 = 32 * jb + 8 * g + 4 * hh, tg = (dir ? 60 - j0 : j0) >> 2; o.Z[4 * jb + g] = *(const u32x2*)(Yb + (size_t)tg * 2048); }
    }
}
template <bool GLA>
__device__ __forceinline__ void ch_out_step(const Params& P, ldsp_t lds, int chain, int cons, int st, int lane, const ChOps& o) {
    const int r = lane & 31, hh = lane >> 5;
    int b, dir, col; bf16_t* Yb;
    if (GLA) { const int qt = chain & 3, hd = (chain >> 3) & 3; dir = (chain >> 2) & 1; b = chain >> 5; const int c = dir ? 63 - st : st; col = hd * 128 + 32 * qt + r;
        Yb = (bf16_t*)(P.ws + (dir ? WS_OB : WS_OF)) + ((size_t)((b * SEQ + c * 64) >> 2) * 512 + col) * 4;
    } else { const int vh = chain & 1, h = (chain >> 2) & 7; dir = (chain >> 1) & 1; b = chain >> 5; const int c = dir ? 63 - st : st; col = h * 64 + 32 * vh + r;
        Yb = (bf16_t*)(P.ws + (dir ? WS_YB : WS_YF)) + ((size_t)((b * SEQ + c * 64) >> 2) * 512 + col) * 4; }
    bf16x8 b00, b01, b10, b11;
    ch_consume(lds, st, cons, lane, b00, b01, b10, b11);
#pragma unroll
    for (int jb = 0; jb < 2; ++jb) {
        f32x16 Yv;
#pragma unroll
        for (int g = 0; g < 4; ++g) { const u32x2 z = o.Z[4 * jb + g];
            const float p0 = bf2f(z.x & 0xffffu), p1 = bf2f(z.x >> 16), p2 = bf2f(z.y & 0xffffu), p3 = bf2f(z.y >> 16);
            Yv[4 * g + 0] = dir ? p3 : p0; Yv[4 * g + 1] = dir ? p2 : p1; Yv[4 * g + 2] = dir ? p1 : p2; Yv[4 * g + 3] = dir ? p0 : p3; }
        Yv = MFMA32(o.A[4 * jb + 0], b00, Yv);
        Yv = MFMA32(o.A[4 * jb + 1], b01, Yv);
        Yv = MFMA32(o.A[4 * jb + 2], b10, Yv);
        Yv = MFMA32(o.A[4 * jb + 3], b11, Yv);
#pragma unroll
        for (int g = 0; g < 4; ++g) { const int j0 = 32 * jb + 8 * g + 4 * hh, tg = (dir ? 60 - j0 : j0) >> 2;
            u32x2 ov; ov.x = dir ? pk2(Yv[4 * g + 3], Yv[4 * g + 2]) : pk2(Yv[4 * g + 0], Yv[4 * g + 1]); ov.y = dir ? pk2(Yv[4 * g + 1], Yv[4 * g + 0]) : pk2(Yv[4 * g + 2], Yv[4 * g + 3]);
            *(u32x2*)(Yb + (size_t)tg * 2048) = ov; }
    }
}
template <bool GLA>
__device__ __forceinline__ void chain_consumer(const Params& P, ldsp_t lds, const int chain, const int cons, const int lane) {
    ChOps OA, OB, OC;
    int st = cons;
    if (st < 64) ch_ld_ops<GLA>(P, chain, st, lane, OA);
    if (st + CH_NCONS < 64) ch_ld_ops<GLA>(P, chain, st + CH_NCONS, lane, OB);
#pragma unroll 1
    while (st < 64) {
        const int s1 = st + CH_NCONS, s2 = st + 2 * CH_NCONS, s3 = st + 3 * CH_NCONS, s4 = st + 4 * CH_NCONS;
        if (s2 < 64) ch_ld_ops<GLA>(P, chain, s2, lane, OC);
        ch_out_step<GLA>(P, lds, chain, cons, st, lane, OA);
        if (s1 >= 64) break;
        if (s3 < 64) ch_ld_ops<GLA>(P, chain, s3, lane, OA);
        ch_out_step<GLA>(P, lds, chain, cons, s1, lane, OB);
        if (s2 >= 64) break;
        if (s4 < 64) ch_ld_ops<GLA>(P, chain, s4, lane, OB);
        ch_out_step<GLA>(P, lds, chain, cons, s2, lane, OC);
        st = s3;
    }
}

constexpr int G_QT = 0, G_KT = RMS_, G_KHT = 2 * RMS_, G_VT = 3 * RMS_, G_AM = 5 * RMS_, G_GK = 6 * RMS_, G_HS = 6 * RMS_ + 16384  , G_SLOT = 6 * RMS_ + 16384 + 2048;
static_assert(2 * G_SLOT <= LDS_MISC, "gla LDS map");
struct GlaSt { float qv[8], kv[8]; };
template <int DIR>
__device__ __forceinline__ void gla_s1(const Params& P, const Ctx& F, const int item, ldsp_t lds, GlaSt& S, const int slot) {
    const int lane = F.lane, wid = F.wid; constexpr int dir = DIR;
    const int hd = (item >> 1) & 3, c = (item >> 3) & 63, b = item >> 9;
    const int t0 = c * 64, tb = b * SEQ;
    const bf16_t* PB = (const bf16_t*)(P.ws + WS_PB);
    const int hi = hd * 64 + lane;
    const float* gb = dir ? P.gb_b : P.gb_f;
    float v0[8], v1[8];
    unsigned rq[8], rk[8], r0[8], r1[8];
    const int rb = wid >> 1, cb0 = 2 * (wid & 1), kg = lane >> 4;
    const int jA = 16 * rb + (lane & 15), tokA = tb + (dir ? t0 + 63 - jA : t0 + jA);
    bf16x8 af = *(const bf16x8*)(PB + (size_t)tokA * LDB_GL + 1024 + 16 * dir + 8 * (kg & 1));
    const bf16_t* GW2T = (const bf16_t*)(P.ws + WS_LORA + 640 * 1024) + (size_t)dir * 4096;
    bf16x8 bfr[2]; float gbv[2];
#pragma unroll
    for (int t = 0; t < 2; ++t) { const int ch = hd * 64 + 16 * (cb0 + t) + (lane & 15); bfr[t] = *(const bf16x8*)(GW2T + ch * 16 + 8 * (kg & 1)); gbv[t] = gb[ch]; }
#pragma unroll
    for (int jj = 0; jj < 8; ++jj) {
        const int j = 8 * wid + jj, tok = tb + (dir ? t0 + 63 - j : t0 + j);
        const bf16_t* row = PB + (size_t)tok * LDB_GL;
        rq[jj] = row[hi]; rk[jj] = row[256 + hi]; r0[jj] = row[512 + hd * 128 + lane]; r1[jj] = row[512 + hd * 128 + 64 + lane];
    }
    __builtin_amdgcn_sched_barrier(0);
    { const bf16x8 zf = {0, 0, 0, 0, 0, 0, 0, 0};
      if (kg >= 2) { af = zf; bfr[0] = zf; bfr[1] = zf; }
#pragma unroll
      for (int t = 0; t < 2; ++t) { const int n = 16 * (cb0 + t) + (lane & 15);
          const f32x4 zz = __builtin_amdgcn_mfma_f32_16x16x32_bf16(af, bfr[t], (f32x4){0.f, 0.f, 0.f, 0.f}, 0, 0, 0);
          float hs = 0.f;
#pragma unroll
          for (int r = 0; r < 4; ++r) { const int j = 16 * rb + 4 * kg + r; const float z = zz[r] + gbv[t];
              const float ls = (fminf(z, 0.f) - __logf(1.f + __expf(-fabsf(z)))) * (1.f / 16.f);
              hs += ls;
              *(LAS float*)(lds + G_GK + (j * 64 + n) * 4) = ls; }
          hs += __shfl_xor(hs, 16);
          if ((kg & 1) == 0) *(LAS float*)(lds + G_HS + ((2 * rb + (kg >> 1)) * 64 + n) * 4) = hs; } }
#pragma unroll
    for (int jj = 0; jj < 8; ++jj) {
        S.qv[jj] = bf2f(rq[jj]) * 0.125f; S.kv[jj] = bf2f(rk[jj]);
        v0[jj] = bf2f(r0[jj]); v1[jj] = bf2f(r1[jj]);
    }
    *(LAS u32x4*)(lds + G_VT + lane * RS + wid * 16) = pack8(v0);
    *(LAS u32x4*)(lds + G_VT + (64 + lane) * RS + wid * 16) = pack8(v1);
}
__device__ __forceinline__ void gla_s2(const Params& P, const Ctx& F, const int item, ldsp_t lds, const GlaSt& S) {
    const int lane = F.lane, wid = F.wid;
    float total = 0.f, pre = 0.f;
    { float h8[8];
#pragma unroll
      for (int q = 0; q < 8; ++q) h8[q] = *(const LAS float*)(lds + G_HS + (q * 64 + lane) * 4);
#pragma unroll
      for (int q = 0; q < 8; ++q) { if (q < wid) pre += h8[q]; else total += h8[q]; } }
    total += pre;
    bf16_t* GQ = (bf16_t*)((unsigned char*)P.out + OUT_GQ) + (size_t)item * 4096;
    const int blk = lane >> 4, g4 = (lane >> 2) & 3, pgp = (g4 == 1) ? 2 : (g4 == 2) ? 1 : g4;
    const int pcol = 16 * blk + 4 * pgp + (lane & 3);
    float kh_[8];
#pragma unroll
    for (int jj = 0; jj < 8; ++jj) {
        const int j = 8 * wid + jj;
        pre += *(const LAS float*)(lds + G_GK + (j * 64 + lane) * 4);
        const float e = __expf(pre), einv = __expf(-pre), eh = __expf(total - pre);
        const float qs = S.qv[jj] * e;
        *(LAS bf16_t*)(lds + G_QT + j * RS + lane * 2) = (bf16_t)f2bf(qs);
        *(LAS bf16_t*)(lds + G_KT + j * RS + lane * 2) = (bf16_t)f2bf(S.kv[jj] * einv);
        kh_[jj] = S.kv[jj] * eh;
        GQ[j * 64 + pcol] = (bf16_t)f2bf(qs);
    }
    *(LAS u32x4*)(lds + G_KHT + lane * RS + wid * 16) = pack8(kh_);
    if (wid == 0) ((float*)(P.ws + WS_DEC))[(size_t)item * 64 + lane] = __expf(total);
}
__device__ __forceinline__ void gla_s3(const Ctx& F, ldsp_t lds) {
    const int lane = F.lane, wid = F.wid;
    const int rb = wid >> 1, cb0 = 2 * (wid & 1), jr = 16 * rb + (lane & 15), q4 = 4 * (lane >> 4);
    const f32x4 zero4 = {0.f, 0.f, 0.f, 0.f};
#pragma unroll
    for (int t = 0; t < 2; ++t) { const int cb = cb0 + t;
        f32x4 av = tile_s<2>(lds + G_QT + 16 * rb * RS, RS, lds + G_KT + 16 * cb * RS, RS, zero4, lane);
#pragma unroll
        for (int r = 0; r < 4; ++r) av[r] = (jr >= 16 * cb + q4 + r) ? av[r] : 0.f;
        st4bf(lds + G_AM + jr * RS + (16 * cb + q4) * 2, av); }
}
template <int DIR>
__device__ __forceinline__ void gla_s4(const Params& P, const Ctx& F, const int item, ldsp_t lds) {
    const int lane = F.lane, wid = F.wid; constexpr int dir = DIR;
    const int hd = (item >> 1) & 3, c = (item >> 3) & 63, b = item >> 9, t0 = c * 64, tb = b * SEQ;
    const int rb = wid >> 1, q4 = 4 * (lane >> 4);
    const f32x4 zero4 = {0.f, 0.f, 0.f, 0.f};
    bf16_t* O = (bf16_t*)(P.ws + (dir ? WS_OB : WS_OF));
    bf16_t* GNT = (bf16_t*)((unsigned char*)P.out + OUT_GNT) + (size_t)item * 8192;
    const int cbz0 = 4 * (wid & 1);
    const int j0 = 16 * rb + q4, tokb = tb + (dir ? t0 + 60 - j0 : t0 + j0);
#pragma unroll
    for (int t = 0; t < 4; ++t) { const int cb = cbz0 + t;
        f32x4 zv = tile_n<2>(lds + G_AM + 16 * rb * RS, RS, lds + G_VT + 16 * cb * RS, RS, zero4, lane);
        const f32x4 zs = dir ? (f32x4){zv[3], zv[2], zv[1], zv[0]} : zv;
        st4bf_g(O + ((size_t)(tokb >> 2) * 512 + hd * 128 + 16 * cb + (lane & 15)) * 4, zs);
        f32x4 nv = tile_n<2>(lds + G_KHT + 16 * rb * RS, RS, lds + G_VT + 16 * cb * RS, RS, zero4, lane);
        st4bf_g(GNT + (16 * cb + (lane & 15)) * 64 + 16 * rb + q4, nv); }
}
__device__ __forceinline__ void gla_prefetch(const Params& P, const Ctx& F, const int item, const int dir) {
    const int hd = (item >> 1) & 3, c = (item >> 3) & 63, b = item >> 9, tid = F.tid;
    if (tid < 320) {
        const int j = tid / 5, a = tid - 5 * j;
        const int col = a == 0 ? 1024 + 16 * dir : a == 1 ? hd * 64 : a == 2 ? 256 + hd * 64 : 512 + hd * 128 + 64 * (a - 3);
        const bf16_t* p = (const bf16_t*)(P.ws + WS_PB) + (size_t)(b * SEQ + c * 64 + j) * LDB_GL + col;
        { unsigned m0s; asm volatile("s_mov_b32 %0, m0\n\ts_mov_b32 m0, %2\n\ts_nop 0\n\tglobal_load_lds_dword %1, off\n\ts_mov_b32 m0, %0" : "=&s"(m0s) : "v"(p), "s"(L_PF) : "memory"); }
    }
}
template <int DIR>
__device__ __forceinline__ void gla_pair(const Params& P, const Ctx& F, const int itA, const int itB, const bool hasB) {
    ldsp_t la = F.lds, lb = F.lds + G_SLOT;
    GlaSt SA, SB;
    gla_s1<DIR>(P, F, itA, la, SA, 0); if (hasB) gla_s1<DIR>(P, F, itB, lb, SB, 1);
    __syncthreads();
    gla_s2(P, F, itA, la, SA); if (hasB) gla_s2(P, F, itB, lb, SB);
    __syncthreads();
    { const int nA = itA + 2 * F.G, nB = itB + 2 * F.G; if (nA < 2048) gla_prefetch(P, F, nA, DIR); if (nB < 2048) gla_prefetch(P, F, nB, DIR); }
    gla_s3(F, la); if (hasB) gla_s3(F, lb);
    __syncthreads();
    gla_s4<DIR>(P, F, itA, la); if (hasB) gla_s4<DIR>(P, F, itB, lb);
    __syncthreads();
}

__device__ __forceinline__ void gla_ld_nd(const unsigned char* ob, const unsigned char* ws, int item, int qt, int r, int hh, u32x2 (&Nf)[8], f32x4 (&Df)[8]) {
    const bf16_t* GNT = (const bf16_t*)(ob + OUT_GNT) + (size_t)item * 8192; const float* DEC = (const float*)(ws + WS_DEC) + (size_t)item * 64;
#pragma unroll
    for (int g = 0; g < 4; ++g) {
        Df[g] = *(const f32x4*)(DEC + 8 * g + 4 * hh); Df[4 + g] = *(const f32x4*)(DEC + 32 + 8 * g + 4 * hh);
        Nf[g] = *(const u32x2*)(GNT + (32 * qt + r) * 64 + 8 * g + 4 * hh); Nf[4 + g] = *(const u32x2*)(GNT + (32 * qt + r) * 64 + 32 + 8 * g + 4 * hh);
    }
}
__device__ __forceinline__ void gla_prod_step(ldsp_t lds, const unsigned char* ob, const unsigned char* ws, int b, int hd, int dir, int qt, int lane, int st,
                                              f32x16& X0, f32x16& X1, const u32x2 (&Nc)[8], const f32x4 (&Dc)[8], u32x2 (&Nn)[8], f32x4 (&Dn)[8]) {
    const int r = lane & 31, hh = lane >> 5;
    const int stn = st < 62 ? st + 2 : 63, cn = dir ? 63 - stn : stn, itemn = ((b * 64 + cn) * 4 + hd) * 2 + dir;
    gla_ld_nd(ob, ws, itemn, qt, r, hh, Nn, Dn);
    const bf16x8 b00 = pack_step(X0, 0), b01 = pack_step(X0, 1), b10 = pack_step(X1, 0), b11 = pack_step(X1, 1);
    ch_publish(lds, st, lane, b00, b01, b10, b11);
#pragma unroll
    for (int g = 0; g < 4; ++g) {
        const f32x4 d0 = Dc[g], d1 = Dc[4 + g]; const u32x2 n0 = Nc[g], n1 = Nc[4 + g];
        X0[4 * g + 0] = d0.x * X0[4 * g + 0] + bf2f(n0.x & 0xffffu); X0[4 * g + 1] = d0.y * X0[4 * g + 1] + bf2f(n0.x >> 16);
        X0[4 * g + 2] = d0.z * X0[4 * g + 2] + bf2f(n0.y & 0xffffu); X0[4 * g + 3] = d0.w * X0[4 * g + 3] + bf2f(n0.y >> 16);
        X1[4 * g + 0] = d1.x * X1[4 * g + 0] + bf2f(n1.x & 0xffffu); X1[4 * g + 1] = d1.y * X1[4 * g + 1] + bf2f(n1.x >> 16);
        X1[4 * g + 2] = d1.z * X1[4 * g + 2] + bf2f(n1.y & 0xffffu); X1[4 * g + 3] = d1.w * X1[4 * g + 3] + bf2f(n1.y >> 16);
    }
}
__device__ __forceinline__ void gla_producer(const Params& P, ldsp_t lds, const int chain, const int lane) {
    const int qt = chain & 3, dir = (chain >> 2) & 1, hd = (chain >> 3) & 3, b = chain >> 5;
    const unsigned char* ws = P.ws; const unsigned char* ob = (const unsigned char*)P.out;
    f32x16 X0, X1;
#pragma unroll
    for (int i = 0; i < 16; ++i) { X0[i] = 0.f; X1[i] = 0.f; }
    u32x2 NA[8], NB[8], NC[8]; f32x4 DA[8], DB[8], DC[8];
    { const int c0 = dir ? 63 : 0, c1 = dir ? 62 : 1;
      gla_ld_nd(ob, ws, ((b * 64 + c0) * 4 + hd) * 2 + dir, qt, lane & 31, lane >> 5, NA, DA);
      gla_ld_nd(ob, ws, ((b * 64 + c1) * 4 + hd) * 2 + dir, qt, lane & 31, lane >> 5, NB, DB); }
#pragma unroll 1
    for (int st = 0; st < 63; st += 3) {
        gla_prod_step(lds, ob, ws, b, hd, dir, qt, lane, st, X0, X1, NA, DA, NC, DC);
        gla_prod_step(lds, ob, ws, b, hd, dir, qt, lane, st + 1, X0, X1, NB, DB, NA, DA);
        gla_prod_step(lds, ob, ws, b, hd, dir, qt, lane, st + 2, X0, X1, NC, DC, NB, DB);
    }
    gla_prod_step(lds, ob, ws, b, hd, dir, qt, lane, 63, X0, X1, NA, DA, NC, DC);
}

__device__ __forceinline__ void ld_tok4(const bf16_t* base, int tok4, int lane, float (&y)[4][8]) {
    const u32x4* p = (const u32x4*)(base + ((size_t)tok4 * 512 + 8 * lane) * 4);
#pragma unroll
    for (int i = 0; i < 4; ++i) { const u32x4 v = p[i];
        y[0][2 * i] = bf2f(v.x & 0xffffu); y[1][2 * i] = bf2f(v.x >> 16); y[2][2 * i] = bf2f(v.y & 0xffffu); y[3][2 * i] = bf2f(v.y >> 16);
        y[0][2 * i + 1] = bf2f(v.z & 0xffffu); y[1][2 * i + 1] = bf2f(v.z >> 16); y[2][2 * i + 1] = bf2f(v.w & 0xffffu); y[3][2 * i + 1] = bf2f(v.w >> 16); }
}
__device__ __forceinline__ void mix_tok4_rw(const Params& P, const int tok4, const int lane) {
    unsigned char* ws = P.ws;
    const bf16_t* YF = (const bf16_t*)(ws + WS_YF); const bf16_t* YB = (const bf16_t*)(ws + WS_YB);
    const bf16_t* GG = (const bf16_t*)(ws + WS_G); const bf16_t* VS = (const bf16_t*)(ws + WS_VS);
    const float* BON = (const float*)(ws + WS_BON);
    const bf16_t* OF = (const bf16_t*)(ws + WS_OF); const bf16_t* OB = (const bf16_t*)(ws + WS_OB);
    const bf16_t* PB = (const bf16_t*)(ws + WS_PB);
    bf16_t* MIX = (bf16_t*)(ws + WS_MIX);
    {
        float ya[4][8], yb[4][8];
        ld_tok4(YF, tok4, lane, ya); ld_tok4(YB, tok4, lane, yb);
        const f32x4 w0 = *(const f32x4*)(P.ln_w + 8 * lane), w1 = *(const f32x4*)(P.ln_w + 8 * lane + 4);
        const f32x4 c0 = *(const f32x4*)(P.ln_b + 8 * lane), c1 = *(const f32x4*)(P.ln_b + 8 * lane + 4);
        const float lw[8] = {w0.x, w0.y, w0.z, w0.w, w1.x, w1.y, w1.z, w1.w}, lb[8] = {c0.x, c0.y, c0.z, c0.w, c1.x, c1.y, c1.z, c1.w};
        const int h = lane >> 3;
        u32x4 gq[4], vq[4]; float bq0[4], bq1[4];
#pragma unroll
        for (int q = 0; q < 4; ++q) { const int tok = 4 * tok4 + q; const size_t o512 = (size_t)tok * 512 + 8 * lane;
            gq[q] = *(const u32x4*)(GG + o512); vq[q] = *(const u32x4*)(VS + o512); bq0[q] = BON[(size_t)tok * 8 + h]; bq1[q] = BON[((size_t)NTOK + tok) * 8 + h]; }
#pragma unroll
        for (int q = 0; q < 4; ++q) {
            const int tok = 4 * tok4 + q;
            float y[8]; float s = 0.f;
#pragma unroll
            for (int e = 0; e < 8; ++e) { y[e] = ya[q][e] + yb[q][e]; s += y[e]; }
            s += __shfl_xor(s, 1); s += __shfl_xor(s, 2); s += __shfl_xor(s, 4);
            const float mean = s * (1.f / 64.f);
            float s2 = 0.f;
#pragma unroll
            for (int e = 0; e < 8; ++e) { y[e] -= mean; s2 += y[e] * y[e]; }
            s2 += __shfl_xor(s2, 1); s2 += __shfl_xor(s2, 2); s2 += __shfl_xor(s2, 4);
            const float rs = rsqrtf(s2 * (1.f / 64.f) + 64e-5f);
            const float bon = bq0[q] + bq1[q];
            float g[8], vs[8], o[8];
            unpack8(gq[q], g); unpack8(vq[q], vs);
#pragma unroll
            for (int e = 0; e < 8; ++e) o[e] = (y[e] * rs * lw[e] + lb[e] + bon * vs[e]) * g[e];
            *(u32x4*)(MIX + (size_t)tok * 1024 + 8 * lane) = pack8(o);
        }
    }
}
__device__ __forceinline__ void mix_tok4_gl(const Params& P, const int tok4, const int lane) {
    unsigned char* ws = P.ws;
    const bf16_t* YF = (const bf16_t*)(ws + WS_YF); const bf16_t* YB = (const bf16_t*)(ws + WS_YB);
    const bf16_t* GG = (const bf16_t*)(ws + WS_G); const bf16_t* VS = (const bf16_t*)(ws + WS_VS);
    const float* BON = (const float*)(ws + WS_BON);
    const bf16_t* OF = (const bf16_t*)(ws + WS_OF); const bf16_t* OB = (const bf16_t*)(ws + WS_OB);
    const bf16_t* PB = (const bf16_t*)(ws + WS_PB);
    bf16_t* MIX = (bf16_t*)(ws + WS_MIX);
    {
        float ya[4][8], yb[4][8];
        ld_tok4(OF, tok4, lane, ya); ld_tok4(OB, tok4, lane, yb);
        const f32x4 w0 = *(const f32x4*)(P.gnorm_w + 8 * lane), w1 = *(const f32x4*)(P.gnorm_w + 8 * lane + 4);
        const float nw[8] = {w0.x, w0.y, w0.z, w0.w, w1.x, w1.y, w1.z, w1.w};
        u32x4 oq[4];
#pragma unroll
        for (int q = 0; q < 4; ++q) oq[q] = *(const u32x4*)(PB + (size_t)(4 * tok4 + q) * LDB_GL + 1056 + 8 * lane);
#pragma unroll
        for (int q = 0; q < 4; ++q) {
            const int tok = 4 * tok4 + q;
            float y[8], og[8], o[8]; float s2 = 0.f;
#pragma unroll
            for (int e = 0; e < 8; ++e) { y[e] = ya[q][e] + yb[q][e]; s2 += y[e] * y[e]; }
            s2 += __shfl_xor(s2, 1); s2 += __shfl_xor(s2, 2); s2 += __shfl_xor(s2, 4); s2 += __shfl_xor(s2, 8);
            const float rs = rsqrtf(s2 * (1.f / 128.f) + 1e-6f);
            unpack8(oq[q], og);
#pragma unroll
            for (int e = 0; e < 8; ++e) o[e] = y[e] * rs * nw[e] * (og[e] * sigmoidf_(og[e]));
            *(u32x4*)(MIX + (size_t)tok * 1024 + 512 + 8 * lane) = pack8(o);
        }
    }
}

struct TBlk { const float* src; bf16_t* dst; int N, ldk; };
__device__ __forceinline__ TBlk moe_blk(const Params& P, int it) {
    bf16_t* WGU = (bf16_t*)(P.ws + WS_WGU); bf16_t* WDN = (bf16_t*)(P.ws + WS_WDN);
    const int e = it / 768, r = it % 768; TBlk t;
    if (r < 512) { const int up = r >> 8, q = r & 255, kb = q >> 4, nb = q & 15, n0 = 32 * nb;
        const float* src = (up ? P.w_up : P.w_gate) + (size_t)e * 1024 * 512;
        const int drow0 = 256 * (n0 >> 7) + (n0 & 127) + 128 * up;
        t.src = src + (size_t)(64 * kb) * 512 + n0; t.N = 512; t.dst = WGU + (size_t)e * 1024 * 1024 + (size_t)drow0 * 1024 + 64 * kb; t.ldk = 1024;
    } else { const int q = r - 512, kb = q >> 5, nb = q & 31;
        t.src = P.w_down + (size_t)e * 512 * 1024 + (size_t)(64 * kb) * 1024 + 32 * nb; t.N = 1024; t.dst = WDN + (size_t)e * 1024 * 512 + (size_t)(32 * nb) * 512 + 64 * kb; t.ldk = 512; }
    return t;
}
__device__ __forceinline__ void tblk_load(const TBlk& t, float (&tv)[32], int lane) {
#pragma unroll
    for (int i = 0; i < 32; ++i) { const int kk = 2 * i + (lane >> 5); tv[i] = t.src[(size_t)kk * t.N + (lane & 31)]; }
}
__device__ __forceinline__ void tblk_store(const TBlk& t, const float (&tv)[32], LAS float* scr, int lane) {
#pragma unroll
    for (int i = 0; i < 32; ++i) { const int kk = 2 * i + (lane >> 5); scr[kk * 33 + (lane & 31)] = tv[i]; }
    asm volatile("s_waitcnt lgkmcnt(0)" ::: "memory");
    const int c = lane & 7;
#pragma unroll
    for (int j = 0; j < 4; ++j) { const int n = (lane >> 3) + 8 * j; const LAS float* s = scr + (8 * c) * 33 + n;
        u32x4 o; o.x = pk2(s[0 * 33], s[1 * 33]); o.y = pk2(s[2 * 33], s[3 * 33]); o.z = pk2(s[4 * 33], s[5 * 33]); o.w = pk2(s[6 * 33], s[7 * 33]);
        *(u32x4*)(t.dst + (size_t)n * t.ldk + 8 * c) = o; }
    asm volatile("s_waitcnt lgkmcnt(0)" ::: "memory");
}
__device__ __forceinline__ void p5b_convert(const Params& P, const Ctx& F, const int gw, const int NGW) {
    LAS float* scr = (LAS float*)(F.lds + F.wid * 16384);
    constexpr int NIT = NEXP * 768;
    float ta[32], tb[32];
    int it = gw;
    if (it >= NIT) return;
    TBlk A = moe_blk(P, it), B = A;
    tblk_load(A, ta, F.lane);
#pragma unroll 1
    while (true) {
        const int i1 = it + NGW, i2 = it + 2 * NGW;
        if (i1 < NIT) { B = moe_blk(P, i1); tblk_load(B, tb, F.lane); }
        tblk_store(A, ta, scr, F.lane);
        if (i1 >= NIT) break;
        if (i2 < NIT) { A = moe_blk(P, i2); tblk_load(A, ta, F.lane); }
        tblk_store(B, tb, scr, F.lane);
        if (i2 >= NIT) break;
        it = i2;
    }
}

constexpr size_t WS_WRT = WS_LORA + 512 * 1024;
constexpr int RT_XS = 2064, RT_LOG = 64 * RT_XS;
__device__ __forceinline__ void p6_router_group(const Params& P, const Ctx& F, const int grp) {
    ldsp_t lds = F.lds; const int lane = F.lane, wid = F.wid;
    unsigned* CNT = (unsigned*)(P.ws + WS_CTL) + CW_CNT;
    int* ELIST = (int*)(P.ws + WS_ELIST); float* ELW = (float*)(P.ws + WS_ELW);
    bf16_t* H2 = (bf16_t*)(P.ws + WS_H2);
    const bf16_t* WrT = (const bf16_t*)(P.ws + WS_WRT);
    {
        const int tok0 = grp * 64;
        if (F.tid < 64) {
            unsigned* pc = (unsigned*)(P.ws + WS_CTL) + CW_PN + 16 * (grp >> 2); unsigned* tmo = (unsigned*)(P.ws + WS_CTL) + CW_BAR + XB_TMO; unsigned polls = 0;
            while ((unsigned)__builtin_amdgcn_readfirstlane((int)__hip_atomic_load(pc, __ATOMIC_RELAXED, __HIP_MEMORY_SCOPE_AGENT)) < 32u) {
                __builtin_amdgcn_s_sleep(2);
                if ((++polls & 1023u) == 0u) { if (__builtin_amdgcn_readfirstlane((int)__hip_atomic_load(tmo, __ATOMIC_RELAXED, __HIP_MEMORY_SCOPE_AGENT)) != 0) break;
                    if (polls > (1u << 22)) { if (F.tid == 0) atomicAdd(tmo, 1u); break; } }
            }
            __builtin_amdgcn_fence(__ATOMIC_ACQUIRE, "agent");
            asm volatile("s_waitcnt vmcnt(0)" ::: "memory");
        }
        __syncthreads();
        PROBE_BEGIN(41)
        {
            f32x4 v[8][4]; float ss[8];
            u32x2 raw[8][4];
#pragma unroll
            for (int i = 0; i < 8; ++i) { const u32x2* xr = (const u32x2*)((const bf16_t*)(P.ws + WS_XMID) + (size_t)(tok0 + 8 * wid + i) * 1024) + lane;
#pragma unroll
                for (int j = 0; j < 4; ++j) raw[i][j] = xr[64 * j]; }
#pragma unroll
            for (int i = 0; i < 8; ++i) { float s = 0.f;
#pragma unroll
                for (int j = 0; j < 4; ++j) { v[i][j] = (f32x4){bf2f(raw[i][j].x & 0xffffu), bf2f(raw[i][j].x >> 16), bf2f(raw[i][j].y & 0xffffu), bf2f(raw[i][j].y >> 16)};
                    s += (v[i][j].x * v[i][j].x + v[i][j].y * v[i][j].y) + (v[i][j].z * v[i][j].z + v[i][j].w * v[i][j].w); }
                ss[i] = s; }
            wave_sum_n<8>(ss);
            f32x4 g[4];
#pragma unroll
            for (int j = 0; j < 4; ++j) g[j] = *((const f32x4*)P.ln2_w + lane + 64 * j);
#pragma unroll
            for (int i = 0; i < 8; ++i) { const float inv = rsqrtf(ss[i] * (1.f / 1024.f) + 1e-6f); const int tl = 8 * wid + i;
                u32x2* o8 = (u32x2*)(H2 + (size_t)(tok0 + tl) * 1024) + lane;
#pragma unroll
                for (int j = 0; j < 4; ++j) { u32x2 o; o.x = pk2(v[i][j].x * inv * g[j].x, v[i][j].y * inv * g[j].y); o.y = pk2(v[i][j].z * inv * g[j].z, v[i][j].w * inv * g[j].w);
                    o8[64 * j] = o; *(LAS u32x2*)(lds + tl * RT_XS + (256 * j + 4 * lane) * 2) = o; } }
        }
        PROBE_END(41)
        __syncthreads();
        PROBE_BEGIN(42)
        {
            const int tt = wid >> 1, kh = wid & 1;
            f32x4 acc[3];
#pragma unroll
            for (int ct = 0; ct < 3; ++ct) acc[ct] = (f32x4){0.f, 0.f, 0.f, 0.f};
            const LAS unsigned char* ap = lds + (16 * tt + (lane & 15)) * RT_XS + (512 * kh + 8 * (lane >> 4)) * 2;
            const bf16_t* bp = WrT + (size_t)(lane & 15) * 1024 + 512 * kh + 8 * (lane >> 4);
#pragma unroll 4
            for (int ks = 0; ks < 16; ++ks) {
                const bf16x8 a = *(const LAS bf16x8*)(ap + ks * 64);
#pragma unroll
                for (int ct = 0; ct < 3; ++ct) { const bf16x8 bq = *(const bf16x8*)(bp + (size_t)ct * 16 * 1024 + ks * 32); acc[ct] = __builtin_amdgcn_mfma_f32_16x16x32_bf16(a, bq, acc[ct], 0, 0, 0); }
            }
#pragma unroll
            for (int ct = 0; ct < 3; ++ct)
#pragma unroll
                for (int r = 0; r < 4; ++r) *(LAS float*)(lds + RT_LOG + ((kh * 64 + 16 * tt + 4 * (lane >> 4) + r) * 48 + 16 * ct + (lane & 15)) * 4) = acc[ct][r];
        }
        PROBE_END(42)
        __syncthreads();
        PROBE_BEGIN(43)
        if (F.tid < 64) {
            const int tok = tok0 + F.tid;
            const LAS float* l0 = (const LAS float*)(lds + RT_LOG + (F.tid * 48) * 4); const LAS float* l1 = (const LAS float*)(lds + RT_LOG + ((64 + F.tid) * 48) * 4);
            float cl[4];
#pragma unroll
            for (int i = 0; i < 4; ++i) cl[i] = l0[i] + l1[i] + P.b_coarse[i];
            int g = 0; float cm = cl[0];
#pragma unroll
            for (int i = 1; i < 4; ++i) if (cl[i] > cm) { cm = cl[i]; g = i; }
            float cs = 0.f;
#pragma unroll
            for (int i = 0; i < 4; ++i) cs += __expf(cl[i] - cm);
            const float pg = 1.f / cs;
            float fl[8];
#pragma unroll
            for (int i = 0; i < 8; ++i) fl[i] = l0[4 + 8 * g + i] + l1[4 + 8 * g + i] + P.b_fine[8 * g + i];
            int i1 = 0; float m1 = fl[0];
#pragma unroll
            for (int i = 1; i < 8; ++i) if (fl[i] > m1) { m1 = fl[i]; i1 = i; }
            int i2 = -1; float m2 = -3.0e38f;
#pragma unroll
            for (int i = 0; i < 8; ++i) if (i != i1 && fl[i] > m2) { m2 = fl[i]; i2 = i; }
            const float e2 = __expf(m2 - m1);
            const float c1 = pg / (1.f + e2), c2 = pg * e2 / (1.f + e2);
            const int ea = 8 * g + i1, eb = 8 * g + i2;
            const unsigned sa = atomicAdd(&CNT[64 * ea], 1u), sb = atomicAdd(&CNT[64 * eb], 1u);
            ELIST[(size_t)ea * NTOK + sa] = tok * 2; ELW[(size_t)ea * NTOK + sa] = c1;
            ELIST[(size_t)eb * NTOK + sb] = tok * 2 + 1; ELW[(size_t)eb * NTOK + sb] = c2;
        }
        PROBE_END(43)
        __syncthreads();
    }
}

__device__ __forceinline__ void build_group_tables(const Params& P, const Ctx& F) {
    LAS int* tab = (LAS int*)(F.lds + LDS_TAB);
    if (F.tid < 32) tab[F.tid] = (int)__hip_atomic_load((unsigned*)(P.ws + WS_CTL) + CW_CNT + 64 * F.tid, __ATOMIC_RELAXED, __HIP_MEMORY_SCOPE_AGENT);
    __syncthreads();
    if (F.tid == 0) { int s = 0; for (int e = 0; e < 32; ++e) { tab[32 + e] = s; s += (tab[e] + 255) >> 8; } tab[64] = s; }
    __syncthreads();
}
struct GroupOrder {
    static constexpr int A_AUX = 0; static constexpr bool LAZY = false;
    LAS const int* tab; const char* Abase; const char* Bbase; const int* elist; unsigned* cnt;
    int G, c, K;
    __device__ __forceinline__ bool next(int i, pg8::Unit& u) const {
        const int L = i * G + c, ntile = tab[64];
        if (L >= ntile * 4) return false;
        const int mg = L >> 2; u.pn = L & 3;
        int e = 0;
#pragma unroll 1
        for (int q = 1; q < 32; ++q) e = (tab[32 + q] <= mg) ? q : e;
        u.e = e; u.mt = mg - tab[32 + e]; u.pm = mg;
        u.a = Abase;
        u.b = Bbase + ((size_t)e * 1024 + 256 * u.pn) * K * 2;
        return true;
    }
    __device__ __forceinline__ void rows(const pg8::Unit& u, int R0, int R1, unsigned& r0, unsigned& r1) const {
        const int cnt_e = tab[u.e]; const int p0 = 256 * u.mt + R0, p1 = 256 * u.mt + R1;
        const int* el = elist + (size_t)u.e * NTOK;
        const unsigned v0 = (unsigned)(el[p0 < cnt_e ? p0 : 0] >> 1), v1 = (unsigned)(el[p1 < cnt_e ? p1 : 0] >> 1);
        r0 = p0 < cnt_e ? v0 : 0u; r1 = p1 < cnt_e ? v1 : 0u;
    }
    __device__ __forceinline__ void a_ready(const pg8::Unit&) const {}
    __device__ __forceinline__ void done(const pg8::Unit& u) const {
        asm volatile("s_waitcnt vmcnt(0)" ::: "memory");
        if ((threadIdx.x & 63) == 0) __hip_atomic_fetch_add(cnt + 16 * u.pm, 1u, __ATOMIC_RELAXED, __HIP_MEMORY_SCOPE_AGENT);
    }
};
struct GroupOrderDown {
    static constexpr bool LAZY = false;
    static constexpr int A_AUX = 17;
    LAS const int* tab; const char* Abase; const char* Bbase; unsigned* cnt; unsigned* tmo;
    int G, c, K; LAS unsigned char* snap;
    __device__ __forceinline__ bool next(int i, pg8::Unit& u) const {
        const int ntile = tab[64], U = ntile * 4, r3 = U - 2 * G;
        int L;
        if (r3 > 0 && r3 < G && U <= 3 * G) { if (c < r3) { if (i > 0) return false; L = U - r3 + c; } else { L = (c - r3) + (G - r3) * i; if (L >= U - r3) return false; } }
        else { L = i * G + c; if (L >= U) return false; }
        const int mg = L >> 2; u.pn = L & 3;
        int e = 0;
#pragma unroll 1
        for (int q = 1; q < 32; ++q) e = (tab[32 + q] <= mg) ? q : e;
        u.e = e; u.mt = mg - tab[32 + e]; u.pm = mg;
        u.a = Abase + (size_t)mg * 256 * K * 2;
        u.b = Bbase + ((size_t)e * 1024 + 256 * u.pn) * K * 2;
        u.qi = i;
        if (threadIdx.x < 64) __builtin_amdgcn_global_load_lds((const unsigned*)(cnt + 16 * mg), (LAS unsigned*)(snap + (i & 3) * 256), 4, 0, 17);
        return true;
    }
    __device__ __forceinline__ void rows(const pg8::Unit&, int, int, unsigned&, unsigned&) const {}
    __device__ __forceinline__ void a_ready(const pg8::Unit& u) const {
        if (threadIdx.x < 64) {
            unsigned polls = 0;
            bool ready = false;
            if (u.qi > 0) ready = (unsigned)__builtin_amdgcn_readfirstlane((int)*(volatile LAS unsigned*)(snap + (u.qi & 3) * 256)) >= 32u;
            if (!ready) {
            while ((unsigned)__builtin_amdgcn_readfirstlane((int)__hip_atomic_load(cnt + 16 * u.pm, __ATOMIC_RELAXED, __HIP_MEMORY_SCOPE_AGENT)) < 32u) {
                __builtin_amdgcn_s_sleep(2);
                if ((++polls & 1023u) == 0u) { if (__builtin_amdgcn_readfirstlane((int)__hip_atomic_load(tmo, __ATOMIC_RELAXED, __HIP_MEMORY_SCOPE_AGENT)) != 0) break;
                    if (polls > (1u << 22)) { if (threadIdx.x == 0) atomicAdd(tmo, 1u); break; } }
            }
            asm volatile("s_waitcnt vmcnt(0)" ::: "memory");
            }
        }
        asm volatile("" ::: "memory"); __builtin_amdgcn_s_barrier(); asm volatile("" ::: "memory");
    }
    __device__ __forceinline__ void done(const pg8::Unit&) const {}
};
struct EpiSwiGLU {
    static constexpr bool PERM = true;
    bf16_t* ACT;
    __device__ __forceinline__ void operator()(const f32x4 (&acc)[2][2][4][2], const pg8::Unit& u, int wr, int wc, int fr, int fq) const {
        const int row0 = u.pm * 256 + wr * 64 + fr, col0 = u.pn * 128 + wc * 32 + 8 * fq;
        const __amdgpu_buffer_rsrc_t rsrc = __builtin_amdgcn_make_buffer_rsrc((void*)ACT, 0, 40960 * 512 * 2, 0x00020000);
#pragma unroll
        for (int ai = 0; ai < 2; ++ai)
#pragma unroll
            for (int m = 0; m < 4; ++m) {
                float o[8];
#pragma unroll
                for (int n = 0; n < 2; ++n)
#pragma unroll
                    for (int q = 0; q < 4; ++q) { const float gt = acc[ai][0][m][n][q], up = acc[ai][1][m][n][q]; o[4 * n + q] = gt * sigmoidf_(gt) * up; }
                __builtin_amdgcn_raw_buffer_store_b128(pack8(o), rsrc, ((row0 + ai * 128 + m * 16) * 512 + col0) * 2, 0, 16);
            }
    }
};
struct EpiDown {
    static constexpr bool PERM = true;
    LAS const int* tab; const int* elist; const float* elw; unsigned char* wsb;
    __device__ __forceinline__ void operator()(const f32x4 (&acc)[2][2][4][2], const pg8::Unit& u, int wr, int wc, int fr, int fq) const {
        const int cnt = tab[u.e]; const int col0 = u.pn * 256 + wc * 32 + 8 * fq;
        const __amdgpu_buffer_rsrc_t rsrc = __builtin_amdgcn_make_buffer_rsrc((void*)wsb, 0, (unsigned)WS_END, 0x00020000);
        int en[2][4]; float wv[2][4];
#pragma unroll
        for (int ai = 0; ai < 2; ++ai)
#pragma unroll
            for (int m = 0; m < 4; ++m) { const int pos = 256 * u.mt + ai * 128 + wr * 64 + m * 16 + fr; const int pc = pos < cnt ? pos : 0;
                en[ai][m] = elist[(size_t)u.e * NTOK + pc]; wv[ai][m] = elw[(size_t)u.e * NTOK + pc]; }
        __builtin_amdgcn_sched_barrier(0);
#pragma unroll
        for (int ai = 0; ai < 2; ++ai)
#pragma unroll
            for (int m = 0; m < 4; ++m) {
                const int pos = 256 * u.mt + ai * 128 + wr * 64 + m * 16 + fr;
                const int e1 = en[ai][m]; const float w = wv[ai][m];
                const unsigned off = (unsigned)((e1 & 1) ? WS_YK1 : WS_YK0) + (unsigned)(e1 >> 1) * 2048u + (unsigned)col0 * 2u;
#pragma unroll
                for (int bj = 0; bj < 2; ++bj) { const f32x4 v0 = acc[ai][bj][m][0], v1 = acc[ai][bj][m][1];
                    u32x4 o; o.x = pk2(v0[0] * w, v0[1] * w); o.y = pk2(v0[2] * w, v0[3] * w); o.z = pk2(v1[0] * w, v1[1] * w); o.w = pk2(v1[2] * w, v1[3] * w);
                    __builtin_amdgcn_raw_buffer_store_b128(o, rsrc, (int)(pos < cnt ? off + bj * 256u : 0xFFFFFFF0u), 0, 0); }
            }
    }
};

__device__ __forceinline__ void final_token2(const Params& P, const int tokA, const int tokB, const bool hasB, const int lane) {
    float* ra = P.out + (size_t)tokA * 1024; float* rb = P.out + (size_t)(hasB ? tokB : tokA) * 1024;
    const bf16_t* y0 = (const bf16_t*)(P.ws + WS_YK0); const bf16_t* y1 = (const bf16_t*)(P.ws + WS_YK1);
    const size_t oa = (size_t)tokA * 1024, ob = (size_t)(hasB ? tokB : tokA) * 1024;
    const bf16_t* xm = (const bf16_t*)(P.ws + WS_XMID);
    f32x4 va[4], vb[4], gf[4]; u32x2 a0[4], a1[4], b0[4], b1[4], xa[4], xb[4];
#pragma unroll
    for (int j = 0; j < 4; ++j) { gf[j] = *((const f32x4*)P.ln_f_w + lane + 64 * j); xa[j] = *((const u32x2*)(xm + oa) + lane + 64 * j); xb[j] = *((const u32x2*)(xm + ob) + lane + 64 * j);
        a0[j] = *((const u32x2*)(y0 + oa) + lane + 64 * j); a1[j] = *((const u32x2*)(y1 + oa) + lane + 64 * j);
        b0[j] = *((const u32x2*)(y0 + ob) + lane + 64 * j); b1[j] = *((const u32x2*)(y1 + ob) + lane + 64 * j); }
    float ss[2] = {0.f, 0.f};
#pragma unroll
    for (int j = 0; j < 4; ++j) {
        va[j] = (f32x4){bf2f(xa[j].x & 0xffffu), bf2f(xa[j].x >> 16), bf2f(xa[j].y & 0xffffu), bf2f(xa[j].y >> 16)};
        vb[j] = (f32x4){bf2f(xb[j].x & 0xffffu), bf2f(xb[j].x >> 16), bf2f(xb[j].y & 0xffffu), bf2f(xb[j].y >> 16)};
        va[j].x += bf2f(a0[j].x & 0xffffu) + bf2f(a1[j].x & 0xffffu); va[j].y += bf2f(a0[j].x >> 16) + bf2f(a1[j].x >> 16);
        va[j].z += bf2f(a0[j].y & 0xffffu) + bf2f(a1[j].y & 0xffffu); va[j].w += bf2f(a0[j].y >> 16) + bf2f(a1[j].y >> 16);
        vb[j].x += bf2f(b0[j].x & 0xffffu) + bf2f(b1[j].x & 0xffffu); vb[j].y += bf2f(b0[j].x >> 16) + bf2f(b1[j].x >> 16);
        vb[j].z += bf2f(b0[j].y & 0xffffu) + bf2f(b1[j].y & 0xffffu); vb[j].w += bf2f(b0[j].y >> 16) + bf2f(b1[j].y >> 16);
        ss[0] += (va[j].x * va[j].x + va[j].y * va[j].y) + (va[j].z * va[j].z + va[j].w * va[j].w);
        ss[1] += (vb[j].x * vb[j].x + vb[j].y * vb[j].y) + (vb[j].z * vb[j].z + vb[j].w * vb[j].w); }
    wave_sum_n<2>(ss);
    const float ia = rsqrtf(ss[0] * (1.f / 1024.f) + 1e-6f), ib = rsqrtf(ss[1] * (1.f / 1024.f) + 1e-6f);
#pragma unroll
    for (int j = 0; j < 4; ++j) { const f32x4 g = gf[j];
        f32x4 o; o.x = va[j].x * ia * g.x; o.y = va[j].y * ia * g.y; o.z = va[j].z * ia * g.z; o.w = va[j].w * ia * g.w;
        *((f32x4*)ra + lane + 64 * j) = o;
        if (hasB) { f32x4 q; q.x = vb[j].x * ib * g.x; q.y = vb[j].y * ib * g.y; q.z = vb[j].z * ib * g.z; q.w = vb[j].w * ib * g.w; *((f32x4*)rb + lane + 64 * j) = q; } }
}

__global__ void __launch_bounds__(512, 2) mk_fwd(Params P) {
    extern __shared__ __attribute__((aligned(16))) unsigned char lds_raw[];
    Ctx F;
    F.lds = (ldsp_t)lds_raw;
    F.tid = threadIdx.x; F.lane = F.tid & 63; F.wid = __builtin_amdgcn_readfirstlane(F.tid >> 6);
    F.G = gridDim.x; { const int bx = blockIdx.x; F.vcu = (F.G % 8 == 0) ? (bx % 8) * (F.G / 8) + bx / 8 : bx; }
    volatile LAS unsigned* MISC = (volatile LAS unsigned*)(F.lds + LDS_MISC);
    if (F.tid < 16) MISC[F.tid] = 0u;
    __syncthreads();
    unsigned* ctl = (unsigned*)(P.ws + WS_CTL);
    const int lo = P.ph_lo, hi = P.ph_hi;
    XcdBarrier bar; bar.bar = ctl + CW_BAR; bar.x = 0; bar.st = MISC;
    if (hi - lo > 1) bar = xcd_barrier_post(ctl + CW_BAR, MISC);
#ifndef PHASE_MASK
#define PHASE_MASK 0xFFFFF
#endif
#define IN(k) (((PHASE_MASK >> (k)) & 1) && lo <= (k) && (k) < hi)
#ifndef REP_MASK
#define REP_MASK 0
#endif
#define NREP(k) (1 + ((REP_MASK >> (k)) & 1))
#define SEAM(k) do { if (IN(k) && IN((k) + 1)) xcd_barrier(bar); } while (0)
    unsigned char* ws = P.ws;
    const int gw = F.vcu * 8 + F.wid, NGW = F.G * 8;

    if (IN(0)) { PROBE_BEGIN(30) for (int rep = 0; rep < NREP(0); ++rep) { p0_prologue(P, F); __syncthreads(); } PROBE_END(30) }
    SEAM(0);
    if (IN(1)) {
        pg8::StaticOrderPub S; S.init(ws + WS_H, ws + WS_BT_RW, NTOK, 2048, 1024, F.G, (int)blockIdx.x); S.cnt = ctl + CW_RW;
        pg8::EpiBf16WT E{(bf16_t*)P.out, LDA_RW, (unsigned)(NTOK * 2048 * 2)};
        { PROBE_BEGIN(20) pg8::gemm_phase<pg8::EpiBf16WT, pg8::StaticOrderPub, false>(F.lds, 1024, S, E); PROBE_END(20) }
            {

        pg8::StaticOrder S; S.init(ws + WS_H, ws + WS_BT_GL, NTOK, 1792, 1024, F.G, (int)blockIdx.x);
        pg8::EpiBf16 E{(bf16_t*)(ws + WS_PB), LDB_GL, GL_COLS};
        { PROBE_BEGIN(20) pg8::gemm_phase<pg8::EpiBf16, pg8::StaticOrder, false>(F.lds, 1024, S, E); PROBE_END(20) }
            }
    }
#if MK_PER_PHASE
    SEAM(1);
#else
    if (IN(1) && IN(2) && F.G != 256) xcd_barrier(bar);
    else if (IN(1) && IN(2)) {
        if (F.tid < 64) {
            const int cc = F.vcu >> 1, k0 = cc >> 2, k1 = (cc + 128) >> 2;
            const int sel = F.lane % 6, kb = sel < 3 ? k0 : k1; int km = kb + (sel % 3) - 1; km = km < 0 ? 0 : (km > 63 ? 63 : km);
            unsigned* pc = ctl + CW_RW + 16 * km; unsigned* tmo = ctl + CW_BAR + XB_TMO; unsigned polls = 0;
            for (;;) {
                const unsigned v = __hip_atomic_load(pc, __ATOMIC_RELAXED, __HIP_MEMORY_SCOPE_AGENT);
                if (__builtin_amdgcn_ballot_w64(v < 64u) == 0ull) break;
                __builtin_amdgcn_s_sleep(2);
                if ((++polls & 1023u) == 0u) { if (__builtin_amdgcn_readfirstlane((int)__hip_atomic_load(tmo, __ATOMIC_RELAXED, __HIP_MEMORY_SCOPE_AGENT)) != 0) break;
                    if (polls > (1u << 22)) { if (F.tid == 0) atomicAdd(tmo, 1u); break; } }
            }
            __builtin_amdgcn_fence(__ATOMIC_ACQUIRE, "agent");
            asm volatile("s_waitcnt vmcnt(0)" ::: "memory");
        }
        __syncthreads();
    }
#endif
    if (IN(2)) { PROBE_BEGIN(33)
        const int q0 = (F.vcu >> 1) * 8, qs = (F.G >> 1) * 8;
        unsigned sink = 0u;
        if (F.vcu & 1) {
            RwRaw R;
#pragma unroll 1
            for (int q = q0; q < 2048; q += qs) {
#pragma unroll 1
                for (int h = 0; h < 8; ++h) { int it = (q + h) * 2 + 1; asm volatile("" : "+s"(it));
                    const int qn = (h < 7) ? q + h + 1 : q + qs; rwkv_item<1>(P, F, it, R, h == 0, qn * 2 + 1, qn < 2048, sink); } }
        } else {
            RwRaw R;
#pragma unroll 1
            for (int q = q0; q < 2048; q += qs) {
#pragma unroll 1
                for (int h = 0; h < 8; ++h) { int it = (q + h) * 2; asm volatile("" : "+s"(it));
                    const int qn = (h < 7) ? q + h + 1 : q + qs; rwkv_item<0>(P, F, it, R, h == 0, qn * 2, qn < 2048, sink); } }
        }
        asm volatile("s_waitcnt vmcnt(0)" : "+v"(sink) :: "memory");
        PROBE_END(33) }
    SEAM(2);
    if (IN(3)) { }
    if (IN(4)) { PROBE_BEGIN(31)
        if (F.vcu & 1) { for (int it = F.vcu; it < 2048; it += 2 * F.G) gla_pair<1>(P, F, it, it + F.G, it + F.G < 2048); }
        else           { for (int it = F.vcu; it < 2048; it += 2 * F.G) gla_pair<0>(P, F, it, it + F.G, it + F.G < 2048); }
        asm volatile("s_waitcnt vmcnt(0)" ::: "memory");
        PROBE_END(31) }
    SEAM(4);
    if (IN(5)) { PROBE_BEGIN(6)
        if (F.tid < 512) *(volatile LAS unsigned*)(F.lds + CH_FLAGS + F.tid * 4) = 0u;
        __syncthreads();
        if (F.vcu < 128) { if (F.wid == 0) rwkv_producer(P, F.lds, F.vcu, F.lane); else chain_consumer<false>(P, F.lds, F.vcu, F.wid - 1, F.lane); }
        else if (F.vcu < 256) { if (F.wid == 0) gla_producer(P, F.lds, F.vcu - 128, F.lane); else chain_consumer<true>(P, F.lds, F.vcu - 128, F.wid - 1, F.lane); }
        PROBE_END(6) }
    SEAM(5);
#if PROBE_ID == 40
    for (int q = 0; q < 8; ++q) xcd_barrier(bar);
#endif
    if (IN(6)) { PROBE_BEGIN(32) for (int rep = 0; rep < NREP(6); ++rep) { for (int t4 = gw; t4 < NTOK / 4; t4 += NGW) mix_tok4_rw(P, t4, F.lane); for (int t4 = gw; t4 < NTOK / 4; t4 += NGW) mix_tok4_gl(P, t4, F.lane); } PROBE_END(32) }
    SEAM(6);
    if (IN(7)) { PROBE_BEGIN(50)
        const bool conv_first = ((F.vcu >> 2) & 1) != 0;
        if (conv_first) { PROBE_BEGIN(34) p5b_convert(P, F, F.vcu * 8 + F.wid, F.G * 8); PROBE_END(34) __syncthreads(); }
        {
            pg8::PanelOrder S{(const char*)(ws + WS_MIX), (const char*)(ws + WS_BT_OUT), ctl + CW_PN, 1024, 4, 256, F.G, F.vcu};
            pg8::EpiResBf16 E{(bf16_t*)(ws + WS_XMID), P.x, 1024};
            { PROBE_BEGIN(20) pg8::gemm_phase<pg8::EpiResBf16, pg8::PanelOrder, false>(F.lds, 1024, S, E); PROBE_END(20) }
        }
        PROBE_BEGIN(7)
        for (int grp = F.vcu; grp < NTOK / 64; grp += F.G) p6_router_group(P, F, grp);
        PROBE_END(7)
        if (!conv_first) { PROBE_BEGIN(34) p5b_convert(P, F, F.vcu * 8 + F.wid, F.G * 8); PROBE_END(34) }
    PROBE_END(50) }
    SEAM(7);
    if (IN(8)) { }
    if (IN(9)) { }
    if (IN(10)) {
        { PROBE_BEGIN(23) build_group_tables(P, F); PROBE_END(23) }
        unsigned* mtc = ctl + CW_MT;
        {
            GroupOrder S{(LAS const int*)(F.lds + LDS_TAB), (const char*)(ws + WS_H2), (const char*)(ws + WS_WGU), (const int*)(ws + WS_ELIST), mtc, F.G, F.vcu, 1024};
            EpiSwiGLU E{(bf16_t*)P.out};
            { PROBE_BEGIN(21) pg8::gemm_phase<EpiSwiGLU, GroupOrder, true>(F.lds, 1024, S, E); PROBE_END(21) }
        }
        {
            GroupOrderDown S{(LAS const int*)(F.lds + LDS_TAB), (const char*)P.out, (const char*)(ws + WS_WDN), mtc, ctl + CW_BAR + XB_TMO, F.G, F.vcu, 512, F.lds + LDS_TAB + 1024};
            EpiDown E{(LAS const int*)(F.lds + LDS_TAB), (const int*)(ws + WS_ELIST), (const float*)(ws + WS_ELW), ws};
            { PROBE_BEGIN(22) pg8::gemm_phase<EpiDown, GroupOrderDown, false>(F.lds, 512, S, E); PROBE_END(22) }
        }
    }
    SEAM(10);
    if (IN(11)) { }
    if (IN(12)) { PROBE_BEGIN(8) for (int tok = gw; tok < NTOK; tok += 2 * NGW) final_token2(P, tok, tok + NGW, tok + NGW < NTOK, F.lane); PROBE_END(8) }
#undef IN
#undef SEAM
}

extern "C" void kernel_launch(void* const* d_in, const int* in_sizes, int n_in, void* d_out, int out_size, void* d_ws, size_t ws_size, hipStream_t stream) {
    static int grid = 0;
    if (grid == 0) {
        if (n_in != 33 || out_size != NTOK * DM || ws_size < WS_END) { fprintf(stderr, "kernel_launch: unexpected problem (n_in %d, out %d, ws %zu, need %zu)\n", n_in, out_size, ws_size, (size_t)WS_END); grid = -1; return; }
        int dev = 0, cus = 0, per_cu = 0;
        if (hipGetDevice(&dev) != hipSuccess || hipDeviceGetAttribute(&cus, hipDeviceAttributeMultiprocessorCount, dev) != hipSuccess) { grid = -1; return; }
        if (hipFuncSetAttribute((const void*)mk_fwd, hipFuncAttributeMaxDynamicSharedMemorySize, LDS_BYTES) != hipSuccess) { fprintf(stderr, "kernel_launch: hipFuncSetAttribute failed\n"); grid = -1; return; }
        if (hipOccupancyMaxActiveBlocksPerMultiprocessor(&per_cu, (const void*)mk_fwd, 512, LDS_BYTES) != hipSuccess || per_cu < 1) fprintf(stderr, "kernel_launch: occupancy query says %d\n", per_cu);
        (void)hipGetLastError();
        grid = cus;
    }
    if (grid < 0) return;
    (void)hipMemsetAsync((char*)d_ws + WS_CTL, 0, CTL_ZERO_BYTES, stream);
    Params p{};
    const float* const* in = (const float* const*)d_in;
    p.x = in[0]; p.ln1_w = in[1]; p.w_in = in[2]; p.rw_mu = in[3];
    p.w0_f = in[4]; p.w2_f = in[5]; p.w0_b = in[6]; p.w2_b = in[7];
    p.a0_f = in[8]; p.a2_f = in[9]; p.a0_b = in[10]; p.a2_b = in[11];
    p.g2 = in[12]; p.k_k = in[13]; p.k_a = in[14]; p.r_k = in[15]; p.ln_w = in[16]; p.ln_b = in[17];
    p.gw2_f = in[18]; p.gb_f = in[19]; p.gw2_b = in[20]; p.gb_b = in[21]; p.gnorm_w = in[22];
    p.w_out = in[23]; p.ln2_w = in[24]; p.w_coarse = in[25]; p.b_coarse = in[26]; p.w_fine = in[27]; p.b_fine = in[28];
    p.w_gate = in[29]; p.w_up = in[30]; p.w_down = in[31]; p.ln_f_w = in[32];
    p.out = (float*)d_out; p.ws = (unsigned char*)d_ws;
#if MK_PER_PHASE
#ifndef REP_PHASE
#define REP_PHASE -1
#endif
    for (int k = 0; k < NPH; ++k) { p.ph_lo = k; p.ph_hi = k + 1; hipLaunchKernelGGL(mk_fwd, dim3(grid), dim3(512), LDS_BYTES, stream, p);
        if (k == REP_PHASE) hipLaunchKernelGGL(mk_fwd, dim3(grid), dim3(512), LDS_BYTES, stream, p); }
#else
    p.ph_lo = 0; p.ph_hi = NPH; hipLaunchKernelGGL(mk_fwd, dim3(grid), dim3(512), LDS_BYTES, stream, p);
#endif
}
```
